# Optimizing an MI355X kernel written in HIP

```python
import jax, jax.numpy as jnp
from jax import lax
import numpy as np

D_MODEL = 1024
BATCH = 8
SEQ = 2048
DEPTH = 2
DEC_BATCH = 128
DEC_SEQ = 1
PAST_LEN = 2048
PAGE_SIZE = 128

D_CONV = 256
D_POOL = 256
N_HEADS = 8
N_KV_HEADS = 2
HEAD_DIM = 64
D_ATTN = N_HEADS * HEAD_DIM
D_MIX = D_CONV + D_POOL + D_ATTN
CONV_WIDTH = 31
CONV_STATE = CONV_WIDTH - 1
POOL_WINDOWS = (2, 4, 8, 16)
N_POOL_GROUPS = len(POOL_WINDOWS)
POOL_GROUP = D_POOL // N_POOL_GROUPS
POOL_STATE = max(POOL_WINDOWS) - 1
CMP_BLOCK = 32
CMP_STRIDE = 16
SLC_BLOCK = 64
N_SEL = 8
WINDOW = 256
Q_BLOCK = 128
ROT_DIM = HEAD_DIM // 4
ROPE_THETA = 500000.0
N_BRANCH = 3
D_KV = N_BRANCH * 2 * N_KV_HEADS * HEAD_DIM
D_IN = 3 * D_CONV + 2 * D_POOL + 2 * D_ATTN + D_KV + N_BRANCH * N_HEADS
EPS = 1e-6
NEG = -1e30
BIG = 1e4

kernel_name = 'hymba_conv_pool_nsa_step'


def rmsnorm(x, g):
    xf = x.astype(jnp.float32)
    y = xf * lax.rsqrt(jnp.mean(xf * xf, axis=-1, keepdims=True) + EPS)
    return (y * g.astype(jnp.float32)).astype(x.dtype)


def layernorm(x, g, b):
    xf = x.astype(jnp.float32)
    mu = jnp.mean(xf, axis=-1, keepdims=True)
    xc = xf - mu
    var = jnp.mean(xc * xc, axis=-1, keepdims=True)
    return (xc * lax.rsqrt(var + EPS) * g.astype(jnp.float32) + b.astype(jnp.float32)).astype(x.dtype)


def rope(x, pos):
    half = ROT_DIM // 2
    inv = ROPE_THETA ** (-jnp.arange(half, dtype=jnp.float32) * 2.0 / ROT_DIM)
    ang = pos.astype(jnp.float32)[:, None] * inv[None, :]
    shp = (pos.shape[0],) + (1,) * (x.ndim - 3) + (half,)
    cos = jnp.cos(ang).reshape(shp)
    sin = jnp.sin(ang).reshape(shp)
    x1 = x[..., :half].astype(jnp.float32)
    x2 = x[..., half:ROT_DIM].astype(jnp.float32)
    out = jnp.concatenate([x1 * cos - x2 * sin, x2 * cos + x1 * sin, x[..., ROT_DIM:].astype(jnp.float32)], axis=-1)
    return out.astype(x.dtype)


def masked_probs(s, mask):
    s = jnp.where(mask, s, NEG)
    m = jnp.max(s, axis=-1, keepdims=True)
    p = jnp.where(mask, jnp.exp(s - m), 0.0)
    return p / jnp.maximum(jnp.sum(p, axis=-1, keepdims=True), 1e-30)


def conv_mixer(u, buf, w_dw, b_dw, ln_g, ln_b, w_pw, b_pw):
    xcat = jnp.concatenate([buf.astype(u.dtype), u], axis=1)
    y = lax.conv_general_dilated(xcat, w_dw[:, None, :].astype(u.dtype), (1,), 'VALID',
                                 dimension_numbers=('NWC', 'WIO', 'NWC'), feature_group_count=u.shape[-1])
    y = layernorm(y + b_dw, ln_g, ln_b)
    y = jax.nn.silu(y) @ w_pw + b_pw
    return y.astype(u.dtype), xcat[:, -CONV_STATE:]


def pool_mixer(u, buf, pos, w_pool, pool_scale):
    N, T, _ = u.shape
    L0 = buf.shape[1]
    xcat = jnp.concatenate([buf.astype(u.dtype), u], axis=1)
    xf = xcat.astype(jnp.float32)
    cs = jnp.pad(jnp.cumsum(xf, axis=1), ((0, 0), (1, 0), (0, 0)))
    end = L0 + 1 + jnp.arange(T)
    diffs = []
    for gi, w in enumerate(POOL_WINDOWS):
        c0, c1 = gi * POOL_GROUP, (gi + 1) * POOL_GROUP
        total = cs[:, end, c0:c1] - cs[:, end - w, c0:c1]
        cnt = jnp.minimum(w, pos + 1).astype(jnp.float32)[None, :, None]
        diffs.append(total / cnt - xf[:, L0:, c0:c1])
    d = jnp.stack(diffs, axis=2)
    y = jnp.einsum('ntgc,gce->ntge', d, w_pool.astype(jnp.float32)).reshape(N, T, D_POOL)
    y = y * pool_scale.astype(jnp.float32)
    return y.astype(u.dtype), xcat[:, -POOL_STATE:]


def compress(k, pe, w1, w2):
    N, L, G, D = k.shape
    r = CMP_BLOCK // CMP_STRIDE
    n_pc = L // CMP_STRIDE
    n_blk = n_pc - r + 1
    pieces = k.reshape(N, n_pc, CMP_STRIDE, G, D)
    blocks = jnp.concatenate([pieces[:, j:j + n_blk] for j in range(r)], axis=2)
    blocks = blocks + pe[None, None, :, None, :]
    flat = jnp.swapaxes(blocks, 2, 3).reshape(N, n_blk, G, CMP_BLOCK * D)
    return jax.nn.gelu(flat @ w1) @ w2


def cmp_slc_chunk(q, pos, kc, vc, cmp_end, ksb, vsb, overlap):
    N, T, H, D = q.shape
    G = N_KV_HEADS
    R = H // G
    scale = HEAD_DIM ** -0.5
    qg = q.reshape(N, T, G, R, D)
    s = jnp.einsum('ntgrd,ncgd->ngrtc', qg, kc).astype(jnp.float32) * scale
    p_c = masked_probs(s, cmp_end[None, :] <= pos[:, None])
    o_c = jnp.einsum('ngrtc,ncgd->ntgrd', p_c.astype(vc.dtype), vc)
    imp = jnp.einsum('ngrtc,cs->ngts', p_c, overlap)
    NS = overlap.shape[1]
    j = jnp.arange(NS)[None, :]
    cur = (pos // SLC_BLOCK)[:, None]
    forced = (j == 0) | (j == cur) | (j == cur - 1)
    score = jnp.where(j <= cur, jnp.where(forced, BIG, imp), -BIG)
    _, idx = lax.top_k(score, min(N_SEL, NS))
    K = idx.shape[-1]
    n_i = jnp.arange(N)[:, None, None, None]
    g_i = jnp.arange(G)[None, :, None, None]
    kg = ksb[n_i, g_i, idx]
    vg = vsb[n_i, g_i, idx]
    kpos = idx[..., None] * SLC_BLOCK + jnp.arange(SLC_BLOCK)
    mask = (kpos <= pos[None, None, :, None, None]).reshape(N, G, 1, T, K * SLC_BLOCK)
    s2 = jnp.einsum('ntgrd,ngtksd->ngrtks', qg, kg).astype(jnp.float32).reshape(N, G, R, T, K * SLC_BLOCK) * scale
    p_s = masked_probs(s2, mask)
    o_s = jnp.einsum('ngrtm,ngtmd->ntgrd', p_s.astype(vg.dtype), vg.reshape(N, G, T, K * SLC_BLOCK, D))
    return o_c.reshape(N, T, H, D), o_s.reshape(N, T, H, D)


def sparse_branches(q, qpos, cmp_rows, slc_rows, pe, w1, w2, n_chunks):
    N, L = cmp_rows.shape[:2]
    Lp = -(-L // SLC_BLOCK) * SLC_BLOCK
    pad = ((0, 0), (0, Lp - L), (0, 0), (0, 0), (0, 0))
    cmp_rows = jnp.pad(cmp_rows, pad)
    slc_rows = jnp.pad(slc_rows, pad)
    kcb = compress(cmp_rows[:, :, 0], pe[0], w1[0], w2[0])
    vcb = compress(cmp_rows[:, :, 1], pe[1], w1[1], w2[1])
    n_cmp = kcb.shape[1]
    n_slc = Lp // SLC_BLOCK
    cmp_start = jnp.arange(n_cmp) * CMP_STRIDE
    cmp_end = cmp_start + CMP_BLOCK - 1
    slc_start = jnp.arange(n_slc) * SLC_BLOCK
    overlap = ((cmp_end[:, None] >= slc_start[None, :]) &
               (cmp_start[:, None] < slc_start[None, :] + SLC_BLOCK)).astype(jnp.float32)
    def to_blocks(a):
        return jnp.transpose(a.reshape(N, n_slc, SLC_BLOCK, N_KV_HEADS, HEAD_DIM), (0, 3, 1, 2, 4))
    ksb = to_blocks(slc_rows[:, :, 0])
    vsb = to_blocks(slc_rows[:, :, 1])
    def chunk(qc, pc):
        return cmp_slc_chunk(qc, pc, kcb, vcb, cmp_end, ksb, vsb, overlap)
    if n_chunks == 1:
        return chunk(q, qpos)
    T = q.shape[1]
    Tc = T // n_chunks
    qs = jnp.moveaxis(q.reshape(N, n_chunks, Tc, N_HEADS, HEAD_DIM), 1, 0)
    ps = qpos.reshape(n_chunks, Tc)
    oc, osl = lax.map(lambda a: chunk(a[0], a[1]), (qs, ps))
    oc = jnp.moveaxis(oc, 0, 1).reshape(N, T, N_HEADS, HEAD_DIM)
    osl = jnp.moveaxis(osl, 0, 1).reshape(N, T, N_HEADS, HEAD_DIM)
    return oc, osl


def window_attn_banded(q, k, v):
    N, S, H, D = q.shape
    G = N_KV_HEADS
    R = H // G
    nb = S // Q_BLOCK
    n_prev = -(-(WINDOW - 1) // Q_BLOCK)
    KW = (n_prev + 1) * Q_BLOCK
    def band(a):
        ap = jnp.pad(a, ((0, 0), (n_prev * Q_BLOCK, 0), (0, 0), (0, 0))).reshape(N, nb + n_prev, Q_BLOCK, G, D)
        return jnp.concatenate([ap[:, j:j + nb] for j in range(n_prev + 1)], axis=2)
    kb, vb = band(k), band(v)
    qb = q.reshape(N, nb, Q_BLOCK, G, R, D)
    qpos = jnp.arange(nb)[:, None] * Q_BLOCK + jnp.arange(Q_BLOCK)[None, :]
    kpos = (jnp.arange(nb)[:, None] - n_prev) * Q_BLOCK + jnp.arange(KW)[None, :]
    kp, qp = kpos[:, None, :], qpos[:, :, None]
    mask = (kp <= qp) & (kp > qp - WINDOW) & (kp >= 0)
    s = jnp.einsum('nbqgrd,nbkgd->nbgrqk', qb, kb).astype(jnp.float32) * (HEAD_DIM ** -0.5)
    p = masked_probs(s, mask[None, :, None, None])
    o = jnp.einsum('nbgrqk,nbkgd->nbqgrd', p.astype(vb.dtype), vb)
    return o.reshape(N, S, H, D)


def window_attn_dense(q, qpos, k, v, kpos):
    N, T, H, D = q.shape
    G = N_KV_HEADS
    R = H // G
    qg = q.reshape(N, T, G, R, D)
    s = jnp.einsum('ntgrd,nsgd->ngrts', qg, k).astype(jnp.float32) * (HEAD_DIM ** -0.5)
    mask = (kpos[None, :] <= qpos[:, None]) & (kpos[None, :] > qpos[:, None] - WINDOW)
    p = masked_probs(s, mask)
    o = jnp.einsum('ngrts,nsgd->ntgrd', p.astype(v.dtype), v)
    return o.reshape(N, T, H, D)


def mixer_inputs(x, pos, w_norm, w_in, g_q, g_k):
    N, T, _ = x.shape
    h = rmsnorm(x, w_norm)
    sizes = (D_CONV, D_CONV, D_CONV, D_POOL, D_POOL, D_ATTN, D_KV, N_BRANCH * N_HEADS, D_ATTN)
    offs = [int(v) for v in np.cumsum(sizes)[:-1]]
    a_val, a_gate, z_a, b_in, z_b, q, kv, gate, z_c = jnp.split(h @ w_in, offs, axis=-1)
    q = rope(rmsnorm(q.reshape(N, T, N_HEADS, HEAD_DIM), g_q), pos)
    kv = kv.reshape(N, T, N_BRANCH, 2, N_KV_HEADS, HEAD_DIM)
    k = rope(rmsnorm(kv[:, :, :, 0], g_k[:, None, :]), pos)
    rows = jnp.stack([k, kv[:, :, :, 1]], axis=3)
    glu = a_val * jax.nn.sigmoid(a_gate)
    gates = jax.nn.sigmoid(gate).reshape(N, T, N_BRANCH, N_HEADS)
    return glu, z_a, b_in, z_b, q, rows, gates, z_c


def mixer_output(x, y_a, z_a, y_b, z_b, o_c, o_s, o_w, gates, z_c, w_out):
    N, T, _ = x.shape
    o = gates[..., 0, :, None] * o_c + gates[..., 1, :, None] * o_s + gates[..., 2, :, None] * o_w
    y = jnp.concatenate([y_a * jax.nn.silu(z_a), y_b * jax.nn.silu(z_b),
                         o.reshape(N, T, D_ATTN) * jax.nn.silu(z_c)], axis=-1)
    return x + (y @ w_out).astype(x.dtype)


def setup_inputs(seed: int = 0) -> dict:
    key = jax.random.key(seed)
    ks = jax.random.split(key, 32)
    f = jnp.float32
    def nrm(k, shape, s=1.0):
        return jax.random.normal(k, shape, f) * s
    n_pages = PAST_LEN // PAGE_SIZE
    n_used = DEC_BATCH * n_pages
    n_phys = n_used + max(1, n_used // 4)
    win_len = min(WINDOW, PAST_LEN)
    page_table = jax.random.permutation(ks[7], n_phys)[:n_used].reshape(DEC_BATCH, n_pages).astype(jnp.int32)
    return {
        'x_prompt': nrm(ks[0], (BATCH, SEQ, D_MODEL)),
        'x_sample': nrm(ks[1], (DEC_BATCH, DEC_SEQ, D_MODEL)),
        'state_conv': nrm(ks[2], (DEPTH, DEC_BATCH, CONV_STATE, D_CONV), 0.5),
        'state_pool': nrm(ks[3], (DEPTH, DEC_BATCH, POOL_STATE, D_POOL)),
        'cache_win_kv': nrm(ks[4], (DEPTH, DEC_BATCH, win_len, 2, N_KV_HEADS, HEAD_DIM)),
        'cache_cmp_kv': nrm(ks[5], (DEPTH, n_phys, PAGE_SIZE, 2, N_KV_HEADS, HEAD_DIM)),
        'cache_slc_kv': nrm(ks[6], (DEPTH, n_phys, PAGE_SIZE, 2, N_KV_HEADS, HEAD_DIM)),
        'page_table': page_table,
        'w_norm': 1.0 + nrm(ks[8], (DEPTH, D_MODEL), 0.02),
        'w_in': nrm(ks[9], (DEPTH, D_MODEL, D_IN), D_MODEL ** -0.5),
        'w_out': nrm(ks[10], (DEPTH, D_MIX, D_MODEL), D_MIX ** -0.5),
        'w_dw': nrm(ks[11], (DEPTH, CONV_WIDTH, D_CONV), CONV_WIDTH ** -0.5),
        'b_dw': nrm(ks[12], (DEPTH, D_CONV), 0.01),
        'ln_g': 1.0 + nrm(ks[13], (DEPTH, D_CONV), 0.02),
        'ln_b': nrm(ks[14], (DEPTH, D_CONV), 0.01),
        'w_pw': nrm(ks[15], (DEPTH, D_CONV, D_CONV), D_CONV ** -0.5),
        'b_pw': nrm(ks[16], (DEPTH, D_CONV), 0.01),
        'w_pool': nrm(ks[17], (DEPTH, N_POOL_GROUPS, POOL_GROUP, POOL_GROUP), POOL_GROUP ** -0.5),
        'pool_scale': 1.0 + nrm(ks[18], (DEPTH, D_POOL), 0.1),
        'g_q': 1.0 + nrm(ks[19], (DEPTH, HEAD_DIM), 0.02),
        'g_k': 1.0 + nrm(ks[20], (DEPTH, N_BRANCH, HEAD_DIM), 0.02),
        'cmp_pe': nrm(ks[21], (DEPTH, 2, CMP_BLOCK, HEAD_DIM), 0.1),
        'cmp_w1': nrm(ks[22], (DEPTH, 2, CMP_BLOCK * HEAD_DIM, HEAD_DIM), (CMP_BLOCK * HEAD_DIM) ** -0.5),
        'cmp_w2': nrm(ks[23], (DEPTH, 2, HEAD_DIM, HEAD_DIM), HEAD_DIM ** -0.5),
    }


def reference(x_prompt, x_sample, state_conv, state_pool, cache_win_kv, cache_cmp_kv, cache_slc_kv, page_table,
              w_norm, w_in, w_out, w_dw, b_dw, ln_g, ln_b, w_pw, b_pw, w_pool, pool_scale,
              g_q, g_k, cmp_pe, cmp_w1, cmp_w2):
    Bp, S, _ = x_prompt.shape
    Bs, T, _ = x_sample.shape
    P = page_table.shape[1] * PAGE_SIZE
    pos_p = jnp.arange(S)
    pos_s = P + jnp.arange(T)
    xp, xs = x_prompt, x_sample
    conv_p, pool_p, win_p, cmp_p, slc_p = [], [], [], [], []
    conv_s, pool_s, win_s, cmp_s, slc_s = [], [], [], [], []
    for l in range(DEPTH):
        glu, z_a, b_in, z_b, q, rows, gates, z_c = mixer_inputs(xp, pos_p, w_norm[l], w_in[l], g_q[l], g_k[l])
        y_a, cv = conv_mixer(glu, jnp.zeros((Bp, CONV_STATE, D_CONV), glu.dtype),
                             w_dw[l], b_dw[l], ln_g[l], ln_b[l], w_pw[l], b_pw[l])
        y_b, pl = pool_mixer(b_in, jnp.zeros((Bp, POOL_STATE, D_POOL), b_in.dtype), pos_p, w_pool[l], pool_scale[l])
        cmp_rows, slc_rows, win_rows = rows[:, :, 0], rows[:, :, 1], rows[:, :, 2]
        o_c, o_s = sparse_branches(q, pos_p, cmp_rows, slc_rows, cmp_pe[l], cmp_w1[l], cmp_w2[l], S // Q_BLOCK)
        o_w = window_attn_banded(q, win_rows[:, :, 0], win_rows[:, :, 1])
        xp = mixer_output(xp, y_a, z_a, y_b, z_b, o_c, o_s, o_w, gates, z_c, w_out[l])
        conv_p.append(cv)
        pool_p.append(pl)
        win_p.append(win_rows[:, S - min(WINDOW, S):])
        cmp_p.append(cmp_rows)
        slc_p.append(slc_rows)
        glu, z_a, b_in, z_b, q, rows, gates, z_c = mixer_inputs(xs, pos_s, w_norm[l], w_in[l], g_q[l], g_k[l])
        y_a, cv = conv_mixer(glu, state_conv[l], w_dw[l], b_dw[l], ln_g[l], ln_b[l], w_pw[l], b_pw[l])
        y_b, pl = pool_mixer(b_in, state_pool[l], pos_s, w_pool[l], pool_scale[l])
        cmp_rows, slc_rows, win_rows = rows[:, :, 0], rows[:, :, 1], rows[:, :, 2]
        past_c = cache_cmp_kv[l][page_table].reshape(Bs, P, 2, N_KV_HEADS, HEAD_DIM)
        past_s = cache_slc_kv[l][page_table].reshape(Bs, P, 2, N_KV_HEADS, HEAD_DIM)
        full_c = jnp.concatenate([past_c.astype(cmp_rows.dtype), cmp_rows], axis=1)
        full_s = jnp.concatenate([past_s.astype(slc_rows.dtype), slc_rows], axis=1)
        o_c, o_s = sparse_branches(q, pos_s, full_c, full_s, cmp_pe[l], cmp_w1[l], cmp_w2[l], 1)
        buf = cache_win_kv[l].astype(win_rows.dtype)
        Lb = buf.shape[1]
        full_w = jnp.concatenate([buf, win_rows], axis=1)
        kpos = P - Lb + jnp.arange(Lb + T)
        o_w = window_attn_dense(q, pos_s, full_w[:, :, 0], full_w[:, :, 1], kpos)
        xs = mixer_output(xs, y_a, z_a, y_b, z_b, o_c, o_s, o_w, gates, z_c, w_out[l])
        conv_s.append(cv)
        pool_s.append(pl)
        win_s.append(full_w[:, T:])
        cmp_s.append(cmp_rows)
        slc_s.append(slc_rows)
    return (xp, xs,
            jnp.stack(conv_p), jnp.stack(pool_p), jnp.stack(win_p), jnp.stack(cmp_p), jnp.stack(slc_p),
            jnp.stack(conv_s), jnp.stack(pool_s), jnp.stack(win_s), jnp.stack(cmp_s), jnp.stack(slc_s))
```

```cpp
#include <hip/hip_runtime.h>
#include <stdint.h>
#include <stdio.h>

constexpr int NPT = 16384, NSM = 128, NTOK = NPT + NSM, SEQ = 2048;
constexpr int D_IN = 3096;
constexpr int C_AVAL = 0, C_AGATE = 256, C_ZA = 512, C_BIN = 768, C_ZB = 1024, C_Q = 1280, C_KV = 1792, C_GATE = 2560, C_ZC = 2584;
constexpr int N_PHYS = 2560;
constexpr float NEGF = -1e30f;

constexpr size_t O_YP = 0;
constexpr size_t O_YS = O_YP + (size_t)NPT * 1024;
constexpr size_t O_CONVP = O_YS + (size_t)NSM * 1024;
constexpr size_t O_POOLP = O_CONVP + 2ull * 8 * 30 * 256;
constexpr size_t O_WINP = O_POOLP + 2ull * 8 * 15 * 256;
constexpr size_t O_CMPP = O_WINP + 2ull * 8 * 256 * 256;
constexpr size_t O_SLCP = O_CMPP + 2ull * 8 * 2048 * 256;
constexpr size_t O_CONVS = O_SLCP + 2ull * 8 * 2048 * 256;
constexpr size_t O_POOLS = O_CONVS + 2ull * 128 * 30 * 256;
constexpr size_t O_WINS = O_POOLS + 2ull * 128 * 15 * 256;
constexpr size_t O_CMPS = O_WINS + 2ull * 128 * 256 * 256;
constexpr size_t O_SLCS = O_CMPS + 2ull * 128 * 256;
constexpr size_t O_END = O_SLCS + 2ull * 128 * 256;


namespace gold {
__device__ __forceinline__ float wave_sum(float v) {
#pragma unroll
  for (int o = 32; o > 0; o >>= 1) v += __shfl_xor(v, o);
  return v;
}
__device__ __forceinline__ float wave_max(float v) {
#pragma unroll
  for (int o = 32; o > 0; o >>= 1) v = fmaxf(v, __shfl_xor(v, o));
  return v;
}
__device__ __forceinline__ float block_sum256(float v, float* sh) {
  v = wave_sum(v);
  __syncthreads();
  if ((threadIdx.x & 63) == 0) sh[threadIdx.x >> 6] = v;
  __syncthreads();
  return sh[0] + sh[1] + sh[2] + sh[3];
}
__device__ __forceinline__ float sigmoidf_(float x) { return 1.f / (1.f + expf(-x)); }
__device__ __forceinline__ float siluf_(float x) { return x / (1.f + expf(-x)); }
__device__ __forceinline__ float gelu_tanh(float x) { return 0.5f * x * (1.f + tanhf(0.7978845608028654f * (x + 0.044715f * x * x * x))); }

__global__ void k_rope_table(float* cs) {
  int i = blockIdx.x * blockDim.x + threadIdx.x;
  if (i >= 2049 * 8) return;
  int pos = i / 8, j = i % 8;
  double inv = pow(500000.0, -(double)j / 8.0);
  double a = (double)pos * inv;
  cs[i * 2] = (float)cos(a);
  cs[i * 2 + 1] = (float)sin(a);
}

__global__ void __launch_bounds__(256) k_rmsnorm(int tok0, const float* xp, const float* xs, const float* wn, float* h) {
  __shared__ float sh[4];
  int tok = tok0 + blockIdx.x;
  const float* x = tok < NPT ? xp + (size_t)tok * 1024 : xs + (size_t)(tok - NPT) * 1024;
  float4 v = ((const float4*)x)[threadIdx.x];
  float ss = block_sum256(v.x * v.x + v.y * v.y + v.z * v.z + v.w * v.w, sh);
  float rinv = rsqrtf(ss * (1.f / 1024.f) + 1e-6f);
  float4 g = ((const float4*)wn)[threadIdx.x];
  float4 o = make_float4(v.x * rinv * g.x, v.y * rinv * g.y, v.z * rinv * g.z, v.w * rinv * g.w);
  ((float4*)(h + (size_t)tok * 1024))[threadIdx.x] = o;
}

__global__ void __launch_bounds__(256) k_sgemm(const float* __restrict__ A, int lda, const float* __restrict__ B, int ldb, float* __restrict__ C, int ldc,
                                               int M, int N, int K, const float* __restrict__ bias, const float* __restrict__ R, int ldr) {
  __shared__ float As[16][68];
  __shared__ float Bs[16][68];
  const int tid = threadIdx.x, tx = tid & 15, ty = tid >> 4;
  const int m0 = blockIdx.y * 64, n0 = blockIdx.x * 64;
  float acc[4][4];
#pragma unroll
  for (int i = 0; i < 4; ++i)
#pragma unroll
    for (int j = 0; j < 4; ++j) acc[i][j] = 0.f;
  for (int k0 = 0; k0 < K; k0 += 16) {
#pragma unroll
    for (int i = 0; i < 4; ++i) {
      int idx = tid + i * 256;
      int m = idx >> 4, k = idx & 15;
      As[k][m] = (m0 + m < M) ? A[(size_t)(m0 + m) * lda + k0 + k] : 0.f;
      int kb = idx >> 6, n = idx & 63;
      Bs[kb][n] = (n0 + n < N) ? B[(size_t)(k0 + kb) * ldb + n0 + n] : 0.f;
    }
    __syncthreads();
#pragma unroll
    for (int k = 0; k < 16; ++k) {
      float a[4], b[4];
#pragma unroll
      for (int i = 0; i < 4; ++i) a[i] = As[k][ty * 4 + i];
#pragma unroll
      for (int j = 0; j < 4; ++j) b[j] = Bs[k][tx * 4 + j];
#pragma unroll
      for (int i = 0; i < 4; ++i)
#pragma unroll
        for (int j = 0; j < 4; ++j) acc[i][j] = fmaf(a[i], b[j], acc[i][j]);
    }
    __syncthreads();
  }
#pragma unroll
  for (int i = 0; i < 4; ++i) {
    int m = m0 + ty * 4 + i;
    if (m >= M) continue;
#pragma unroll
    for (int j = 0; j < 4; ++j) {
      int n = n0 + tx * 4 + j;
      if (n >= N) continue;
      float v = acc[i][j];
      if (bias) v += bias[n];
      if (R) v += R[(size_t)m * ldr + n];
      C[(size_t)m * ldc + n] = v;
    }
  }
}

__global__ void __launch_bounds__(256) k_post(const float* proj, const float* g_q, const float* g_k  , const float* cs,
                                              float* qbuf, float* rows, float* glu, float* gates, int tok0) {
  const int tok = tok0 + blockIdx.x, tid = threadIdx.x, wave = tid >> 6, lane = tid & 63;
  const int pos = tok < NPT ? (tok % SEQ) : 2048;
  const float* pr = proj + (size_t)tok * D_IN;
  for (int u = wave; u < 14; u += 4) {
    int col; float gain; float* dst;
    if (u < 8) { col = C_Q + u * 64; gain = g_q[lane]; dst = qbuf + (size_t)tok * 512 + u * 64; }
    else { int ku = u - 8, br = ku >> 1, g = ku & 1; col = C_KV + br * 256 + g * 64; gain = g_k[br * 64 + lane]; dst = rows + (size_t)tok * 768 + br * 256 + g * 64; }
    float v = pr[col + lane];
    float ss = wave_sum(v * v);
    float y = v * rsqrtf(ss * (1.f / 64.f) + 1e-6f) * gain;
    float partner = __shfl_xor(y, 8);
    float out = y;
    if (lane < 16) {
      int j = lane & 7;
      float c = cs[(pos * 8 + j) * 2], s = cs[(pos * 8 + j) * 2 + 1];
      out = (lane < 8) ? (y * c - partner * s) : (y * c + partner * s);
    }
    dst[lane] = out;
  }
  for (int i = tid; i < 384; i += 256) {
    int br = i / 128, rem = i % 128;
    rows[(size_t)tok * 768 + br * 256 + 128 + rem] = pr[C_KV + br * 256 + 128 + rem];
  }
  glu[(size_t)tok * 256 + tid] = pr[C_AVAL + tid] * sigmoidf_(pr[C_AGATE + tid]);
  if (tid < 24) gates[(size_t)tok * 24 + tid] = sigmoidf_(pr[C_GATE + tid]);
}

__global__ void k_states(int l, const float* proj, const float* rows, const float* glu, const float* state_conv, const float* state_pool,
                         const float* cache_win, float* out, int do_prompt, int do_sample) {
  const size_t gtid = (size_t)blockIdx.x * blockDim.x + threadIdx.x, gstride = (size_t)gridDim.x * blockDim.x;
  if (do_prompt) {
  for (size_t i = gtid; i < (size_t)NPT * 256; i += gstride) {
    size_t tok = i / 256; int c = (int)(i % 256);
    out[O_CMPP + (size_t)l * NPT * 256 + i] = rows[tok * 768 + c];
    out[O_SLCP + (size_t)l * NPT * 256 + i] = rows[tok * 768 + 256 + c];
  }
  for (size_t i = gtid; i < (size_t)8 * 256 * 256; i += gstride) {
    int b = (int)(i / 65536); int r = (int)((i / 256) % 256); int c = (int)(i % 256);
    out[O_WINP + (size_t)l * 8 * 65536 + i] = rows[((size_t)b * SEQ + 1792 + r) * 768 + 512 + c];
  }
  for (size_t i = gtid; i < (size_t)8 * 30 * 256; i += gstride) {
    int b = (int)(i / (30 * 256)); int r = (int)((i / 256) % 30); int c = (int)(i % 256);
    out[O_CONVP + (size_t)l * 8 * 30 * 256 + i] = glu[((size_t)b * SEQ + 2018 + r) * 256 + c];
  }
  for (size_t i = gtid; i < (size_t)8 * 15 * 256; i += gstride) {
    int b = (int)(i / (15 * 256)); int r = (int)((i / 256) % 15); int c = (int)(i % 256);
    out[O_POOLP + (size_t)l * 8 * 15 * 256 + i] = proj[((size_t)b * SEQ + 2033 + r) * D_IN + C_BIN + c];
  }
  }
  if (!do_sample) return;
  for (size_t i = gtid; i < (size_t)NSM * 256; i += gstride) {
    size_t b = i / 256; int c = (int)(i % 256);
    out[O_CMPS + (size_t)l * NSM * 256 + i] = rows[(NPT + b) * 768 + c];
    out[O_SLCS + (size_t)l * NSM * 256 + i] = rows[(NPT + b) * 768 + 256 + c];
  }
  for (size_t i = gtid; i < (size_t)NSM * 65536; i += gstride) {
    size_t b = i / 65536; int r = (int)((i / 256) % 256); int c = (int)(i % 256);
    float v = (r < 255) ? cache_win[((size_t)l * NSM + b) * 65536 + (size_t)(r + 1) * 256 + c] : rows[(NPT + b) * 768 + 512 + c];
    out[O_WINS + (size_t)l * NSM * 65536 + i] = v;
  }
  for (size_t i = gtid; i < (size_t)NSM * 30 * 256; i += gstride) {
    size_t b = i / (30 * 256); int r = (int)((i / 256) % 30); int c = (int)(i % 256);
    float v = (r < 29) ? state_conv[((size_t)l * NSM + b) * 30 * 256 + (size_t)(r + 1) * 256 + c] : glu[(NPT + b) * 256 + c];
    out[O_CONVS + (size_t)l * NSM * 30 * 256 + i] = v;
  }
  for (size_t i = gtid; i < (size_t)NSM * 15 * 256; i += gstride) {
    size_t b = i / (15 * 256); int r = (int)((i / 256) % 15); int c = (int)(i % 256);
    float v = (r < 14) ? state_pool[((size_t)l * NSM + b) * 15 * 256 + (size_t)(r + 1) * 256 + c] : proj[(NPT + b) * D_IN + C_BIN + c];
    out[O_POOLS + (size_t)l * NSM * 15 * 256 + i] = v;
  }
}

__global__ void __launch_bounds__(256) k_conv(int l, const float* glu, const float* state_conv, const float* w_dw  , const float* b_dw,
                                              const float* ln_g, const float* ln_b, float* abuf, int tok0) {
  __shared__ float sh[4];
  const int tok = tok0 + blockIdx.x, c = threadIdx.x;
  float acc = 0.f;
  if (tok < NPT) {
    int b = tok / SEQ, t = tok % SEQ;
    for (int k = 0; k < 31; ++k) {
      int tt = t + k - 30;
      if (tt >= 0) acc = fmaf(w_dw[k * 256 + c], glu[((size_t)b * SEQ + tt) * 256 + c], acc);
    }
  } else {
    int b = tok - NPT;
    for (int k = 0; k < 30; ++k) acc = fmaf(w_dw[k * 256 + c], state_conv[((size_t)l * NSM + b) * 30 * 256 + k * 256 + c], acc);
    acc = fmaf(w_dw[30 * 256 + c], glu[(size_t)tok * 256 + c], acc);
  }
  float y = acc + b_dw[c];
  float mean = block_sum256(y, sh) * (1.f / 256.f);
  float xc = y - mean;
  float var = block_sum256(xc * xc, sh) * (1.f / 256.f);
  float z = xc * rsqrtf(var + 1e-6f) * ln_g[c] + ln_b[c];
  abuf[(size_t)tok * 256 + c] = siluf_(z);
}

__global__ void __launch_bounds__(256) k_pool(int l, const float* proj, const float* state_pool, const float* w_pool  , const float* pool_scale, float* yb, int tok0) {
  __shared__ float sd[256];
  const int tok = tok0 + blockIdx.x, tid = threadIdx.x, g = tid >> 6, e = tid & 63;
  const int w = 2 << g;
  float cur = proj[(size_t)tok * D_IN + C_BIN + tid];
  float total = 0.f, cnt;
  if (tok < NPT) {
    int b = tok / SEQ, t = tok % SEQ;
    for (int j = 0; j < w; ++j) if (t - j >= 0) total += proj[((size_t)b * SEQ + t - j) * D_IN + C_BIN + tid];
    cnt = (float)min(w, t + 1);
  } else {
    int b = tok - NPT;
    total = cur;
    for (int j = 1; j < w; ++j) total += state_pool[((size_t)l * NSM + b) * 15 * 256 + (size_t)(15 - j) * 256 + tid];
    cnt = (float)w;
  }
  sd[tid] = total / cnt - cur;
  __syncthreads();
  float y = 0.f;
  for (int c = 0; c < 64; ++c) y = fmaf(sd[g * 64 + c], w_pool[(g * 64 + c) * 64 + e], y);
  yb[(size_t)tok * 256 + tid] = y * pool_scale[tid];
}

template <bool SAMPLE>
__global__ void __launch_bounds__(64) k_compress(int l, const float* rows, const float* cache_cmp, const int* page_table,
                                                 const float* pe  , const float* w1  , const float* w2  ,
                                                 float* kc  , float* vc) {
  __shared__ float sh[64];
  const int e = threadIdx.x, blk = blockIdx.x, n = blockIdx.y >> 1, g = blockIdx.y & 1, kv = blockIdx.z;
  float acc = 0.f;
  for (int p = 0; p < 32; ++p) {
    int pos = blk * 16 + p;
    const float* row;
    if (SAMPLE) {
      int page = page_table[n * 16 + (pos >> 7)];
      row = cache_cmp + (((size_t)l * N_PHYS + page) * 128 + (pos & 127)) * 256 + kv * 128 + g * 64;
    } else {
      row = rows + ((size_t)n * SEQ + pos) * 768 + kv * 128 + g * 64;
    }
    const float* pep = pe + (kv * 32 + p) * 64;
    const float* wp = w1 + ((size_t)kv * 2048 + p * 64) * 64 + e;
    for (int d = 0; d < 64; ++d) acc = fmaf(row[d] + pep[d], wp[d * 64], acc);
  }
  sh[e] = gelu_tanh(acc);
  __syncthreads();
  float o = 0.f;
  for (int j = 0; j < 64; ++j) o = fmaf(sh[j], w2[(kv * 64 + j) * 64 + e], o);
  float* dst = kv ? vc : kc;
  dst[(((size_t)n * 128 + blk) * 2 + g) * 64 + e] = o;
}

template <bool SAMPLE>
__global__ void __launch_bounds__(256) k_attn(int l, const float* qbuf, const float* rows, const float* gates, const float* proj,
                                              const float* kc, const float* vc, const float* cache_slc, const float* cache_win, const int* page_table,
                                              float* mix) {
  __shared__ float qs[4][64];
  __shared__ float pc[4][128];
  __shared__ float ps[4][512];
  __shared__ float imp[33];
  __shared__ int sel[8];
  const int tid = threadIdx.x, r = tid >> 6, lane = tid & 63;
  int tok, n, pos; const int g = blockIdx.y;
  if (SAMPLE) { n = blockIdx.x; tok = NPT + n; pos = 2048; } else { tok = blockIdx.x; n = tok / SEQ; pos = tok % SEQ; }
  const int h = g * 4 + r;
  qs[r][lane] = qbuf[(size_t)tok * 512 + h * 64 + lane];
  __syncthreads();
  float o_c = 0.f;
  {
    float s[2]; bool valid[2];
#pragma unroll
    for (int j = 0; j < 2; ++j) {
      int c = lane + 64 * j;
      valid[j] = (c < 127) && (16 * c + 31 <= pos);
      float d = 0.f;
      if (valid[j]) { const float* kr = kc + (((size_t)n * 128 + c) * 2 + g) * 64; for (int i = 0; i < 64; ++i) d = fmaf(qs[r][i], kr[i], d); }
      s[j] = valid[j] ? d * 0.125f : NEGF;
    }
    float m = wave_max(fmaxf(s[0], s[1]));
    float p0 = valid[0] ? expf(s[0] - m) : 0.f, p1 = valid[1] ? expf(s[1] - m) : 0.f;
    float sum = fmaxf(wave_sum(p0 + p1), 1e-30f);
    pc[r][lane] = p0 / sum; pc[r][lane + 64] = p1 / sum;
    __syncthreads();
    for (int c = 0; c < 127; ++c) { float p = pc[r][c]; if (p != 0.f) o_c = fmaf(p, vc[(((size_t)n * 128 + c) * 2 + g) * 64 + lane], o_c); }
  }
  const int NS = SAMPLE ? 33 : 32, cur = pos >> 6;
  if (tid < NS) {
    int s = tid, lo = max(0, 4 * s - 1), hi = min(126, 4 * s + 3);
    float v = 0.f;
    for (int rr = 0; rr < 4; ++rr) for (int c = lo; c <= hi; ++c) v += pc[rr][c];
    bool forced = (s == 0) || (s == cur) || (s == cur - 1);
    imp[s] = (s <= cur) ? (forced ? 1e4f : v) : -1e4f;
  }
  __syncthreads();
  if (tid == 0) {
    unsigned long long taken = 0ull;
    for (int k = 0; k < 8; ++k) {
      int best = -1; float bv = -3e38f;
      for (int s = 0; s < NS; ++s) if (!((taken >> s) & 1ull) && imp[s] > bv) { bv = imp[s]; best = s; }
      taken |= 1ull << best; sel[k] = best;
    }
  }
  __syncthreads();
  float o_s = 0.f;
  {
    float s8[8]; bool v8[8]; float m = NEGF;
#pragma unroll
    for (int k = 0; k < 8; ++k) {
      int kpos = sel[k] * 64 + lane;
      v8[k] = kpos <= pos;
      float d = 0.f;
      if (v8[k]) {
        const float* kr;
        if (SAMPLE) {
          if (kpos < 2048) { int page = page_table[n * 16 + (kpos >> 7)]; kr = cache_slc + (((size_t)l * N_PHYS + page) * 128 + (kpos & 127)) * 256 + g * 64; }
          else kr = rows + (size_t)tok * 768 + 256 + g * 64;
        } else kr = rows + ((size_t)n * SEQ + kpos) * 768 + 256 + g * 64;
        for (int i = 0; i < 64; ++i) d = fmaf(qs[r][i], kr[i], d);
      }
      s8[k] = v8[k] ? d * 0.125f : NEGF;
      m = fmaxf(m, s8[k]);
    }
    m = wave_max(m);
    float sum = 0.f;
#pragma unroll
    for (int k = 0; k < 8; ++k) { s8[k] = v8[k] ? expf(s8[k] - m) : 0.f; sum += s8[k]; }
    sum = fmaxf(wave_sum(sum), 1e-30f);
#pragma unroll
    for (int k = 0; k < 8; ++k) ps[r][k * 64 + lane] = s8[k] / sum;
    __syncthreads();
    for (int k = 0; k < 8; ++k) {
      for (int j = 0; j < 64; ++j) {
        float p = ps[r][k * 64 + j];
        if (p != 0.f) {
          int kpos = sel[k] * 64 + j;
          const float* vr;
          if (SAMPLE) {
            if (kpos < 2048) { int page = page_table[n * 16 + (kpos >> 7)]; vr = cache_slc + (((size_t)l * N_PHYS + page) * 128 + (kpos & 127)) * 256 + 128 + g * 64; }
            else vr = rows + (size_t)tok * 768 + 256 + 128 + g * 64;
          } else vr = rows + ((size_t)n * SEQ + kpos) * 768 + 256 + 128 + g * 64;
          o_s = fmaf(p, vr[lane], o_s);
        }
      }
    }
    __syncthreads();
  }
  float o_w = 0.f;
  {
    float s4[4]; bool v4[4]; float m = NEGF;
#pragma unroll
    for (int k = 0; k < 4; ++k) {
      int kpos = pos - 255 + lane + 64 * k;
      v4[k] = kpos >= 0;
      float d = 0.f;
      if (v4[k]) {
        const float* kr;
        if (SAMPLE) {
          if (kpos < 2048) kr = cache_win + (((size_t)l * NSM + n) * 256 + (kpos - 1792)) * 256 + g * 64;
          else kr = rows + (size_t)tok * 768 + 512 + g * 64;
        } else kr = rows + ((size_t)n * SEQ + kpos) * 768 + 512 + g * 64;
        for (int i = 0; i < 64; ++i) d = fmaf(qs[r][i], kr[i], d);
      }
      s4[k] = v4[k] ? d * 0.125f : NEGF;
      m = fmaxf(m, s4[k]);
    }
    m = wave_max(m);
    float sum = 0.f;
#pragma unroll
    for (int k = 0; k < 4; ++k) { s4[k] = v4[k] ? expf(s4[k] - m) : 0.f; sum += s4[k]; }
    sum = fmaxf(wave_sum(sum), 1e-30f);
#pragma unroll
    for (int k = 0; k < 4; ++k) ps[r][k * 64 + lane] = s4[k] / sum;
    __syncthreads();
    for (int j = 0; j < 256; ++j) {
      float p = ps[r][j];
      if (p != 0.f) {
        int kpos = pos - 255 + j;
        const float* vr;
        if (SAMPLE) {
          if (kpos < 2048) vr = cache_win + (((size_t)l * NSM + n) * 256 + (kpos - 1792)) * 256 + 128 + g * 64;
          else vr = rows + (size_t)tok * 768 + 512 + 128 + g * 64;
        } else vr = rows + ((size_t)n * SEQ + kpos) * 768 + 512 + 128 + g * 64;
        o_w = fmaf(p, vr[lane], o_w);
      }
    }
  }
  const float* gt = gates + (size_t)tok * 24;
  float o = gt[h] * o_c + gt[8 + h] * o_s + gt[16 + h] * o_w;
  mix[(size_t)tok * 1024 + 512 + h * 64 + lane] = o * siluf_(proj[(size_t)tok * D_IN + C_ZC + h * 64 + lane]);
}

__global__ void k_mix_ab(const float* proj, const float* ya, const float* yb, float* mix, int tok0, int ntok) {
  size_t i = (size_t)blockIdx.x * blockDim.x + threadIdx.x;
  if (i >= (size_t)ntok * 256) return;
  i += (size_t)tok0 * 256;
  size_t tok = i / 256; int c = (int)(i % 256);
  mix[tok * 1024 + c] = ya[i] * siluf_(proj[tok * D_IN + C_ZA + c]);
  mix[tok * 1024 + 256 + c] = yb[i] * siluf_(proj[tok * D_IN + C_ZB + c]);
}
}
namespace pg8 {
#define PG8_LAS __attribute__((address_space(3)))
typedef unsigned short bf16_t;
typedef short bf16x8 __attribute__((ext_vector_type(8)));
typedef float f32x4 __attribute__((ext_vector_type(4)));
typedef unsigned u32x4 __attribute__((ext_vector_type(4)));
constexpr int BM = 256, BK = 64, HALF = 128, HTB = HALF * BK * 2  , STAGE_BYTES = 8 * HTB, NXCD = 8, WGM = 8;

__host__ __device__ __forceinline__ int lds_byte(int r, int c) { const int st = (r >> 4) * 2 + (c >> 5), rr = r & 15, cc = c & 31, ob = rr * 64 + cc * 2; return st * 1024 + (ob ^ (((ob >> 9) & 1) << 5)); }
__host__ __device__ __forceinline__ void stage_rc(int b, int& R, int& C) { const int st = b / 1024, sb = b % 1024, swz = sb ^ (((sb >> 9) & 1) << 5); R = (st >> 1) * 16 + swz / 64; C = (st & 1) * 32 + (swz % 64) / 2; }
__host__ __device__ __forceinline__ int perm32(int rho) { const int n = rho >> 4, i = rho & 15; return 8 * (i >> 2) + 4 * n + (i & 3); }

struct Unit { int pm, pn; };
struct Gemm { const bf16_t* A; const bf16_t* Bt; int M, N, K; };

struct StaticOrder {
    int nM, nN, nwg, G, c;
    __host__ __device__ void init(int M, int N, int G_, int c_) { nM = M / BM; nN = N / BM; nwg = nM * nN; G = G_; c = c_; }
    __host__ __device__ bool next(int i, Unit& u) const {
        const long L = (long)i * G + c; if (L >= nwg) return false;
        int wgid = (int)L; { const int q = nwg / NXCD, r = nwg % NXCD, xcd = wgid % NXCD, off = wgid / NXCD; wgid = (xcd < r ? xcd * (q + 1) : r * (q + 1) + (xcd - r) * q) + off; }
        const int nig = WGM * nN, gid = wgid / nig, fm = gid * WGM, gsz = (nM - fm) < WGM ? (nM - fm) : WGM;
        u.pm = fm + ((wgid % nig) % gsz); u.pn = (wgid % nig) / gsz; return true;
    }
    __device__ __forceinline__ void a_ready(const Unit&) const {}
    __device__ __forceinline__ void done(const Unit&) const {}
};
__device__ __forceinline__ unsigned cvt_pk_bf16(float lo, float hi) { unsigned r; asm volatile("v_cvt_pk_bf16_f32 %0, %1, %2" : "=v"(r) : "v"(lo), "v"(hi)); return r; }

template <class Epi, class Sched, bool STAMP = false>
__device__ __forceinline__ void gemm_phase(PG8_LAS unsigned char* lds, const Gemm g, const Sched& S, const Epi& E, unsigned long long* stamps) {
    const int tid = threadIdx.x, wid = __builtin_amdgcn_readfirstlane(tid >> 6), lane = tid & 63, wr = wid >> 2, wc = wid & 3, fr = lane & 15, fq = lane >> 4;
    const int K = g.K, nt = K / BK;
    int ts_lo = 0, ts_hi = 0, nts = 0; const unsigned long long rt_entry = STAMP ? (unsigned long long)wall_clock64() : 0ull;
#define PG8_STAMP() do { if (STAMP && wid == 0 && nts < 64) { const unsigned long long _c = (unsigned long long)clock64(); \
        ts_lo = (lane == nts) ? (int)(unsigned)_c : ts_lo; ts_hi = (lane == nts) ? (int)(unsigned)(_c >> 32) : ts_hi; ++nts; } } while (0)
    PG8_STAMP();
    unsigned voffA[2], voffB[2];
#pragma unroll
    for (int i = 0; i < 2; ++i) { int R, C; stage_rc(tid * 16 + i * 8192, R, C); const int Rb = Epi::PERM ? ((R & ~31) + perm32(R & 31)) : R;
        voffA[i] = (unsigned)(R * K + C) * 2u; voffB[i] = (unsigned)(Rb * K + C) * 2u; }
    const size_t kstep = (size_t)(BK * 2);
    const size_t hstep = (size_t)HALF * K * 2;
    const size_t tstep = 2 * hstep;
    const unsigned ldsw = (unsigned)wid * 1024u;
    const int aoff = lds_byte(wr * 64 + fr, fq * 8), boff = lds_byte(wc * 32 + fr, fq * 8);
#define PG8_SA(b, h) (((b) * 2 + (h)) * HTB)
#define PG8_SB(b, h) ((4 + (b) * 2 + (h)) * HTB)
#define PG8_STAGE(bufoff, gbase, voff) do { _Pragma("unroll") for (int _i = 0; _i < 2; ++_i) \
        __builtin_amdgcn_global_load_lds((const unsigned*)((const char*)(gbase) + (voff)[_i]), (PG8_LAS unsigned*)(lds + (bufoff) + ldsw + _i * 8192), 16, 0, 0); } while (0)
#define PG8_LDA(dst, b, h) do { _Pragma("unroll") for (int m = 0; m < 4; ++m) _Pragma("unroll") for (int k = 0; k < 2; ++k) dst[m][k] = *(const PG8_LAS bf16x8*)(lds + PG8_SA(b, h) + aoff + m * 2048 + k * 1024); } while (0)
#define PG8_LDB(dst, b, h) do { _Pragma("unroll") for (int n = 0; n < 2; ++n) _Pragma("unroll") for (int k = 0; k < 2; ++k) dst[n][k] = *(const PG8_LAS bf16x8*)(lds + PG8_SB(b, h) + boff + n * 2048 + k * 1024); } while (0)
#define PG8_MMA(ai, bj, At, Bt) do { __builtin_amdgcn_s_setprio(1); _Pragma("unroll") for (int m = 0; m < 4; ++m) _Pragma("unroll") for (int n = 0; n < 2; ++n) _Pragma("unroll") for (int k = 0; k < 2; ++k) \
        acc[ai][bj][m][n] = __builtin_amdgcn_mfma_f32_16x16x32_bf16(Bt[n][k], At[m][k], acc[ai][bj][m][n], 0, 0, 0); __builtin_amdgcn_s_setprio(0); } while (0)
#define PG8_WAIT_V(n) asm volatile("s_waitcnt vmcnt(" #n ")" ::: "memory")
#define PG8_WAIT_L(n) asm volatile("s_waitcnt lgkmcnt(" #n ")" ::: "memory")
#define PG8_BAR __builtin_amdgcn_s_barrier()
#define PG8_SCHED __builtin_amdgcn_sched_barrier(0)
    Unit cur, nxt; int ui = 0;
    if (!S.next(0, cur)) return;
    f32x4 acc[2][2][4][2];
#pragma unroll
    for (int a = 0; a < 2; ++a)
#pragma unroll
        for (int b = 0; b < 2; ++b)
#pragma unroll
            for (int m = 0; m < 4; ++m)
#pragma unroll
                for (int n = 0; n < 2; ++n) acc[a][b][m][n] = (f32x4){0.f, 0.f, 0.f, 0.f};
    bf16x8 At[4][2], B0[2][2], B1[2][2];
    const char* cA = (const char*)g.A + (size_t)cur.pm * tstep; const char* cB = (const char*)g.Bt + (size_t)cur.pn * tstep;
    S.a_ready(cur);
    PG8_STAGE(PG8_SB(0, 0), cB, voffB); PG8_STAGE(PG8_SA(0, 0), cA, voffA); PG8_STAGE(PG8_SB(0, 1), cB + hstep, voffB); PG8_STAGE(PG8_SA(0, 1), cA + hstep, voffA);
    if (wr == 1) PG8_BAR;
    PG8_WAIT_V(4); PG8_BAR;
    PG8_STAGE(PG8_SB(1, 0), cB + kstep, voffB); PG8_STAGE(PG8_SA(1, 0), cA + kstep, voffA); PG8_STAGE(PG8_SB(1, 1), cB + hstep + kstep, voffB);
    PG8_WAIT_V(6); PG8_BAR;
    PG8_STAMP();
    for (;;) {
        const bool has_next = S.next(ui + 1, nxt);
        const char* nA = has_next ? (const char*)g.A + (size_t)nxt.pm * tstep : cA; const char* nB = has_next ? (const char*)g.Bt + (size_t)nxt.pn * tstep : cB;
        for (int t = 0; t < nt; t += 2) {
            const bool last = (t == nt - 2);
            const char* a1 = cA + (size_t)(t + 1) * kstep;
            const char* a2 = last ? nA : cA + (size_t)(t + 2) * kstep; const char* b2 = last ? nB : cB + (size_t)(t + 2) * kstep;
            const char* a3 = a2 + kstep; const char* b3 = b2 + kstep;
            if (last && has_next) S.a_ready(nxt);
            PG8_LDB(B0, 0, 0); PG8_SCHED; PG8_LDA(At, 0, 0); PG8_STAGE(PG8_SA(1, 1), a1 + hstep, voffA);
            PG8_WAIT_L(8); PG8_BAR; PG8_WAIT_L(0); PG8_MMA(0, 0, At, B0); PG8_BAR; PG8_SCHED;
            PG8_LDB(B1, 0, 1); PG8_STAGE(PG8_SB(0, 0), b2, voffB);
            PG8_BAR; PG8_WAIT_L(0); PG8_MMA(0, 1, At, B1); PG8_BAR;
            PG8_LDA(At, 0, 1); PG8_STAGE(PG8_SA(0, 0), a2, voffA);
            PG8_BAR; PG8_WAIT_L(0); PG8_MMA(1, 0, At, B0); PG8_BAR; PG8_SCHED;
            PG8_STAGE(PG8_SB(0, 1), b2 + hstep, voffB);
            PG8_WAIT_V(6); PG8_BAR; PG8_MMA(1, 1, At, B1); PG8_BAR;
            PG8_LDB(B0, 1, 0); PG8_SCHED; PG8_LDA(At, 1, 0); PG8_STAGE(PG8_SA(0, 1), a2 + hstep, voffA);
            PG8_WAIT_L(8); PG8_BAR; PG8_WAIT_L(0); PG8_MMA(0, 0, At, B0); PG8_BAR; PG8_SCHED;
            PG8_LDB(B1, 1, 1); PG8_STAGE(PG8_SB(1, 0), b3, voffB);
            PG8_BAR; PG8_WAIT_L(0); PG8_MMA(0, 1, At, B1); PG8_BAR;
            PG8_LDA(At, 1, 1); PG8_STAGE(PG8_SA(1, 0), a3, voffA);
            PG8_BAR; PG8_WAIT_L(0); PG8_MMA(1, 0, At, B0); PG8_BAR; PG8_SCHED;
            PG8_STAGE(PG8_SB(1, 1), b3 + hstep, voffB);
            PG8_WAIT_V(6); PG8_BAR; PG8_MMA(1, 1, At, B1); PG8_BAR;
        }
        PG8_STAMP();
        if constexpr (!Epi::AFTER_DRAIN) { E(acc, cur, wr, wc, fr, fq); S.done(cur); }
        PG8_STAMP();
        if (!has_next) break;
#pragma unroll
        for (int a = 0; a < 2; ++a)
#pragma unroll
            for (int b = 0; b < 2; ++b)
#pragma unroll
                for (int m = 0; m < 4; ++m)
#pragma unroll
                    for (int n = 0; n < 2; ++n) acc[a][b][m][n] = (f32x4){0.f, 0.f, 0.f, 0.f};
        cur = nxt; cA = nA; cB = nB; ++ui;
    }
    PG8_WAIT_V(0);
    if (wr == 0) PG8_BAR;
    PG8_BAR;
    if constexpr (Epi::AFTER_DRAIN) { E.fused(acc, cur, wr, wc, fr, fq, lds, wid, lane); S.done(cur); }
    PG8_STAMP();
    if (STAMP && wid == 0) { stamps[lane] = lane < nts ? (((unsigned long long)(unsigned)ts_hi << 32) | (unsigned)ts_lo) : 0ull;
        if (lane == 62) stamps[62] = rt_entry; if (lane == 63) stamps[63] = (unsigned long long)wall_clock64(); }
#undef PG8_STAMP
#undef PG8_SA
#undef PG8_SB
#undef PG8_STAGE
#undef PG8_LDA
#undef PG8_LDB
#undef PG8_MMA
#undef PG8_WAIT_V
#undef PG8_WAIT_L
#undef PG8_BAR
#undef PG8_SCHED
}
}
namespace fast {
using pg8::bf16_t; using pg8::bf16x8; using pg8::f32x4; using pg8::Unit; using pg8::cvt_pk_bf16;
typedef unsigned u32x2 __attribute__((ext_vector_type(2)));
typedef float f32x2 __attribute__((ext_vector_type(2)));
typedef unsigned u32x4 __attribute__((ext_vector_type(4)));
#define LAS __attribute__((address_space(3)))
constexpr int LDS_BYTES = 144 * 1024;
__device__ __forceinline__ float bf2f(bf16_t b) { return __uint_as_float(((unsigned)b) << 16); }
__device__ __forceinline__ float bflo(unsigned u) { return __uint_as_float(u << 16); }
__device__ __forceinline__ float bfhi(unsigned u) { return __uint_as_float(u & 0xffff0000u); }
__device__ __forceinline__ bf16_t f2bf(float f) { return (bf16_t)(cvt_pk_bf16(f, 0.f) & 0xffffu); }

__global__ void k_bridge_mix(const float* mix, bf16_t* mixb, size_t n) {
  size_t i = ((size_t)blockIdx.x * blockDim.x + threadIdx.x) * 2;
  if (i < n) *(unsigned*)(mixb + i) = cvt_pk_bf16(mix[i], mix[i + 1]);
}

template <bool LAST> struct EpiD {
  static constexpr bool PERM = true, AFTER_DRAIN = false;
  const float* resid; float* xout; bf16_t* xb; float* ssq;
  __device__ __forceinline__ void operator()(const f32x4 (&acc)[2][2][4][2], const Unit& u, int wr, int wc, int fr, int fq) const {
    const int row0 = u.pm * 256 + wr * 64 + fr, col0 = u.pn * 256 + wc * 32 + 8 * fq;
#pragma unroll
    for (int ai = 0; ai < 2; ++ai)
#pragma unroll
      for (int m = 0; m < 4; ++m) {
        const size_t row = (size_t)(row0 + ai * 128 + m * 16);
        float ss = 0.f;
#pragma unroll
        for (int bj = 0; bj < 2; ++bj) {
          const size_t o = row * 1024 + col0 + bj * 128;
          const f32x4 r0 = *(const f32x4*)(resid + o), r1 = *(const f32x4*)(resid + o + 4);
          const f32x4 v0 = acc[ai][bj][m][0] + r0, v1 = acc[ai][bj][m][1] + r1;
          *(f32x4*)(xout + o) = v0; *(f32x4*)(xout + o + 4) = v1;
          if (!LAST) {
            u32x4 pk; pk.x = cvt_pk_bf16(v0[0], v0[1]); pk.y = cvt_pk_bf16(v0[2], v0[3]); pk.z = cvt_pk_bf16(v1[0], v1[1]); pk.w = cvt_pk_bf16(v1[2], v1[3]);
            *(u32x4*)(xb + o) = pk;
            ss += v0[0] * v0[0] + v0[1] * v0[1] + v0[2] * v0[2] + v0[3] * v0[3] + v1[0] * v1[0] + v1[1] * v1[1] + v1[2] * v1[2] + v1[3] * v1[3];
          }
        }
        if (!LAST) {
          ss += __shfl_xor(ss, 16); ss += __shfl_xor(ss, 32);
          if (fq == 0) ssq[row * 16 + u.pn * 4 + wc] = ss;
        }
      }
  }
};
struct PhaseDArgs { const bf16_t* mixb; const bf16_t* WoutT; const float* resid; float* xout; bf16_t* xb; float* ssq; };
template <bool LAST> __device__ __forceinline__ void phaseD(LAS unsigned char* lds, const PhaseDArgs& a) {
  pg8::Gemm g{a.mixb, a.WoutT, NPT, 1024, 1024};
  pg8::StaticOrder S; S.init(NPT, 1024, gridDim.x, blockIdx.x);
  EpiD<LAST> E{a.resid, a.xout, a.xb, a.ssq};
  pg8::gemm_phase<EpiD<LAST>, pg8::StaticOrder, false>(lds, g, S, E, nullptr);
}
template <bool LAST> __global__ void __launch_bounds__(512, 2) k_phaseD(PhaseDArgs a) {
  extern __shared__ __attribute__((aligned(16))) unsigned char shm[];
  phaseD<LAST>((LAS unsigned char*)shm, a);
}

__device__ __forceinline__ int win_logical_col(int np) {
  if (np >= 3072) return np < 3096 ? C_GATE + (np - 3072) : -1;
  const int tile = np >> 8, j = np & 255, bj = j >> 7, wc = (j >> 5) & 3, i = j & 31, jj = j & 127;
  switch (tile) {
    case 0: case 1: return (bj ? C_AGATE : C_AVAL) + tile * 128 + jj;
    case 2: return C_ZA + j;
    case 3: return C_BIN + j;
    case 4: return C_ZB + j;
    case 5: case 6: return C_Q + ((tile - 5) * 4 + wc) * 64 + bj * 32 + i;
    case 7: case 8: case 9: return C_KV + (tile - 7) * 256 + wc * 64 + bj * 32 + i;
    default: return C_ZC + (tile - 10) * 256 + j;
  }
}
template <int MODE  >
__global__ void __launch_bounds__(256) k_transpose_w(const float* src, int ld_src, const float* scale, bf16_t* dst, int N, int K) {
  __shared__ float t[64][65];
  const int n0 = blockIdx.x * 64, k0 = blockIdx.y * 64, tid = threadIdx.x;
  for (int i = tid; i < 4096; i += 256) {
    const int k = i >> 6, n = i & 63;
    int col = MODE == 1 ? win_logical_col(n0 + n) : (n0 + n);
    float v = 0.f;
    if (n0 + n < N && col >= 0) { v = src[(size_t)(k0 + k) * ld_src + col]; if (scale) v *= scale[k0 + k]; }
    t[k][n] = v;
  }
  __syncthreads();
  for (int i = tid; i < 2048; i += 256) {
    const int n = i >> 5, k = (i & 31) * 2;
    if (n0 + n < N) *(unsigned*)(dst + (size_t)(n0 + n) * K + k0 + k) = cvt_pk_bf16(t[k][n], t[k + 1][n]);
  }
}

__global__ void k_bridge_q(const float* qbuf, bf16_t* qb, size_t n) {
  size_t i = ((size_t)blockIdx.x * blockDim.x + threadIdx.x) * 2;
  const float sc = 0.125f * 1.4426950408889634f;
  if (i < n) *(unsigned*)(qb + i) = cvt_pk_bf16(qbuf[i] * sc, qbuf[i + 1] * sc);
}
__global__ void k_bridge_kv(const float* rows, int br, bf16_t* kk, bf16_t* vT) {
  size_t i = (size_t)blockIdx.x * blockDim.x + threadIdx.x;
  if (i >= (size_t)NPT * 128) return;
  const int d = (int)(i & 63), g = (int)((i >> 6) & 1); const size_t tok = i >> 7; const int b = (int)(tok / SEQ), t = (int)(tok % SEQ);
  kk[(((size_t)b * 2 + g) * SEQ + t) * 64 + d] = f2bf(rows[tok * 768 + br * 256 + g * 64 + d]);
  vT[(((size_t)b * 2 + g) * 64 + d) * SEQ + t] = f2bf(rows[tok * 768 + br * 256 + 128 + g * 64 + d]);
}
__global__ void k_bridge_kc(const float* kc, const float* vc, bf16_t* kcP, bf16_t* vcPT, int nseq) {
  size_t i = (size_t)blockIdx.x * blockDim.x + threadIdx.x;
  if (i >= (size_t)nseq * 128 * 128) return;
  const int d = (int)(i & 63), g = (int)((i >> 6) & 1), c = (int)((i >> 7) & 127), b = (int)(i >> 14);
  const float kv = c < 127 ? kc[i] : 0.f, vv = c < 127 ? vc[i] : 0.f;
  kcP[(((size_t)b * 2 + g) * 128 + c) * 64 + d] = f2bf(kv);
  vcPT[(((size_t)b * 2 + g) * 64 + d) * 128 + c] = f2bf(vv);
}
__global__ void k_bridge_silu(const float* proj, int col0, int ncol, bf16_t* dst, size_t ntok) {
  size_t i = (size_t)blockIdx.x * blockDim.x + threadIdx.x;
  if (i >= ntok * ncol) return;
  const size_t tok = i / ncol; const int c = (int)(i % ncol);
  const float z = proj[tok * D_IN + col0 + c];
  dst[i] = f2bf(z / (1.f + __expf(-z)));
}

#ifndef SKIPCOND
#define SKIPCOND __any(mine)
#endif
typedef float f32x16 __attribute__((ext_vector_type(16)));
typedef short bf16x4 __attribute__((ext_vector_type(4)));
struct PhaseCArgs { const bf16_t *qb, *ks, *vsT, *kw, *vwT, *kcP, *vcPT, *szc; const float* gates; bf16_t* mixb; };

__device__ __forceinline__ f32x16 qk_tile(const bf16_t* krows, const bf16x8 (&qf)[4], int c32, int hh) {
  f32x16 s;
#pragma unroll
  for (int i = 0; i < 16; ++i) s[i] = 0.f;
  const bf16_t* kp = krows + (size_t)c32 * 64 + 8 * hh;
  bf16x8 kf[4];
#pragma unroll
  for (int ks = 0; ks < 4; ++ks) kf[ks] = *(const bf16x8*)(kp + 16 * ks);
#pragma unroll
  for (int ks = 0; ks < 4; ++ks) s = __builtin_amdgcn_mfma_f32_32x32x16_bf16(kf[ks], qf[ks], s, 0, 0, 0);
  return s;
}
__device__ __forceinline__ void pv_tile(f32x16 (&o)[2], const bf16_t* vT, int ldv, const f32x16& p, int c32, int hh) {
#pragma unroll
  for (int s = 0; s < 2; ++s) {
    union { bf16x8 v; unsigned u[4]; } pf;
#pragma unroll
    for (int j = 0; j < 4; ++j) pf.u[j] = cvt_pk_bf16(p[8 * s + 2 * j], p[8 * s + 2 * j + 1]);
#pragma unroll
    for (int dt = 0; dt < 2; ++dt) {
      const bf16_t* vp = vT + (size_t)(32 * dt + c32) * ldv + 16 * s + 4 * hh;
      union { bf16x8 v; bf16x4 h[2]; } vf;
      vf.h[0] = *(const bf16x4*)(vp);
      vf.h[1] = *(const bf16x4*)(vp + 8);
      o[dt] = __builtin_amdgcn_mfma_f32_32x32x16_bf16(vf.v, pf.v, o[dt], 0, 0, 0);
    }
  }
}

__device__ __forceinline__ void attn_item(const PhaseCArgs& a, LAS unsigned char* lds, int b, int qbi, int g) {
  const int tid = threadIdx.x, w = tid >> 6, lane = tid & 63, c32 = lane & 31, hh = lane >> 5;
  const int t0 = qbi * 64, tl = c32 >> 2, r = c32 & 3;
  const int t = t0 + 8 * w + tl, head = 4 * g + r;
  const size_t tok = (size_t)b * SEQ + t;
  const size_t bg = (size_t)b * 2 + g;
  LAS float* impl = (LAS float*)lds + w * 256;
  bf16x8 qf[4];
  {
    const bf16_t* qp = a.qb + (tok * 8 + head) * 64 + 8 * hh;
#pragma unroll
    for (int ks = 0; ks < 4; ++ks) qf[ks] = *(const bf16x8*)(qp + 16 * ks);
  }
  const float* gt = a.gates + tok * 24;
  const float gate_c = gt[head], gate_s = gt[8 + head], gate_w = gt[16 + head];
  f32x16 ot[2];
  unsigned selmask;
  {
    const bf16_t* kc = a.kcP + bg * 128 * 64;
    const bf16_t* vc = a.vcPT + bg * 64 * 128;
    const int clim = ((t - 31) >> 4) - 4 * hh;
    float m = NEGF, sum = 0.f;
#pragma unroll 1
    for (int kt = 0; kt < 4; ++kt) {
      f32x16 sc = qk_tile(kc + kt * 32 * 64, qf, c32, hh);
      const int cl = clim - 32 * kt;
      float mt = NEGF;
#pragma unroll
      for (int i = 0; i < 16; ++i) { const bool valid = ((i & 3) + 8 * (i >> 2)) <= cl; sc[i] = valid ? sc[i] : NEGF; mt = fmaxf(mt, sc[i]); }
      mt = fmaxf(mt, __shfl_xor(mt, 32));
      const float mn = fmaxf(m, mt);
      float ps = 0.f;
#pragma unroll
      for (int i = 0; i < 16; ++i) ps += (sc[i] > -1e29f) ? __builtin_amdgcn_exp2f(sc[i] - mn) : 0.f;
      sum = sum * __builtin_amdgcn_exp2f(m - mn) + ps; m = mn;
    }
    sum += __shfl_xor(sum, 32);
    const float inv = sum > 0.f ? 1.f / sum : 0.f;
    f32x16 oc[2];
#pragma unroll
    for (int i = 0; i < 16; ++i) { oc[0][i] = 0.f; oc[1][i] = 0.f; }
    float prev = 0.f;
#pragma unroll 1
    for (int kt = 0; kt < 4; ++kt) {
      f32x16 sc = qk_tile(kc + kt * 32 * 64, qf, c32, hh);
      const int cl = clim - 32 * kt;
#pragma unroll
      for (int i = 0; i < 16; ++i) { const bool valid = ((i & 3) + 8 * (i >> 2)) <= cl; sc[i] = valid ? __builtin_amdgcn_exp2f(sc[i] - m) * inv : 0.f; }
#pragma unroll
      for (int ii = 0; ii < 4; ++ii) {
        const float q4 = (sc[4 * ii] + sc[4 * ii + 1]) + (sc[4 * ii + 2] + sc[4 * ii + 3]);
        const float pp = __shfl_xor(sc[4 * ii + 3], 32);
        float v = q4 + (hh ? pp : prev);
        prev = pp;
        v += __shfl_xor(v, 1); v += __shfl_xor(v, 2);
        if (r == 0) impl[tl * 32 + 2 * (4 * kt + ii) + hh] = v;
      }
      pv_tile(oc, vc + kt * 32, 128, sc, c32, hh);
    }
#pragma unroll
    for (int i = 0; i < 16; ++i) { ot[0][i] = gate_c * oc[0][i]; ot[1][i] = gate_c * oc[1][i]; }
  }
  __syncthreads();
#ifndef NO_SEL
  {
    const int tl2 = lane >> 3, sg = lane & 7, cur = qbi;
    float scv[32];
#pragma unroll
    for (int s = 0; s < 32; ++s) {
      const float v = impl[tl2 * 32 + s];
      const bool forced = (s == 0) || (s == cur) || (s == cur - 1);
      scv[s] = (s <= cur) ? (forced ? 1e4f : v) : -1e4f;
    }
    unsigned mk = 0u;
#pragma unroll
    for (int e = 0; e < 4; ++e) {
      const int s = sg * 4 + e;
      float mine = 0.f;
#pragma unroll
      for (int s2 = 0; s2 < 32; ++s2) mine = (s2 == s) ? scv[s2] : mine;
      int rank = 0;
#pragma unroll
      for (int s2 = 0; s2 < 32; ++s2) rank += (scv[s2] > mine || (scv[s2] == mine && s2 < s)) ? 1 : 0;
      if (rank < 8 && s <= cur) mk |= 1u << s;
    }
    mk |= __shfl_xor(mk, 1); mk |= __shfl_xor(mk, 2); mk |= __shfl_xor(mk, 4);
    selmask = __shfl(mk, tl * 8);
  }
#else
  selmask = 0xffffffffu;
#endif
  __syncthreads();
#ifndef NO_SLC
  {
    float m = NEGF, l = 0.f;
    f32x16 o[2];
#pragma unroll
    for (int i = 0; i < 16; ++i) { o[0][i] = 0.f; o[1][i] = 0.f; }
    const bf16_t* kbase = a.ks + bg * SEQ * 64;
    const bf16_t* vbase = a.vsT + bg * 64 * SEQ;
#pragma unroll 1
    for (int kt = 0; kt < 2 * qbi + 2; ++kt) {
      const bool mine = (selmask >> (kt >> 1)) & 1u;
      if (SKIPCOND) {
        const int key0 = 32 * kt;
        f32x16 s = qk_tile(kbase + (size_t)key0 * 64, qf, c32, hh);
        float mt = NEGF;
        const int klim = mine ? (t - key0 - 4 * hh) : -1;
#pragma unroll
        for (int i = 0; i < 16; ++i) {
          const bool valid = ((i & 3) + 8 * (i >> 2)) <= klim;
          s[i] = valid ? s[i] : NEGF;
          mt = fmaxf(mt, s[i]);
        }
        mt = fmaxf(mt, __shfl_xor(mt, 32));
        const float mn = fmaxf(m, mt);
        const float alpha = __builtin_amdgcn_exp2f(m - mn);
        float ps = 0.f;
#pragma unroll
        for (int i = 0; i < 16; ++i) { const float p = (s[i] > -1e29f) ? __builtin_amdgcn_exp2f(s[i] - mn) : 0.f; s[i] = p; ps += p; }
        l = l * alpha + ps; m = mn;
#pragma unroll
        for (int i = 0; i < 16; ++i) { o[0][i] *= alpha; o[1][i] *= alpha; }
        pv_tile(o, vbase + key0, SEQ, s, c32, hh);
      }
    }
    l += __shfl_xor(l, 32);
    const float sc = gate_s / l;
#pragma unroll
    for (int i = 0; i < 16; ++i) { ot[0][i] += sc * o[0][i]; ot[1][i] += sc * o[1][i]; }
  }
#endif
#ifndef NO_WIN
  {
    float m = NEGF, l = 0.f;
    f32x16 o[2];
#pragma unroll
    for (int i = 0; i < 16; ++i) { o[0][i] = 0.f; o[1][i] = 0.f; }
    const bf16_t* kbase = a.kw + bg * SEQ * 64;
    const bf16_t* vbase = a.vwT + bg * 64 * SEQ;
    const int tmin = t0 + 8 * w, tmax = tmin + 7;
    int kt_lo = (tmin - 255) >> 5; if (kt_lo < 0) kt_lo = 0;
    const int kt_hi = tmax >> 5;
#pragma unroll 1
    for (int kt = kt_lo; kt <= kt_hi; ++kt) {
      const int key0 = 32 * kt;
      f32x16 s = qk_tile(kbase + (size_t)key0 * 64, qf, c32, hh);
      float mt = NEGF;
      const int khi = t - key0 - 4 * hh, klo = khi - 256;
#pragma unroll
      for (int i = 0; i < 16; ++i) {
        const int kc_ = (i & 3) + 8 * (i >> 2);
        const bool valid = (kc_ <= khi) && (kc_ > klo);
        s[i] = valid ? s[i] : NEGF;
        mt = fmaxf(mt, s[i]);
      }
      mt = fmaxf(mt, __shfl_xor(mt, 32));
      const float mn = fmaxf(m, mt);
      const float alpha = __builtin_amdgcn_exp2f(m - mn);
      float ps = 0.f;
#pragma unroll
      for (int i = 0; i < 16; ++i) { const float p = (s[i] > -1e29f) ? __builtin_amdgcn_exp2f(s[i] - mn) : 0.f; s[i] = p; ps += p; }
      l = l * alpha + ps; m = mn;
#pragma unroll
      for (int i = 0; i < 16; ++i) { o[0][i] *= alpha; o[1][i] *= alpha; }
      pv_tile(o, vbase + key0, SEQ, s, c32, hh);
    }
    l += __shfl_xor(l, 32);
    const float sc = gate_w / l;
#pragma unroll
    for (int i = 0; i < 16; ++i) { ot[0][i] += sc * o[0][i]; ot[1][i] += sc * o[1][i]; }
  }
#endif
#pragma unroll
  for (int dt = 0; dt < 2; ++dt)
#pragma unroll
    for (int ii = 0; ii < 4; ++ii) {
      const int d0 = 32 * dt + 8 * ii + 4 * hh;
      const u32x2 z = *(const u32x2*)(a.szc + tok * 512 + head * 64 + d0);
      u32x2 ov;
      ov.x = cvt_pk_bf16(ot[dt][4 * ii] * bflo(z.x), ot[dt][4 * ii + 1] * bfhi(z.x));
      ov.y = cvt_pk_bf16(ot[dt][4 * ii + 2] * bflo(z.y), ot[dt][4 * ii + 3] * bfhi(z.y));
      *(u32x2*)(a.mixb + tok * 1024 + 512 + head * 64 + d0) = ov;
    }
}
__device__ __forceinline__ void phaseC(LAS unsigned char* lds, const PhaseCArgs& a) {
  for (int p = blockIdx.x; p < 256; p += gridDim.x) {
    const int b = p >> 5, g = (p >> 4) & 1, qlo = p & 15;
    attn_item(a, lds, b, qlo, g);
    __syncthreads();
    attn_item(a, lds, b, 31 - qlo, g);
    __syncthreads();
  }
}
__global__ void __launch_bounds__(512, 2) k_phaseC(PhaseCArgs a) {
  extern __shared__ __attribute__((aligned(16))) unsigned char shm[];
  phaseC((LAS unsigned char*)shm, a);
}

__global__ void k_bridge_cvt(const float* src, int ld_src, int col0, int ncol, bf16_t* dst, size_t ntok) {
  size_t i = (size_t)blockIdx.x * blockDim.x + threadIdx.x;
  if (i >= ntok * ncol) return;
  const size_t tok = i / ncol; const int c = (int)(i % ncol);
  dst[i] = f2bf(src[tok * ld_src + col0 + c]);
}
__global__ void __launch_bounds__(256) k_prep_x(const float* xp, const float* xs, bf16_t* xb, float* ssq) {
  const int row = blockIdx.x * 4 + (threadIdx.x >> 6), lane = threadIdx.x & 63;
  if (row >= NTOK) return;
  const float* x = row < NPT ? xp + (size_t)row * 1024 : xs + (size_t)(row - NPT) * 1024;
#pragma unroll
  for (int j = 0; j < 4; ++j) {
    const f32x4 v = *(const f32x4*)(x + j * 256 + lane * 4);
    u32x2 pk; pk.x = cvt_pk_bf16(v[0], v[1]); pk.y = cvt_pk_bf16(v[2], v[3]);
    *(u32x2*)(xb + (size_t)row * 1024 + j * 256 + lane * 4) = pk;
    float ss = v[0] * v[0] + v[1] * v[1] + v[2] * v[2] + v[3] * v[3];
    ss += __shfl_xor(ss, 1); ss += __shfl_xor(ss, 2); ss += __shfl_xor(ss, 4); ss += __shfl_xor(ss, 8);
    if ((lane & 15) == 0) ssq[(size_t)row * 16 + j * 4 + (lane >> 4)] = ss;
  }
}
__global__ void __launch_bounds__(64) k_prep_cbias(const float* pe, const float* w1, float* cbias) {
  const int lk = blockIdx.x, e = threadIdx.x;
  const float* pp = pe + (size_t)lk * 2048; const float* ww = w1 + (size_t)lk * 2048 * 64;
  float acc = 0.f;
  for (int k = 0; k < 2048; ++k) acc = fmaf(pp[k], ww[(size_t)k * 64 + e], acc);
  cbias[lk * 64 + e] = acc;
}
__device__ __forceinline__ float rinv_from_ssq(const float* ssq, size_t row) {
  const f32x4* p = (const f32x4*)(ssq + row * 16);
  const f32x4 a = p[0], b = p[1], c = p[2], d = p[3];
  const float s = ((a[0] + a[1]) + (a[2] + a[3])) + ((b[0] + b[1]) + (b[2] + b[3])) + ((c[0] + c[1]) + (c[2] + c[3])) + ((d[0] + d[1]) + (d[2] + d[3]));
  return rsqrtf(s * (1.f / 1024.f) + 1e-6f);
}
__device__ __forceinline__ f32x4 mfma16(bf16x8 a, bf16x8 b, f32x4 c) { return __builtin_amdgcn_mfma_f32_16x16x32_bf16(a, b, c, 0, 0, 0); }
__device__ __forceinline__ float fsilu(float z) { return z / (1.f + __expf(-z)); }
__device__ __forceinline__ float fsigmoid(float z) { return 1.f / (1.f + __expf(-z)); }

struct PhaseBArgs {
  const bf16_t *glu, *bin, *sza, *szb, *xb; const float* ssq;
  const bf16_t *WpwT, *WpoolT, *WgT, *W1T, *W2T; const float* cbias;
  const float *w_dw, *b_dw, *ln_g, *ln_b, *b_pw, *pool_scale;
  const float* cmp_rows_p;
  bf16_t *mixb, *kcP, *vcPT; float* gates;
};

__device__ __forceinline__ void conv_item(const PhaseBArgs& a, LAS unsigned char* lds, int b, int chunk) {
  const int tid = threadIdx.x, w = tid >> 6, lane = tid & 63;
  const int t0 = chunk * 128;
  for (int i = tid; i < 158 * 32; i += 512) {
    const int row = i >> 5, ch = i & 31, t = t0 - 30 + row;
    u32x4 v = {0u, 0u, 0u, 0u};
    if (t >= 0) v = *(const u32x4*)(a.glu + ((size_t)b * SEQ + t) * 256 + ch * 8);
    *(LAS u32x4*)(lds + row * 512 + ch * 16) = v;
  }
  __syncthreads();
  const int cp = tid & 127, tg = tid >> 7;
  float acc0[32], acc1[32];
  {
    const f32x2 bd = *(const f32x2*)(a.b_dw + 2 * cp);
#pragma unroll
    for (int j = 0; j < 32; ++j) { acc0[j] = bd.x; acc1[j] = bd.y; }
    float w0[31], w1[31];
#pragma unroll
    for (int k = 0; k < 31; ++k) { const f32x2 wv = *(const f32x2*)(a.w_dw + k * 256 + 2 * cp); w0[k] = wv.x; w1[k] = wv.y; }
    const LAS unsigned* wp = (const LAS unsigned*)(lds + (tg * 32) * 512 + cp * 4);
#pragma unroll
    for (int rr = 0; rr < 62; ++rr) {
      const unsigned xv = wp[rr * 128];
      const float x0 = bflo(xv), x1 = bfhi(xv);
#pragma unroll
      for (int k = 0; k < 31; ++k) {
        const int j = rr - k;
        if (j >= 0 && j < 32) { acc0[j] = fmaf(w0[k], x0, acc0[j]); acc1[j] = fmaf(w1[k], x1, acc1[j]); }
      }
    }
  }
  __syncthreads();
#pragma unroll
  for (int j = 0; j < 32; ++j) *(LAS f32x2*)(lds + (tg * 32 + j) * 1088 + cp * 8) = (f32x2){acc0[j], acc1[j]};
  __syncthreads();
  {
    const int tok = tid >> 2, q = tid & 3;
    f32x4 v[16]; float s = 0.f;
#pragma unroll
    for (int i = 0; i < 16; ++i) { v[i] = *(const LAS f32x4*)(lds + tok * 1088 + (4 * i + q) * 16); s += (v[i][0] + v[i][1]) + (v[i][2] + v[i][3]); }
    s += __shfl_xor(s, 1); s += __shfl_xor(s, 2);
    const float mean = s * (1.f / 256.f);
    float s2 = 0.f;
#pragma unroll
    for (int i = 0; i < 16; ++i) { v[i] = v[i] - mean; s2 += (v[i][0] * v[i][0] + v[i][1] * v[i][1]) + (v[i][2] * v[i][2] + v[i][3] * v[i][3]); }
    s2 += __shfl_xor(s2, 1); s2 += __shfl_xor(s2, 2);
    const float rstd = rsqrtf(s2 * (1.f / 256.f) + 1e-6f);
#pragma unroll
    for (int i = 0; i < 16; ++i) {
      const int c0 = (4 * i + q) * 4;
      const f32x4 gg = *(const f32x4*)(a.ln_g + c0), bb = *(const f32x4*)(a.ln_b + c0);
      f32x4 z = v[i] * rstd * gg + bb;
      u32x2 pk; pk.x = cvt_pk_bf16(fsilu(z[0]), fsilu(z[1])); pk.y = cvt_pk_bf16(fsilu(z[2]), fsilu(z[3]));
      *(LAS u32x2*)(lds + tok * 1088 + c0 * 2) = pk;
    }
  }
  __syncthreads();
  {
    const int fr = lane & 15, fq = lane >> 4;
    f32x4 acc[16];
#pragma unroll
    for (int nt = 0; nt < 16; ++nt) acc[nt] = (f32x4){0.f, 0.f, 0.f, 0.f};
#pragma unroll 2
    for (int ks = 0; ks < 8; ++ks) {
      const bf16x8 af = *(const LAS bf16x8*)(lds + (16 * w + fr) * 1088 + (ks * 32 + fq * 8) * 2);
#pragma unroll
      for (int nt = 0; nt < 16; ++nt) {
        const bf16x8 bf = *(const bf16x8*)(a.WpwT + (size_t)(nt * 16 + fr) * 256 + ks * 32 + fq * 8);
        acc[nt] = mfma16(bf, af, acc[nt]);
      }
    }
    const size_t tok = (size_t)b * SEQ + t0 + 16 * w + fr;
#pragma unroll
    for (int nt = 0; nt < 16; ++nt) {
      const int c0 = nt * 16 + 4 * fq;
      const f32x4 bp = *(const f32x4*)(a.b_pw + c0);
      const u32x2 z = *(const u32x2*)(a.sza + tok * 256 + c0);
      u32x2 ov;
      ov.x = cvt_pk_bf16((acc[nt][0] + bp[0]) * bflo(z.x), (acc[nt][1] + bp[1]) * bfhi(z.x));
      ov.y = cvt_pk_bf16((acc[nt][2] + bp[2]) * bflo(z.y), (acc[nt][3] + bp[3]) * bfhi(z.y));
      *(u32x2*)(a.mixb + tok * 1024 + c0) = ov;
    }
  }
  __syncthreads();
}

__device__ __forceinline__ void pool_item(const PhaseBArgs& a, LAS unsigned char* lds, int b, int chunk) {
  const int tid = threadIdx.x, w = tid >> 6, lane = tid & 63;
  const int t0 = chunk * 128;
  constexpr int DOFF = 143 * 512;
  for (int i = tid; i < 143 * 32; i += 512) {
    const int row = i >> 5, ch = i & 31, t = t0 - 15 + row;
    u32x4 v = {0u, 0u, 0u, 0u};
    if (t >= 0) v = *(const u32x4*)(a.bin + ((size_t)b * SEQ + t) * 256 + ch * 8);
    *(LAS u32x4*)(lds + row * 512 + ch * 16) = v;
  }
  __syncthreads();
  {
    const int cp = tid & 127, tg = tid >> 7, grp = cp >> 5, wn = 2 << grp;
    const LAS unsigned* wp = (const LAS unsigned*)(lds + cp * 4);
    const int r0 = 15 + tg * 32;
    float run0 = 0.f, run1 = 0.f;
    for (int i = 1; i < wn; ++i) { const unsigned xv = wp[(r0 - i) * 128]; run0 += bflo(xv); run1 += bfhi(xv); }
#pragma unroll 4
    for (int j = 0; j < 32; ++j) {
      const int rr = r0 + j, t = t0 + tg * 32 + j;
      const unsigned xv = wp[rr * 128];
      const float x0 = bflo(xv), x1 = bfhi(xv);
      run0 += x0; run1 += x1;
      const float icnt = 1.f / (float)min(wn, t + 1);
      const unsigned dv = cvt_pk_bf16(run0 * icnt - x0, run1 * icnt - x1);
      *(LAS unsigned*)(lds + DOFF + (tg * 32 + j) * 528 + cp * 4) = dv;
      const unsigned xo = wp[(rr - wn + 1) * 128];
      run0 -= bflo(xo); run1 -= bfhi(xo);
    }
  }
  __syncthreads();
  {
    const int fr = lane & 15, fq = lane >> 4;
    const size_t tok = (size_t)b * SEQ + t0 + 16 * w + fr;
#pragma unroll
    for (int g = 0; g < 4; ++g) {
      f32x4 acc[4];
#pragma unroll
      for (int nt = 0; nt < 4; ++nt) acc[nt] = (f32x4){0.f, 0.f, 0.f, 0.f};
#pragma unroll
      for (int ks = 0; ks < 2; ++ks) {
        const bf16x8 af = *(const LAS bf16x8*)(lds + DOFF + (16 * w + fr) * 528 + (g * 64 + ks * 32 + fq * 8) * 2);
#pragma unroll
        for (int nt = 0; nt < 4; ++nt) {
          const bf16x8 bf = *(const bf16x8*)(a.WpoolT + (size_t)(g * 64 + nt * 16 + fr) * 64 + ks * 32 + fq * 8);
          acc[nt] = mfma16(bf, af, acc[nt]);
        }
      }
#pragma unroll
      for (int nt = 0; nt < 4; ++nt) {
        const int c0 = g * 64 + nt * 16 + 4 * fq;
        const f32x4 sc = *(const f32x4*)(a.pool_scale + c0);
        const u32x2 z = *(const u32x2*)(a.szb + tok * 256 + c0);
        u32x2 ov;
        ov.x = cvt_pk_bf16(acc[nt][0] * sc[0] * bflo(z.x), acc[nt][1] * sc[1] * bfhi(z.x));
        ov.y = cvt_pk_bf16(acc[nt][2] * sc[2] * bflo(z.y), acc[nt][3] * sc[3] * bfhi(z.y));
        *(u32x2*)(a.mixb + tok * 1024 + 256 + c0) = ov;
      }
    }
  }
  __syncthreads();
}

__device__ __forceinline__ void gates_item(const PhaseBArgs& a, int chunk) {
  const int tid = threadIdx.x, w = tid >> 6, lane = tid & 63, fr = lane & 15, fq = lane >> 4;
  const size_t row = (size_t)chunk * 128 + 16 * w + fr;
  f32x4 acc[2] = {(f32x4){0.f, 0.f, 0.f, 0.f}, (f32x4){0.f, 0.f, 0.f, 0.f}};
  const bf16_t* ap = a.xb + row * 1024 + fq * 8;
  const bf16_t* bp = a.WgT + (size_t)fr * 1024 + fq * 8;
#pragma unroll 8
  for (int ks = 0; ks < 32; ++ks) {
    const bf16x8 af = *(const bf16x8*)(ap + ks * 32);
    const bf16x8 b0 = *(const bf16x8*)(bp + ks * 32), b1 = *(const bf16x8*)(bp + 16 * 1024 + ks * 32);
    acc[0] = mfma16(b0, af, acc[0]); acc[1] = mfma16(b1, af, acc[1]);
  }
  const float rinv = rinv_from_ssq(a.ssq, row);
#pragma unroll
  for (int nt = 0; nt < 2; ++nt) {
    const int c0 = nt * 16 + 4 * fq;
    if (c0 < 24) {
      f32x4 o;
#pragma unroll
      for (int e = 0; e < 4; ++e) o[e] = fsigmoid(acc[nt][e] * rinv);
      *(f32x4*)(a.gates + row * 24 + c0) = o;
    }
  }
}

struct CmpSrc { const float* base; const int* pages; };
__device__ __forceinline__ const float* cmp_row_ptr(const CmpSrc& s, int pos) {
  if (s.pages) return s.base + ((size_t)s.pages[pos >> 7] * 128 + (pos & 127)) * 256;
  return s.base + (size_t)pos * 256;
}
__device__ __forceinline__ float gelu_tanh_f(float x) {
  const float u = 0.7978845608028654f * (x + 0.044715f * x * x * x);
  const float e = __expf(2.f * u);
  const float th = 1.f - 2.f / (e + 1.f);
  return 0.5f * x * (1.f + th);
}
__device__ __forceinline__ void compress_item(LAS unsigned char* lds, const CmpSrc& src, int g, int kv, const bf16_t* W1T  , const bf16_t* W2T  ,
                                              const float* cbias  , bf16_t* kc_out  , bf16_t* vcT_out  ) {
  const int tid = threadIdx.x, w = tid >> 6, lane = tid & 63, fr = lane & 15, fq = lane >> 4;
  constexpr int BST = 272;
  constexpr int BBUF = 128 * BST;
  constexpr int POFF = 2 * BBUF;
  const float* arow = cmp_row_ptr(src, (16 * w + fr) * 16) + kv * 128 + g * 64 + fq * 8;
  const bf16_t* bsrc = W1T + (size_t)(tid >> 2) * 1024 + (tid & 3) * 32;
  LAS unsigned char* bdst = lds + (tid >> 2) * BST + (tid & 3) * 64;
  f32x4 acc[8];
#pragma unroll
  for (int nt = 0; nt < 8; ++nt) acc[nt] = (f32x4){0.f, 0.f, 0.f, 0.f};
  u32x4 breg[4]; f32x4 areg[8];
#pragma unroll
  for (int i = 0; i < 4; ++i) breg[i] = *(const u32x4*)(bsrc + i * 8);
#pragma unroll
  for (int i = 0; i < 4; ++i) { areg[2 * i] = *(const f32x4*)(arow + (i >> 1) * 256 + (i & 1) * 32); areg[2 * i + 1] = *(const f32x4*)(arow + (i >> 1) * 256 + (i & 1) * 32 + 4); }
#pragma unroll 1
  for (int c = 0; c < 8; ++c) {
    LAS unsigned char* bb = bdst + (c & 1) * BBUF;
#pragma unroll
    for (int i = 0; i < 4; ++i) *(LAS u32x4*)(bb + i * 16) = breg[i];
    bf16x8 af[4];
#pragma unroll
    for (int i = 0; i < 4; ++i) {
      union { bf16x8 v; unsigned u[4]; } t;
      t.u[0] = cvt_pk_bf16(areg[2 * i][0], areg[2 * i][1]); t.u[1] = cvt_pk_bf16(areg[2 * i][2], areg[2 * i][3]);
      t.u[2] = cvt_pk_bf16(areg[2 * i + 1][0], areg[2 * i + 1][1]); t.u[3] = cvt_pk_bf16(areg[2 * i + 1][2], areg[2 * i + 1][3]);
      af[i] = t.v;
    }
    if (c < 7) {
#pragma unroll
      for (int i = 0; i < 4; ++i) breg[i] = *(const u32x4*)(bsrc + (c + 1) * 128 + i * 8);
#pragma unroll
      for (int i = 0; i < 4; ++i) { const float* ap = arow + (2 * (c + 1) + (i >> 1)) * 256 + (i & 1) * 32; areg[2 * i] = *(const f32x4*)ap; areg[2 * i + 1] = *(const f32x4*)(ap + 4); }
    }
    __syncthreads();
    const LAS unsigned char* br = lds + (c & 1) * BBUF + fr * BST + fq * 16;
#pragma unroll
    for (int i = 0; i < 4; ++i)
#pragma unroll
      for (int nt = 0; nt < 8; ++nt) {
        const bf16x8 bf = *(const LAS bf16x8*)(br + nt * 16 * BST + i * 64);
        acc[nt] = mfma16(bf, af[i], acc[nt]);
      }
  }
#pragma unroll
  for (int nt = 0; nt < 8; ++nt) *(LAS f32x4*)(lds + POFF + (16 * w + fr) * 528 + (nt * 16 + 4 * fq) * 4) = acc[nt];
  __syncthreads();
  {
    const int i = 16 * w + fr, i1 = i < 127 ? i + 1 : 127;
    f32x4 o[4];
#pragma unroll
    for (int nt = 0; nt < 4; ++nt) o[nt] = (f32x4){0.f, 0.f, 0.f, 0.f};
#pragma unroll
    for (int ks = 0; ks < 2; ++ks) {
      const int k0 = ks * 32 + fq * 8;
      union { bf16x8 v; unsigned u[4]; } hf;
#pragma unroll
      for (int h2 = 0; h2 < 2; ++h2) {
        const f32x4 pa = *(const LAS f32x4*)(lds + POFF + i * 528 + (k0 + 4 * h2) * 4);
        const f32x4 pb = *(const LAS f32x4*)(lds + POFF + i1 * 528 + (64 + k0 + 4 * h2) * 4);
        const f32x4 cb = *(const f32x4*)(cbias + k0 + 4 * h2);
        const f32x4 x = pa + pb + cb;
        hf.u[2 * h2] = cvt_pk_bf16(gelu_tanh_f(x[0]), gelu_tanh_f(x[1]));
        hf.u[2 * h2 + 1] = cvt_pk_bf16(gelu_tanh_f(x[2]), gelu_tanh_f(x[3]));
      }
#pragma unroll
      for (int nt = 0; nt < 4; ++nt) {
        const bf16x8 bf = *(const bf16x8*)(W2T + (size_t)(nt * 16 + fr) * 64 + k0);
        o[nt] = mfma16(bf, hf.v, o[nt]);
      }
    }
    const bool real = i < 127;
#pragma unroll
    for (int nt = 0; nt < 4; ++nt) {
      const int c0 = nt * 16 + 4 * fq;
      const float v0 = real ? o[nt][0] : 0.f, v1 = real ? o[nt][1] : 0.f, v2 = real ? o[nt][2] : 0.f, v3 = real ? o[nt][3] : 0.f;
      if (kv == 0) { u32x2 pk; pk.x = cvt_pk_bf16(v0, v1); pk.y = cvt_pk_bf16(v2, v3); *(u32x2*)(kc_out + (size_t)i * 64 + c0) = pk; }
      else { vcT_out[(size_t)(c0 + 0) * 128 + i] = f2bf(v0); vcT_out[(size_t)(c0 + 1) * 128 + i] = f2bf(v1); vcT_out[(size_t)(c0 + 2) * 128 + i] = f2bf(v2); vcT_out[(size_t)(c0 + 3) * 128 + i] = f2bf(v3); }
    }
  }
  __syncthreads();
}

__device__ __forceinline__ void phaseB(LAS unsigned char* lds, const PhaseBArgs& a) {
  const int G = gridDim.x, wg = blockIdx.x;
#ifndef NO_CONV
  for (int it = wg; it < 128; it += G) conv_item(a, lds, it >> 4, it & 15);
#endif
#ifndef NO_POOL
  for (int it = (wg + G - 128 % G) % G; it < 128; it += G) pool_item(a, lds, it >> 4, it & 15);
#endif
#ifndef NO_CMPR
  for (int it = (wg + G - 128 % G) % G; it < 32; it += G) {
    const int b = it >> 2, g = (it >> 1) & 1, kv = it & 1;
    CmpSrc src{a.cmp_rows_p + (size_t)b * SEQ * 256, nullptr};
    compress_item(lds, src, g, kv, a.W1T + (size_t)kv * 128 * 1024, a.W2T + (size_t)kv * 4096, a.cbias + kv * 64,
                  a.kcP + ((size_t)b * 2 + g) * 128 * 64, a.vcPT + ((size_t)b * 2 + g) * 64 * 128);
  }
#endif
#ifndef NO_GATES
  for (int it = (wg + G - 160 % G) % G; it < 128; it += G) gates_item(a, it);
#endif
}
__global__ void __launch_bounds__(512, 2) k_phaseB(PhaseBArgs a) {
  extern __shared__ __attribute__((aligned(16))) unsigned char shm[];
  phaseB((LAS unsigned char*)shm, a);
}

struct EpiA {
  static constexpr bool PERM = true, AFTER_DRAIN = false;
  int l; int pad_;
  const float* ssq; const float* g_q; const float* g_k; const float* cs;
  bf16_t *glu, *bin, *sza, *szb, *szc, *qb, *ks, *vsT, *kw, *vwT; float* out;
  __device__ __forceinline__ void norm_rope(f32x4 (&v)[2][2], const float* gain, int t, int fq) const {
    float ss = 0.f;
#pragma unroll
    for (int bj = 0; bj < 2; ++bj)
#pragma unroll
      for (int n = 0; n < 2; ++n) ss += (v[bj][n][0] * v[bj][n][0] + v[bj][n][1] * v[bj][n][1]) + (v[bj][n][2] * v[bj][n][2] + v[bj][n][3] * v[bj][n][3]);
    ss += __shfl_xor(ss, 16); ss += __shfl_xor(ss, 32);
    const float rn = rsqrtf(ss * (1.f / 64.f) + 1e-6f);
#pragma unroll
    for (int bj = 0; bj < 2; ++bj)
#pragma unroll
      for (int n = 0; n < 2; ++n) { const f32x4 gg = *(const f32x4*)(gain + 32 * bj + 8 * fq + 4 * n); v[bj][n] = v[bj][n] * rn * gg; }
#pragma unroll
    for (int n = 0; n < 2; ++n) {
      const f32x4 c0 = *(const f32x4*)(cs + t * 16 + 8 * n), c1 = *(const f32x4*)(cs + t * 16 + 8 * n + 4);
      const float cc[4] = {c0[0], c0[2], c1[0], c1[2]}, sn[4] = {c0[1], c0[3], c1[1], c1[3]};
#pragma unroll
      for (int e = 0; e < 4; ++e) {
        const float y = v[0][n][e], pr = __shfl_xor(y, 16);
        const float r0 = y * cc[e] - pr * sn[e], r1 = y * cc[e] + pr * sn[e];
        v[0][n][e] = fq == 0 ? r0 : (fq == 1 ? r1 : y);
      }
    }
  }
  __device__ __forceinline__ void operator()(const f32x4 (&acc)[2][2][4][2], const Unit& u, int wr, int wc, int fr, int fq) const {
    const int pn = u.pn;
    const int row0 = u.pm * 256 + wr * 64 + fr;
    const int jc = 32 * wc + 8 * fq;
#pragma unroll
    for (int ai = 0; ai < 2; ++ai)
#pragma unroll
      for (int m = 0; m < 4; ++m) {
        const int row = row0 + ai * 128 + m * 16;
        const size_t tok = (size_t)row;
        const int b = row >> 11, t = row & 2047;
        float rinv;
        { const f32x4 p = *(const f32x4*)(ssq + tok * 16 + fq * 4); float sq = (p[0] + p[1]) + (p[2] + p[3]); sq += __shfl_xor(sq, 16); sq += __shfl_xor(sq, 32); rinv = rsqrtf(sq * (1.f / 1024.f) + 1e-6f); }
        f32x4 v[2][2];
#pragma unroll
        for (int bj = 0; bj < 2; ++bj)
#pragma unroll
          for (int n = 0; n < 2; ++n) v[bj][n] = acc[ai][bj][m][n] * rinv;
        if (pn < 2) {
          const int c = pn * 128 + jc;
          f32x4 o0, o1;
#pragma unroll
          for (int e = 0; e < 4; ++e) { o0[e] = v[0][0][e] * fsigmoid(v[1][0][e]); o1[e] = v[0][1][e] * fsigmoid(v[1][1][e]); }
          u32x4 pk; pk.x = cvt_pk_bf16(o0[0], o0[1]); pk.y = cvt_pk_bf16(o0[2], o0[3]); pk.z = cvt_pk_bf16(o1[0], o1[1]); pk.w = cvt_pk_bf16(o1[2], o1[3]);
          *(u32x4*)(glu + tok * 256 + c) = pk;
          if (t >= 2018) { float* dst = out + O_CONVP + ((size_t)(l * 8 + b) * 30 + (t - 2018)) * 256 + c; *(f32x4*)dst = o0; *(f32x4*)(dst + 4) = o1; }
        } else if (pn == 3) {
#pragma unroll
          for (int bj = 0; bj < 2; ++bj) {
            const int c = 128 * bj + jc;
            u32x4 pk; pk.x = cvt_pk_bf16(v[bj][0][0], v[bj][0][1]); pk.y = cvt_pk_bf16(v[bj][0][2], v[bj][0][3]); pk.z = cvt_pk_bf16(v[bj][1][0], v[bj][1][1]); pk.w = cvt_pk_bf16(v[bj][1][2], v[bj][1][3]);
            *(u32x4*)(bin + tok * 256 + c) = pk;
            if (t >= 2033) { float* dst = out + O_POOLP + ((size_t)(l * 8 + b) * 15 + (t - 2033)) * 256 + c; *(f32x4*)dst = v[bj][0]; *(f32x4*)(dst + 4) = v[bj][1]; }
          }
        } else if (pn == 2 || pn == 4 || pn >= 10) {
          bf16_t* base = pn == 2 ? sza + tok * 256 : (pn == 4 ? szb + tok * 256 : szc + tok * 512 + (pn - 10) * 256);
#pragma unroll
          for (int bj = 0; bj < 2; ++bj) {
            u32x4 pk; pk.x = cvt_pk_bf16(fsilu(v[bj][0][0]), fsilu(v[bj][0][1])); pk.y = cvt_pk_bf16(fsilu(v[bj][0][2]), fsilu(v[bj][0][3]));
            pk.z = cvt_pk_bf16(fsilu(v[bj][1][0]), fsilu(v[bj][1][1])); pk.w = cvt_pk_bf16(fsilu(v[bj][1][2]), fsilu(v[bj][1][3]));
            *(u32x4*)(base + 128 * bj + jc) = pk;
          }
        } else if (pn <= 6) {
          const int head = (pn - 5) * 4 + wc;
          norm_rope(v, g_q, t, fq);
          const float sc = 0.125f * 1.4426950408889634f;
#pragma unroll
          for (int bj = 0; bj < 2; ++bj) {
            u32x4 pk; pk.x = cvt_pk_bf16(v[bj][0][0] * sc, v[bj][0][1] * sc); pk.y = cvt_pk_bf16(v[bj][0][2] * sc, v[bj][0][3] * sc);
            pk.z = cvt_pk_bf16(v[bj][1][0] * sc, v[bj][1][1] * sc); pk.w = cvt_pk_bf16(v[bj][1][2] * sc, v[bj][1][3] * sc);
            *(u32x4*)(qb + (tok * 8 + head) * 64 + 32 * bj + 8 * fq) = pk;
          }
        } else {
          const int br = pn - 7, kvsel = wc >> 1, g = wc & 1;
          if (kvsel == 0) norm_rope(v, g_k + br * 64, t, fq);
          float* fdst = nullptr;
          if (br == 0) fdst = out + O_CMPP + ((size_t)l * NPT + tok) * 256;
          else if (br == 1) fdst = out + O_SLCP + ((size_t)l * NPT + tok) * 256;
          else if (t >= 1792) fdst = out + O_WINP + ((size_t)(l * 8 + b) * 256 + (t - 1792)) * 256;
          if (fdst) {
#pragma unroll
            for (int bj = 0; bj < 2; ++bj) { float* d2 = fdst + kvsel * 128 + g * 64 + 32 * bj + 8 * fq; *(f32x4*)d2 = v[bj][0]; *(f32x4*)(d2 + 4) = v[bj][1]; }
          }
          if (br >= 1) {
            const size_t bg = (size_t)b * 2 + g;
            if (kvsel == 0) {
              bf16_t* kd = (br == 1 ? ks : kw) + (bg * SEQ + t) * 64;
#pragma unroll
              for (int bj = 0; bj < 2; ++bj) {
                u32x4 pk; pk.x = cvt_pk_bf16(v[bj][0][0], v[bj][0][1]); pk.y = cvt_pk_bf16(v[bj][0][2], v[bj][0][3]); pk.z = cvt_pk_bf16(v[bj][1][0], v[bj][1][1]); pk.w = cvt_pk_bf16(v[bj][1][2], v[bj][1][3]);
                *(u32x4*)(kd + 32 * bj + 8 * fq) = pk;
              }
            } else {
              bf16_t* vd = (br == 1 ? vsT : vwT) + bg * 64 * SEQ + t;
#pragma unroll
              for (int bj = 0; bj < 2; ++bj)
#pragma unroll
                for (int n = 0; n < 2; ++n)
#pragma unroll
                  for (int e = 0; e < 4; ++e) vd[(size_t)(32 * bj + 8 * fq + 4 * n + e) * SEQ] = f2bf(v[bj][n][e]);
            }
          }
        }
      }
  }
};
struct PhaseAArgs { EpiA epi; const bf16_t* xb; const bf16_t* WinT; };
__device__ __forceinline__ void phaseA(LAS unsigned char* lds, const PhaseAArgs& a) {
  pg8::Gemm g{a.xb, a.WinT, NPT, 3072, 1024};
  pg8::StaticOrder S; S.init(NPT, 3072, gridDim.x, blockIdx.x);
  pg8::gemm_phase<EpiA, pg8::StaticOrder, false>(lds, g, S, a.epi, nullptr);
}
__global__ void __launch_bounds__(512, 2) k_phaseA(PhaseAArgs a) {
  extern __shared__ __attribute__((aligned(16))) unsigned char shm[];
  phaseA((LAS unsigned char*)shm, a);
}

__device__ __forceinline__ float wsum(float v) {
#pragma unroll
  for (int o = 32; o > 0; o >>= 1) v += __shfl_xor(v, o);
  return v;
}
__device__ __forceinline__ float wmax(float v) {
#pragma unroll
  for (int o = 32; o > 0; o >>= 1) v = fmaxf(v, __shfl_xor(v, o));
  return v;
}
template <int NT> __device__ __forceinline__ void thin_gemm(const bf16_t* A, int lda, const bf16_t* Bt, int ldb, int K, f32x4 (&acc)[NT], int fr, int fq) {
  const bf16_t* ap = A + (size_t)fr * lda + fq * 8;
  const bf16_t* bp = Bt + (size_t)fr * ldb + fq * 8;
#pragma unroll
  for (int nt = 0; nt < NT; ++nt) acc[nt] = (f32x4){0.f, 0.f, 0.f, 0.f};
#pragma unroll 4
  for (int k0 = 0; k0 < K; k0 += 32) {
    const bf16x8 af = *(const bf16x8*)(ap + k0);
#pragma unroll
    for (int nt = 0; nt < NT; ++nt) { const bf16x8 bf = *(const bf16x8*)(bp + (size_t)nt * 16 * ldb + k0); acc[nt] = mfma16(bf, af, acc[nt]); }
  }
}
__device__ __forceinline__ void s1_unit(const bf16_t* xb_s, const float* ssq_s, const bf16_t* WinT, float* sproj, int u) {
  const int tid = threadIdx.x, w = tid >> 6, lane = tid & 63, fr = lane & 15, fq = lane >> 4;
  const int n0 = 64 * u, row = 16 * w + fr;
  f32x4 acc[4];
  if (u < 48) thin_gemm<4>(xb_s + (size_t)16 * w * 1024, 1024, WinT + (size_t)n0 * 1024, 1024, 1024, acc, fr, fq);
  else { f32x4 a2[2]; thin_gemm<2>(xb_s + (size_t)16 * w * 1024, 1024, WinT + (size_t)n0 * 1024, 1024, 1024, a2, fr, fq); acc[0] = a2[0]; acc[1] = a2[1]; acc[2] = acc[3] = (f32x4){0.f, 0.f, 0.f, 0.f}; }
  const float rinv = rinv_from_ssq(ssq_s, row);
#pragma unroll
  for (int nt = 0; nt < 4; ++nt) {
    const int np = n0 + nt * 16 + 4 * fq;
    if (np < 3096) { const int lc = win_logical_col(np); *(f32x4*)(sproj + (size_t)row * 3104 + lc) = acc[nt] * rinv; }
  }
}
template <bool LAST> __device__ __forceinline__ void s4_unit(const bf16_t* mix_s, const bf16_t* WoutT, const float* xs, float* xs_out, bf16_t* xb_s, float* ssq_s, int u) {
  const int tid = threadIdx.x, w = tid >> 6, lane = tid & 63, fr = lane & 15, fq = lane >> 4;
  const int n0 = 64 * u, row = 16 * w + fr;
  f32x4 acc[4];
  thin_gemm<4>(mix_s + (size_t)16 * w * 1024, 1024, WoutT + (size_t)n0 * 1024, 1024, 1024, acc, fr, fq);
  float ss = 0.f;
#pragma unroll
  for (int nt = 0; nt < 4; ++nt) {
    const int c = n0 + nt * 16 + 4 * fq;
    const f32x4 v = acc[nt] + *(const f32x4*)(xs + (size_t)row * 1024 + c);
    *(f32x4*)(xs_out + (size_t)row * 1024 + c) = v;
    if (!LAST) { u32x2 pk; pk.x = cvt_pk_bf16(v[0], v[1]); pk.y = cvt_pk_bf16(v[2], v[3]); *(u32x2*)(xb_s + (size_t)row * 1024 + c) = pk; ss += (v[0] * v[0] + v[1] * v[1]) + (v[2] * v[2] + v[3] * v[3]); }
  }
  if (!LAST) { ss += __shfl_xor(ss, 16); ss += __shfl_xor(ss, 32); if (fq == 0) ssq_s[(size_t)row * 16 + u] = ss; }
}

struct SampArgs {
  int l; int pad_;
  const float* sproj;
  const float *g_q, *g_k, *cs;
  const float *state_conv_l, *state_pool_l;
  const float *w_dw, *b_dw, *ln_g, *ln_b, *w_pw, *b_pw, *w_pool, *pool_scale;
  const float *cache_slc_l, *cache_win_l; const int* page_table;
  const bf16_t *kcS, *vcST;
  float *sq, *srows, *sgates;
  bf16_t* mix_s;
  float* out;
};
__device__ __forceinline__ void s2_item(const SampArgs& a, LAS unsigned char* lds, int b) {
  const int tid = threadIdx.x, w = tid >> 6, lane = tid & 63, l = a.l;
  const float* pr = a.sproj + (size_t)b * 3104;
  LAS float* sh = (LAS float*)lds;
  const float* csp = a.cs + 2048 * 16;
  {
    const float v = pr[C_Q + w * 64 + lane];
    const float y = v * rsqrtf(wsum(v * v) * (1.f / 64.f) + 1e-6f) * a.g_q[lane];
    const float pp = __shfl_xor(y, 8);
    float o = y;
    if (lane < 16) { const int j = lane & 7; const float c = csp[j * 2], sn = csp[j * 2 + 1]; o = lane < 8 ? y * c - pp * sn : y * c + pp * sn; }
    a.sq[(size_t)b * 512 + w * 64 + lane] = o;
  }
  if (w < 6) {
    const int br = w >> 1, g = w & 1;
    const float v = pr[C_KV + br * 256 + g * 64 + lane];
    const float y = v * rsqrtf(wsum(v * v) * (1.f / 64.f) + 1e-6f) * a.g_k[br * 64 + lane];
    const float pp = __shfl_xor(y, 8);
    float o = y;
    if (lane < 16) { const int j = lane & 7; const float c = csp[j * 2], sn = csp[j * 2 + 1]; o = lane < 8 ? y * c - pp * sn : y * c + pp * sn; }
    const float vv = pr[C_KV + br * 256 + 128 + g * 64 + lane];
    a.srows[(size_t)b * 768 + br * 256 + g * 64 + lane] = o;
    a.srows[(size_t)b * 768 + br * 256 + 128 + g * 64 + lane] = vv;
    float* dst = br == 0 ? a.out + O_CMPS + ((size_t)l * NSM + b) * 256 : (br == 1 ? a.out + O_SLCS + ((size_t)l * NSM + b) * 256 : a.out + O_WINS + (((size_t)l * NSM + b) * 256 + 255) * 256);
    dst[g * 64 + lane] = o; dst[128 + g * 64 + lane] = vv;
  }
  if (tid < 24) a.sgates[(size_t)b * 24 + tid] = fsigmoid(pr[C_GATE + tid]);
  float yv = 0.f;
  if (tid < 256) {
    const int c = tid;
    const float glu = pr[C_AVAL + c] * fsigmoid(pr[C_AGATE + c]);
    const float* st = a.state_conv_l + (size_t)b * 30 * 256 + c;
    float* cso = a.out + O_CONVS + ((size_t)l * NSM + b) * 30 * 256 + c;
    float acc = a.b_dw[c];
    for (int k = 0; k < 30; ++k) { const float sv = st[k * 256]; acc = fmaf(a.w_dw[k * 256 + c], sv, acc); if (k >= 1) cso[(k - 1) * 256] = sv; }
    acc = fmaf(a.w_dw[30 * 256 + c], glu, acc);
    cso[29 * 256] = glu;
    yv = acc;
  } else {
    const int ch = tid - 256, g = ch >> 6, wn = 2 << g;
    const float cur = pr[C_BIN + ch];
    const float* st = a.state_pool_l + (size_t)b * 15 * 256 + ch;
    float* pso = a.out + O_POOLS + ((size_t)l * NSM + b) * 15 * 256 + ch;
    float total = cur;
    for (int j = 1; j < 15; ++j) pso[(j - 1) * 256] = st[j * 256];
    pso[14 * 256] = cur;
    for (int j = 1; j < wn; ++j) total += st[(15 - j) * 256];
    sh[256 + ch] = total / (float)wn - cur;
  }
  { const float s1 = wsum(yv); if (lane == 0) sh[512 + w] = s1; }
  __syncthreads();
  const float mean = (sh[512] + sh[513] + sh[514] + sh[515]) * (1.f / 256.f);
  const float xc = yv - mean;
  { const float s2 = wsum(xc * xc); if (lane == 0) sh[520 + w] = s2; }
  __syncthreads();
  if (tid < 256) {
    const float var = (sh[520] + sh[521] + sh[522] + sh[523]) * (1.f / 256.f);
    const float z = xc * rsqrtf(var + 1e-6f) * a.ln_g[tid] + a.ln_b[tid];
    sh[tid] = fsilu(z);
  }
  __syncthreads();
  if (tid < 256) {
    const int n = tid;
    float o = a.b_pw[n];
    for (int k = 0; k < 256; ++k) o = fmaf(sh[k], a.w_pw[k * 256 + n], o);
    a.mix_s[(size_t)b * 1024 + n] = f2bf(o * fsilu(pr[C_ZA + n]));
  } else {
    const int ch = tid - 256, g = ch >> 6, e = ch & 63;
    float o = 0.f;
    for (int c = 0; c < 64; ++c) o = fmaf(sh[256 + g * 64 + c], a.w_pool[(g * 64 + c) * 64 + e], o);
    a.mix_s[(size_t)b * 1024 + 256 + ch] = f2bf(o * a.pool_scale[ch] * fsilu(pr[C_ZB + ch]));
  }
  __syncthreads();
}
__device__ __forceinline__ void s3_item(const SampArgs& a, LAS unsigned char* lds, int n, int g) {
  const int tid = threadIdx.x, w = tid >> 6, lane = tid & 63, r = w & 3, l = a.l;
  const bool act = w < 4;
  const int pos = 2048, h = g * 4 + r;
  LAS float* qs = (LAS float*)lds;
  LAS float* pc = qs + 256;
  LAS float* ps = pc + 512;
  LAS float* imp = ps + 2048;
  LAS int* sel = (LAS int*)(imp + 64);
  const size_t bg = (size_t)n * 2 + g;
  if (act) qs[r * 64 + lane] = a.sq[(size_t)n * 512 + h * 64 + lane];
  __syncthreads();
  float o_c = 0.f, o_s = 0.f, o_w = 0.f;
  if (act) {
    float s[2];
#pragma unroll
    for (int j = 0; j < 2; ++j) {
      const int c = lane + 64 * j;
      float d = 0.f;
      if (c < 127) { const bf16_t* kr = a.kcS + (bg * 128 + c) * 64; for (int i = 0; i < 64; i += 2) { const unsigned kk = *(const unsigned*)(kr + i); d = fmaf(qs[r * 64 + i], bflo(kk), d); d = fmaf(qs[r * 64 + i + 1], bfhi(kk), d); } }
      s[j] = c < 127 ? d * 0.125f : NEGF;
    }
    const float m = wmax(fmaxf(s[0], s[1]));
    const float p0 = __expf(s[0] - m), p1 = (lane + 64 < 127) ? __expf(s[1] - m) : 0.f;
    const float sum = wsum(p0 + p1);
    pc[r * 128 + lane] = p0 / sum; pc[r * 128 + lane + 64] = p1 / sum;
  }
  __syncthreads();
  if (act) {
    const bf16_t* vr = a.vcST + (bg * 64 + lane) * 128;
    for (int c = 0; c < 127; ++c) o_c = fmaf(pc[r * 128 + c], bf2f(vr[c]), o_c);
  }
  if (tid < 33) {
    const int s = tid, lo = max(0, 4 * s - 1), hi = min(126, 4 * s + 3);
    float v = 0.f;
    for (int rr = 0; rr < 4; ++rr) for (int c = lo; c <= hi; ++c) v += pc[rr * 128 + c];
    const bool forced = (s == 0) || (s == 32) || (s == 31);
    imp[s] = forced ? 1e4f : v;
  }
  __syncthreads();
  if (tid == 0) {
    unsigned long long taken = 0ull;
    for (int k = 0; k < 8; ++k) {
      int best = -1; float bv = -3e38f;
      for (int s = 0; s < 33; ++s) if (!((taken >> s) & 1ull) && imp[s] > bv) { bv = imp[s]; best = s; }
      taken |= 1ull << best; sel[k] = best;
    }
  }
  __syncthreads();
  if (act) {
    float s8[8]; bool v8[8]; float m = NEGF;
#pragma unroll
    for (int k = 0; k < 8; ++k) {
      const int kpos = sel[k] * 64 + lane;
      v8[k] = kpos <= pos;
      float d = 0.f;
      if (v8[k]) {
        const float* kr;
        if (kpos < 2048) { const int page = a.page_table[n * 16 + (kpos >> 7)]; kr = a.cache_slc_l + ((size_t)page * 128 + (kpos & 127)) * 256 + g * 64; }
        else kr = a.srows + (size_t)n * 768 + 256 + g * 64;
        for (int i = 0; i < 64; i += 4) { const f32x4 kk = *(const f32x4*)(kr + i); d = fmaf(qs[r * 64 + i], kk[0], d); d = fmaf(qs[r * 64 + i + 1], kk[1], d); d = fmaf(qs[r * 64 + i + 2], kk[2], d); d = fmaf(qs[r * 64 + i + 3], kk[3], d); }
      }
      s8[k] = v8[k] ? d * 0.125f : NEGF;
      m = fmaxf(m, s8[k]);
    }
    m = wmax(m);
    float sum = 0.f;
#pragma unroll
    for (int k = 0; k < 8; ++k) { s8[k] = v8[k] ? __expf(s8[k] - m) : 0.f; sum += s8[k]; }
    sum = fmaxf(wsum(sum), 1e-30f);
#pragma unroll
    for (int k = 0; k < 8; ++k) ps[r * 512 + k * 64 + lane] = s8[k] / sum;
  }
  __syncthreads();
  if (act) {
    for (int k = 0; k < 8; ++k) {
      const int blk = sel[k];
      if (blk < 32) {
        const int page = a.page_table[n * 16 + (blk >> 1)];
        const float* vb = a.cache_slc_l + ((size_t)page * 128 + (blk & 1) * 64) * 256 + 128 + g * 64 + lane;
        for (int j = 0; j < 64; ++j) o_s = fmaf(ps[r * 512 + k * 64 + j], vb[(size_t)j * 256], o_s);
      } else {
        o_s = fmaf(ps[r * 512 + k * 64], a.srows[(size_t)n * 768 + 256 + 128 + g * 64 + lane], o_s);
      }
    }
  }
  __syncthreads();
  if (act) {
    float s4[4]; float m = NEGF;
#pragma unroll
    for (int k = 0; k < 4; ++k) {
      const int kpos = pos - 255 + lane + 64 * k;
      const float* kr = kpos < 2048 ? a.cache_win_l + ((size_t)n * 256 + (kpos - 1792)) * 256 + g * 64 : a.srows + (size_t)n * 768 + 512 + g * 64;
      float d = 0.f;
      for (int i = 0; i < 64; i += 4) { const f32x4 kk = *(const f32x4*)(kr + i); d = fmaf(qs[r * 64 + i], kk[0], d); d = fmaf(qs[r * 64 + i + 1], kk[1], d); d = fmaf(qs[r * 64 + i + 2], kk[2], d); d = fmaf(qs[r * 64 + i + 3], kk[3], d); }
      s4[k] = d * 0.125f;
      m = fmaxf(m, s4[k]);
    }
    m = wmax(m);
    float sum = 0.f;
#pragma unroll
    for (int k = 0; k < 4; ++k) { s4[k] = __expf(s4[k] - m); sum += s4[k]; }
    sum = wsum(sum);
#pragma unroll
    for (int k = 0; k < 4; ++k) ps[r * 512 + k * 64 + lane] = s4[k] / sum;
  }
  __syncthreads();
  if (act) {
    const float* vb = a.cache_win_l + ((size_t)n * 256 + 1) * 256 + 128 + g * 64 + lane;
    for (int j = 0; j < 255; ++j) o_w = fmaf(ps[r * 512 + j], vb[(size_t)j * 256], o_w);
    o_w = fmaf(ps[r * 512 + 255], a.srows[(size_t)n * 768 + 512 + 128 + g * 64 + lane], o_w);
    const float* gt = a.sgates + (size_t)n * 24;
    const float o = gt[h] * o_c + gt[8 + h] * o_s + gt[16 + h] * o_w;
    a.mix_s[(size_t)n * 1024 + 512 + h * 64 + lane] = f2bf(o * fsilu(a.sproj[(size_t)n * 3104 + C_ZC + h * 64 + lane]));
  }
  __syncthreads();
}

__global__ void __launch_bounds__(512, 2) k_s1(const bf16_t* xb_s, const float* ssq_s, const bf16_t* WinT, float* sproj) {
  for (int u = blockIdx.x; u < 49; u += gridDim.x) s1_unit(xb_s, ssq_s, WinT, sproj, u);
}
__global__ void __launch_bounds__(512, 2) k_s2(SampArgs a) {
  extern __shared__ __attribute__((aligned(16))) unsigned char shm[];
  for (int b = blockIdx.x; b < NSM; b += gridDim.x) s2_item(a, (LAS unsigned char*)shm, b);
}
struct CmpSArgs { const float* cache_cmp_l; const int* page_table; const bf16_t *W1T, *W2T; const float* cbias; bf16_t *kcS, *vcST; };
__global__ void __launch_bounds__(512, 2) k_cmps(CmpSArgs a) {
  extern __shared__ __attribute__((aligned(16))) unsigned char shm[];
  for (int it = blockIdx.x; it < 512; it += gridDim.x) {
    const int n = it >> 2, g = (it >> 1) & 1, kv = it & 1;
    CmpSrc src{a.cache_cmp_l, a.page_table + n * 16};
    compress_item((LAS unsigned char*)shm, src, g, kv, a.W1T + (size_t)kv * 128 * 1024, a.W2T + (size_t)kv * 4096, a.cbias + kv * 64,
                  a.kcS + ((size_t)n * 2 + g) * 128 * 64, a.vcST + ((size_t)n * 2 + g) * 64 * 128);
  }
}
__global__ void __launch_bounds__(512, 2) k_s3(SampArgs a) {
  extern __shared__ __attribute__((aligned(16))) unsigned char shm[];
  for (int it = blockIdx.x; it < 256; it += gridDim.x) s3_item(a, (LAS unsigned char*)shm, it >> 1, it & 1);
}
template <bool LAST> __global__ void __launch_bounds__(512, 2) k_s4(const bf16_t* mix_s, const bf16_t* WoutT, const float* xs, float* xs_out, bf16_t* xb_s, float* ssq_s) {
  for (int u = blockIdx.x; u < 16; u += gridDim.x) s4_unit<LAST>(mix_s, WoutT, xs, xs_out, xb_s, ssq_s, u);
}
__device__ __forceinline__ void wins_copy(const float* cache_win_l, float* out_l, int part, int nparts) {
  const size_t total4 = (size_t)NSM * 255 * 64;
  for (size_t i = (size_t)part * 512 + threadIdx.x; i < total4; i += (size_t)nparts * 512) {
    const size_t n = i / (255 * 64), rem = i % (255 * 64);
    *(f32x4*)(out_l + n * 65536 + rem * 4) = *(const f32x4*)(cache_win_l + n * 65536 + 256 + rem * 4);
  }
}
__global__ void __launch_bounds__(512, 2) k_wins(const float* cache_win_l, float* out_l) { wins_copy(cache_win_l, out_l, blockIdx.x, gridDim.x); }
}
static void sgemm(hipStream_t st, const float* A, int lda, const float* B, int ldb, float* C, int ldc, int M, int N, int K, const float* bias, const float* R, int ldr) {
  dim3 grid((N + 63) / 64, (M + 63) / 64);
  hipLaunchKernelGGL(gold::k_sgemm, grid, dim3(256), 0, st, A, lda, B, ldb, C, ldc, M, N, K, bias, R, ldr);
}

extern "C" void kernel_launch(void* const* d_in, const int* in_sizes, int n_in, void* d_out, int out_size, void* d_ws, size_t ws_size, hipStream_t stream) {
  using namespace gold;
  using fast::bf16_t;
  const float* x_prompt = (const float*)d_in[0];
  const float* x_sample = (const float*)d_in[1];
  const float* state_conv = (const float*)d_in[2];
  const float* state_pool = (const float*)d_in[3];
  const float* cache_win = (const float*)d_in[4];
  const float* cache_cmp = (const float*)d_in[5];
  const float* cache_slc = (const float*)d_in[6];
  const int* page_table = (const int*)d_in[7];
  const float* w_norm = (const float*)d_in[8];
  const float* w_in = (const float*)d_in[9];
  const float* w_out = (const float*)d_in[10];
  const float* w_dw = (const float*)d_in[11];
  const float* b_dw = (const float*)d_in[12];
  const float* ln_g = (const float*)d_in[13];
  const float* ln_b = (const float*)d_in[14];
  const float* w_pw = (const float*)d_in[15];
  const float* b_pw = (const float*)d_in[16];
  const float* w_pool = (const float*)d_in[17];
  const float* pool_scale = (const float*)d_in[18];
  const float* g_q = (const float*)d_in[19];
  const float* g_k = (const float*)d_in[20];
  const float* cmp_pe = (const float*)d_in[21];
  const float* cmp_w1 = (const float*)d_in[22];
  const float* cmp_w2 = (const float*)d_in[23];
  float* out = (float*)d_out;

  static bool inited = false;
  if (!inited) {
    inited = true;
    (void)hipFuncSetAttribute((const void*)fast::k_phaseD<false>, hipFuncAttributeMaxDynamicSharedMemorySize, fast::LDS_BYTES);
    (void)hipFuncSetAttribute((const void*)fast::k_s2, hipFuncAttributeMaxDynamicSharedMemorySize, fast::LDS_BYTES);
    (void)hipFuncSetAttribute((const void*)fast::k_s3, hipFuncAttributeMaxDynamicSharedMemorySize, fast::LDS_BYTES);
    (void)hipFuncSetAttribute((const void*)fast::k_cmps, hipFuncAttributeMaxDynamicSharedMemorySize, fast::LDS_BYTES);
    (void)hipFuncSetAttribute((const void*)fast::k_phaseA, hipFuncAttributeMaxDynamicSharedMemorySize, fast::LDS_BYTES);
    (void)hipFuncSetAttribute((const void*)fast::k_phaseB, hipFuncAttributeMaxDynamicSharedMemorySize, fast::LDS_BYTES);
    (void)hipFuncSetAttribute((const void*)fast::k_phaseC, hipFuncAttributeMaxDynamicSharedMemorySize, fast::LDS_BYTES);
    (void)hipFuncSetAttribute((const void*)fast::k_phaseD<true>, hipFuncAttributeMaxDynamicSharedMemorySize, fast::LDS_BYTES);
  }

  unsigned char* wsb = (unsigned char*)d_ws;
  size_t off = 0;
  auto takeb = [&](size_t bytes) { unsigned char* p = wsb + off; off += (bytes + 255) & ~(size_t)255; return p; };
  auto take = [&](size_t n) { return (float*)takeb(n * 4); };
  auto take16 = [&](size_t n) { return (bf16_t*)takeb(n * 2); };
  float* cs = take(2049 * 16);
  float* h = take((size_t)NTOK * 1024);
  float* proj = take((size_t)NTOK * D_IN);
  float* qbuf = take((size_t)NTOK * 512);
  float* rows = take((size_t)NTOK * 768);
  float* glu = take((size_t)NTOK * 256);
  float* gates = take((size_t)NTOK * 24);
  float* abuf = take((size_t)NTOK * 256);
  float* ya = take((size_t)NTOK * 256);
  float* yb = take((size_t)NTOK * 256);
  float* mix = take((size_t)NTOK * 1024);
  float* kc_p = take((size_t)8 * 128 * 128);
  float* vc_p = take((size_t)8 * 128 * 128);
  float* kc_s = take((size_t)128 * 128 * 128);
  float* vc_s = take((size_t)128 * 128 * 128);
  float* x1p = take((size_t)NPT * 1024);
  float* x1s = take((size_t)NSM * 1024);
  bf16_t* mixb = take16((size_t)NTOK * 1024);
  bf16_t* WoutT = take16((size_t)2 * 1024 * 1024);
  bf16_t* xb = take16((size_t)NTOK * 1024);
  float* ssq = take((size_t)NTOK * 16);
  bf16_t* qb = take16((size_t)NPT * 512);
  bf16_t* ksb = take16((size_t)NPT * 128);
  bf16_t* vsT = take16((size_t)NPT * 128);
  bf16_t* kwb = take16((size_t)NPT * 128);
  bf16_t* vwT = take16((size_t)NPT * 128);
  bf16_t* kcP = take16((size_t)8 * 2 * 128 * 64);
  bf16_t* vcPT = take16((size_t)8 * 2 * 128 * 64);
  bf16_t* szc = take16((size_t)NPT * 512);
  bf16_t* glub = take16((size_t)NPT * 256);
  bf16_t* binb = take16((size_t)NPT * 256);
  bf16_t* sza = take16((size_t)NPT * 256);
  bf16_t* szb = take16((size_t)NPT * 256);
  float* gatesf = take((size_t)NPT * 24);
  bf16_t* WinT = take16((size_t)2 * 3104 * 1024);
  bf16_t* WpwT = take16((size_t)2 * 256 * 256);
  bf16_t* WpoolT = take16((size_t)2 * 4 * 64 * 64);
  bf16_t* W1T = take16((size_t)2 * 2 * 128 * 1024);
  bf16_t* W2T = take16((size_t)2 * 2 * 64 * 64);
  float* cbias = take((size_t)2 * 2 * 64);
  float* sproj = take((size_t)NSM * 3104);
  float* sq = take((size_t)NSM * 512);
  float* srows = take((size_t)NSM * 768);
  float* sgates = take((size_t)NSM * 24);
  bf16_t* kcS = take16((size_t)NSM * 2 * 128 * 64);
  bf16_t* vcST = take16((size_t)NSM * 2 * 128 * 64);

  hipLaunchKernelGGL(k_rope_table, dim3((2049 * 8 + 255) / 256), dim3(256), 0, stream, cs);
  for (int l = 0; l < 2; ++l)
    hipLaunchKernelGGL(fast::k_transpose_w<0>, dim3(16, 16), dim3(256), 0, stream, w_out + (size_t)l * 1024 * 1024, 1024, (const float*)nullptr, WoutT + (size_t)l * 1024 * 1024, 1024, 1024);
  for (int l = 0; l < 2; ++l) {
    hipLaunchKernelGGL(fast::k_transpose_w<1>, dim3(49, 16), dim3(256), 0, stream, w_in + (size_t)l * 1024 * D_IN, D_IN, w_norm + l * 1024, WinT + (size_t)l * 3104 * 1024, 3104, 1024);
    hipLaunchKernelGGL(fast::k_transpose_w<0>, dim3(4, 4), dim3(256), 0, stream, w_pw + (size_t)l * 65536, 256, (const float*)nullptr, WpwT + (size_t)l * 65536, 256, 256);
    for (int g = 0; g < 4; ++g)
      hipLaunchKernelGGL(fast::k_transpose_w<0>, dim3(1, 1), dim3(256), 0, stream, w_pool + (size_t)(l * 4 + g) * 4096, 64, (const float*)nullptr, WpoolT + (size_t)(l * 4 + g) * 4096, 64, 64);
    for (int kv = 0; kv < 2; ++kv) {
      const float* w1 = cmp_w1 + (size_t)(l * 2 + kv) * 2048 * 64;
      bf16_t* dst = W1T + (size_t)(l * 2 + kv) * 128 * 1024;
      hipLaunchKernelGGL(fast::k_transpose_w<0>, dim3(1, 16), dim3(256), 0, stream, w1, 64, (const float*)nullptr, dst, 64, 1024);
      hipLaunchKernelGGL(fast::k_transpose_w<0>, dim3(1, 16), dim3(256), 0, stream, w1 + 1024 * 64, 64, (const float*)nullptr, dst + 64 * 1024, 64, 1024);
      hipLaunchKernelGGL(fast::k_transpose_w<0>, dim3(1, 1), dim3(256), 0, stream, cmp_w2 + (size_t)(l * 2 + kv) * 4096, 64, (const float*)nullptr, W2T + (size_t)(l * 2 + kv) * 4096, 64, 64);
    }
  }
  hipLaunchKernelGGL(fast::k_prep_cbias, dim3(4), dim3(64), 0, stream, cmp_pe, cmp_w1, cbias);
  hipLaunchKernelGGL(fast::k_prep_x, dim3(NTOK / 4), dim3(256), 0, stream, x_prompt, x_sample, xb, ssq);
  const float* xp = x_prompt; const float* xs = x_sample;
  for (int l = 0; l < 2; ++l) {
    float* xp_out = (l == 1) ? out + O_YP : x1p;
    float* xs_out = (l == 1) ? out + O_YS : x1s;
    hipLaunchKernelGGL(fast::k_s1, dim3(256), dim3(512), 0, stream, xb + (size_t)NPT * 1024, ssq + (size_t)NPT * 16, WinT + (size_t)l * 3104 * 1024, sproj);
    {
      fast::PhaseAArgs aa{};
      aa.epi.l = l; aa.epi.pad_ = 0; aa.epi.ssq = ssq; aa.epi.g_q = g_q + l * 64; aa.epi.g_k = g_k + l * 192; aa.epi.cs = cs;
      aa.epi.glu = glub; aa.epi.bin = binb; aa.epi.sza = sza; aa.epi.szb = szb; aa.epi.szc = szc; aa.epi.qb = qb;
      aa.epi.ks = ksb; aa.epi.vsT = vsT; aa.epi.kw = kwb; aa.epi.vwT = vwT; aa.epi.out = out;
      aa.xb = xb; aa.WinT = WinT + (size_t)l * 3104 * 1024;
      hipLaunchKernelGGL(fast::k_phaseA, dim3(256), dim3(512), fast::LDS_BYTES, stream, aa);
    }
    fast::SampArgs sa{};
    sa.l = l; sa.pad_ = 0; sa.sproj = sproj; sa.g_q = g_q + l * 64; sa.g_k = g_k + l * 192; sa.cs = cs;
    sa.state_conv_l = state_conv + (size_t)l * NSM * 30 * 256; sa.state_pool_l = state_pool + (size_t)l * NSM * 15 * 256;
    sa.w_dw = w_dw + l * 31 * 256; sa.b_dw = b_dw + l * 256; sa.ln_g = ln_g + l * 256; sa.ln_b = ln_b + l * 256; sa.w_pw = w_pw + (size_t)l * 65536; sa.b_pw = b_pw + l * 256;
    sa.w_pool = w_pool + (size_t)l * 4 * 4096; sa.pool_scale = pool_scale + l * 256;
    sa.cache_slc_l = cache_slc + (size_t)l * N_PHYS * 128 * 256; sa.cache_win_l = cache_win + (size_t)l * NSM * 65536; sa.page_table = page_table;
    sa.kcS = kcS; sa.vcST = vcST; sa.sq = sq; sa.srows = srows; sa.sgates = sgates; sa.mix_s = mixb + (size_t)NPT * 1024; sa.out = out;
    hipLaunchKernelGGL(fast::k_s2, dim3(128), dim3(512), fast::LDS_BYTES, stream, sa);
    {
      fast::CmpSArgs cs_{cache_cmp + (size_t)l * N_PHYS * 128 * 256, page_table, W1T + (size_t)l * 2 * 128 * 1024, W2T + (size_t)l * 2 * 4096, cbias + l * 128, kcS, vcST};
      hipLaunchKernelGGL(fast::k_cmps, dim3(256), dim3(512), fast::LDS_BYTES, stream, cs_);
    }
    hipLaunchKernelGGL(fast::k_wins, dim3(256), dim3(512), 0, stream, cache_win + (size_t)l * NSM * 65536, out + O_WINS + (size_t)l * NSM * 65536);
    {
      fast::PhaseBArgs ba{};
      ba.glu = glub; ba.bin = binb; ba.sza = sza; ba.szb = szb; ba.xb = xb; ba.ssq = ssq;
      ba.WpwT = WpwT + (size_t)l * 65536; ba.WpoolT = WpoolT + (size_t)l * 4 * 4096; ba.WgT = WinT + ((size_t)l * 3104 + 3072) * 1024;
      ba.W1T = W1T + (size_t)l * 2 * 128 * 1024; ba.W2T = W2T + (size_t)l * 2 * 4096; ba.cbias = cbias + l * 128;
      ba.w_dw = w_dw + l * 31 * 256; ba.b_dw = b_dw + l * 256; ba.ln_g = ln_g + l * 256; ba.ln_b = ln_b + l * 256; ba.b_pw = b_pw + l * 256; ba.pool_scale = pool_scale + l * 256;
      ba.cmp_rows_p = out + O_CMPP + (size_t)l * NPT * 256;
      ba.mixb = mixb; ba.kcP = kcP; ba.vcPT = vcPT; ba.gates = gatesf;
      hipLaunchKernelGGL(fast::k_phaseB, dim3(256), dim3(512), fast::LDS_BYTES, stream, ba);
    }
    hipLaunchKernelGGL(fast::k_s3, dim3(256), dim3(512), fast::LDS_BYTES, stream, sa);
    {
      fast::PhaseCArgs ca{qb, ksb, vsT, kwb, vwT, kcP, vcPT, szc, gatesf, mixb};
      hipLaunchKernelGGL(fast::k_phaseC, dim3(256), dim3(512), fast::LDS_BYTES, stream, ca);
    }
    fast::PhaseDArgs da{mixb, WoutT + (size_t)l * 1024 * 1024, xp, xp_out, xb, ssq};
    if (l == 1) hipLaunchKernelGGL(fast::k_phaseD<true>, dim3(256), dim3(512), fast::LDS_BYTES, stream, da);
    else hipLaunchKernelGGL(fast::k_phaseD<false>, dim3(256), dim3(512), fast::LDS_BYTES, stream, da);
    if (l == 1) hipLaunchKernelGGL(fast::k_s4<true>, dim3(16), dim3(512), 0, stream, (const bf16_t*)(mixb + (size_t)NPT * 1024), (const bf16_t*)(WoutT + (size_t)l * 1024 * 1024), xs, xs_out, xb + (size_t)NPT * 1024, ssq + (size_t)NPT * 16);
    else hipLaunchKernelGGL(fast::k_s4<false>, dim3(16), dim3(512), 0, stream, (const bf16_t*)(mixb + (size_t)NPT * 1024), (const bf16_t*)(WoutT + (size_t)l * 1024 * 1024), xs, xs_out, xb + (size_t)NPT * 1024, ssq + (size_t)NPT * 16);
    xp = xp_out; xs = xs_out;
  }
}
```

```cpp
#include <hip/hip_runtime.h>
#include <stdint.h>
#include <stdio.h>
__device__ __forceinline__ int tidx() { int t = threadIdx.x; asm volatile("" : "+v"(t)); return t; }

constexpr int NPT = 16384, NSM = 128, NTOK = NPT + NSM, SEQ = 2048;
constexpr int D_IN = 3096;
constexpr int C_AVAL = 0, C_AGATE = 256, C_ZA = 512, C_BIN = 768, C_ZB = 1024, C_Q = 1280, C_KV = 1792, C_GATE = 2560, C_ZC = 2584;
constexpr int N_PHYS = 2560;
constexpr float NEGF = -1e30f;

constexpr size_t O_YP = 0;
constexpr size_t O_YS = O_YP + (size_t)NPT * 1024;
constexpr size_t O_CONVP = O_YS + (size_t)NSM * 1024;
constexpr size_t O_POOLP = O_CONVP + 2ull * 8 * 30 * 256;
constexpr size_t O_WINP = O_POOLP + 2ull * 8 * 15 * 256;
constexpr size_t O_CMPP = O_WINP + 2ull * 8 * 256 * 256;
constexpr size_t O_SLCP = O_CMPP + 2ull * 8 * 2048 * 256;
constexpr size_t O_CONVS = O_SLCP + 2ull * 8 * 2048 * 256;
constexpr size_t O_POOLS = O_CONVS + 2ull * 128 * 30 * 256;
constexpr size_t O_WINS = O_POOLS + 2ull * 128 * 15 * 256;
constexpr size_t O_CMPS = O_WINS + 2ull * 128 * 256 * 256;
constexpr size_t O_SLCS = O_CMPS + 2ull * 128 * 256;
constexpr size_t O_END = O_SLCS + 2ull * 128 * 256;


namespace pg8 {
#define PG8_LAS __attribute__((address_space(3)))
typedef unsigned short bf16_t;
typedef short bf16x8 __attribute__((ext_vector_type(8)));
typedef float f32x4 __attribute__((ext_vector_type(4)));
typedef unsigned u32x4 __attribute__((ext_vector_type(4)));
constexpr int BM = 256, BK = 64, HALF = 128, HTB = HALF * BK * 2  , STAGE_BYTES = 8 * HTB, NXCD = 8, WGM = 8;

__host__ __device__ __forceinline__ int lds_byte(int r, int c) { const int st = (r >> 4) * 2 + (c >> 5), rr = r & 15, cc = c & 31, ob = rr * 64 + cc * 2; return st * 1024 + (ob ^ (((ob >> 9) & 1) << 5)); }
__host__ __device__ __forceinline__ void stage_rc(int b, int& R, int& C) { const int st = b / 1024, sb = b % 1024, swz = sb ^ (((sb >> 9) & 1) << 5); R = (st >> 1) * 16 + swz / 64; C = (st & 1) * 32 + (swz % 64) / 2; }
__host__ __device__ __forceinline__ int perm32(int rho) { const int n = rho >> 4, i = rho & 15; return 8 * (i >> 2) + 4 * n + (i & 3); }

struct Unit { int pm, pn; };
struct Gemm { const bf16_t* A; const bf16_t* Bt; int M, N, K; };

struct StaticOrder {
    int nM, nN, nwg, G, c;
    __host__ __device__ void init(int M, int N, int G_, int c_) { nM = M / BM; nN = N / BM; nwg = nM * nN; G = G_; c = c_; }
    __host__ __device__ bool next(int i, Unit& u) const {
        const long L = (long)i * G + c; if (L >= nwg) return false;
        int wgid = (int)L; { const int q = nwg / NXCD, r = nwg % NXCD, xcd = wgid % NXCD, off = wgid / NXCD; wgid = (xcd < r ? xcd * (q + 1) : r * (q + 1) + (xcd - r) * q) + off; }
        const int nig = WGM * nN, gid = wgid / nig, fm = gid * WGM, gsz = (nM - fm) < WGM ? (nM - fm) : WGM;
        u.pm = fm + ((wgid % nig) % gsz); u.pn = (wgid % nig) / gsz; return true;
    }
    __device__ __forceinline__ void a_ready(const Unit&) const {}
    __device__ __forceinline__ void done(const Unit&) const {}
};
__device__ __forceinline__ unsigned cvt_pk_bf16(float lo, float hi) { unsigned r; asm volatile("v_cvt_pk_bf16_f32 %0, %1, %2" : "=v"(r) : "v"(lo), "v"(hi)); return r; }

template <class Epi, class Sched, bool STAMP = false>
__device__ __forceinline__ void gemm_phase(PG8_LAS unsigned char* lds, const Gemm g, const Sched& S, const Epi& E, unsigned long long* stamps) {
    const int tid = tidx(), wid = __builtin_amdgcn_readfirstlane(tid >> 6), lane = tid & 63, wr = wid >> 2, wc = wid & 3, fr = lane & 15, fq = lane >> 4;
    const int K = g.K, nt = K / BK;
    int ts_lo = 0, ts_hi = 0, nts = 0; const unsigned long long rt_entry = STAMP ? (unsigned long long)wall_clock64() : 0ull;
#define PG8_STAMP() do { if (STAMP && wid == 0 && nts < 64) { const unsigned long long _c = (unsigned long long)clock64(); \
        ts_lo = (lane == nts) ? (int)(unsigned)_c : ts_lo; ts_hi = (lane == nts) ? (int)(unsigned)(_c >> 32) : ts_hi; ++nts; } } while (0)
    PG8_STAMP();
    unsigned voffA[2], voffB[2];
#pragma unroll
    for (int i = 0; i < 2; ++i) { int R, C; stage_rc(tid * 16 + i * 8192, R, C); const int Rb = Epi::PERM ? ((R & ~31) + perm32(R & 31)) : R;
        voffA[i] = (unsigned)(R * K + C) * 2u; voffB[i] = (unsigned)(Rb * K + C) * 2u; }
    const size_t kstep = (size_t)(BK * 2);
    const size_t hstep = (size_t)HALF * K * 2;
    const size_t tstep = 2 * hstep;
    const unsigned ldsw = (unsigned)wid * 1024u;
    const int aoff = lds_byte(wr * 64 + fr, fq * 8), boff = lds_byte(wc * 32 + fr, fq * 8);
#define PG8_SA(b, h) (((b) * 2 + (h)) * HTB)
#define PG8_SB(b, h) ((4 + (b) * 2 + (h)) * HTB)
#define PG8_STAGE(bufoff, gbase, voff) do { _Pragma("unroll") for (int _i = 0; _i < 2; ++_i) \
        __builtin_amdgcn_global_load_lds((const unsigned*)((const char*)(gbase) + (voff)[_i]), (PG8_LAS unsigned*)(lds + (bufoff) + ldsw + _i * 8192), 16, 0, 0); } while (0)
#define PG8_LDA(dst, b, h) do { _Pragma("unroll") for (int m = 0; m < 4; ++m) _Pragma("unroll") for (int k = 0; k < 2; ++k) dst[m][k] = *(const PG8_LAS bf16x8*)(lds + PG8_SA(b, h) + aoff + m * 2048 + k * 1024); } while (0)
#define PG8_LDB(dst, b, h) do { _Pragma("unroll") for (int n = 0; n < 2; ++n) _Pragma("unroll") for (int k = 0; k < 2; ++k) dst[n][k] = *(const PG8_LAS bf16x8*)(lds + PG8_SB(b, h) + boff + n * 2048 + k * 1024); } while (0)
#define PG8_MMA(ai, bj, At, Bt) do { __builtin_amdgcn_s_setprio(1); _Pragma("unroll") for (int m = 0; m < 4; ++m) _Pragma("unroll") for (int n = 0; n < 2; ++n) _Pragma("unroll") for (int k = 0; k < 2; ++k) \
        acc[ai][bj][m][n] = __builtin_amdgcn_mfma_f32_16x16x32_bf16(Bt[n][k], At[m][k], acc[ai][bj][m][n], 0, 0, 0); __builtin_amdgcn_s_setprio(0); } while (0)
#define PG8_WAIT_V(n) asm volatile("s_waitcnt vmcnt(" #n ")" ::: "memory")
#define PG8_WAIT_L(n) asm volatile("s_waitcnt lgkmcnt(" #n ")" ::: "memory")
#define PG8_BAR __builtin_amdgcn_s_barrier()
#define PG8_SCHED __builtin_amdgcn_sched_barrier(0)
    Unit cur, nxt; int ui = 0;
    if (!S.next(0, cur)) return;
    f32x4 acc[2][2][4][2];
#pragma unroll
    for (int a = 0; a < 2; ++a)
#pragma unroll
        for (int b = 0; b < 2; ++b)
#pragma unroll
            for (int m = 0; m < 4; ++m)
#pragma unroll
                for (int n = 0; n < 2; ++n) acc[a][b][m][n] = (f32x4){0.f, 0.f, 0.f, 0.f};
    bf16x8 At[4][2], B0[2][2], B1[2][2];
    const char* cA = (const char*)g.A + (size_t)cur.pm * tstep; const char* cB = (const char*)g.Bt + (size_t)cur.pn * tstep;
    S.a_ready(cur);
    PG8_STAGE(PG8_SB(0, 0), cB, voffB); PG8_STAGE(PG8_SA(0, 0), cA, voffA); PG8_STAGE(PG8_SB(0, 1), cB + hstep, voffB); PG8_STAGE(PG8_SA(0, 1), cA + hstep, voffA);
    if (wr == 1) PG8_BAR;
    PG8_WAIT_V(4); PG8_BAR;
    PG8_STAGE(PG8_SB(1, 0), cB + kstep, voffB); PG8_STAGE(PG8_SA(1, 0), cA + kstep, voffA); PG8_STAGE(PG8_SB(1, 1), cB + hstep + kstep, voffB);
    PG8_WAIT_V(6); PG8_BAR;
    PG8_STAMP();
    for (;;) {
        const bool has_next = S.next(ui + 1, nxt);
        const char* nA = has_next ? (const char*)g.A + (size_t)nxt.pm * tstep : cA; const char* nB = has_next ? (const char*)g.Bt + (size_t)nxt.pn * tstep : cB;
        for (int t = 0; t < nt; t += 2) {
            const bool last = (t == nt - 2);
            const char* a1 = cA + (size_t)(t + 1) * kstep;
            const char* a2 = last ? nA : cA + (size_t)(t + 2) * kstep; const char* b2 = last ? nB : cB + (size_t)(t + 2) * kstep;
            const char* a3 = a2 + kstep; const char* b3 = b2 + kstep;
            if (last && has_next) S.a_ready(nxt);
            PG8_LDB(B0, 0, 0); PG8_SCHED; PG8_LDA(At, 0, 0); PG8_STAGE(PG8_SA(1, 1), a1 + hstep, voffA);
            PG8_WAIT_L(8); PG8_BAR; PG8_WAIT_L(0); PG8_MMA(0, 0, At, B0); PG8_BAR; PG8_SCHED;
            PG8_LDB(B1, 0, 1); PG8_STAGE(PG8_SB(0, 0), b2, voffB);
            PG8_BAR; PG8_WAIT_L(0); PG8_MMA(0, 1, At, B1); PG8_BAR;
            PG8_LDA(At, 0, 1); PG8_STAGE(PG8_SA(0, 0), a2, voffA);
            PG8_BAR; PG8_WAIT_L(0); PG8_MMA(1, 0, At, B0); PG8_BAR; PG8_SCHED;
            PG8_STAGE(PG8_SB(0, 1), b2 + hstep, voffB);
            PG8_WAIT_V(6); PG8_BAR; PG8_MMA(1, 1, At, B1); PG8_BAR;
            PG8_LDB(B0, 1, 0); PG8_SCHED; PG8_LDA(At, 1, 0); PG8_STAGE(PG8_SA(0, 1), a2 + hstep, voffA);
            PG8_WAIT_L(8); PG8_BAR; PG8_WAIT_L(0); PG8_MMA(0, 0, At, B0); PG8_BAR; PG8_SCHED;
            PG8_LDB(B1, 1, 1); PG8_STAGE(PG8_SB(1, 0), b3, voffB);
            PG8_BAR; PG8_WAIT_L(0); PG8_MMA(0, 1, At, B1); PG8_BAR;
            PG8_LDA(At, 1, 1); PG8_STAGE(PG8_SA(1, 0), a3, voffA);
            PG8_BAR; PG8_WAIT_L(0); PG8_MMA(1, 0, At, B0); PG8_BAR; PG8_SCHED;
            PG8_STAGE(PG8_SB(1, 1), b3 + hstep, voffB);
            PG8_WAIT_V(6); PG8_BAR; PG8_MMA(1, 1, At, B1); PG8_BAR;
        }
        PG8_STAMP();
        if constexpr (!Epi::AFTER_DRAIN) { E(acc, cur, wr, wc, fr, fq); S.done(cur); }
        PG8_STAMP();
        if (!has_next) break;
#pragma unroll
        for (int a = 0; a < 2; ++a)
#pragma unroll
            for (int b = 0; b < 2; ++b)
#pragma unroll
                for (int m = 0; m < 4; ++m)
#pragma unroll
                    for (int n = 0; n < 2; ++n) acc[a][b][m][n] = (f32x4){0.f, 0.f, 0.f, 0.f};
        cur = nxt; cA = nA; cB = nB; ++ui;
    }
    PG8_WAIT_V(0);
    if (wr == 0) PG8_BAR;
    PG8_BAR;
    if constexpr (Epi::AFTER_DRAIN) { E.fused(acc, cur, wr, wc, fr, fq, lds, wid, lane); S.done(cur); }
    PG8_STAMP();
    if (STAMP && wid == 0) { stamps[lane] = lane < nts ? (((unsigned long long)(unsigned)ts_hi << 32) | (unsigned)ts_lo) : 0ull;
        if (lane == 62) stamps[62] = rt_entry; if (lane == 63) stamps[63] = (unsigned long long)wall_clock64(); }
#undef PG8_STAMP
#undef PG8_SA
#undef PG8_SB
#undef PG8_STAGE
#undef PG8_LDA
#undef PG8_LDB
#undef PG8_MMA
#undef PG8_WAIT_V
#undef PG8_WAIT_L
#undef PG8_BAR
#undef PG8_SCHED
}
}
#define XB_TMO      128
#define XB_XCNT(j)  (256  + 64 * (j))
#define XB_XSUB(j)  (1280 + 64 * (j))
#define XB_XGEN(j)  (2304 + 64 * (j))
#define XB_TOP      3328
#define XB_TOPGEN   3392
#define XCD_BAR_WORDS 3456
#define XB_SPIN_CAP (1u << 18)
#ifndef LAS
#define LAS __attribute__((address_space(3)))
#endif

__device__ __forceinline__ unsigned xb_ld(unsigned* p)              { return __hip_atomic_load(p, __ATOMIC_RELAXED, __HIP_MEMORY_SCOPE_AGENT); }
__device__ __forceinline__ unsigned xb_add(unsigned* p, unsigned v) { return __hip_atomic_fetch_add(p, v, __ATOMIC_RELAXED, __HIP_MEMORY_SCOPE_AGENT); }
__device__ __forceinline__ unsigned xb_xcc_id() { return (unsigned)__builtin_amdgcn_s_getreg((3 << 11) | 20) & 0xFu; }
#define XB_SPIN(cond, bar) do { unsigned _sp = 0; while (cond) { __builtin_amdgcn_s_sleep(1); \
    if ((++_sp & 255u) == 0u) { if (xb_ld(&(bar)[XB_TMO])) break; if (_sp > XB_SPIN_CAP) { atomicAdd(&(bar)[XB_TMO], 1u); break; } } } } while (0)

struct XcdBarrier {
    unsigned* bar; unsigned x;
    volatile LAS unsigned* st;
};

__device__ __forceinline__ XcdBarrier xcd_barrier_post(unsigned* bar, volatile LAS unsigned* st) {
    XcdBarrier b; b.bar = bar; b.x = xb_xcc_id(); b.st = st;
    if (threadIdx.x == 0) (void)xb_add(&bar[XB_XCNT(b.x)], 1u);
    return b;
}
__device__ __forceinline__ void xcd_barrier_complete(unsigned* bar, unsigned x, unsigned& nloc, unsigned& nx) {
    const unsigned G = gridDim.x * gridDim.y * gridDim.z;
    unsigned sum, cnt, mine, sp = 0u;
    for (;;) {
        sum = 0u; cnt = 0u; mine = 0u;
#pragma unroll
        for (unsigned j = 0; j < 16; ++j) { const unsigned c = xb_ld(&bar[XB_XCNT(j)]); sum += c; cnt += (c > 0u) ? 1u : 0u; mine = (j == x) ? c : mine; }
        if (sum == G) break;
        __builtin_amdgcn_s_sleep(1);
        if ((++sp & 255u) == 0u) { if (xb_ld(&bar[XB_TMO])) break; if (sp > XB_SPIN_CAP) { atomicAdd(&bar[XB_TMO], 1u); break; } }
    }
    nloc = mine > 0u ? mine : 1u; nx = cnt > 0u ? cnt : 1u;
}

__device__ __forceinline__ void xcd_barrier(const XcdBarrier& b) {
    asm volatile("s_waitcnt vmcnt(0)" ::: "memory");
    __syncthreads();
    if (threadIdx.x == 0) {
        unsigned* bar = b.bar;
        __builtin_amdgcn_s_waitcnt(0);
        unsigned nloc = b.st[0], nx = b.st[1];
        if (nloc == 0u) { xcd_barrier_complete(bar, b.x, nloc, nx); b.st[0] = nloc; b.st[1] = nx; }
        const unsigned old = xb_add(&bar[XB_XSUB(b.x)], 1u);
        const unsigned gen = old / nloc;
        if (old + 1u == (gen + 1u) * nloc) {
            __builtin_amdgcn_fence(__ATOMIC_RELEASE, "agent");
            asm volatile("s_waitcnt vmcnt(0)" ::: "memory");
            const unsigned og = xb_add(&bar[XB_TOP], 1u);
            const unsigned tg = og / nx;
            if (og + 1u == (tg + 1u) * nx) xb_add(&bar[XB_TOPGEN], 1u);
            else XB_SPIN(xb_ld(&bar[XB_TOPGEN]) == tg, bar);
            __builtin_amdgcn_fence(__ATOMIC_ACQUIRE, "agent");
            xb_add(&bar[XB_XGEN(b.x)], 1u);
            asm volatile("s_waitcnt vmcnt(0)" ::: "memory");
        } else {
            XB_SPIN(xb_ld(&bar[XB_XGEN(b.x)]) == gen, bar);
            __builtin_amdgcn_fence(__ATOMIC_ACQUIRE, "agent");
            asm volatile("s_waitcnt vmcnt(0)" ::: "memory");
        }
    }
    __syncthreads();
}

namespace fast {
using pg8::bf16_t; using pg8::bf16x8; using pg8::f32x4; using pg8::Unit; using pg8::cvt_pk_bf16;
typedef unsigned u32x2 __attribute__((ext_vector_type(2)));
typedef float f32x2 __attribute__((ext_vector_type(2)));
typedef unsigned u32x4 __attribute__((ext_vector_type(4)));
#ifndef LAS
#define LAS __attribute__((address_space(3)))
#endif
constexpr int LDS_BYTES = 144 * 1024;
__device__ __forceinline__ float bf2f(bf16_t b) { return __uint_as_float(((unsigned)b) << 16); }
__device__ __forceinline__ float bflo(unsigned u) { return __uint_as_float(u << 16); }
__device__ __forceinline__ float bfhi(unsigned u) { return __uint_as_float(u & 0xffff0000u); }
__device__ __forceinline__ bf16_t f2bf(float f) { return (bf16_t)(cvt_pk_bf16(f, 0.f) & 0xffffu); }

__global__ void k_bridge_mix(const float* mix, bf16_t* mixb, size_t n) {
  size_t i = ((size_t)blockIdx.x * blockDim.x + tidx()) * 2;
  if (i < n) *(unsigned*)(mixb + i) = cvt_pk_bf16(mix[i], mix[i + 1]);
}

template <bool LAST> struct EpiD {
  static constexpr bool PERM = true, AFTER_DRAIN = false;
  const float* resid; float* xout; bf16_t* xb; float* ssq;
  __device__ __forceinline__ void operator()(const f32x4 (&acc)[2][2][4][2], const Unit& u, int wr_, int wc_, int fr_, int fq_) const {
    const int tz = tidx(), wid_ = tz >> 6, wr = wid_ >> 2, wc = wid_ & 3, fr = tz & 15, fq = (tz >> 4) & 3;
    const int row0 = u.pm * 256 + wr * 64 + fr, col0 = u.pn * 256 + wc * 32 + 8 * fq;
#pragma unroll
    for (int ai = 0; ai < 2; ++ai)
#pragma unroll
      for (int m = 0; m < 4; ++m) {
        const size_t row = (size_t)(row0 + ai * 128 + m * 16);
        float ss = 0.f;
#pragma unroll
        for (int bj = 0; bj < 2; ++bj) {
          const size_t o = row * 1024 + col0 + bj * 128;
          const f32x4 r0 = *(const f32x4*)(resid + o), r1 = *(const f32x4*)(resid + o + 4);
          const f32x4 v0 = acc[ai][bj][m][0] + r0, v1 = acc[ai][bj][m][1] + r1;
          *(f32x4*)(xout + o) = v0; *(f32x4*)(xout + o + 4) = v1;
          if (!LAST) {
            u32x4 pk; pk.x = cvt_pk_bf16(v0[0], v0[1]); pk.y = cvt_pk_bf16(v0[2], v0[3]); pk.z = cvt_pk_bf16(v1[0], v1[1]); pk.w = cvt_pk_bf16(v1[2], v1[3]);
            *(u32x4*)(xb + o) = pk;
            ss += v0[0] * v0[0] + v0[1] * v0[1] + v0[2] * v0[2] + v0[3] * v0[3] + v1[0] * v1[0] + v1[1] * v1[1] + v1[2] * v1[2] + v1[3] * v1[3];
          }
        }
        if (!LAST) {
          ss += __shfl_xor(ss, 16); ss += __shfl_xor(ss, 32);
          if (fq == 0) ssq[row * 16 + u.pn * 4 + wc] = ss;
        }
      }
  }
};
struct PhaseDArgs { const bf16_t* mixb; const bf16_t* WoutT; const float* resid; float* xout; bf16_t* xb; float* ssq; };
template <bool LAST> __device__ __forceinline__ void phaseD(LAS unsigned char* lds, const PhaseDArgs& a) {
  pg8::Gemm g{a.mixb, a.WoutT, NPT, 1024, 1024};
  pg8::StaticOrder S; S.init(NPT, 1024, gridDim.x, blockIdx.x);
  EpiD<LAST> E{a.resid, a.xout, a.xb, a.ssq};
  pg8::gemm_phase<EpiD<LAST>, pg8::StaticOrder, false>(lds, g, S, E, nullptr);
}
template <bool LAST> __global__ void __launch_bounds__(512, 2) k_phaseD(PhaseDArgs a) {
  extern __shared__ __attribute__((aligned(16))) unsigned char shm[];
  phaseD<LAST>((LAS unsigned char*)shm, a);
}

__device__ __forceinline__ int win_logical_col(int np) {
  if (np >= 3072) return np < 3096 ? C_GATE + (np - 3072) : -1;
  const int tile = np >> 8, j = np & 255, bj = j >> 7, wc = (j >> 5) & 3, i = j & 31, jj = j & 127;
  switch (tile) {
    case 0: case 1: return (bj ? C_AGATE : C_AVAL) + tile * 128 + jj;
    case 2: return C_ZA + j;
    case 3: return C_BIN + j;
    case 4: return C_ZB + j;
    case 5: case 6: return C_Q + ((tile - 5) * 4 + wc) * 64 + bj * 32 + i;
    case 7: case 8: case 9: return C_KV + (tile - 7) * 256 + wc * 64 + bj * 32 + i;
    default: return C_ZC + (tile - 10) * 256 + j;
  }
}
template <int MODE  >
__global__ void __launch_bounds__(256) k_transpose_w(const float* src, int ld_src, const float* scale, bf16_t* dst, int N, int K) {
  __shared__ float t[64][65];
  const int n0 = blockIdx.x * 64, k0 = blockIdx.y * 64, tid = tidx();
  for (int i = tid; i < 4096; i += 256) {
    const int k = i >> 6, n = i & 63;
    int col = MODE == 1 ? win_logical_col(n0 + n) : (n0 + n);
    float v = 0.f;
    if (n0 + n < N && col >= 0) { v = src[(size_t)(k0 + k) * ld_src + col]; if (scale) v *= scale[k0 + k]; }
    t[k][n] = v;
  }
  __syncthreads();
  for (int i = tid; i < 2048; i += 256) {
    const int n = i >> 5, k = (i & 31) * 2;
    if (n0 + n < N) *(unsigned*)(dst + (size_t)(n0 + n) * K + k0 + k) = cvt_pk_bf16(t[k][n], t[k + 1][n]);
  }
}

__global__ void k_bridge_q(const float* qbuf, bf16_t* qb, size_t n) {
  size_t i = ((size_t)blockIdx.x * blockDim.x + tidx()) * 2;
  const float sc = 0.125f * 1.4426950408889634f;
  if (i < n) *(unsigned*)(qb + i) = cvt_pk_bf16(qbuf[i] * sc, qbuf[i + 1] * sc);
}
__global__ void k_bridge_kv(const float* rows, int br, bf16_t* kk, bf16_t* vT) {
  size_t i = (size_t)blockIdx.x * blockDim.x + tidx();
  if (i >= (size_t)NPT * 128) return;
  const int d = (int)(i & 63), g = (int)((i >> 6) & 1); const size_t tok = i >> 7; const int b = (int)(tok / SEQ), t = (int)(tok % SEQ);
  kk[(((size_t)b * 2 + g) * SEQ + t) * 64 + d] = f2bf(rows[tok * 768 + br * 256 + g * 64 + d]);
  vT[(((size_t)b * 2 + g) * 64 + d) * SEQ + t] = f2bf(rows[tok * 768 + br * 256 + 128 + g * 64 + d]);
}
__global__ void k_bridge_kc(const float* kc, const float* vc, bf16_t* kcP, bf16_t* vcPT, int nseq) {
  size_t i = (size_t)blockIdx.x * blockDim.x + tidx();
  if (i >= (size_t)nseq * 128 * 128) return;
  const int d = (int)(i & 63), g = (int)((i >> 6) & 1), c = (int)((i >> 7) & 127), b = (int)(i >> 14);
  const float kv = c < 127 ? kc[i] : 0.f, vv = c < 127 ? vc[i] : 0.f;
  kcP[(((size_t)b * 2 + g) * 128 + c) * 64 + d] = f2bf(kv);
  vcPT[(((size_t)b * 2 + g) * 64 + d) * 128 + c] = f2bf(vv);
}
__global__ void k_bridge_silu(const float* proj, int col0, int ncol, bf16_t* dst, size_t ntok) {
  size_t i = (size_t)blockIdx.x * blockDim.x + tidx();
  if (i >= ntok * ncol) return;
  const size_t tok = i / ncol; const int c = (int)(i % ncol);
  const float z = proj[tok * D_IN + col0 + c];
  dst[i] = f2bf(z / (1.f + __expf(-z)));
}

#ifndef SKIPCOND
#define SKIPCOND __any(mine)
#endif
typedef float f32x16 __attribute__((ext_vector_type(16)));
typedef short bf16x4 __attribute__((ext_vector_type(4)));
struct PhaseCArgs { const bf16_t *qb, *ks, *vsT, *kw, *vwT, *kcP, *vcPT, *szc; const float* gates; bf16_t* mixb; };

__device__ __forceinline__ f32x16 qk_tile(const bf16_t* krows, const bf16x8 (&qf)[4], int c32, int hh) {
  f32x16 s;
#pragma unroll
  for (int i = 0; i < 16; ++i) s[i] = 0.f;
  const bf16_t* kp = krows + (size_t)c32 * 64 + 8 * hh;
  bf16x8 kf[4];
#pragma unroll
  for (int ks = 0; ks < 4; ++ks) kf[ks] = *(const bf16x8*)(kp + 16 * ks);
#pragma unroll
  for (int ks = 0; ks < 4; ++ks) s = __builtin_amdgcn_mfma_f32_32x32x16_bf16(kf[ks], qf[ks], s, 0, 0, 0);
  return s;
}
__device__ __forceinline__ void pv_tile(f32x16 (&o)[2], const bf16_t* vT, int ldv, const f32x16& p, int c32, int hh) {
#pragma unroll
  for (int s = 0; s < 2; ++s) {
    union { bf16x8 v; unsigned u[4]; } pf;
#pragma unroll
    for (int j = 0; j < 4; ++j) pf.u[j] = cvt_pk_bf16(p[8 * s + 2 * j], p[8 * s + 2 * j + 1]);
#pragma unroll
    for (int dt = 0; dt < 2; ++dt) {
      const bf16_t* vp = vT + (size_t)(32 * dt + c32) * ldv + 16 * s + 4 * hh;
      union { bf16x8 v; bf16x4 h[2]; } vf;
      vf.h[0] = *(const bf16x4*)(vp);
      vf.h[1] = *(const bf16x4*)(vp + 8);
      o[dt] = __builtin_amdgcn_mfma_f32_32x32x16_bf16(vf.v, pf.v, o[dt], 0, 0, 0);
    }
  }
}

__device__ __forceinline__ void attn_item(const PhaseCArgs& a, LAS unsigned char* lds, int b, int qbi, int g) {
  const int tid = tidx(), w = tid >> 6, lane = tid & 63, c32 = lane & 31, hh = lane >> 5;
  const int t0 = qbi * 64, tl = c32 >> 2, r = c32 & 3;
  const int t = t0 + 8 * w + tl, head = 4 * g + r;
  const size_t tok = (size_t)b * SEQ + t;
  const size_t bg = (size_t)b * 2 + g;
  LAS float* impl = (LAS float*)lds + w * 256;
  bf16x8 qf[4];
  {
    const bf16_t* qp = a.qb + (tok * 8 + head) * 64 + 8 * hh;
#pragma unroll
    for (int ks = 0; ks < 4; ++ks) qf[ks] = *(const bf16x8*)(qp + 16 * ks);
  }
  const float* gt = a.gates + tok * 24;
  const float gate_c = gt[head], gate_s = gt[8 + head], gate_w = gt[16 + head];
  f32x16 ot[2];
  unsigned selmask;
  {
    const bf16_t* kc = a.kcP + bg * 128 * 64;
    const bf16_t* vc = a.vcPT + bg * 64 * 128;
    const int clim = ((t - 31) >> 4) - 4 * hh;
    float m = NEGF, sum = 0.f;
#pragma unroll 1
    for (int kt = 0; kt < 4; ++kt) {
      f32x16 sc = qk_tile(kc + kt * 32 * 64, qf, c32, hh);
      const int cl = clim - 32 * kt;
      float mt = NEGF;
#pragma unroll
      for (int i = 0; i < 16; ++i) { const bool valid = ((i & 3) + 8 * (i >> 2)) <= cl; sc[i] = valid ? sc[i] : NEGF; mt = fmaxf(mt, sc[i]); }
      mt = fmaxf(mt, __shfl_xor(mt, 32));
      const float mn = fmaxf(m, mt);
      float ps = 0.f;
#pragma unroll
      for (int i = 0; i < 16; ++i) ps += (sc[i] > -1e29f) ? __builtin_amdgcn_exp2f(sc[i] - mn) : 0.f;
      sum = sum * __builtin_amdgcn_exp2f(m - mn) + ps; m = mn;
    }
    sum += __shfl_xor(sum, 32);
    const float inv = sum > 0.f ? 1.f / sum : 0.f;
    f32x16 oc[2];
#pragma unroll
    for (int i = 0; i < 16; ++i) { oc[0][i] = 0.f; oc[1][i] = 0.f; }
    float prev = 0.f;
#pragma unroll 1
    for (int kt = 0; kt < 4; ++kt) {
      f32x16 sc = qk_tile(kc + kt * 32 * 64, qf, c32, hh);
      const int cl = clim - 32 * kt;
#pragma unroll
      for (int i = 0; i < 16; ++i) { const bool valid = ((i & 3) + 8 * (i >> 2)) <= cl; sc[i] = valid ? __builtin_amdgcn_exp2f(sc[i] - m) * inv : 0.f; }
#pragma unroll
      for (int ii = 0; ii < 4; ++ii) {
        const float q4 = (sc[4 * ii] + sc[4 * ii + 1]) + (sc[4 * ii + 2] + sc[4 * ii + 3]);
        const float pp = __shfl_xor(sc[4 * ii + 3], 32);
        float v = q4 + (hh ? pp : prev);
        prev = pp;
        v += __shfl_xor(v, 1); v += __shfl_xor(v, 2);
        if (r == 0) impl[tl * 32 + 2 * (4 * kt + ii) + hh] = v;
      }
      pv_tile(oc, vc + kt * 32, 128, sc, c32, hh);
    }
#pragma unroll
    for (int i = 0; i < 16; ++i) { ot[0][i] = gate_c * oc[0][i]; ot[1][i] = gate_c * oc[1][i]; }
  }
  __syncthreads();
#ifndef NO_SEL
  {
    const int tl2 = lane >> 3, sg = lane & 7, cur = qbi;
    float scv[32];
#pragma unroll
    for (int s = 0; s < 32; ++s) {
      const float v = impl[tl2 * 32 + s];
      const bool forced = (s == 0) || (s == cur) || (s == cur - 1);
      scv[s] = (s <= cur) ? (forced ? 1e4f : v) : -1e4f;
    }
    unsigned mk = 0u;
#pragma unroll
    for (int e = 0; e < 4; ++e) {
      const int s = sg * 4 + e;
      float mine = 0.f;
#pragma unroll
      for (int s2 = 0; s2 < 32; ++s2) mine = (s2 == s) ? scv[s2] : mine;
      int rank = 0;
#pragma unroll
      for (int s2 = 0; s2 < 32; ++s2) rank += (scv[s2] > mine || (scv[s2] == mine && s2 < s)) ? 1 : 0;
      if (rank < 8 && s <= cur) mk |= 1u << s;
    }
    mk |= __shfl_xor(mk, 1); mk |= __shfl_xor(mk, 2); mk |= __shfl_xor(mk, 4);
    selmask = __shfl(mk, tl * 8);
  }
#else
  selmask = 0xffffffffu;
#endif
  __syncthreads();
#ifndef NO_SLC
  {
    float m = NEGF, l = 0.f;
    f32x16 o[2];
#pragma unroll
    for (int i = 0; i < 16; ++i) { o[0][i] = 0.f; o[1][i] = 0.f; }
    const bf16_t* kbase = a.ks + bg * SEQ * 64;
    const bf16_t* vbase = a.vsT + bg * 64 * SEQ;
#pragma unroll 1
    for (int kt = 0; kt < 2 * qbi + 2; ++kt) {
      const bool mine = (selmask >> (kt >> 1)) & 1u;
      if (SKIPCOND) {
        const int key0 = 32 * kt;
        f32x16 s = qk_tile(kbase + (size_t)key0 * 64, qf, c32, hh);
        float mt = NEGF;
        const int klim = mine ? (t - key0 - 4 * hh) : -1;
#pragma unroll
        for (int i = 0; i < 16; ++i) {
          const bool valid = ((i & 3) + 8 * (i >> 2)) <= klim;
          s[i] = valid ? s[i] : NEGF;
          mt = fmaxf(mt, s[i]);
        }
        mt = fmaxf(mt, __shfl_xor(mt, 32));
        const float mn = fmaxf(m, mt);
        const float alpha = __builtin_amdgcn_exp2f(m - mn);
        float ps = 0.f;
#pragma unroll
        for (int i = 0; i < 16; ++i) { const float p = (s[i] > -1e29f) ? __builtin_amdgcn_exp2f(s[i] - mn) : 0.f; s[i] = p; ps += p; }
        l = l * alpha + ps; m = mn;
#pragma unroll
        for (int i = 0; i < 16; ++i) { o[0][i] *= alpha; o[1][i] *= alpha; }
        pv_tile(o, vbase + key0, SEQ, s, c32, hh);
      }
    }
    l += __shfl_xor(l, 32);
    const float sc = gate_s / l;
#pragma unroll
    for (int i = 0; i < 16; ++i) { ot[0][i] += sc * o[0][i]; ot[1][i] += sc * o[1][i]; }
  }
#endif
#ifndef NO_WIN
  {
    float m = NEGF, l = 0.f;
    f32x16 o[2];
#pragma unroll
    for (int i = 0; i < 16; ++i) { o[0][i] = 0.f; o[1][i] = 0.f; }
    const bf16_t* kbase = a.kw + bg * SEQ * 64;
    const bf16_t* vbase = a.vwT + bg * 64 * SEQ;
    const int tmin = t0 + 8 * w, tmax = tmin + 7;
    int kt_lo = (tmin - 255) >> 5; if (kt_lo < 0) kt_lo = 0;
    const int kt_hi = tmax >> 5;
#pragma unroll 1
    for (int kt = kt_lo; kt <= kt_hi; ++kt) {
      const int key0 = 32 * kt;
      f32x16 s = qk_tile(kbase + (size_t)key0 * 64, qf, c32, hh);
      float mt = NEGF;
      const int khi = t - key0 - 4 * hh, klo = khi - 256;
#pragma unroll
      for (int i = 0; i < 16; ++i) {
        const int kc_ = (i & 3) + 8 * (i >> 2);
        const bool valid = (kc_ <= khi) && (kc_ > klo);
        s[i] = valid ? s[i] : NEGF;
        mt = fmaxf(mt, s[i]);
      }
      mt = fmaxf(mt, __shfl_xor(mt, 32));
      const float mn = fmaxf(m, mt);
      const float alpha = __builtin_amdgcn_exp2f(m - mn);
      float ps = 0.f;
#pragma unroll
      for (int i = 0; i < 16; ++i) { const float p = (s[i] > -1e29f) ? __builtin_amdgcn_exp2f(s[i] - mn) : 0.f; s[i] = p; ps += p; }
      l = l * alpha + ps; m = mn;
#pragma unroll
      for (int i = 0; i < 16; ++i) { o[0][i] *= alpha; o[1][i] *= alpha; }
      pv_tile(o, vbase + key0, SEQ, s, c32, hh);
    }
    l += __shfl_xor(l, 32);
    const float sc = gate_w / l;
#pragma unroll
    for (int i = 0; i < 16; ++i) { ot[0][i] += sc * o[0][i]; ot[1][i] += sc * o[1][i]; }
  }
#endif
#pragma unroll
  for (int dt = 0; dt < 2; ++dt)
#pragma unroll
    for (int ii = 0; ii < 4; ++ii) {
      const int d0 = 32 * dt + 8 * ii + 4 * hh;
      const u32x2 z = *(const u32x2*)(a.szc + tok * 512 + head * 64 + d0);
      u32x2 ov;
      ov.x = cvt_pk_bf16(ot[dt][4 * ii] * bflo(z.x), ot[dt][4 * ii + 1] * bfhi(z.x));
      ov.y = cvt_pk_bf16(ot[dt][4 * ii + 2] * bflo(z.y), ot[dt][4 * ii + 3] * bfhi(z.y));
      *(u32x2*)(a.mixb + tok * 1024 + 512 + head * 64 + d0) = ov;
    }
}
__device__ __forceinline__ void phaseC(LAS unsigned char* lds, const PhaseCArgs& a) {
  for (int p = blockIdx.x; p < 256; p += gridDim.x) {
    const int b = p >> 5, g = (p >> 4) & 1, qlo = p & 15;
    attn_item(a, lds, b, qlo, g);
    __syncthreads();
    attn_item(a, lds, b, 31 - qlo, g);
    __syncthreads();
  }
}
__global__ void __launch_bounds__(512, 2) k_phaseC(PhaseCArgs a) {
  extern __shared__ __attribute__((aligned(16))) unsigned char shm[];
  phaseC((LAS unsigned char*)shm, a);
}

__global__ void k_bridge_cvt(const float* src, int ld_src, int col0, int ncol, bf16_t* dst, size_t ntok) {
  size_t i = (size_t)blockIdx.x * blockDim.x + tidx();
  if (i >= ntok * ncol) return;
  const size_t tok = i / ncol; const int c = (int)(i % ncol);
  dst[i] = f2bf(src[tok * ld_src + col0 + c]);
}
__global__ void __launch_bounds__(256) k_prep_x(const float* xp, const float* xs, bf16_t* xb, float* ssq) {
  const int row = blockIdx.x * 4 + (tidx() >> 6), lane = tidx() & 63;
  if (row >= NTOK) return;
  const float* x = row < NPT ? xp + (size_t)row * 1024 : xs + (size_t)(row - NPT) * 1024;
#pragma unroll
  for (int j = 0; j < 4; ++j) {
    const f32x4 v = *(const f32x4*)(x + j * 256 + lane * 4);
    u32x2 pk; pk.x = cvt_pk_bf16(v[0], v[1]); pk.y = cvt_pk_bf16(v[2], v[3]);
    *(u32x2*)(xb + (size_t)row * 1024 + j * 256 + lane * 4) = pk;
    float ss = v[0] * v[0] + v[1] * v[1] + v[2] * v[2] + v[3] * v[3];
    ss += __shfl_xor(ss, 1); ss += __shfl_xor(ss, 2); ss += __shfl_xor(ss, 4); ss += __shfl_xor(ss, 8);
    if ((lane & 15) == 0) ssq[(size_t)row * 16 + j * 4 + (lane >> 4)] = ss;
  }
}
__global__ void __launch_bounds__(64) k_prep_cbias(const float* pe, const float* w1, float* cbias) {
  const int lk = blockIdx.x, e = tidx();
  const float* pp = pe + (size_t)lk * 2048; const float* ww = w1 + (size_t)lk * 2048 * 64;
  float acc = 0.f;
  for (int k = 0; k < 2048; ++k) acc = fmaf(pp[k], ww[(size_t)k * 64 + e], acc);
  cbias[lk * 64 + e] = acc;
}
__device__ __forceinline__ float rinv_from_ssq(const float* ssq, size_t row) {
  const f32x4* p = (const f32x4*)(ssq + row * 16);
  const f32x4 a = p[0], b = p[1], c = p[2], d = p[3];
  const float s = ((a[0] + a[1]) + (a[2] + a[3])) + ((b[0] + b[1]) + (b[2] + b[3])) + ((c[0] + c[1]) + (c[2] + c[3])) + ((d[0] + d[1]) + (d[2] + d[3]));
  return rsqrtf(s * (1.f / 1024.f) + 1e-6f);
}
__device__ __forceinline__ f32x4 mfma16(bf16x8 a, bf16x8 b, f32x4 c) { return __builtin_amdgcn_mfma_f32_16x16x32_bf16(a, b, c, 0, 0, 0); }
__device__ __forceinline__ float fsilu(float z) { return z / (1.f + __expf(-z)); }
__device__ __forceinline__ float fsigmoid(float z) { return 1.f / (1.f + __expf(-z)); }

struct PhaseBArgs {
  const bf16_t *glu, *bin, *sza, *szb, *xb; const float* ssq;
  const bf16_t *WpwT, *WpoolT, *WgT, *W1T, *W2T; const float* cbias;
  const float *w_dw, *b_dw, *ln_g, *ln_b, *b_pw, *pool_scale;
  const float* cmp_rows_p;
  bf16_t *mixb, *kcP, *vcPT; float* gates;
};

__device__ __forceinline__ void conv_item(const PhaseBArgs& a, LAS unsigned char* lds, int b, int chunk) {
  const int tid = tidx(), w = tid >> 6, lane = tid & 63;
  const int t0 = chunk * 128;
  for (int i = tid; i < 158 * 32; i += 512) {
    const int row = i >> 5, ch = i & 31, t = t0 - 30 + row;
    u32x4 v = {0u, 0u, 0u, 0u};
    if (t >= 0) v = *(const u32x4*)(a.glu + ((size_t)b * SEQ + t) * 256 + ch * 8);
    *(LAS u32x4*)(lds + row * 512 + ch * 16) = v;
  }
  __syncthreads();
  const int cp = tid & 127, tg = tid >> 7;
  float acc0[32], acc1[32];
  {
    const f32x2 bd = *(const f32x2*)(a.b_dw + 2 * cp);
#pragma unroll
    for (int j = 0; j < 32; ++j) { acc0[j] = bd.x; acc1[j] = bd.y; }
    float w0[31], w1[31];
#pragma unroll
    for (int k = 0; k < 31; ++k) { const f32x2 wv = *(const f32x2*)(a.w_dw + k * 256 + 2 * cp); w0[k] = wv.x; w1[k] = wv.y; }
    const LAS unsigned* wp = (const LAS unsigned*)(lds + (tg * 32) * 512 + cp * 4);
#pragma unroll
    for (int rr = 0; rr < 62; ++rr) {
      const unsigned xv = wp[rr * 128];
      const float x0 = bflo(xv), x1 = bfhi(xv);
#pragma unroll
      for (int k = 0; k < 31; ++k) {
        const int j = rr - k;
        if (j >= 0 && j < 32) { acc0[j] = fmaf(w0[k], x0, acc0[j]); acc1[j] = fmaf(w1[k], x1, acc1[j]); }
      }
    }
  }
  __syncthreads();
#pragma unroll
  for (int j = 0; j < 32; ++j) *(LAS f32x2*)(lds + (tg * 32 + j) * 1088 + cp * 8) = (f32x2){acc0[j], acc1[j]};
  __syncthreads();
  {
    const int tok = tid >> 2, q = tid & 3;
    f32x4 v[16]; float s = 0.f;
#pragma unroll
    for (int i = 0; i < 16; ++i) { v[i] = *(const LAS f32x4*)(lds + tok * 1088 + (4 * i + q) * 16); s += (v[i][0] + v[i][1]) + (v[i][2] + v[i][3]); }
    s += __shfl_xor(s, 1); s += __shfl_xor(s, 2);
    const float mean = s * (1.f / 256.f);
    float s2 = 0.f;
#pragma unroll
    for (int i = 0; i < 16; ++i) { v[i] = v[i] - mean; s2 += (v[i][0] * v[i][0] + v[i][1] * v[i][1]) + (v[i][2] * v[i][2] + v[i][3] * v[i][3]); }
    s2 += __shfl_xor(s2, 1); s2 += __shfl_xor(s2, 2);
    const float rstd = rsqrtf(s2 * (1.f / 256.f) + 1e-6f);
#pragma unroll
    for (int i = 0; i < 16; ++i) {
      const int c0 = (4 * i + q) * 4;
      const f32x4 gg = *(const f32x4*)(a.ln_g + c0), bb = *(const f32x4*)(a.ln_b + c0);
      f32x4 z = v[i] * rstd * gg + bb;
      u32x2 pk; pk.x = cvt_pk_bf16(fsilu(z[0]), fsilu(z[1])); pk.y = cvt_pk_bf16(fsilu(z[2]), fsilu(z[3]));
      *(LAS u32x2*)(lds + tok * 1088 + c0 * 2) = pk;
    }
  }
  __syncthreads();
  {
    const int fr = lane & 15, fq = lane >> 4;
    f32x4 acc[16];
#pragma unroll
    for (int nt = 0; nt < 16; ++nt) acc[nt] = (f32x4){0.f, 0.f, 0.f, 0.f};
#pragma unroll 2
    for (int ks = 0; ks < 8; ++ks) {
      const bf16x8 af = *(const LAS bf16x8*)(lds + (16 * w + fr) * 1088 + (ks * 32 + fq * 8) * 2);
#pragma unroll
      for (int nt = 0; nt < 16; ++nt) {
        const bf16x8 bf = *(const bf16x8*)(a.WpwT + (size_t)(nt * 16 + fr) * 256 + ks * 32 + fq * 8);
        acc[nt] = mfma16(bf, af, acc[nt]);
      }
    }
    const size_t tok = (size_t)b * SEQ + t0 + 16 * w + fr;
#pragma unroll
    for (int nt = 0; nt < 16; ++nt) {
      const int c0 = nt * 16 + 4 * fq;
      const f32x4 bp = *(const f32x4*)(a.b_pw + c0);
      const u32x2 z = *(const u32x2*)(a.sza + tok * 256 + c0);
      u32x2 ov;
      ov.x = cvt_pk_bf16((acc[nt][0] + bp[0]) * bflo(z.x), (acc[nt][1] + bp[1]) * bfhi(z.x));
      ov.y = cvt_pk_bf16((acc[nt][2] + bp[2]) * bflo(z.y), (acc[nt][3] + bp[3]) * bfhi(z.y));
      *(u32x2*)(a.mixb + tok * 1024 + c0) = ov;
    }
  }
  __syncthreads();
}

__device__ __forceinline__ void pool_item(const PhaseBArgs& a, LAS unsigned char* lds, int b, int chunk) {
  const int tid = tidx(), w = tid >> 6, lane = tid & 63;
  const int t0 = chunk * 128;
  constexpr int DOFF = 143 * 512;
  for (int i = tid; i < 143 * 32; i += 512) {
    const int row = i >> 5, ch = i & 31, t = t0 - 15 + row;
    u32x4 v = {0u, 0u, 0u, 0u};
    if (t >= 0) v = *(const u32x4*)(a.bin + ((size_t)b * SEQ + t) * 256 + ch * 8);
    *(LAS u32x4*)(lds + row * 512 + ch * 16) = v;
  }
  __syncthreads();
  {
    const int cp = tid & 127, tg = tid >> 7, grp = cp >> 5, wn = 2 << grp;
    const LAS unsigned* wp = (const LAS unsigned*)(lds + cp * 4);
    const int r0 = 15 + tg * 32;
    float run0 = 0.f, run1 = 0.f;
    for (int i = 1; i < wn; ++i) { const unsigned xv = wp[(r0 - i) * 128]; run0 += bflo(xv); run1 += bfhi(xv); }
#pragma unroll 4
    for (int j = 0; j < 32; ++j) {
      const int rr = r0 + j, t = t0 + tg * 32 + j;
      const unsigned xv = wp[rr * 128];
      const float x0 = bflo(xv), x1 = bfhi(xv);
      run0 += x0; run1 += x1;
      const float icnt = 1.f / (float)min(wn, t + 1);
      const unsigned dv = cvt_pk_bf16(run0 * icnt - x0, run1 * icnt - x1);
      *(LAS unsigned*)(lds + DOFF + (tg * 32 + j) * 528 + cp * 4) = dv;
      const unsigned xo = wp[(rr - wn + 1) * 128];
      run0 -= bflo(xo); run1 -= bfhi(xo);
    }
  }
  __syncthreads();
  {
    const int fr = lane & 15, fq = lane >> 4;
    const size_t tok = (size_t)b * SEQ + t0 + 16 * w + fr;
#pragma unroll
    for (int g = 0; g < 4; ++g) {
      f32x4 acc[4];
#pragma unroll
      for (int nt = 0; nt < 4; ++nt) acc[nt] = (f32x4){0.f, 0.f, 0.f, 0.f};
#pragma unroll
      for (int ks = 0; ks < 2; ++ks) {
        const bf16x8 af = *(const LAS bf16x8*)(lds + DOFF + (16 * w + fr) * 528 + (g * 64 + ks * 32 + fq * 8) * 2);
#pragma unroll
        for (int nt = 0; nt < 4; ++nt) {
          const bf16x8 bf = *(const bf16x8*)(a.WpoolT + (size_t)(g * 64 + nt * 16 + fr) * 64 + ks * 32 + fq * 8);
          acc[nt] = mfma16(bf, af, acc[nt]);
        }
      }
#pragma unroll
      for (int nt = 0; nt < 4; ++nt) {
        const int c0 = g * 64 + nt * 16 + 4 * fq;
        const f32x4 sc = *(const f32x4*)(a.pool_scale + c0);
        const u32x2 z = *(const u32x2*)(a.szb + tok * 256 + c0);
        u32x2 ov;
        ov.x = cvt_pk_bf16(acc[nt][0] * sc[0] * bflo(z.x), acc[nt][1] * sc[1] * bfhi(z.x));
        ov.y = cvt_pk_bf16(acc[nt][2] * sc[2] * bflo(z.y), acc[nt][3] * sc[3] * bfhi(z.y));
        *(u32x2*)(a.mixb + tok * 1024 + 256 + c0) = ov;
      }
    }
  }
  __syncthreads();
}

__device__ __forceinline__ void gates_item(const PhaseBArgs& a, int chunk) {
  const int tid = tidx(), w = tid >> 6, lane = tid & 63, fr = lane & 15, fq = lane >> 4;
  const size_t row = (size_t)chunk * 128 + 16 * w + fr;
  f32x4 acc[2] = {(f32x4){0.f, 0.f, 0.f, 0.f}, (f32x4){0.f, 0.f, 0.f, 0.f}};
  const bf16_t* ap = a.xb + row * 1024 + fq * 8;
  const bf16_t* bp = a.WgT + (size_t)fr * 1024 + fq * 8;
#pragma unroll 8
  for (int ks = 0; ks < 32; ++ks) {
    const bf16x8 af = *(const bf16x8*)(ap + ks * 32);
    const bf16x8 b0 = *(const bf16x8*)(bp + ks * 32), b1 = *(const bf16x8*)(bp + 16 * 1024 + ks * 32);
    acc[0] = mfma16(b0, af, acc[0]); acc[1] = mfma16(b1, af, acc[1]);
  }
  const float rinv = rinv_from_ssq(a.ssq, row);
#pragma unroll
  for (int nt = 0; nt < 2; ++nt) {
    const int c0 = nt * 16 + 4 * fq;
    if (c0 < 24) {
      f32x4 o;
#pragma unroll
      for (int e = 0; e < 4; ++e) o[e] = fsigmoid(acc[nt][e] * rinv);
      *(f32x4*)(a.gates + row * 24 + c0) = o;
    }
  }
}

struct CmpSrc { const float* base; const int* pages; };
__device__ __forceinline__ const float* cmp_row_ptr(const CmpSrc& s, int pos) {
  if (s.pages) return s.base + ((size_t)s.pages[pos >> 7] * 128 + (pos & 127)) * 256;
  return s.base + (size_t)pos * 256;
}
__device__ __forceinline__ float gelu_tanh_f(float x) {
  const float u = 0.7978845608028654f * (x + 0.044715f * x * x * x);
  const float e = __expf(2.f * u);
  const float th = 1.f - 2.f / (e + 1.f);
  return 0.5f * x * (1.f + th);
}
__device__ __forceinline__ void compress_item(LAS unsigned char* lds, const CmpSrc& src, int g, int kv, const bf16_t* W1T  , const bf16_t* W2T  ,
                                              const float* cbias  , bf16_t* kc_out  , bf16_t* vcT_out  ) {
  const int tid = tidx(), w = tid >> 6, lane = tid & 63, fr = lane & 15, fq = lane >> 4;
  constexpr int BST = 272;
  constexpr int BBUF = 128 * BST;
  constexpr int POFF = 2 * BBUF;
  const float* arow = cmp_row_ptr(src, (16 * w + fr) * 16) + kv * 128 + g * 64 + fq * 8;
  const bf16_t* bsrc = W1T + (size_t)(tid >> 2) * 1024 + (tid & 3) * 32;
  LAS unsigned char* bdst = lds + (tid >> 2) * BST + (tid & 3) * 64;
  f32x4 acc[8];
#pragma unroll
  for (int nt = 0; nt < 8; ++nt) acc[nt] = (f32x4){0.f, 0.f, 0.f, 0.f};
  u32x4 breg[4]; f32x4 areg[8];
#pragma unroll
  for (int i = 0; i < 4; ++i) breg[i] = *(const u32x4*)(bsrc + i * 8);
#pragma unroll
  for (int i = 0; i < 4; ++i) { areg[2 * i] = *(const f32x4*)(arow + (i >> 1) * 256 + (i & 1) * 32); areg[2 * i + 1] = *(const f32x4*)(arow + (i >> 1) * 256 + (i & 1) * 32 + 4); }
#pragma unroll 1
  for (int c = 0; c < 8; ++c) {
    LAS unsigned char* bb = bdst + (c & 1) * BBUF;
#pragma unroll
    for (int i = 0; i < 4; ++i) *(LAS u32x4*)(bb + i * 16) = breg[i];
    bf16x8 af[4];
#pragma unroll
    for (int i = 0; i < 4; ++i) {
      union { bf16x8 v; unsigned u[4]; } t;
      t.u[0] = cvt_pk_bf16(areg[2 * i][0], areg[2 * i][1]); t.u[1] = cvt_pk_bf16(areg[2 * i][2], areg[2 * i][3]);
      t.u[2] = cvt_pk_bf16(areg[2 * i + 1][0], areg[2 * i + 1][1]); t.u[3] = cvt_pk_bf16(areg[2 * i + 1][2], areg[2 * i + 1][3]);
      af[i] = t.v;
    }
    if (c < 7) {
#pragma unroll
      for (int i = 0; i < 4; ++i) breg[i] = *(const u32x4*)(bsrc + (c + 1) * 128 + i * 8);
#pragma unroll
      for (int i = 0; i < 4; ++i) { const float* ap = arow + (2 * (c + 1) + (i >> 1)) * 256 + (i & 1) * 32; areg[2 * i] = *(const f32x4*)ap; areg[2 * i + 1] = *(const f32x4*)(ap + 4); }
    }
    __syncthreads();
    const LAS unsigned char* br = lds + (c & 1) * BBUF + fr * BST + fq * 16;
#pragma unroll
    for (int i = 0; i < 4; ++i)
#pragma unroll
      for (int nt = 0; nt < 8; ++nt) {
        const bf16x8 bf = *(const LAS bf16x8*)(br + nt * 16 * BST + i * 64);
        acc[nt] = mfma16(bf, af[i], acc[nt]);
      }
  }
#pragma unroll
  for (int nt = 0; nt < 8; ++nt) *(LAS f32x4*)(lds + POFF + (16 * w + fr) * 528 + (nt * 16 + 4 * fq) * 4) = acc[nt];
  __syncthreads();
  {
    const int i = 16 * w + fr, i1 = i < 127 ? i + 1 : 127;
    f32x4 o[4];
#pragma unroll
    for (int nt = 0; nt < 4; ++nt) o[nt] = (f32x4){0.f, 0.f, 0.f, 0.f};
#pragma unroll
    for (int ks = 0; ks < 2; ++ks) {
      const int k0 = ks * 32 + fq * 8;
      union { bf16x8 v; unsigned u[4]; } hf;
#pragma unroll
      for (int h2 = 0; h2 < 2; ++h2) {
        const f32x4 pa = *(const LAS f32x4*)(lds + POFF + i * 528 + (k0 + 4 * h2) * 4);
        const f32x4 pb = *(const LAS f32x4*)(lds + POFF + i1 * 528 + (64 + k0 + 4 * h2) * 4);
        const f32x4 cb = *(const f32x4*)(cbias + k0 + 4 * h2);
        const f32x4 x = pa + pb + cb;
        hf.u[2 * h2] = cvt_pk_bf16(gelu_tanh_f(x[0]), gelu_tanh_f(x[1]));
        hf.u[2 * h2 + 1] = cvt_pk_bf16(gelu_tanh_f(x[2]), gelu_tanh_f(x[3]));
      }
#pragma unroll
      for (int nt = 0; nt < 4; ++nt) {
        const bf16x8 bf = *(const bf16x8*)(W2T + (size_t)(nt * 16 + fr) * 64 + k0);
        o[nt] = mfma16(bf, hf.v, o[nt]);
      }
    }
    const bool real = i < 127;
#pragma unroll
    for (int nt = 0; nt < 4; ++nt) {
      const int c0 = nt * 16 + 4 * fq;
      const float v0 = real ? o[nt][0] : 0.f, v1 = real ? o[nt][1] : 0.f, v2 = real ? o[nt][2] : 0.f, v3 = real ? o[nt][3] : 0.f;
      if (kv == 0) { u32x2 pk; pk.x = cvt_pk_bf16(v0, v1); pk.y = cvt_pk_bf16(v2, v3); *(u32x2*)(kc_out + (size_t)i * 64 + c0) = pk; }
      else { vcT_out[(size_t)(c0 + 0) * 128 + i] = f2bf(v0); vcT_out[(size_t)(c0 + 1) * 128 + i] = f2bf(v1); vcT_out[(size_t)(c0 + 2) * 128 + i] = f2bf(v2); vcT_out[(size_t)(c0 + 3) * 128 + i] = f2bf(v3); }
    }
  }
  __syncthreads();
}

__device__ __forceinline__ void phaseB(LAS unsigned char* lds, const PhaseBArgs& a) {
  const int G = gridDim.x, wg = blockIdx.x;
#ifndef NO_CONV
  for (int it = wg; it < 128; it += G) conv_item(a, lds, it >> 4, it & 15);
#endif
#ifndef NO_POOL
  for (int it = (wg + G - 128 % G) % G; it < 128; it += G) pool_item(a, lds, it >> 4, it & 15);
#endif
#ifndef NO_CMPR
  for (int it = (wg + G - 128 % G) % G; it < 32; it += G) {
    const int b = it >> 2, g = (it >> 1) & 1, kv = it & 1;
    CmpSrc src{a.cmp_rows_p + (size_t)b * SEQ * 256, nullptr};
    compress_item(lds, src, g, kv, a.W1T + (size_t)kv * 128 * 1024, a.W2T + (size_t)kv * 4096, a.cbias + kv * 64,
                  a.kcP + ((size_t)b * 2 + g) * 128 * 64, a.vcPT + ((size_t)b * 2 + g) * 64 * 128);
  }
#endif
#ifndef NO_GATES
  for (int it = (wg + G - 160 % G) % G; it < 128; it += G) gates_item(a, it);
#endif
}
__global__ void __launch_bounds__(512, 2) k_phaseB(PhaseBArgs a) {
  extern __shared__ __attribute__((aligned(16))) unsigned char shm[];
  phaseB((LAS unsigned char*)shm, a);
}

struct EpiA {
  static constexpr bool PERM = true, AFTER_DRAIN = false;
  int l; int pad_;
  const float* ssq; const float* g_q; const float* g_k; const float* cs;
  bf16_t *glu, *bin, *sza, *szb, *szc, *qb, *ks, *vsT, *kw, *vwT; float* out;
  __device__ __forceinline__ void norm_rope(f32x4 (&v)[2][2], const float* gain, int t, int fq) const {
    float ss = 0.f;
#pragma unroll
    for (int bj = 0; bj < 2; ++bj)
#pragma unroll
      for (int n = 0; n < 2; ++n) ss += (v[bj][n][0] * v[bj][n][0] + v[bj][n][1] * v[bj][n][1]) + (v[bj][n][2] * v[bj][n][2] + v[bj][n][3] * v[bj][n][3]);
    ss += __shfl_xor(ss, 16); ss += __shfl_xor(ss, 32);
    const float rn = rsqrtf(ss * (1.f / 64.f) + 1e-6f);
#pragma unroll
    for (int bj = 0; bj < 2; ++bj)
#pragma unroll
      for (int n = 0; n < 2; ++n) { const f32x4 gg = *(const f32x4*)(gain + 32 * bj + 8 * fq + 4 * n); v[bj][n] = v[bj][n] * rn * gg; }
#pragma unroll
    for (int n = 0; n < 2; ++n) {
      const f32x4 c0 = *(const f32x4*)(cs + t * 16 + 8 * n), c1 = *(const f32x4*)(cs + t * 16 + 8 * n + 4);
      const float cc[4] = {c0[0], c0[2], c1[0], c1[2]}, sn[4] = {c0[1], c0[3], c1[1], c1[3]};
#pragma unroll
      for (int e = 0; e < 4; ++e) {
        const float y = v[0][n][e], pr = __shfl_xor(y, 16);
        const float r0 = y * cc[e] - pr * sn[e], r1 = y * cc[e] + pr * sn[e];
        v[0][n][e] = fq == 0 ? r0 : (fq == 1 ? r1 : y);
      }
    }
  }
  __device__ __forceinline__ void operator()(const f32x4 (&acc)[2][2][4][2], const Unit& u, int wr_, int wc_, int fr_, int fq_) const {
    const int tz = tidx(), wid_ = tz >> 6, wr = wid_ >> 2, wc = wid_ & 3, fr = tz & 15, fq = (tz >> 4) & 3;
    const int pn = u.pn;
    const int row0 = u.pm * 256 + wr * 64 + fr;
    const int jc = 32 * wc + 8 * fq;
#pragma unroll
    for (int ai = 0; ai < 2; ++ai)
#pragma unroll
      for (int m = 0; m < 4; ++m) {
        const int row = row0 + ai * 128 + m * 16;
        const size_t tok = (size_t)row;
        const int b = row >> 11, t = row & 2047;
        float rinv;
        { const f32x4 p = *(const f32x4*)(ssq + tok * 16 + fq * 4); float sq = (p[0] + p[1]) + (p[2] + p[3]); sq += __shfl_xor(sq, 16); sq += __shfl_xor(sq, 32); rinv = rsqrtf(sq * (1.f / 1024.f) + 1e-6f); }
        f32x4 v[2][2];
#pragma unroll
        for (int bj = 0; bj < 2; ++bj)
#pragma unroll
          for (int n = 0; n < 2; ++n) v[bj][n] = acc[ai][bj][m][n] * rinv;
        if (pn < 2) {
          const int c = pn * 128 + jc;
          f32x4 o0, o1;
#pragma unroll
          for (int e = 0; e < 4; ++e) { o0[e] = v[0][0][e] * fsigmoid(v[1][0][e]); o1[e] = v[0][1][e] * fsigmoid(v[1][1][e]); }
          u32x4 pk; pk.x = cvt_pk_bf16(o0[0], o0[1]); pk.y = cvt_pk_bf16(o0[2], o0[3]); pk.z = cvt_pk_bf16(o1[0], o1[1]); pk.w = cvt_pk_bf16(o1[2], o1[3]);
          *(u32x4*)(glu + tok * 256 + c) = pk;
          if (t >= 2018) { float* dst = out + O_CONVP + ((size_t)(l * 8 + b) * 30 + (t - 2018)) * 256 + c; *(f32x4*)dst = o0; *(f32x4*)(dst + 4) = o1; }
        } else if (pn == 3) {
#pragma unroll
          for (int bj = 0; bj < 2; ++bj) {
            const int c = 128 * bj + jc;
            u32x4 pk; pk.x = cvt_pk_bf16(v[bj][0][0], v[bj][0][1]); pk.y = cvt_pk_bf16(v[bj][0][2], v[bj][0][3]); pk.z = cvt_pk_bf16(v[bj][1][0], v[bj][1][1]); pk.w = cvt_pk_bf16(v[bj][1][2], v[bj][1][3]);
            *(u32x4*)(bin + tok * 256 + c) = pk;
            if (t >= 2033) { float* dst = out + O_POOLP + ((size_t)(l * 8 + b) * 15 + (t - 2033)) * 256 + c; *(f32x4*)dst = v[bj][0]; *(f32x4*)(dst + 4) = v[bj][1]; }
          }
        } else if (pn == 2 || pn == 4 || pn >= 10) {
          bf16_t* base = pn == 2 ? sza + tok * 256 : (pn == 4 ? szb + tok * 256 : szc + tok * 512 + (pn - 10) * 256);
#pragma unroll
          for (int bj = 0; bj < 2; ++bj) {
            u32x4 pk; pk.x = cvt_pk_bf16(fsilu(v[bj][0][0]), fsilu(v[bj][0][1])); pk.y = cvt_pk_bf16(fsilu(v[bj][0][2]), fsilu(v[bj][0][3]));
            pk.z = cvt_pk_bf16(fsilu(v[bj][1][0]), fsilu(v[bj][1][1])); pk.w = cvt_pk_bf16(fsilu(v[bj][1][2]), fsilu(v[bj][1][3]));
            *(u32x4*)(base + 128 * bj + jc) = pk;
          }
        } else if (pn <= 6) {
          const int head = (pn - 5) * 4 + wc;
          norm_rope(v, g_q, t, fq);
          const float sc = 0.125f * 1.4426950408889634f;
#pragma unroll
          for (int bj = 0; bj < 2; ++bj) {
            u32x4 pk; pk.x = cvt_pk_bf16(v[bj][0][0] * sc, v[bj][0][1] * sc); pk.y = cvt_pk_bf16(v[bj][0][2] * sc, v[bj][0][3] * sc);
            pk.z = cvt_pk_bf16(v[bj][1][0] * sc, v[bj][1][1] * sc); pk.w = cvt_pk_bf16(v[bj][1][2] * sc, v[bj][1][3] * sc);
            *(u32x4*)(qb + (tok * 8 + head) * 64 + 32 * bj + 8 * fq) = pk;
          }
        } else {
          const int br = pn - 7, kvsel = wc >> 1, g = wc & 1;
          if (kvsel == 0) norm_rope(v, g_k + br * 64, t, fq);
          float* fdst = nullptr;
          if (br == 0) fdst = out + O_CMPP + ((size_t)l * NPT + tok) * 256;
          else if (br == 1) fdst = out + O_SLCP + ((size_t)l * NPT + tok) * 256;
          else if (t >= 1792) fdst = out + O_WINP + ((size_t)(l * 8 + b) * 256 + (t - 1792)) * 256;
          if (fdst) {
#pragma unroll
            for (int bj = 0; bj < 2; ++bj) { float* d2 = fdst + kvsel * 128 + g * 64 + 32 * bj + 8 * fq; *(f32x4*)d2 = v[bj][0]; *(f32x4*)(d2 + 4) = v[bj][1]; }
          }
          if (br >= 1) {
            const size_t bg = (size_t)b * 2 + g;
            if (kvsel == 0) {
              bf16_t* kd = (br == 1 ? ks : kw) + (bg * SEQ + t) * 64;
#pragma unroll
              for (int bj = 0; bj < 2; ++bj) {
                u32x4 pk; pk.x = cvt_pk_bf16(v[bj][0][0], v[bj][0][1]); pk.y = cvt_pk_bf16(v[bj][0][2], v[bj][0][3]); pk.z = cvt_pk_bf16(v[bj][1][0], v[bj][1][1]); pk.w = cvt_pk_bf16(v[bj][1][2], v[bj][1][3]);
                *(u32x4*)(kd + 32 * bj + 8 * fq) = pk;
              }
            } else {
              bf16_t* vd = (br == 1 ? vsT : vwT) + bg * 64 * SEQ + t;
#pragma unroll
              for (int bj = 0; bj < 2; ++bj)
#pragma unroll
                for (int n = 0; n < 2; ++n)
#pragma unroll
                  for (int e = 0; e < 4; ++e) vd[(size_t)(32 * bj + 8 * fq + 4 * n + e) * SEQ] = f2bf(v[bj][n][e]);
            }
          }
        }
      }
  }
};
struct PhaseAArgs { EpiA epi; const bf16_t* xb; const bf16_t* WinT; };
__device__ __forceinline__ void phaseA(LAS unsigned char* lds, const PhaseAArgs& a) {
  pg8::Gemm g{a.xb, a.WinT, NPT, 3072, 1024};
  pg8::StaticOrder S; S.init(NPT, 3072, gridDim.x, blockIdx.x);
  pg8::gemm_phase<EpiA, pg8::StaticOrder, false>(lds, g, S, a.epi, nullptr);
}
__global__ void __launch_bounds__(512, 2) k_phaseA(PhaseAArgs a) {
  extern __shared__ __attribute__((aligned(16))) unsigned char shm[];
  phaseA((LAS unsigned char*)shm, a);
}

__device__ __forceinline__ float wsum(float v) {
#pragma unroll
  for (int o = 32; o > 0; o >>= 1) v += __shfl_xor(v, o);
  return v;
}
__device__ __forceinline__ float wmax(float v) {
#pragma unroll
  for (int o = 32; o > 0; o >>= 1) v = fmaxf(v, __shfl_xor(v, o));
  return v;
}
template <int NT> __device__ __forceinline__ void thin_gemm(const bf16_t* A, int lda, const bf16_t* Bt, int ldb, int K, f32x4 (&acc)[NT], int fr, int fq) {
  const bf16_t* ap = A + (size_t)fr * lda + fq * 8;
  const bf16_t* bp = Bt + (size_t)fr * ldb + fq * 8;
#pragma unroll
  for (int nt = 0; nt < NT; ++nt) acc[nt] = (f32x4){0.f, 0.f, 0.f, 0.f};
#pragma unroll 4
  for (int k0 = 0; k0 < K; k0 += 32) {
    const bf16x8 af = *(const bf16x8*)(ap + k0);
#pragma unroll
    for (int nt = 0; nt < NT; ++nt) { const bf16x8 bf = *(const bf16x8*)(bp + (size_t)nt * 16 * ldb + k0); acc[nt] = mfma16(bf, af, acc[nt]); }
  }
}
__device__ __forceinline__ void s1_unit(const bf16_t* xb_s, const float* ssq_s, const bf16_t* WinT, float* sproj, int u) {
  const int tid = tidx(), w = tid >> 6, lane = tid & 63, fr = lane & 15, fq = lane >> 4;
  const int n0 = 64 * u, row = 16 * w + fr;
  f32x4 acc[4];
  if (u < 48) thin_gemm<4>(xb_s + (size_t)16 * w * 1024, 1024, WinT + (size_t)n0 * 1024, 1024, 1024, acc, fr, fq);
  else { f32x4 a2[2]; thin_gemm<2>(xb_s + (size_t)16 * w * 1024, 1024, WinT + (size_t)n0 * 1024, 1024, 1024, a2, fr, fq); acc[0] = a2[0]; acc[1] = a2[1]; acc[2] = acc[3] = (f32x4){0.f, 0.f, 0.f, 0.f}; }
  const float rinv = rinv_from_ssq(ssq_s, row);
#pragma unroll
  for (int nt = 0; nt < 4; ++nt) {
    const int np = n0 + nt * 16 + 4 * fq;
    if (np < 3096) { const int lc = win_logical_col(np); *(f32x4*)(sproj + (size_t)row * 3104 + lc) = acc[nt] * rinv; }
  }
}
template <bool LAST> __device__ __forceinline__ void s4_unit(const bf16_t* mix_s, const bf16_t* WoutT, const float* xs, float* xs_out, bf16_t* xb_s, float* ssq_s, int u) {
  const int tid = tidx(), w = tid >> 6, lane = tid & 63, fr = lane & 15, fq = lane >> 4;
  const int n0 = 64 * u, row = 16 * w + fr;
  f32x4 acc[4];
  thin_gemm<4>(mix_s + (size_t)16 * w * 1024, 1024, WoutT + (size_t)n0 * 1024, 1024, 1024, acc, fr, fq);
  float ss = 0.f;
#pragma unroll
  for (int nt = 0; nt < 4; ++nt) {
    const int c = n0 + nt * 16 + 4 * fq;
    const f32x4 v = acc[nt] + *(const f32x4*)(xs + (size_t)row * 1024 + c);
    *(f32x4*)(xs_out + (size_t)row * 1024 + c) = v;
    if (!LAST) { u32x2 pk; pk.x = cvt_pk_bf16(v[0], v[1]); pk.y = cvt_pk_bf16(v[2], v[3]); *(u32x2*)(xb_s + (size_t)row * 1024 + c) = pk; ss += (v[0] * v[0] + v[1] * v[1]) + (v[2] * v[2] + v[3] * v[3]); }
  }
  if (!LAST) { ss += __shfl_xor(ss, 16); ss += __shfl_xor(ss, 32); if (fq == 0) ssq_s[(size_t)row * 16 + u] = ss; }
}

struct SampArgs {
  int l; int pad_;
  const float* sproj;
  const float *g_q, *g_k, *cs;
  const float *state_conv_l, *state_pool_l;
  const float *w_dw, *b_dw, *ln_g, *ln_b, *w_pw, *b_pw, *w_pool, *pool_scale;
  const float *cache_slc_l, *cache_win_l; const int* page_table;
  const bf16_t *kcS, *vcST;
  float *sq, *srows, *sgates;
  bf16_t* mix_s;
  float* out;
};
__device__ __forceinline__ void s2_item(const SampArgs& a, LAS unsigned char* lds, int b) {
  const int tid = tidx(), w = tid >> 6, lane = tid & 63, l = a.l;
  const float* pr = a.sproj + (size_t)b * 3104;
  LAS float* sh = (LAS float*)lds;
  const float* csp = a.cs + 2048 * 16;
  {
    const float v = pr[C_Q + w * 64 + lane];
    const float y = v * rsqrtf(wsum(v * v) * (1.f / 64.f) + 1e-6f) * a.g_q[lane];
    const float pp = __shfl_xor(y, 8);
    float o = y;
    if (lane < 16) { const int j = lane & 7; const float c = csp[j * 2], sn = csp[j * 2 + 1]; o = lane < 8 ? y * c - pp * sn : y * c + pp * sn; }
    a.sq[(size_t)b * 512 + w * 64 + lane] = o;
  }
  if (w < 6) {
    const int br = w >> 1, g = w & 1;
    const float v = pr[C_KV + br * 256 + g * 64 + lane];
    const float y = v * rsqrtf(wsum(v * v) * (1.f / 64.f) + 1e-6f) * a.g_k[br * 64 + lane];
    const float pp = __shfl_xor(y, 8);
    float o = y;
    if (lane < 16) { const int j = lane & 7; const float c = csp[j * 2], sn = csp[j * 2 + 1]; o = lane < 8 ? y * c - pp * sn : y * c + pp * sn; }
    const float vv = pr[C_KV + br * 256 + 128 + g * 64 + lane];
    a.srows[(size_t)b * 768 + br * 256 + g * 64 + lane] = o;
    a.srows[(size_t)b * 768 + br * 256 + 128 + g * 64 + lane] = vv;
    float* dst = br == 0 ? a.out + O_CMPS + ((size_t)l * NSM + b) * 256 : (br == 1 ? a.out + O_SLCS + ((size_t)l * NSM + b) * 256 : a.out + O_WINS + (((size_t)l * NSM + b) * 256 + 255) * 256);
    dst[g * 64 + lane] = o; dst[128 + g * 64 + lane] = vv;
  }
  if (tid < 24) a.sgates[(size_t)b * 24 + tid] = fsigmoid(pr[C_GATE + tid]);
  float yv = 0.f;
  if (tid < 256) {
    const int c = tid;
    const float glu = pr[C_AVAL + c] * fsigmoid(pr[C_AGATE + c]);
    const float* st = a.state_conv_l + (size_t)b * 30 * 256 + c;
    float* cso = a.out + O_CONVS + ((size_t)l * NSM + b) * 30 * 256 + c;
    float acc = a.b_dw[c];
    for (int k = 0; k < 30; ++k) { const float sv = st[k * 256]; acc = fmaf(a.w_dw[k * 256 + c], sv, acc); if (k >= 1) cso[(k - 1) * 256] = sv; }
    acc = fmaf(a.w_dw[30 * 256 + c], glu, acc);
    cso[29 * 256] = glu;
    yv = acc;
  } else {
    const int ch = tid - 256, g = ch >> 6, wn = 2 << g;
    const float cur = pr[C_BIN + ch];
    const float* st = a.state_pool_l + (size_t)b * 15 * 256 + ch;
    float* pso = a.out + O_POOLS + ((size_t)l * NSM + b) * 15 * 256 + ch;
    float total = cur;
    for (int j = 1; j < 15; ++j) pso[(j - 1) * 256] = st[j * 256];
    pso[14 * 256] = cur;
    for (int j = 1; j < wn; ++j) total += st[(15 - j) * 256];
    sh[256 + ch] = total / (float)wn - cur;
  }
  { const float s1 = wsum(yv); if (lane == 0) sh[512 + w] = s1; }
  __syncthreads();
  const float mean = (sh[512] + sh[513] + sh[514] + sh[515]) * (1.f / 256.f);
  const float xc = yv - mean;
  { const float s2 = wsum(xc * xc); if (lane == 0) sh[520 + w] = s2; }
  __syncthreads();
  if (tid < 256) {
    const float var = (sh[520] + sh[521] + sh[522] + sh[523]) * (1.f / 256.f);
    const float z = xc * rsqrtf(var + 1e-6f) * a.ln_g[tid] + a.ln_b[tid];
    sh[tid] = fsilu(z);
  }
  __syncthreads();
  if (tid < 256) {
    const int n = tid;
    float o = a.b_pw[n];
    for (int k = 0; k < 256; ++k) o = fmaf(sh[k], a.w_pw[k * 256 + n], o);
    a.mix_s[(size_t)b * 1024 + n] = f2bf(o * fsilu(pr[C_ZA + n]));
  } else {
    const int ch = tid - 256, g = ch >> 6, e = ch & 63;
    float o = 0.f;
    for (int c = 0; c < 64; ++c) o = fmaf(sh[256 + g * 64 + c], a.w_pool[(g * 64 + c) * 64 + e], o);
    a.mix_s[(size_t)b * 1024 + 256 + ch] = f2bf(o * a.pool_scale[ch] * fsilu(pr[C_ZB + ch]));
  }
  __syncthreads();
}
__device__ __forceinline__ void s3_item(const SampArgs& a, LAS unsigned char* lds, int n, int g) {
  const int tid = tidx(), w = tid >> 6, lane = tid & 63, r = w & 3, l = a.l;
  const bool act = w < 4;
  const int pos = 2048, h = g * 4 + r;
  LAS float* qs = (LAS float*)lds;
  LAS float* pc = qs + 256;
  LAS float* ps = pc + 512;
  LAS float* imp = ps + 2048;
  LAS int* sel = (LAS int*)(imp + 64);
  const size_t bg = (size_t)n * 2 + g;
  if (act) qs[r * 64 + lane] = a.sq[(size_t)n * 512 + h * 64 + lane];
  __syncthreads();
  float o_c = 0.f, o_s = 0.f, o_w = 0.f;
  if (act) {
    float s[2];
#pragma unroll
    for (int j = 0; j < 2; ++j) {
      const int c = lane + 64 * j;
      float d = 0.f;
      if (c < 127) { const bf16_t* kr = a.kcS + (bg * 128 + c) * 64; for (int i = 0; i < 64; i += 2) { const unsigned kk = *(const unsigned*)(kr + i); d = fmaf(qs[r * 64 + i], bflo(kk), d); d = fmaf(qs[r * 64 + i + 1], bfhi(kk), d); } }
      s[j] = c < 127 ? d * 0.125f : NEGF;
    }
    const float m = wmax(fmaxf(s[0], s[1]));
    const float p0 = __expf(s[0] - m), p1 = (lane + 64 < 127) ? __expf(s[1] - m) : 0.f;
    const float sum = wsum(p0 + p1);
    pc[r * 128 + lane] = p0 / sum; pc[r * 128 + lane + 64] = p1 / sum;
  }
  __syncthreads();
  if (act) {
    const bf16_t* vr = a.vcST + (bg * 64 + lane) * 128;
    for (int c = 0; c < 127; ++c) o_c = fmaf(pc[r * 128 + c], bf2f(vr[c]), o_c);
  }
  if (tid < 33) {
    const int s = tid, lo = max(0, 4 * s - 1), hi = min(126, 4 * s + 3);
    float v = 0.f;
    for (int rr = 0; rr < 4; ++rr) for (int c = lo; c <= hi; ++c) v += pc[rr * 128 + c];
    const bool forced = (s == 0) || (s == 32) || (s == 31);
    imp[s] = forced ? 1e4f : v;
  }
  __syncthreads();
  if (tid == 0) {
    unsigned long long taken = 0ull;
    for (int k = 0; k < 8; ++k) {
      int best = -1; float bv = -3e38f;
      for (int s = 0; s < 33; ++s) if (!((taken >> s) & 1ull) && imp[s] > bv) { bv = imp[s]; best = s; }
      taken |= 1ull << best; sel[k] = best;
    }
  }
  __syncthreads();
  if (act) {
    float s8[8]; bool v8[8]; float m = NEGF;
#pragma unroll
    for (int k = 0; k < 8; ++k) {
      const int kpos = sel[k] * 64 + lane;
      v8[k] = kpos <= pos;
      float d = 0.f;
      if (v8[k]) {
        const float* kr;
        if (kpos < 2048) { const int page = a.page_table[n * 16 + (kpos >> 7)]; kr = a.cache_slc_l + ((size_t)page * 128 + (kpos & 127)) * 256 + g * 64; }
        else kr = a.srows + (size_t)n * 768 + 256 + g * 64;
        for (int i = 0; i < 64; i += 4) { const f32x4 kk = *(const f32x4*)(kr + i); d = fmaf(qs[r * 64 + i], kk[0], d); d = fmaf(qs[r * 64 + i + 1], kk[1], d); d = fmaf(qs[r * 64 + i + 2], kk[2], d); d = fmaf(qs[r * 64 + i + 3], kk[3], d); }
      }
      s8[k] = v8[k] ? d * 0.125f : NEGF;
      m = fmaxf(m, s8[k]);
    }
    m = wmax(m);
    float sum = 0.f;
#pragma unroll
    for (int k = 0; k < 8; ++k) { s8[k] = v8[k] ? __expf(s8[k] - m) : 0.f; sum += s8[k]; }
    sum = fmaxf(wsum(sum), 1e-30f);
#pragma unroll
    for (int k = 0; k < 8; ++k) ps[r * 512 + k * 64 + lane] = s8[k] / sum;
  }
  __syncthreads();
  if (act) {
    for (int k = 0; k < 8; ++k) {
      const int blk = sel[k];
      if (blk < 32) {
        const int page = a.page_table[n * 16 + (blk >> 1)];
        const float* vb = a.cache_slc_l + ((size_t)page * 128 + (blk & 1) * 64) * 256 + 128 + g * 64 + lane;
        for (int j = 0; j < 64; ++j) o_s = fmaf(ps[r * 512 + k * 64 + j], vb[(size_t)j * 256], o_s);
      } else {
        o_s = fmaf(ps[r * 512 + k * 64], a.srows[(size_t)n * 768 + 256 + 128 + g * 64 + lane], o_s);
      }
    }
  }
  __syncthreads();
  if (act) {
    float s4[4]; float m = NEGF;
#pragma unroll
    for (int k = 0; k < 4; ++k) {
      const int kpos = pos - 255 + lane + 64 * k;
      const float* kr = kpos < 2048 ? a.cache_win_l + ((size_t)n * 256 + (kpos - 1792)) * 256 + g * 64 : a.srows + (size_t)n * 768 + 512 + g * 64;
      float d = 0.f;
      for (int i = 0; i < 64; i += 4) { const f32x4 kk = *(const f32x4*)(kr + i); d = fmaf(qs[r * 64 + i], kk[0], d); d = fmaf(qs[r * 64 + i + 1], kk[1], d); d = fmaf(qs[r * 64 + i + 2], kk[2], d); d = fmaf(qs[r * 64 + i + 3], kk[3], d); }
      s4[k] = d * 0.125f;
      m = fmaxf(m, s4[k]);
    }
    m = wmax(m);
    float sum = 0.f;
#pragma unroll
    for (int k = 0; k < 4; ++k) { s4[k] = __expf(s4[k] - m); sum += s4[k]; }
    sum = wsum(sum);
#pragma unroll
    for (int k = 0; k < 4; ++k) ps[r * 512 + k * 64 + lane] = s4[k] / sum;
  }
  __syncthreads();
  if (act) {
    const float* vb = a.cache_win_l + ((size_t)n * 256 + 1) * 256 + 128 + g * 64 + lane;
    for (int j = 0; j < 255; ++j) o_w = fmaf(ps[r * 512 + j], vb[(size_t)j * 256], o_w);
    o_w = fmaf(ps[r * 512 + 255], a.srows[(size_t)n * 768 + 512 + 128 + g * 64 + lane], o_w);
    const float* gt = a.sgates + (size_t)n * 24;
    const float o = gt[h] * o_c + gt[8 + h] * o_s + gt[16 + h] * o_w;
    a.mix_s[(size_t)n * 1024 + 512 + h * 64 + lane] = f2bf(o * fsilu(a.sproj[(size_t)n * 3104 + C_ZC + h * 64 + lane]));
  }
  __syncthreads();
}

__global__ void __launch_bounds__(512, 2) k_s1(const bf16_t* xb_s, const float* ssq_s, const bf16_t* WinT, float* sproj) {
  for (int u = blockIdx.x; u < 49; u += gridDim.x) s1_unit(xb_s, ssq_s, WinT, sproj, u);
}
__global__ void __launch_bounds__(512, 2) k_s2(SampArgs a) {
  extern __shared__ __attribute__((aligned(16))) unsigned char shm[];
  for (int b = blockIdx.x; b < NSM; b += gridDim.x) s2_item(a, (LAS unsigned char*)shm, b);
}
struct CmpSArgs { const float* cache_cmp_l; const int* page_table; const bf16_t *W1T, *W2T; const float* cbias; bf16_t *kcS, *vcST; };
__global__ void __launch_bounds__(512, 2) k_cmps(CmpSArgs a) {
  extern __shared__ __attribute__((aligned(16))) unsigned char shm[];
  for (int it = blockIdx.x; it < 512; it += gridDim.x) {
    const int n = it >> 2, g = (it >> 1) & 1, kv = it & 1;
    CmpSrc src{a.cache_cmp_l, a.page_table + n * 16};
    compress_item((LAS unsigned char*)shm, src, g, kv, a.W1T + (size_t)kv * 128 * 1024, a.W2T + (size_t)kv * 4096, a.cbias + kv * 64,
                  a.kcS + ((size_t)n * 2 + g) * 128 * 64, a.vcST + ((size_t)n * 2 + g) * 64 * 128);
  }
}
__global__ void __launch_bounds__(512, 2) k_s3(SampArgs a) {
  extern __shared__ __attribute__((aligned(16))) unsigned char shm[];
  for (int it = blockIdx.x; it < 256; it += gridDim.x) s3_item(a, (LAS unsigned char*)shm, it >> 1, it & 1);
}
template <bool LAST> __global__ void __launch_bounds__(512, 2) k_s4(const bf16_t* mix_s, const bf16_t* WoutT, const float* xs, float* xs_out, bf16_t* xb_s, float* ssq_s) {
  for (int u = blockIdx.x; u < 16; u += gridDim.x) s4_unit<LAST>(mix_s, WoutT, xs, xs_out, xb_s, ssq_s, u);
}
__device__ __forceinline__ void wins_copy(const float* cache_win_l, float* out_l, int part, int nparts) {
  const size_t total4 = (size_t)NSM * 255 * 64;
  for (size_t i = (size_t)part * 512 + tidx(); i < total4; i += (size_t)nparts * 512) {
    const size_t n = i / (255 * 64), rem = i % (255 * 64);
    *(f32x4*)(out_l + n * 65536 + rem * 4) = *(const f32x4*)(cache_win_l + n * 65536 + 256 + rem * 4);
  }
}
__global__ void __launch_bounds__(512, 2) k_wins(const float* cache_win_l, float* out_l) { wins_copy(cache_win_l, out_l, blockIdx.x, gridDim.x); }
}
namespace fast {
struct MegaArgs {
  const float *x_prompt, *x_sample, *state_conv, *state_pool, *cache_win, *cache_cmp, *cache_slc; const int* page_table;
  const float *w_norm, *w_in, *w_out, *w_dw, *b_dw, *ln_g, *ln_b, *w_pw, *b_pw, *w_pool, *pool_scale, *g_q, *g_k, *cmp_pe, *cmp_w1, *cmp_w2;
  float* out;
  unsigned* bar;
  float *cs, *ssq, *gatesf, *cbias, *sproj, *sq, *srows, *sgates, *x1p, *x1s;
  bf16_t *xb, *mixb, *qb, *ksb, *vsT, *kwb, *vwT, *kcP, *vcPT, *szc, *glub, *binb, *sza, *szb, *WinT, *WoutT, *WpwT, *WpoolT, *W1T, *W2T, *kcS, *vcST;
};

template <int MODE>
__device__ __forceinline__ void transpose_tile(const float* src, int ld_src, const float* scale, bf16_t* dst, int N, int K, int n0, int k0, LAS float* t) {
  const int tid = tidx();
  for (int i = tid; i < 4096; i += 512) {
    const int k = i >> 6, n = i & 63;
    const int col = MODE == 1 ? win_logical_col(n0 + n) : (n0 + n);
    float v = 0.f;
    if (n0 + n < N && col >= 0) { v = src[(size_t)(k0 + k) * ld_src + col]; if (scale) v *= scale[k0 + k]; }
    t[k * 65 + n] = v;
  }
  __syncthreads();
  for (int i = tid; i < 2048; i += 512) {
    const int n = i >> 5, k = (i & 31) * 2;
    if (n0 + n < N) *(unsigned*)(dst + (size_t)(n0 + n) * K + k0 + k) = cvt_pk_bf16(t[k * 65 + n], t[(k + 1) * 65 + n]);
  }
  __syncthreads();
}

__device__ __forceinline__ void phase0(const MegaArgs& a, LAS unsigned char* lds) {
  const int G = gridDim.x, wg = blockIdx.x, tid = tidx();
  LAS float* t = (LAS float*)lds;
  for (int it = wg; it < 2 * 1126; it += G) {
    const int l = it / 1126; int r = it % 1126;
    if (r < 784) { transpose_tile<1>(a.w_in + (size_t)l * 1024 * D_IN, D_IN, a.w_norm + l * 1024, a.WinT + (size_t)l * 3104 * 1024, 3104, 1024, (r % 49) * 64, (r / 49) * 64, t); continue; }
    r -= 784;
    if (r < 256) { transpose_tile<0>(a.w_out + (size_t)l * 1024 * 1024, 1024, nullptr, a.WoutT + (size_t)l * 1024 * 1024, 1024, 1024, (r & 15) * 64, (r >> 4) * 64, t); continue; }
    r -= 256;
    if (r < 16) { transpose_tile<0>(a.w_pw + (size_t)l * 65536, 256, nullptr, a.WpwT + (size_t)l * 65536, 256, 256, (r & 3) * 64, (r >> 2) * 64, t); continue; }
    r -= 16;
    if (r < 4) { transpose_tile<0>(a.w_pool + (size_t)(l * 4 + r) * 4096, 64, nullptr, a.WpoolT + (size_t)(l * 4 + r) * 4096, 64, 64, 0, 0, t); continue; }
    r -= 4;
    if (r < 64) { const int kv = r >> 5, half = (r >> 4) & 1, kt = r & 15;
      transpose_tile<0>(a.cmp_w1 + ((size_t)(l * 2 + kv) * 2048 + half * 1024) * 64, 64, nullptr, a.W1T + ((size_t)(l * 2 + kv) * 128 + half * 64) * 1024, 64, 1024, 0, kt * 64, t); continue; }
    r -= 64;
    transpose_tile<0>(a.cmp_w2 + (size_t)(l * 2 + r) * 4096, 64, nullptr, a.W2T + (size_t)(l * 2 + r) * 4096, 64, 64, 0, 0, t);
  }
  for (int lk = G - 1 - wg; lk >= 0 && lk < 4; lk += G) {
    const int e = tid & 63, part = tid >> 6;
    const float* pp = a.cmp_pe + (size_t)lk * 2048 + part * 256; const float* ww = a.cmp_w1 + ((size_t)lk * 2048 + part * 256) * 64 + e;
    float acc = 0.f;
    for (int k = 0; k < 256; ++k) acc = fmaf(pp[k], ww[(size_t)k * 64], acc);
    t[part * 64 + e] = acc;
    __syncthreads();
    if (tid < 64) { float s = 0.f; for (int p2 = 0; p2 < 8; ++p2) s += t[p2 * 64 + tid]; a.cbias[lk * 64 + tid] = s; }
    __syncthreads();
  }
  for (int i = wg * 512 + tid; i < 2049 * 8; i += G * 512) {
    const int pos = i >> 3, j = i & 7;
    const double ang = (double)pos * pow(500000.0, -(double)j / 8.0);
    a.cs[i * 2] = (float)cos(ang); a.cs[i * 2 + 1] = (float)sin(ang);
  }
  for (int row = wg * 8 + (tid >> 6); row < NTOK; row += G * 8) {
    const int lane = tid & 63;
    const float* x = row < NPT ? a.x_prompt + (size_t)row * 1024 : a.x_sample + (size_t)(row - NPT) * 1024;
#pragma unroll
    for (int j = 0; j < 4; ++j) {
      const f32x4 v = *(const f32x4*)(x + j * 256 + lane * 4);
      u32x2 pk; pk.x = cvt_pk_bf16(v[0], v[1]); pk.y = cvt_pk_bf16(v[2], v[3]);
      *(u32x2*)(a.xb + (size_t)row * 1024 + j * 256 + lane * 4) = pk;
      float ss = v[0] * v[0] + v[1] * v[1] + v[2] * v[2] + v[3] * v[3];
      ss += __shfl_xor(ss, 1); ss += __shfl_xor(ss, 2); ss += __shfl_xor(ss, 4); ss += __shfl_xor(ss, 8);
      if ((lane & 15) == 0) a.ssq[(size_t)row * 16 + j * 4 + (lane >> 4)] = ss;
    }
  }
  for (int l = 0; l < 2; ++l) wins_copy(a.cache_win + (size_t)l * NSM * 65536, a.out + O_WINS + (size_t)l * NSM * 65536, wg, G);
}

__global__ void __launch_bounds__(512, 2) k_mega(MegaArgs a) {
  extern __shared__ __attribute__((aligned(16))) unsigned char shm[];
  LAS unsigned char* lds = (LAS unsigned char*)shm;
  volatile LAS unsigned* xbw = (volatile LAS unsigned*)(lds + LDS_BYTES - 16);
  if (tidx() == 0) { xbw[0] = 0u; xbw[1] = 0u; xbw[2] = 0u; xbw[3] = 0u; }
  __syncthreads();
  (void)xcd_barrier_post(a.bar, xbw);
#define GRID_BARRIER() do { XcdBarrier b_; b_.bar = a.bar; b_.x = xb_xcc_id(); b_.st = xbw; xcd_barrier(b_); } while (0)
  const int G = gridDim.x, wg = blockIdx.x;

  phase0(a, lds);
  GRID_BARRIER();

#pragma unroll 1
  for (int l = 0; l < 2; ++l) {
    const float* xp = l == 0 ? a.x_prompt : a.x1p;
    const float* xs = l == 0 ? a.x_sample : a.x1s;
    float* xp_out = l == 0 ? a.x1p : a.out + O_YP;
    float* xs_out = l == 0 ? a.x1s : a.out + O_YS;
    const bf16_t* WinT_l = a.WinT + (size_t)l * 3104 * 1024;
    const bf16_t* W1T_l = a.W1T + (size_t)l * 2 * 128 * 1024;
    const bf16_t* W2T_l = a.W2T + (size_t)l * 2 * 4096;
    const float* cbias_l = a.cbias + l * 128;
    {
      PhaseAArgs aa;
      aa.epi.l = l; aa.epi.pad_ = 0; aa.epi.ssq = a.ssq; aa.epi.g_q = a.g_q + l * 64; aa.epi.g_k = a.g_k + l * 192; aa.epi.cs = a.cs;
      aa.epi.glu = a.glub; aa.epi.bin = a.binb; aa.epi.sza = a.sza; aa.epi.szb = a.szb; aa.epi.szc = a.szc; aa.epi.qb = a.qb;
      aa.epi.ks = a.ksb; aa.epi.vsT = a.vsT; aa.epi.kw = a.kwb; aa.epi.vwT = a.vwT; aa.epi.out = a.out;
      aa.xb = a.xb; aa.WinT = WinT_l;
      phaseA(lds, aa);
    }
    for (int u = wg; u < 49; u += G) s1_unit(a.xb + (size_t)NPT * 1024, a.ssq + (size_t)NPT * 16, WinT_l, a.sproj, u);
    for (int it = wg; it < 512; it += G) {
      const int n = it >> 2, g = (it >> 1) & 1, kv = it & 1;
      CmpSrc src{a.cache_cmp + (size_t)l * N_PHYS * 128 * 256, a.page_table + n * 16};
      compress_item(lds, src, g, kv, W1T_l + (size_t)kv * 128 * 1024, W2T_l + (size_t)kv * 4096, cbias_l + kv * 64,
                    a.kcS + ((size_t)n * 2 + g) * 128 * 64, a.vcST + ((size_t)n * 2 + g) * 64 * 128);
    }
    GRID_BARRIER();
    SampArgs sa;
    sa.l = l; sa.pad_ = 0; sa.sproj = a.sproj; sa.g_q = a.g_q + l * 64; sa.g_k = a.g_k + l * 192; sa.cs = a.cs;
    sa.state_conv_l = a.state_conv + (size_t)l * NSM * 30 * 256; sa.state_pool_l = a.state_pool + (size_t)l * NSM * 15 * 256;
    sa.w_dw = a.w_dw + l * 31 * 256; sa.b_dw = a.b_dw + l * 256; sa.ln_g = a.ln_g + l * 256; sa.ln_b = a.ln_b + l * 256; sa.w_pw = a.w_pw + (size_t)l * 65536; sa.b_pw = a.b_pw + l * 256;
    sa.w_pool = a.w_pool + (size_t)l * 4 * 4096; sa.pool_scale = a.pool_scale + l * 256;
    sa.cache_slc_l = a.cache_slc + (size_t)l * N_PHYS * 128 * 256; sa.cache_win_l = a.cache_win + (size_t)l * NSM * 65536; sa.page_table = a.page_table;
    sa.kcS = a.kcS; sa.vcST = a.vcST; sa.sq = a.sq; sa.srows = a.srows; sa.sgates = a.sgates; sa.mix_s = a.mixb + (size_t)NPT * 1024; sa.out = a.out;
    {
      PhaseBArgs ba;
      ba.glu = a.glub; ba.bin = a.binb; ba.sza = a.sza; ba.szb = a.szb; ba.xb = a.xb; ba.ssq = a.ssq;
      ba.WpwT = a.WpwT + (size_t)l * 65536; ba.WpoolT = a.WpoolT + (size_t)l * 4 * 4096; ba.WgT = WinT_l + (size_t)3072 * 1024;
      ba.W1T = W1T_l; ba.W2T = W2T_l; ba.cbias = cbias_l;
      ba.w_dw = sa.w_dw; ba.b_dw = sa.b_dw; ba.ln_g = sa.ln_g; ba.ln_b = sa.ln_b; ba.b_pw = sa.b_pw; ba.pool_scale = sa.pool_scale;
      ba.cmp_rows_p = a.out + O_CMPP + (size_t)l * NPT * 256;
      ba.mixb = a.mixb; ba.kcP = a.kcP; ba.vcPT = a.vcPT; ba.gates = a.gatesf;
      phaseB(lds, ba);
    }
    for (int b = (wg + G - 32 % G) % G; b < NSM; b += G) s2_item(sa, lds, b);
    GRID_BARRIER();
    {
      PhaseCArgs ca{a.qb, a.ksb, a.vsT, a.kwb, a.vwT, a.kcP, a.vcPT, a.szc, a.gatesf, a.mixb};
      phaseC(lds, ca);
    }
    for (int it = wg; it < 256; it += G) s3_item(sa, lds, it >> 1, it & 1);
    GRID_BARRIER();
    {
      PhaseDArgs da{a.mixb, a.WoutT + (size_t)l * 1024 * 1024, xp, xp_out, a.xb, a.ssq};
      if (l == 0) phaseD<false>(lds, da); else phaseD<true>(lds, da);
    }
    if (l == 0) { for (int u = wg; u < 16; u += G) s4_unit<false>(a.mixb + (size_t)NPT * 1024, a.WoutT + (size_t)l * 1024 * 1024, xs, xs_out, a.xb + (size_t)NPT * 1024, a.ssq + (size_t)NPT * 16, u); }
    else { for (int u = wg; u < 16; u += G) s4_unit<true>(a.mixb + (size_t)NPT * 1024, a.WoutT + (size_t)l * 1024 * 1024, xs, xs_out, a.xb + (size_t)NPT * 1024, a.ssq + (size_t)NPT * 16, u); }
    if (l == 0) GRID_BARRIER();
  }
}
}
extern "C" void kernel_launch(void* const* d_in, const int* in_sizes, int n_in, void* d_out, int out_size, void* d_ws, size_t ws_size, hipStream_t stream) {
  using fast::bf16_t;
  static int grid = 0;
  if (grid == 0) {
    int dev = 0, cus = 0, per_cu = 0;
    (void)hipGetDevice(&dev);
    (void)hipDeviceGetAttribute(&cus, hipDeviceAttributeMultiprocessorCount, dev);
    (void)hipFuncSetAttribute((const void*)fast::k_mega, hipFuncAttributeMaxDynamicSharedMemorySize, fast::LDS_BYTES);
    if (hipOccupancyMaxActiveBlocksPerMultiprocessor(&per_cu, (const void*)fast::k_mega, 512, fast::LDS_BYTES) != hipSuccess || per_cu < 1) per_cu = 1;
    (void)hipGetLastError();
    grid = cus > 0 ? cus : 256;
  }
  unsigned char* wsb = (unsigned char*)d_ws;
  size_t off = 0;
  auto takeb = [&](size_t bytes) { unsigned char* p = wsb + off; off += (bytes + 255) & ~(size_t)255; return p; };
  auto take = [&](size_t n) { return (float*)takeb(n * 4); };
  auto take16 = [&](size_t n) { return (bf16_t*)takeb(n * 2); };
  fast::MegaArgs a{};
  a.x_prompt = (const float*)d_in[0]; a.x_sample = (const float*)d_in[1]; a.state_conv = (const float*)d_in[2]; a.state_pool = (const float*)d_in[3];
  a.cache_win = (const float*)d_in[4]; a.cache_cmp = (const float*)d_in[5]; a.cache_slc = (const float*)d_in[6]; a.page_table = (const int*)d_in[7];
  a.w_norm = (const float*)d_in[8]; a.w_in = (const float*)d_in[9]; a.w_out = (const float*)d_in[10]; a.w_dw = (const float*)d_in[11]; a.b_dw = (const float*)d_in[12];
  a.ln_g = (const float*)d_in[13]; a.ln_b = (const float*)d_in[14]; a.w_pw = (const float*)d_in[15]; a.b_pw = (const float*)d_in[16]; a.w_pool = (const float*)d_in[17];
  a.pool_scale = (const float*)d_in[18]; a.g_q = (const float*)d_in[19]; a.g_k = (const float*)d_in[20]; a.cmp_pe = (const float*)d_in[21]; a.cmp_w1 = (const float*)d_in[22]; a.cmp_w2 = (const float*)d_in[23];
  a.out = (float*)d_out;
  a.bar = (unsigned*)takeb(XCD_BAR_WORDS * 4);
  a.cs = take(2049 * 16); a.ssq = take((size_t)NTOK * 16); a.gatesf = take((size_t)NPT * 24); a.cbias = take(2 * 2 * 64);
  a.sproj = take((size_t)NSM * 3104); a.sq = take((size_t)NSM * 512); a.srows = take((size_t)NSM * 768); a.sgates = take((size_t)NSM * 24);
  a.x1p = take((size_t)NPT * 1024); a.x1s = take((size_t)NSM * 1024);
  a.xb = take16((size_t)NTOK * 1024); a.mixb = take16((size_t)NTOK * 1024); a.qb = take16((size_t)NPT * 512);
  a.ksb = take16((size_t)NPT * 128); a.vsT = take16((size_t)NPT * 128); a.kwb = take16((size_t)NPT * 128); a.vwT = take16((size_t)NPT * 128);
  a.kcP = take16((size_t)8 * 2 * 128 * 64); a.vcPT = take16((size_t)8 * 2 * 128 * 64); a.szc = take16((size_t)NPT * 512);
  a.glub = take16((size_t)NPT * 256); a.binb = take16((size_t)NPT * 256); a.sza = take16((size_t)NPT * 256); a.szb = take16((size_t)NPT * 256);
  a.WinT = take16((size_t)2 * 3104 * 1024); a.WoutT = take16((size_t)2 * 1024 * 1024); a.WpwT = take16((size_t)2 * 65536); a.WpoolT = take16((size_t)2 * 4 * 4096);
  a.W1T = take16((size_t)2 * 2 * 128 * 1024); a.W2T = take16((size_t)2 * 2 * 4096); a.kcS = take16((size_t)NSM * 2 * 128 * 64); a.vcST = take16((size_t)NSM * 2 * 128 * 64);
  (void)hipMemsetAsync(a.bar, 0, XCD_BAR_WORDS * 4, stream);
  hipLaunchKernelGGL(fast::k_mega, dim3(grid), dim3(512), fast::LDS_BYTES, stream, a);
}
```

```cpp
#include <hip/hip_runtime.h>
#include <stdint.h>
#include <stdio.h>
__device__ __forceinline__ int tidx() { int t = threadIdx.x; asm volatile("" : "+v"(t)); return t; }

constexpr int NPT = 16384, NSM = 128, NTOK = NPT + NSM, SEQ = 2048;
constexpr int D_IN = 3096;
constexpr int C_AVAL = 0, C_AGATE = 256, C_ZA = 512, C_BIN = 768, C_ZB = 1024, C_Q = 1280, C_KV = 1792, C_GATE = 2560, C_ZC = 2584;
constexpr int N_PHYS = 2560;
constexpr float NEGF = -1e30f;

constexpr size_t O_YP = 0;
constexpr size_t O_YS = O_YP + (size_t)NPT * 1024;
constexpr size_t O_CONVP = O_YS + (size_t)NSM * 1024;
constexpr size_t O_POOLP = O_CONVP + 2ull * 8 * 30 * 256;
constexpr size_t O_WINP = O_POOLP + 2ull * 8 * 15 * 256;
constexpr size_t O_CMPP = O_WINP + 2ull * 8 * 256 * 256;
constexpr size_t O_SLCP = O_CMPP + 2ull * 8 * 2048 * 256;
constexpr size_t O_CONVS = O_SLCP + 2ull * 8 * 2048 * 256;
constexpr size_t O_POOLS = O_CONVS + 2ull * 128 * 30 * 256;
constexpr size_t O_WINS = O_POOLS + 2ull * 128 * 15 * 256;
constexpr size_t O_CMPS = O_WINS + 2ull * 128 * 256 * 256;
constexpr size_t O_SLCS = O_CMPS + 2ull * 128 * 256;
constexpr size_t O_END = O_SLCS + 2ull * 128 * 256;


namespace pg8 {
#define PG8_LAS __attribute__((address_space(3)))
typedef unsigned short bf16_t;
typedef short bf16x8 __attribute__((ext_vector_type(8)));
typedef float f32x4 __attribute__((ext_vector_type(4)));
typedef unsigned u32x4 __attribute__((ext_vector_type(4)));
constexpr int BM = 256, BK = 64, HALF = 128, HTB = HALF * BK * 2  , STAGE_BYTES = 8 * HTB, NXCD = 8, WGM = 8;

__host__ __device__ __forceinline__ int lds_byte(int r, int c) { const int st = (r >> 4) * 2 + (c >> 5), rr = r & 15, cc = c & 31, ob = rr * 64 + cc * 2; return st * 1024 + (ob ^ (((ob >> 9) & 1) << 5)); }
__host__ __device__ __forceinline__ void stage_rc(int b, int& R, int& C) { const int st = b / 1024, sb = b % 1024, swz = sb ^ (((sb >> 9) & 1) << 5); R = (st >> 1) * 16 + swz / 64; C = (st & 1) * 32 + (swz % 64) / 2; }
__host__ __device__ __forceinline__ int perm32(int rho) { const int n = rho >> 4, i = rho & 15; return 8 * (i >> 2) + 4 * n + (i & 3); }

struct Unit { int pm, pn; };
struct Gemm { const bf16_t* A; const bf16_t* Bt; int M, N, K; };

struct StaticOrder {
    int nM, nN, nwg, G, c;
    __host__ __device__ void init(int M, int N, int G_, int c_) { nM = M / BM; nN = N / BM; nwg = nM * nN; G = G_; c = c_; }
    __host__ __device__ bool next(int i, Unit& u) const {
        const long L = (long)i * G + c; if (L >= nwg) return false;
        int wgid = (int)L; { const int q = nwg / NXCD, r = nwg % NXCD, xcd = wgid % NXCD, off = wgid / NXCD; wgid = (xcd < r ? xcd * (q + 1) : r * (q + 1) + (xcd - r) * q) + off; }
        const int nig = WGM * nN, gid = wgid / nig, fm = gid * WGM, gsz = (nM - fm) < WGM ? (nM - fm) : WGM;
        u.pm = fm + ((wgid % nig) % gsz); u.pn = (wgid % nig) / gsz; return true;
    }
    __device__ __forceinline__ void a_ready(const Unit&) const {}
    __device__ __forceinline__ void done(const Unit&) const {}
};
__device__ __forceinline__ unsigned cvt_pk_bf16(float lo, float hi) { unsigned r; asm volatile("v_cvt_pk_bf16_f32 %0, %1, %2" : "=v"(r) : "v"(lo), "v"(hi)); return r; }

template <class Epi, class Sched, bool STAMP = false>
__device__ __forceinline__ void gemm_phase(PG8_LAS unsigned char* lds, const Gemm g, const Sched& S, const Epi& E, unsigned long long* stamps) {
    const int tid = tidx(), wid = __builtin_amdgcn_readfirstlane(tid >> 6), lane = tid & 63, wr = wid >> 2, wc = wid & 3, fr = lane & 15, fq = lane >> 4;
    const int K = g.K, nt = K / BK;
    int ts_lo = 0, ts_hi = 0, nts = 0; const unsigned long long rt_entry = STAMP ? (unsigned long long)wall_clock64() : 0ull;
#define PG8_STAMP() do { if (STAMP && wid == 0 && nts < 64) { const unsigned long long _c = (unsigned long long)clock64(); \
        ts_lo = (lane == nts) ? (int)(unsigned)_c : ts_lo; ts_hi = (lane == nts) ? (int)(unsigned)(_c >> 32) : ts_hi; ++nts; } } while (0)
    PG8_STAMP();
    unsigned voffA[2], voffB[2];
#pragma unroll
    for (int i = 0; i < 2; ++i) { int R, C; stage_rc(tid * 16 + i * 8192, R, C); const int Rb = Epi::PERM ? ((R & ~31) + perm32(R & 31)) : R;
        voffA[i] = (unsigned)(R * K + C) * 2u; voffB[i] = (unsigned)(Rb * K + C) * 2u; }
    const size_t kstep = (size_t)(BK * 2);
    const size_t hstep = (size_t)HALF * K * 2;
    const size_t tstep = 2 * hstep;
    const unsigned ldsw = (unsigned)wid * 1024u;
    const int aoff = lds_byte(wr * 64 + fr, fq * 8), boff = lds_byte(wc * 32 + fr, fq * 8);
#define PG8_SA(b, h) (((b) * 2 + (h)) * HTB)
#define PG8_SB(b, h) ((4 + (b) * 2 + (h)) * HTB)
#define PG8_STAGE(bufoff, gbase, voff) do { _Pragma("unroll") for (int _i = 0; _i < 2; ++_i) \
        __builtin_amdgcn_global_load_lds((const unsigned*)((const char*)(gbase) + (voff)[_i]), (PG8_LAS unsigned*)(lds + (bufoff) + ldsw + _i * 8192), 16, 0, 0); } while (0)
#define PG8_LDA(dst, b, h) do { _Pragma("unroll") for (int m = 0; m < 4; ++m) _Pragma("unroll") for (int k = 0; k < 2; ++k) dst[m][k] = *(const PG8_LAS bf16x8*)(lds + PG8_SA(b, h) + aoff + m * 2048 + k * 1024); } while (0)
#define PG8_LDB(dst, b, h) do { _Pragma("unroll") for (int n = 0; n < 2; ++n) _Pragma("unroll") for (int k = 0; k < 2; ++k) dst[n][k] = *(const PG8_LAS bf16x8*)(lds + PG8_SB(b, h) + boff + n * 2048 + k * 1024); } while (0)
#define PG8_MMA(ai, bj, At, Bt) do { __builtin_amdgcn_s_setprio(1); _Pragma("unroll") for (int m = 0; m < 4; ++m) _Pragma("unroll") for (int n = 0; n < 2; ++n) _Pragma("unroll") for (int k = 0; k < 2; ++k) \
        acc[ai][bj][m][n] = __builtin_amdgcn_mfma_f32_16x16x32_bf16(Bt[n][k], At[m][k], acc[ai][bj][m][n], 0, 0, 0); __builtin_amdgcn_s_setprio(0); } while (0)
#define PG8_WAIT_V(n) asm volatile("s_waitcnt vmcnt(" #n ")" ::: "memory")
#define PG8_WAIT_L(n) asm volatile("s_waitcnt lgkmcnt(" #n ")" ::: "memory")
#define PG8_BAR __builtin_amdgcn_s_barrier()
#define PG8_SCHED __builtin_amdgcn_sched_barrier(0)
    Unit cur, nxt; int ui = 0;
    if (!S.next(0, cur)) return;
    f32x4 acc[2][2][4][2];
#pragma unroll
    for (int a = 0; a < 2; ++a)
#pragma unroll
        for (int b = 0; b < 2; ++b)
#pragma unroll
            for (int m = 0; m < 4; ++m)
#pragma unroll
                for (int n = 0; n < 2; ++n) acc[a][b][m][n] = (f32x4){0.f, 0.f, 0.f, 0.f};
    bf16x8 At[4][2], B0[2][2], B1[2][2];
    const char* cA = (const char*)g.A + (size_t)cur.pm * tstep; const char* cB = (const char*)g.Bt + (size_t)cur.pn * tstep;
    S.a_ready(cur);
    PG8_STAGE(PG8_SB(0, 0), cB, voffB); PG8_STAGE(PG8_SA(0, 0), cA, voffA); PG8_STAGE(PG8_SB(0, 1), cB + hstep, voffB); PG8_STAGE(PG8_SA(0, 1), cA + hstep, voffA);
    if (wr == 1) PG8_BAR;
    PG8_WAIT_V(4); PG8_BAR;
    PG8_STAGE(PG8_SB(1, 0), cB + kstep, voffB); PG8_STAGE(PG8_SA(1, 0), cA + kstep, voffA); PG8_STAGE(PG8_SB(1, 1), cB + hstep + kstep, voffB);
    PG8_WAIT_V(6); PG8_BAR;
    PG8_STAMP();
    for (;;) {
        const bool has_next = S.next(ui + 1, nxt);
        const char* nA = has_next ? (const char*)g.A + (size_t)nxt.pm * tstep : cA; const char* nB = has_next ? (const char*)g.Bt + (size_t)nxt.pn * tstep : cB;
        for (int t = 0; t < nt; t += 2) {
            const bool last = (t == nt - 2);
            const char* a1 = cA + (size_t)(t + 1) * kstep;
            const char* a2 = last ? nA : cA + (size_t)(t + 2) * kstep; const char* b2 = last ? nB : cB + (size_t)(t + 2) * kstep;
            const char* a3 = a2 + kstep; const char* b3 = b2 + kstep;
            if (last && has_next) S.a_ready(nxt);
            PG8_LDB(B0, 0, 0); PG8_SCHED; PG8_LDA(At, 0, 0); PG8_STAGE(PG8_SA(1, 1), a1 + hstep, voffA);
            PG8_WAIT_L(8); PG8_BAR; PG8_WAIT_L(0); PG8_MMA(0, 0, At, B0); PG8_BAR; PG8_SCHED;
            PG8_LDB(B1, 0, 1); PG8_STAGE(PG8_SB(0, 0), b2, voffB);
            PG8_BAR; PG8_WAIT_L(0); PG8_MMA(0, 1, At, B1); PG8_BAR;
            PG8_LDA(At, 0, 1); PG8_STAGE(PG8_SA(0, 0), a2, voffA);
            PG8_BAR; PG8_WAIT_L(0); PG8_MMA(1, 0, At, B0); PG8_BAR; PG8_SCHED;
            PG8_STAGE(PG8_SB(0, 1), b2 + hstep, voffB);
            PG8_WAIT_V(6); PG8_BAR; PG8_MMA(1, 1, At, B1); PG8_BAR;
            PG8_LDB(B0, 1, 0); PG8_SCHED; PG8_LDA(At, 1, 0); PG8_STAGE(PG8_SA(0, 1), a2 + hstep, voffA);
            PG8_WAIT_L(8); PG8_BAR; PG8_WAIT_L(0); PG8_MMA(0, 0, At, B0); PG8_BAR; PG8_SCHED;
            PG8_LDB(B1, 1, 1); PG8_STAGE(PG8_SB(1, 0), b3, voffB);
            PG8_BAR; PG8_WAIT_L(0); PG8_MMA(0, 1, At, B1); PG8_BAR;
            PG8_LDA(At, 1, 1); PG8_STAGE(PG8_SA(1, 0), a3, voffA);
            PG8_BAR; PG8_WAIT_L(0); PG8_MMA(1, 0, At, B0); PG8_BAR; PG8_SCHED;
            PG8_STAGE(PG8_SB(1, 1), b3 + hstep, voffB);
            PG8_WAIT_V(6); PG8_BAR; PG8_MMA(1, 1, At, B1); PG8_BAR;
        }
        PG8_STAMP();
        if constexpr (!Epi::AFTER_DRAIN) { E(acc, cur, wr, wc, fr, fq); S.done(cur); }
        PG8_STAMP();
        if (!has_next) break;
#pragma unroll
        for (int a = 0; a < 2; ++a)
#pragma unroll
            for (int b = 0; b < 2; ++b)
#pragma unroll
                for (int m = 0; m < 4; ++m)
#pragma unroll
                    for (int n = 0; n < 2; ++n) acc[a][b][m][n] = (f32x4){0.f, 0.f, 0.f, 0.f};
        cur = nxt; cA = nA; cB = nB; ++ui;
    }
    PG8_WAIT_V(0);
    if (wr == 0) PG8_BAR;
    PG8_BAR;
    if constexpr (Epi::AFTER_DRAIN) { E.fused(acc, cur, wr, wc, fr, fq, lds, wid, lane); S.done(cur); }
    PG8_STAMP();
    if (STAMP && wid == 0) { stamps[lane] = lane < nts ? (((unsigned long long)(unsigned)ts_hi << 32) | (unsigned)ts_lo) : 0ull;
        if (lane == 62) stamps[62] = rt_entry; if (lane == 63) stamps[63] = (unsigned long long)wall_clock64(); }
#undef PG8_STAMP
#undef PG8_SA
#undef PG8_SB
#undef PG8_STAGE
#undef PG8_LDA
#undef PG8_LDB
#undef PG8_MMA
#undef PG8_WAIT_V
#undef PG8_WAIT_L
#undef PG8_BAR
#undef PG8_SCHED
}
}
#define XB_TMO      128
#define XB_XCNT(j)  (256  + 64 * (j))
#define XB_XSUB(j)  (1280 + 64 * (j))
#define XB_XGEN(j)  (2304 + 64 * (j))
#define XB_TOP      3328
#define XB_TOPGEN   3392
#define XCD_BAR_WORDS 3456
#define XB_SPIN_CAP (1u << 18)
#ifndef LAS
#define LAS __attribute__((address_space(3)))
#endif

__device__ __forceinline__ unsigned xb_ld(unsigned* p)              { return __hip_atomic_load(p, __ATOMIC_RELAXED, __HIP_MEMORY_SCOPE_AGENT); }
__device__ __forceinline__ unsigned xb_add(unsigned* p, unsigned v) { return __hip_atomic_fetch_add(p, v, __ATOMIC_RELAXED, __HIP_MEMORY_SCOPE_AGENT); }
__device__ __forceinline__ unsigned xb_xcc_id() { return (unsigned)__builtin_amdgcn_s_getreg((3 << 11) | 20) & 0xFu; }
#define XB_SPIN(cond, bar) do { unsigned _sp = 0; while (cond) { __builtin_amdgcn_s_sleep(1); \
    if ((++_sp & 255u) == 0u) { if (xb_ld(&(bar)[XB_TMO])) break; if (_sp > XB_SPIN_CAP) { atomicAdd(&(bar)[XB_TMO], 1u); break; } } } } while (0)

struct XcdBarrier {
    unsigned* bar; unsigned x;
    volatile LAS unsigned* st;
};

__device__ __forceinline__ XcdBarrier xcd_barrier_post(unsigned* bar, volatile LAS unsigned* st) {
    XcdBarrier b; b.bar = bar; b.x = xb_xcc_id(); b.st = st;
    if (threadIdx.x == 0) (void)xb_add(&bar[XB_XCNT(b.x)], 1u);
    return b;
}
__device__ __forceinline__ void xcd_barrier_complete(unsigned* bar, unsigned x, unsigned& nloc, unsigned& nx) {
    const unsigned G = gridDim.x * gridDim.y * gridDim.z;
    unsigned sum, cnt, mine, sp = 0u;
    for (;;) {
        sum = 0u; cnt = 0u; mine = 0u;
#pragma unroll
        for (unsigned j = 0; j < 16; ++j) { const unsigned c = xb_ld(&bar[XB_XCNT(j)]); sum += c; cnt += (c > 0u) ? 1u : 0u; mine = (j == x) ? c : mine; }
        if (sum == G) break;
        __builtin_amdgcn_s_sleep(1);
        if ((++sp & 255u) == 0u) { if (xb_ld(&bar[XB_TMO])) break; if (sp > XB_SPIN_CAP) { atomicAdd(&bar[XB_TMO], 1u); break; } }
    }
    nloc = mine > 0u ? mine : 1u; nx = cnt > 0u ? cnt : 1u;
}

__device__ __forceinline__ void xcd_barrier(const XcdBarrier& b) {
    asm volatile("s_waitcnt vmcnt(0)" ::: "memory");
    __syncthreads();
    if (threadIdx.x == 0) {
        unsigned* bar = b.bar;
        __builtin_amdgcn_s_waitcnt(0);
        unsigned nloc = b.st[0], nx = b.st[1];
        if (nloc == 0u) { xcd_barrier_complete(bar, b.x, nloc, nx); b.st[0] = nloc; b.st[1] = nx; }
        const unsigned old = xb_add(&bar[XB_XSUB(b.x)], 1u);
        const unsigned gen = old / nloc;
        if (old + 1u == (gen + 1u) * nloc) {
            __builtin_amdgcn_fence(__ATOMIC_RELEASE, "agent");
            asm volatile("s_waitcnt vmcnt(0)" ::: "memory");
            const unsigned og = xb_add(&bar[XB_TOP], 1u);
            const unsigned tg = og / nx;
            if (og + 1u == (tg + 1u) * nx) xb_add(&bar[XB_TOPGEN], 1u);
            else XB_SPIN(xb_ld(&bar[XB_TOPGEN]) == tg, bar);
            __builtin_amdgcn_fence(__ATOMIC_ACQUIRE, "agent");
            xb_add(&bar[XB_XGEN(b.x)], 1u);
            asm volatile("s_waitcnt vmcnt(0)" ::: "memory");
        } else {
            XB_SPIN(xb_ld(&bar[XB_XGEN(b.x)]) == gen, bar);
            __builtin_amdgcn_fence(__ATOMIC_ACQUIRE, "agent");
            asm volatile("s_waitcnt vmcnt(0)" ::: "memory");
        }
    }
    __syncthreads();
}

namespace fast {
using pg8::bf16_t; using pg8::bf16x8; using pg8::f32x4; using pg8::Unit;
typedef float f32x2_c __attribute__((ext_vector_type(2)));
typedef __bf16 bf16x2_c __attribute__((ext_vector_type(2)));
__device__ __forceinline__ unsigned cvt_pk_bf16(float lo, float hi) { const f32x2_c v = {lo, hi}; return __builtin_bit_cast(unsigned, __builtin_convertvector(v, bf16x2_c)); }
typedef unsigned u32x2 __attribute__((ext_vector_type(2)));
typedef float f32x2 __attribute__((ext_vector_type(2)));
typedef unsigned u32x4 __attribute__((ext_vector_type(4)));
#ifndef LAS
#define LAS __attribute__((address_space(3)))
#endif
constexpr int LDS_BYTES = 144 * 1024;
__device__ __forceinline__ float bf2f(bf16_t b) { return __uint_as_float(((unsigned)b) << 16); }
__device__ __forceinline__ float bflo(unsigned u) { return __uint_as_float(u << 16); }
__device__ __forceinline__ float bfhi(unsigned u) { return __uint_as_float(u & 0xffff0000u); }
__device__ __forceinline__ bf16_t f2bf(float f) { return (bf16_t)(cvt_pk_bf16(f, 0.f) & 0xffffu); }

#ifdef MULTI_LAUNCH
__global__ void k_bridge_mix(const float* mix, bf16_t* mixb, size_t n) {
  size_t i = ((size_t)blockIdx.x * blockDim.x + tidx()) * 2;
  if (i < n) *(unsigned*)(mixb + i) = cvt_pk_bf16(mix[i], mix[i + 1]);
}
#endif

template <bool LAST> struct EpiD {
  static constexpr bool PERM = true, AFTER_DRAIN = false;
  const float* resid; float* xout; bf16_t* xb; float* ssq;
  __device__ __forceinline__ void operator()(const f32x4 (&acc)[2][2][4][2], const Unit& u, int wr_, int wc_, int fr_, int fq_) const {
    const int tz = tidx(), wid_ = tz >> 6, wr = wid_ >> 2, wc = wid_ & 3, fr = tz & 15, fq = (tz >> 4) & 3;
    const int row0 = u.pm * 256 + wr * 64 + fr, col0 = u.pn * 256 + wc * 32 + 8 * fq;
#pragma unroll
    for (int ai = 0; ai < 2; ++ai)
#pragma unroll
      for (int m = 0; m < 4; ++m) {
        const size_t row = (size_t)(row0 + ai * 128 + m * 16);
        float ss = 0.f;
#pragma unroll
        for (int bj = 0; bj < 2; ++bj) {
          const size_t o = row * 1024 + col0 + bj * 128;
          const f32x4 r0 = *(const f32x4*)(resid + o), r1 = *(const f32x4*)(resid + o + 4);
          const f32x4 v0 = acc[ai][bj][m][0] + r0, v1 = acc[ai][bj][m][1] + r1;
          *(f32x4*)(xout + o) = v0; *(f32x4*)(xout + o + 4) = v1;
          if (!LAST) {
            u32x4 pk; pk.x = cvt_pk_bf16(v0[0], v0[1]); pk.y = cvt_pk_bf16(v0[2], v0[3]); pk.z = cvt_pk_bf16(v1[0], v1[1]); pk.w = cvt_pk_bf16(v1[2], v1[3]);
            *(u32x4*)(xb + o) = pk;
            ss += v0[0] * v0[0] + v0[1] * v0[1] + v0[2] * v0[2] + v0[3] * v0[3] + v1[0] * v1[0] + v1[1] * v1[1] + v1[2] * v1[2] + v1[3] * v1[3];
          }
        }
        if (!LAST) {
          ss += __shfl_xor(ss, 16); ss += __shfl_xor(ss, 32);
          if (fq == 0) ssq[row * 16 + u.pn * 4 + wc] = ss;
        }
      }
  }
};
struct PhaseDArgs { const bf16_t* mixb; const bf16_t* WoutT; const float* resid; float* xout; bf16_t* xb; float* ssq; };
template <bool LAST> __device__ __forceinline__ void phaseD(LAS unsigned char* lds, const PhaseDArgs& a) {
  pg8::Gemm g{a.mixb, a.WoutT, NPT, 1024, 1024};
  pg8::StaticOrder S; S.init(NPT, 1024, gridDim.x, blockIdx.x);
  EpiD<LAST> E{a.resid, a.xout, a.xb, a.ssq};
  pg8::gemm_phase<EpiD<LAST>, pg8::StaticOrder, false>(lds, g, S, E, nullptr);
}
#ifdef MULTI_LAUNCH
template <bool LAST> __global__ void __launch_bounds__(512, 2) k_phaseD(PhaseDArgs a) {
  extern __shared__ __attribute__((aligned(16))) unsigned char shm[];
  phaseD<LAST>((LAS unsigned char*)shm, a);
}
#endif

__device__ __forceinline__ int win_logical_col(int np) {
  if (np >= 3072) return np < 3096 ? C_GATE + (np - 3072) : -1;
  const int tile = np >> 8, j = np & 255, bj = j >> 7, wc = (j >> 5) & 3, i = j & 31, jj = j & 127;
  switch (tile) {
    case 0: case 1: return (bj ? C_AGATE : C_AVAL) + tile * 128 + jj;
    case 2: return C_ZA + j;
    case 3: return C_BIN + j;
    case 4: return C_ZB + j;
    case 5: case 6: return C_Q + ((tile - 5) * 4 + wc) * 64 + bj * 32 + i;
    case 7: case 8: case 9: return C_KV + (tile - 7) * 256 + wc * 64 + bj * 32 + i;
    default: return C_ZC + (tile - 10) * 256 + j;
  }
}
#ifdef MULTI_LAUNCH
template <int MODE  >
__global__ void __launch_bounds__(256) k_transpose_w(const float* src, int ld_src, const float* scale, bf16_t* dst, int N, int K) {
  __shared__ float t[64][65];
  const int n0 = blockIdx.x * 64, k0 = blockIdx.y * 64, tid = tidx();
  for (int i = tid; i < 4096; i += 256) {
    const int k = i >> 6, n = i & 63;
    int col = MODE == 1 ? win_logical_col(n0 + n) : (n0 + n);
    float v = 0.f;
    if (n0 + n < N && col >= 0) { v = src[(size_t)(k0 + k) * ld_src + col]; if (scale) v *= scale[k0 + k]; }
    t[k][n] = v;
  }
  __syncthreads();
  for (int i = tid; i < 2048; i += 256) {
    const int n = i >> 5, k = (i & 31) * 2;
    if (n0 + n < N) *(unsigned*)(dst + (size_t)(n0 + n) * K + k0 + k) = cvt_pk_bf16(t[k][n], t[k + 1][n]);
  }
}
#endif

#ifdef MULTI_LAUNCH
__global__ void k_bridge_q(const float* qbuf, bf16_t* qb, size_t n) {
  size_t i = ((size_t)blockIdx.x * blockDim.x + tidx()) * 2;
  const float sc = 0.125f * 1.4426950408889634f;
  if (i < n) *(unsigned*)(qb + i) = cvt_pk_bf16(qbuf[i] * sc, qbuf[i + 1] * sc);
}
#endif
#ifdef MULTI_LAUNCH
__global__ void k_bridge_kv(const float* rows, int br, bf16_t* kk, bf16_t* vT) {
  size_t i = (size_t)blockIdx.x * blockDim.x + tidx();
  if (i >= (size_t)NPT * 128) return;
  const int d = (int)(i & 63), g = (int)((i >> 6) & 1); const size_t tok = i >> 7; const int b = (int)(tok / SEQ), t = (int)(tok % SEQ);
  kk[(((size_t)b * 2 + g) * SEQ + t) * 64 + d] = f2bf(rows[tok * 768 + br * 256 + g * 64 + d]);
  vT[(((size_t)b * 2 + g) * 64 + d) * SEQ + t] = f2bf(rows[tok * 768 + br * 256 + 128 + g * 64 + d]);
}
#endif
#ifdef MULTI_LAUNCH
__global__ void k_bridge_kc(const float* kc, const float* vc, bf16_t* kcP, bf16_t* vcPT, int nseq) {
  size_t i = (size_t)blockIdx.x * blockDim.x + tidx();
  if (i >= (size_t)nseq * 128 * 128) return;
  const int d = (int)(i & 63), g = (int)((i >> 6) & 1), c = (int)((i >> 7) & 127), b = (int)(i >> 14);
  const float kv = c < 127 ? kc[i] : 0.f, vv = c < 127 ? vc[i] : 0.f;
  kcP[(((size_t)b * 2 + g) * 128 + c) * 64 + d] = f2bf(kv);
  vcPT[(((size_t)b * 2 + g) * 64 + d) * 128 + c] = f2bf(vv);
}
#endif
#ifdef MULTI_LAUNCH
__global__ void k_bridge_silu(const float* proj, int col0, int ncol, bf16_t* dst, size_t ntok) {
  size_t i = (size_t)blockIdx.x * blockDim.x + tidx();
  if (i >= ntok * ncol) return;
  const size_t tok = i / ncol; const int c = (int)(i % ncol);
  const float z = proj[tok * D_IN + col0 + c];
  dst[i] = f2bf(z / (1.f + __expf(-z)));
}
#endif

#ifndef SKIPCOND
#define SKIPCOND __any(mine)
#endif
typedef float f32x16 __attribute__((ext_vector_type(16)));
typedef short bf16x4 __attribute__((ext_vector_type(4)));
struct PhaseCArgs { const bf16_t *qb, *ks, *vsT, *kw, *vwT, *kcP, *vcPT, *szc; const float* gates; bf16_t* mixb; const float* g_k;   };

__device__ __forceinline__ f32x16 qk_tile(const bf16_t* krows, const bf16x8 (&qf)[4], int c32, int hh) {
  f32x16 s;
#pragma unroll
  for (int i = 0; i < 16; ++i) s[i] = 0.f;
  const bf16_t* kp = krows + (size_t)c32 * 64 + 8 * hh;
  bf16x8 kf[4];
#pragma unroll
  for (int ks = 0; ks < 4; ++ks) kf[ks] = *(const bf16x8*)(kp + 16 * ks);
#pragma unroll
  for (int ks = 0; ks < 4; ++ks) s = __builtin_amdgcn_mfma_f32_32x32x16_bf16(kf[ks], qf[ks], s, 0, 0, 0);
  return s;
}
__device__ __forceinline__ void pv_tile(f32x16 (&o)[2], const bf16_t* vT, int ldv, const f32x16& p, int c32, int hh) {
#pragma unroll
  for (int s = 0; s < 2; ++s) {
    union { bf16x8 v; unsigned u[4]; } pf;
#pragma unroll
    for (int j = 0; j < 4; ++j) pf.u[j] = cvt_pk_bf16(p[8 * s + 2 * j], p[8 * s + 2 * j + 1]);
#pragma unroll
    for (int dt = 0; dt < 2; ++dt) {
      const bf16_t* vp = vT + (size_t)(32 * dt + c32) * ldv + 16 * s + 4 * hh;
      union { bf16x8 v; bf16x4 h[2]; } vf;
      vf.h[0] = *(const bf16x4*)(vp);
      vf.h[1] = *(const bf16x4*)(vp + 8);
      o[dt] = __builtin_amdgcn_mfma_f32_32x32x16_bf16(vf.v, pf.v, o[dt], 0, 0, 0);
    }
  }
}

constexpr int AT_KB = 64 * 144, AT_VB = 64 * 136, AT_STAGE = AT_KB + AT_VB;
constexpr int AT_NBUF = 3;
constexpr int AT_IMP = AT_NBUF * AT_STAGE;
constexpr int AT_OT = AT_IMP + 8192;
struct StageRegs { u32x4 k; u32x4 v; };
__device__ __forceinline__ StageRegs stage_load(const bf16_t* ksrc, const bf16_t* vsrc, int ldv, int tid) {
  StageRegs r;
  r.k = *(const u32x4*)(ksrc + (size_t)(tid >> 3) * 64 + (tid & 7) * 8);
  r.v = *(const u32x4*)(vsrc + (size_t)(tid >> 3) * ldv + (tid & 7) * 8);
  return r;
}
__device__ __forceinline__ void stage_store(LAS unsigned char* buf, const StageRegs& r, int tid) {
  *(LAS u32x4*)(buf + (tid >> 3) * 144 + (tid & 7) * 16) = r.k;
  LAS unsigned char* vp = buf + AT_KB + (tid >> 3) * 136 + (tid & 7) * 16;
  *(LAS u32x2*)vp = (u32x2){r.v.x, r.v.y}; *(LAS u32x2*)(vp + 8) = (u32x2){r.v.z, r.v.w};
}
__device__ __forceinline__ f32x16 qk_lds(const LAS unsigned char* buf, int tt, const bf16x8 (&qf)[4], int c32, int hh) {
  f32x16 s;
#pragma unroll
  for (int i = 0; i < 16; ++i) s[i] = 0.f;
  const LAS unsigned char* kp = buf + (32 * tt + c32) * 144 + 16 * hh;
#pragma unroll
  for (int ks = 0; ks < 4; ++ks) { const bf16x8 kf = *(const LAS bf16x8*)(kp + 32 * ks); s = __builtin_amdgcn_mfma_f32_32x32x16_bf16(kf, qf[ks], s, 0, 0, 0); }
  return s;
}
__device__ __forceinline__ void pv_lds(f32x16 (&o)[2], const LAS unsigned char* buf, int tt, const f32x16& p, int c32, int hh) {
#pragma unroll
  for (int s = 0; s < 2; ++s) {
    union { bf16x8 v; unsigned u[4]; } pf;
#pragma unroll
    for (int j = 0; j < 4; ++j) pf.u[j] = cvt_pk_bf16(p[8 * s + 2 * j], p[8 * s + 2 * j + 1]);
#pragma unroll
    for (int dt = 0; dt < 2; ++dt) {
      const LAS unsigned char* vp = buf + AT_KB + (32 * dt + c32) * 136 + (32 * tt + 16 * s + 4 * hh) * 2;
      union { bf16x8 v; u32x2 h[2]; } vf;
      vf.h[0] = *(const LAS u32x2*)vp; vf.h[1] = *(const LAS u32x2*)(vp + 16);
      o[dt] = __builtin_amdgcn_mfma_f32_32x32x16_bf16(vf.v, pf.v, o[dt], 0, 0, 0);
    }
  }
}
__device__ __forceinline__ f32x16 qk_lds_init(const LAS unsigned char* buf, int tt, const bf16x8 (&qf)[4], int c32, int hh, float cinit) {
  f32x16 s;
#pragma unroll
  for (int i = 0; i < 16; ++i) s[i] = cinit;
  const LAS unsigned char* kp = buf + (32 * tt + c32) * 144 + 16 * hh;
#pragma unroll
  for (int ks = 0; ks < 4; ++ks) { const bf16x8 kf = *(const LAS bf16x8*)(kp + 32 * ks); s = __builtin_amdgcn_mfma_f32_32x32x16_bf16(kf, qf[ks], s, 0, 0, 0); }
  return s;
}
template <bool MASKED>
__device__ __forceinline__ void stage_pv_ref(f32x16 (&o)[2], float& l, const LAS unsigned char* buf, const bf16x8 (&qf)[4], int c32, int hh, float cinit, int klim0, int klo0) {
  f32x16 s0 = qk_lds_init(buf, 0, qf, c32, hh, cinit), s1 = qk_lds_init(buf, 1, qf, c32, hh, cinit);
  float ps = 0.f;
#pragma unroll
  for (int i = 0; i < 16; ++i) {
    float p0 = __builtin_amdgcn_exp2f(s0[i]), p1 = __builtin_amdgcn_exp2f(s1[i]);
    if (MASKED) {
      const int x = (i & 3) + 8 * (i >> 2);
      p0 = (x <= klim0 && x > klo0) ? p0 : 0.f;
      p1 = (x <= klim0 - 32 && x > klo0 - 32) ? p1 : 0.f;
    }
    s0[i] = p0; s1[i] = p1; ps += p0 + p1;
  }
  l += ps;
  pv_lds(o, buf, 0, s0, c32, hh);
  pv_lds(o, buf, 1, s1, c32, hh);
}

#ifdef ATTN_ONLINE
template <bool MASKED>
__device__ __forceinline__ void stage_softmax_pv(f32x16 (&o)[2], float& m, float& l, const LAS unsigned char* buf, const bf16x8 (&qf)[4], int c32, int hh, int klim0, int klo0, bool mine) {
  f32x16 s0 = qk_lds(buf, 0, qf, c32, hh), s1 = qk_lds(buf, 1, qf, c32, hh);
  float mt = NEGF;
  if (MASKED) {
#pragma unroll
    for (int i = 0; i < 16; ++i) {
      const int x = (i & 3) + 8 * (i >> 2);
      s0[i] = (x <= klim0 && x > klo0) ? s0[i] : NEGF;
      s1[i] = (x <= klim0 - 32 && x > klo0 - 32) ? s1[i] : NEGF;
      mt = fmaxf(mt, fmaxf(s0[i], s1[i]));
    }
  } else {
#pragma unroll
    for (int i = 0; i < 16; ++i) mt = fmaxf(mt, fmaxf(s0[i], s1[i]));
    mt = mine ? mt : NEGF;
  }
  mt = fmaxf(mt, __shfl_xor(mt, 32));
  const float mn = fmaxf(m, mt);
  const float alpha = __builtin_amdgcn_exp2f(m - mn);
  float ps = 0.f;
  if (MASKED) {
#pragma unroll
    for (int i = 0; i < 16; ++i) {
      const float p0 = (s0[i] > -1e29f) ? __builtin_amdgcn_exp2f(s0[i] - mn) : 0.f, p1 = (s1[i] > -1e29f) ? __builtin_amdgcn_exp2f(s1[i] - mn) : 0.f;
      s0[i] = p0; s1[i] = p1; ps += p0 + p1;
    }
  } else {
    const float msub = mine ? mn : 1e30f;
#pragma unroll
    for (int i = 0; i < 16; ++i) { s0[i] = __builtin_amdgcn_exp2f(s0[i] - msub); s1[i] = __builtin_amdgcn_exp2f(s1[i] - msub); ps += s0[i] + s1[i]; }
  }
  l = l * alpha + ps; m = mn;
  if (!__all(alpha == 1.f)) {
#pragma unroll
    for (int i = 0; i < 16; ++i) { o[0][i] *= alpha; o[1][i] *= alpha; }
  }
  pv_lds(o, buf, 0, s0, c32, hh);
  pv_lds(o, buf, 1, s1, c32, hh);
}

#endif
__device__ __forceinline__ void attn_item(const PhaseCArgs& a, LAS unsigned char* lds, int b, int qbi, int g) {
  const int tid = tidx(), w = tid >> 6, lane = tid & 63, c32 = lane & 31, hh = lane >> 5;
  const int t0 = qbi * 64, tl = c32 >> 2, r = c32 & 3;
  const int t = t0 + 8 * w + tl, head = 4 * g + r;
  const size_t tok = (size_t)b * SEQ + t;
  const size_t bg = (size_t)b * 2 + g;
  LAS float* impl = (LAS float*)(lds + AT_IMP) + w * 256;
  bf16x8 qf[4];
  {
    const bf16_t* qp = a.qb + (tok * 8 + head) * 64 + 8 * hh;
#pragma unroll
    for (int ks = 0; ks < 4; ++ks) qf[ks] = *(const bf16x8*)(qp + 16 * ks);
  }
  const float* gt = a.gates + tok * 24;
  const float gate_c = gt[head], gate_s = gt[8 + head], gate_w = gt[16 + head];
  float ref_s, ref_w;
  {
    float gs = fabsf(a.g_k[64 + lane]), gw = fabsf(a.g_k[128 + lane]);
#pragma unroll
    for (int o_ = 32; o_ > 0; o_ >>= 1) { gs = fmaxf(gs, __shfl_xor(gs, o_)); gw = fmaxf(gw, __shfl_xor(gw, o_)); }
    float qq = 0.f;
#pragma unroll
    for (int ks = 0; ks < 4; ++ks)
#pragma unroll
      for (int j = 0; j < 8; ++j) { const float qv = bf2f((bf16_t)qf[ks][j]); qq = fmaf(qv, qv, qq); }
    qq += __shfl_xor(qq, 32);
    const float qn = sqrtf(qq) * 8.f * 1.02f;
    ref_s = qn * gs; ref_w = qn * gw;
  }
  asm volatile("" : "+v"(ref_s), "+v"(ref_w));
  const int wj0 = qbi >= 4 ? qbi - 4 : 0;
  const int n_slc = qbi + 1, n_win = qbi - wj0 + 1, n_st = 4 + n_slc + n_win;
  const bf16_t* kcb = a.kcP + bg * 128 * 64; const bf16_t* vcb = a.vcPT + bg * 64 * 128;
  const bf16_t* ksb = a.ks + bg * SEQ * 64;  const bf16_t* vsb = a.vsT + bg * 64 * SEQ;
  const bf16_t* kwb = a.kw + bg * SEQ * 64;  const bf16_t* vwb = a.vwT + bg * 64 * SEQ;
#define AT_SRC(s_, KP, VP, LDV) do { const int s__ = (s_);                                                        \
    if (s__ < 4) { KP = kcb + (size_t)(s__ & 1) * 64 * 64; VP = vcb + (s__ & 1) * 64; LDV = 128; }                 \
    else if (s__ < 4 + n_slc) { const int j__ = s__ - 4; KP = ksb + (size_t)j__ * 64 * 64; VP = vsb + j__ * 64; LDV = SEQ; } \
    else { const int j__ = wj0 + (s__ - 4 - n_slc); KP = kwb + (size_t)j__ * 64 * 64; VP = vwb + j__ * 64; LDV = SEQ; } } while (0)
  StageRegs sr;
  { const bf16_t* kp; const bf16_t* vp; int ldv; AT_SRC(0, kp, vp, ldv); sr = stage_load(kp, vp, ldv, tid); }
  stage_store(lds, sr, tid);
  __syncthreads();
  f32x16 o[2];
#pragma unroll
  for (int i = 0; i < 16; ++i) { o[0][i] = 0.f; o[1][i] = 0.f; }
  LAS f32x4* otl = (LAS f32x4*)(lds + AT_OT) + (w * 8) * 64 + lane;
  float m = NEGF, l = 0.f, inv = 0.f, prev = 0.f;
  unsigned selmask = 0u;
  const int clim = ((t - 31) >> 4) - 4 * hh;
#pragma unroll 1
  for (int s = 0; s < n_st; ++s) {
    const LAS unsigned char* buf = lds + (s % AT_NBUF) * AT_STAGE;
    if (s + 1 < n_st) { const bf16_t* kp; const bf16_t* vp; int ldv; AT_SRC(s + 1, kp, vp, ldv); sr = stage_load(kp, vp, ldv, tid); }
    if (s < 2) {
      f32x16 s0 = qk_lds(buf, 0, qf, c32, hh), s1 = qk_lds(buf, 1, qf, c32, hh);
      const int cl = clim - 64 * s;
      float mt = NEGF;
#pragma unroll
      for (int i = 0; i < 16; ++i) { const int x = (i & 3) + 8 * (i >> 2); s0[i] = x <= cl ? s0[i] : NEGF; s1[i] = x <= cl - 32 ? s1[i] : NEGF; mt = fmaxf(mt, fmaxf(s0[i], s1[i])); }
      mt = fmaxf(mt, __shfl_xor(mt, 32));
      const float mn = fmaxf(m, mt);
      float ps = 0.f;
#pragma unroll
      for (int i = 0; i < 16; ++i) { ps += (s0[i] > -1e29f) ? __builtin_amdgcn_exp2f(s0[i] - mn) : 0.f; ps += (s1[i] > -1e29f) ? __builtin_amdgcn_exp2f(s1[i] - mn) : 0.f; }
      l = l * __builtin_amdgcn_exp2f(m - mn) + ps; m = mn;
      if (s == 1) { l += __shfl_xor(l, 32); inv = l > 0.f ? 1.f / l : 0.f; }
    } else if (s < 4) {
#pragma unroll
      for (int tt = 0; tt < 2; ++tt) {
        f32x16 sc = qk_lds(buf, tt, qf, c32, hh);
        const int cl = clim - 64 * (s - 2) - 32 * tt;
#pragma unroll
        for (int i = 0; i < 16; ++i) { const bool valid = ((i & 3) + 8 * (i >> 2)) <= cl; sc[i] = valid ? __builtin_amdgcn_exp2f(sc[i] - m) * inv : 0.f; }
#pragma unroll
        for (int ii = 0; ii < 4; ++ii) {
          const float q4 = (sc[4 * ii] + sc[4 * ii + 1]) + (sc[4 * ii + 2] + sc[4 * ii + 3]);
          const float pp = __shfl_xor(sc[4 * ii + 3], 32);
          float v = q4 + (hh ? pp : prev);
          prev = pp;
          v += __shfl_xor(v, 1); v += __shfl_xor(v, 2);
          if (r == 0) impl[tl * 32 + 2 * (4 * (2 * (s - 2) + tt) + ii) + hh] = v;
        }
        pv_lds(o, buf, tt, sc, c32, hh);
      }
      if (s == 3) {
#pragma unroll
        for (int dt = 0; dt < 2; ++dt)
#pragma unroll
          for (int i4 = 0; i4 < 4; ++i4) otl[(dt * 4 + i4) * 64] = (f32x4){gate_c * o[dt][4 * i4], gate_c * o[dt][4 * i4 + 1], gate_c * o[dt][4 * i4 + 2], gate_c * o[dt][4 * i4 + 3]};
#pragma unroll
        for (int i = 0; i < 16; ++i) { o[0][i] = 0.f; o[1][i] = 0.f; }
        m = NEGF; l = 0.f;
      }
    } else if (s < 4 + n_slc) {
      const int j = s - 4;
      const bool mine = (selmask >> j) & 1u;
      if (__any(mine)) {
#ifdef ATTN_ONLINE
        if (j < qbi) stage_softmax_pv<false>(o, m, l, buf, qf, c32, hh, 0, 0, mine);
        else { const int klim = mine ? (t - 64 * j - 4 * hh) : -1; stage_softmax_pv<true>(o, m, l, buf, qf, c32, hh, klim, -1000000, mine); }
#else
        const float cinit = mine ? -ref_s : -1e30f;
        if (j < qbi) stage_pv_ref<false>(o, l, buf, qf, c32, hh, cinit, 0, 0);
        else stage_pv_ref<true>(o, l, buf, qf, c32, hh, cinit, t - 64 * j - 4 * hh, -1000000);
#endif
      }
      if (j == qbi) {
        l += __shfl_xor(l, 32);
        const float sc = gate_s / fmaxf(l, 1e-37f);
#pragma unroll
        for (int dt = 0; dt < 2; ++dt)
#pragma unroll
          for (int i4 = 0; i4 < 4; ++i4) { f32x4 v = otl[(dt * 4 + i4) * 64]; v[0] += sc * o[dt][4 * i4]; v[1] += sc * o[dt][4 * i4 + 1]; v[2] += sc * o[dt][4 * i4 + 2]; v[3] += sc * o[dt][4 * i4 + 3]; otl[(dt * 4 + i4) * 64] = v; }
#pragma unroll
        for (int i = 0; i < 16; ++i) { o[0][i] = 0.f; o[1][i] = 0.f; }
        m = NEGF; l = 0.f;
      }
    } else {
      const int j = wj0 + (s - 4 - n_slc);
      const int tmin = t0 + 8 * w;
      if (64 * j + 63 > tmin - 256) {
#ifdef ATTN_ONLINE
        if (j < qbi && j >= qbi - 3) stage_softmax_pv<false>(o, m, l, buf, qf, c32, hh, 0, 0, true);
        else { const int khi = t - 64 * j - 4 * hh; stage_softmax_pv<true>(o, m, l, buf, qf, c32, hh, khi, khi - 256, true); }
#else
        if (j < qbi && j >= qbi - 3) stage_pv_ref<false>(o, l, buf, qf, c32, hh, -ref_w, 0, 0);
        else { const int khi = t - 64 * j - 4 * hh; stage_pv_ref<true>(o, l, buf, qf, c32, hh, -ref_w, khi, khi - 256); }
#endif
      }
    }
    if (s + 1 < n_st) stage_store(lds + ((s + 1) % AT_NBUF) * AT_STAGE, sr, tid);
    __syncthreads();
    if (s == 3) {
      const int tl2 = lane >> 3, sg = lane & 7, cur = qbi;
      float scv[32];
#pragma unroll
      for (int s2 = 0; s2 < 32; ++s2) {
        const float v = impl[tl2 * 32 + s2];
        const bool forced = (s2 == 0) || (s2 == cur) || (s2 == cur - 1);
        scv[s2] = (s2 <= cur) ? (forced ? 1e4f : v) : -1e4f;
      }
      unsigned mk = 0u;
#pragma unroll
      for (int e = 0; e < 4; ++e) {
        const int sx = sg * 4 + e;
        float mine = 0.f;
#pragma unroll
        for (int s2 = 0; s2 < 32; ++s2) mine = (s2 == sx) ? scv[s2] : mine;
        int rank = 0;
#pragma unroll
        for (int s2 = 0; s2 < 32; ++s2) rank += (scv[s2] > mine || (scv[s2] == mine && s2 < sx)) ? 1 : 0;
        if (rank < 8 && sx <= cur) mk |= 1u << sx;
      }
      mk |= __shfl_xor(mk, 1); mk |= __shfl_xor(mk, 2); mk |= __shfl_xor(mk, 4);
      selmask = __shfl(mk, tl * 8);
    }
  }
#undef AT_SRC
  l += __shfl_xor(l, 32);
  const float scw = gate_w / fmaxf(l, 1e-37f);
#pragma unroll
  for (int dt = 0; dt < 2; ++dt)
#pragma unroll
    for (int ii = 0; ii < 4; ++ii) {
      const int d0 = 32 * dt + 8 * ii + 4 * hh;
      const f32x4 pk = otl[(dt * 4 + ii) * 64];
      const u32x2 z = *(const u32x2*)(a.szc + tok * 512 + head * 64 + d0);
      u32x2 ov;
      ov.x = cvt_pk_bf16((pk[0] + scw * o[dt][4 * ii]) * bflo(z.x), (pk[1] + scw * o[dt][4 * ii + 1]) * bfhi(z.x));
      ov.y = cvt_pk_bf16((pk[2] + scw * o[dt][4 * ii + 2]) * bflo(z.y), (pk[3] + scw * o[dt][4 * ii + 3]) * bfhi(z.y));
      *(u32x2*)(a.mixb + tok * 1024 + 512 + head * 64 + d0) = ov;
    }
}
__device__ __forceinline__ void phaseC(LAS unsigned char* lds, const PhaseCArgs& a) {
  for (int p = blockIdx.x; p < 256; p += gridDim.x) {
    const int b = p >> 5, g = (p >> 4) & 1, qlo = p & 15;
    attn_item(a, lds, b, qlo, g);
    __syncthreads();
    attn_item(a, lds, b, 31 - qlo, g);
    __syncthreads();
  }
}
#ifdef MULTI_LAUNCH
__global__ void __launch_bounds__(512, 2) k_phaseC(PhaseCArgs a) {
  extern __shared__ __attribute__((aligned(16))) unsigned char shm[];
  phaseC((LAS unsigned char*)shm, a);
}
#endif

#ifdef MULTI_LAUNCH
__global__ void k_bridge_cvt(const float* src, int ld_src, int col0, int ncol, bf16_t* dst, size_t ntok) {
  size_t i = (size_t)blockIdx.x * blockDim.x + tidx();
  if (i >= ntok * ncol) return;
  const size_t tok = i / ncol; const int c = (int)(i % ncol);
  dst[i] = f2bf(src[tok * ld_src + col0 + c]);
}
#endif
#ifdef MULTI_LAUNCH
__global__ void __launch_bounds__(256) k_prep_x(const float* xp, const float* xs, bf16_t* xb, float* ssq) {
  const int row = blockIdx.x * 4 + (tidx() >> 6), lane = tidx() & 63;
  if (row >= NTOK) return;
  const float* x = row < NPT ? xp + (size_t)row * 1024 : xs + (size_t)(row - NPT) * 1024;
#pragma unroll
  for (int j = 0; j < 4; ++j) {
    const f32x4 v = *(const f32x4*)(x + j * 256 + lane * 4);
    u32x2 pk; pk.x = cvt_pk_bf16(v[0], v[1]); pk.y = cvt_pk_bf16(v[2], v[3]);
    *(u32x2*)(xb + (size_t)row * 1024 + j * 256 + lane * 4) = pk;
    float ss = v[0] * v[0] + v[1] * v[1] + v[2] * v[2] + v[3] * v[3];
    ss += __shfl_xor(ss, 1); ss += __shfl_xor(ss, 2); ss += __shfl_xor(ss, 4); ss += __shfl_xor(ss, 8);
    if ((lane & 15) == 0) ssq[(size_t)row * 16 + j * 4 + (lane >> 4)] = ss;
  }
}
#endif
#ifdef MULTI_LAUNCH
__global__ void __launch_bounds__(64) k_prep_cbias(const float* pe, const float* w1, float* cbias) {
  const int lk = blockIdx.x, e = tidx();
  const float* pp = pe + (size_t)lk * 2048; const float* ww = w1 + (size_t)lk * 2048 * 64;
  float acc = 0.f;
  for (int k = 0; k < 2048; ++k) acc = fmaf(pp[k], ww[(size_t)k * 64 + e], acc);
  cbias[lk * 64 + e] = acc;
}
#endif
__device__ __forceinline__ float rinv_from_ssq(const float* ssq, size_t row) {
  const f32x4* p = (const f32x4*)(ssq + row * 16);
  const f32x4 a = p[0], b = p[1], c = p[2], d = p[3];
  const float s = ((a[0] + a[1]) + (a[2] + a[3])) + ((b[0] + b[1]) + (b[2] + b[3])) + ((c[0] + c[1]) + (c[2] + c[3])) + ((d[0] + d[1]) + (d[2] + d[3]));
  return rsqrtf(s * (1.f / 1024.f) + 1e-6f);
}
__device__ __forceinline__ f32x4 mfma16(bf16x8 a, bf16x8 b, f32x4 c) { return __builtin_amdgcn_mfma_f32_16x16x32_bf16(a, b, c, 0, 0, 0); }
__device__ __forceinline__ float fsilu(float z) { return z / (1.f + __expf(-z)); }
__device__ __forceinline__ float fsigmoid(float z) { return 1.f / (1.f + __expf(-z)); }

template <int NT> __device__ __forceinline__ void small_gemm(LAS unsigned char* lds, const bf16_t* A, int lda, const bf16_t* Bt, int ldb, int K, f32x4 (&acc)[NT]) {
  const int tid = tidx(), w = tid >> 6, lane = tid & 63, fr = lane & 15, fq = lane >> 4;
  constexpr int ST = 272, BUF = (128 + 16 * NT) * ST, NB = (16 * NT * 16 + 511) / 512;
  const int ar = tid >> 2, ap = tid & 3;
  const bf16_t* asrc = A + (size_t)ar * lda + ap * 32;
  u32x4 areg[4], breg[NB];
#pragma unroll
  for (int nt = 0; nt < NT; ++nt) acc[nt] = (f32x4){0.f, 0.f, 0.f, 0.f};
  auto loadc = [&](int c) {
#pragma unroll
    for (int i = 0; i < 4; ++i) areg[i] = *(const u32x4*)(asrc + c * 128 + i * 8);
#pragma unroll
    for (int i = 0; i < NB; ++i) { const int pc = tid + i * 512; if (pc < 16 * NT * 16) breg[i] = *(const u32x4*)(Bt + (size_t)(pc >> 4) * ldb + c * 128 + (pc & 15) * 8); }
  };
  auto storec = [&](int c) {
    LAS unsigned char* base = lds + (c & 1) * BUF;
#pragma unroll
    for (int i = 0; i < 4; ++i) *(LAS u32x4*)(base + ar * ST + ap * 64 + i * 16) = areg[i];
#pragma unroll
    for (int i = 0; i < NB; ++i) { const int pc = tid + i * 512; if (pc < 16 * NT * 16) *(LAS u32x4*)(base + (128 + (pc >> 4)) * ST + (pc & 15) * 16) = breg[i]; }
  };
  const int nc = K / 128;
  loadc(0);
#pragma unroll 1
  for (int c = 0; c < nc; ++c) {
    storec(c);
    if (c + 1 < nc) loadc(c + 1);
    __syncthreads();
    const LAS unsigned char* base = lds + (c & 1) * BUF;
#pragma unroll
    for (int i = 0; i < 4; ++i) {
      const bf16x8 af = *(const LAS bf16x8*)(base + (16 * w + fr) * ST + i * 64 + fq * 16);
#pragma unroll
      for (int nt = 0; nt < NT; ++nt) { const bf16x8 bf = *(const LAS bf16x8*)(base + (128 + nt * 16 + fr) * ST + i * 64 + fq * 16); acc[nt] = mfma16(bf, af, acc[nt]); }
    }
  }
  __syncthreads();
}

struct PhaseBArgs {
  const bf16_t *glu, *bin, *sza, *szb, *xb; const float* ssq;
  const bf16_t *WpwT, *WpoolT, *WgT, *W1T, *W2T; const float* cbias;
  const float *w_dw, *b_dw, *ln_g, *ln_b, *b_pw, *pool_scale;
  const float* cmp_rows_p;
  bf16_t *mixb, *kcP, *vcPT; float* gates;
#ifdef PROBE_REP
  int repb[4];
#endif
};
#ifdef PROBE_REP
#define REPB(i) _Pragma("unroll 1") for (int repb_ = 0; repb_ < a.repb[i]; ++repb_)
#else
#define REPB(i)
#endif

__device__ __forceinline__ void conv_item(const PhaseBArgs& a, LAS unsigned char* lds, int b, int chunk) {
  const int tid = tidx(), w = tid >> 6, lane = tid & 63;
  const int t0 = chunk * 128;
  for (int i = tid; i < 158 * 32; i += 512) {
    const int row = i >> 5, ch = i & 31, t = t0 - 30 + row;
    u32x4 v = {0u, 0u, 0u, 0u};
    if (t >= 0) v = *(const u32x4*)(a.glu + ((size_t)b * SEQ + t) * 256 + ch * 8);
    *(LAS u32x4*)(lds + row * 512 + ch * 16) = v;
  }
  __syncthreads();
  const int cp = tid & 127, tg = tid >> 7;
  f32x2 res[32];
  {
    const f32x2 bd = *(const f32x2*)(a.b_dw + 2 * cp);
    f32x2 wt[31];
#pragma unroll
    for (int k = 0; k < 31; ++k) wt[k] = *(const f32x2*)(a.w_dw + k * 256 + 2 * cp);
    const LAS unsigned* wp = (const LAS unsigned*)(lds + (tg * 32) * 512 + cp * 4);
#ifdef PROBE_REP
    _Pragma("unroll 1") for (int rq_ = 0; rq_ < a.repb[1]; ++rq_) { asm volatile("" ::: "memory");
#endif
#pragma unroll
    for (int blk = 0; blk < 4; ++blk) {
      f32x2 xw[38];
#pragma unroll
      for (int i = 0; i < 38; ++i) { const unsigned xv = wp[(blk * 8 + i) * 128]; xw[i] = (f32x2){bflo(xv), bfhi(xv)}; }
      f32x2 ac[8];
#pragma unroll
      for (int j = 0; j < 8; ++j) ac[j] = bd;
#pragma unroll
      for (int k = 0; k < 31; ++k)
#pragma unroll
        for (int j = 0; j < 8; ++j) ac[j] = __builtin_elementwise_fma(wt[k], xw[j + k], ac[j]);
#pragma unroll
      for (int j = 0; j < 8; ++j) res[blk * 8 + j] = ac[j];
    }
#ifdef PROBE_REP
    }
#endif
  }
  __syncthreads();
#pragma unroll
  for (int j = 0; j < 32; ++j) *(LAS f32x2*)(lds + (tg * 32 + j) * 1088 + cp * 8) = res[j];
  __syncthreads();
  {
    const int tok = tid >> 2, q = tid & 3;
    f32x4 v[16]; float s = 0.f;
#pragma unroll
    for (int i = 0; i < 16; ++i) { v[i] = *(const LAS f32x4*)(lds + tok * 1088 + (4 * i + q) * 16); s += (v[i][0] + v[i][1]) + (v[i][2] + v[i][3]); }
    s += __shfl_xor(s, 1); s += __shfl_xor(s, 2);
    const float mean = s * (1.f / 256.f);
    float s2 = 0.f;
#pragma unroll
    for (int i = 0; i < 16; ++i) { v[i] = v[i] - mean; s2 += (v[i][0] * v[i][0] + v[i][1] * v[i][1]) + (v[i][2] * v[i][2] + v[i][3] * v[i][3]); }
    s2 += __shfl_xor(s2, 1); s2 += __shfl_xor(s2, 2);
    const float rstd = rsqrtf(s2 * (1.f / 256.f) + 1e-6f);
#pragma unroll
    for (int i = 0; i < 16; ++i) {
      const int c0 = (4 * i + q) * 4;
      const f32x4 gg = *(const f32x4*)(a.ln_g + c0), bb = *(const f32x4*)(a.ln_b + c0);
      f32x4 z = v[i] * rstd * gg + bb;
      u32x2 pk; pk.x = cvt_pk_bf16(fsilu(z[0]), fsilu(z[1])); pk.y = cvt_pk_bf16(fsilu(z[2]), fsilu(z[3]));
      *(LAS u32x2*)(lds + tok * 1088 + c0 * 2) = pk;
    }
  }
  __syncthreads();
  {
    const int fr = lane & 15, fq = lane >> 4;
    bf16x8 bfr[2][8];
#pragma unroll
    for (int nt = 0; nt < 2; ++nt)
#pragma unroll
      for (int ks = 0; ks < 8; ++ks) bfr[nt][ks] = *(const bf16x8*)(a.WpwT + (size_t)(32 * w + nt * 16 + fr) * 256 + ks * 32 + fq * 8);
    const size_t tok0 = (size_t)b * SEQ + t0;
#pragma unroll 2
    for (int mt = 0; mt < 8; ++mt) {
      f32x4 acc0 = {0.f, 0.f, 0.f, 0.f}, acc1 = {0.f, 0.f, 0.f, 0.f};
#pragma unroll
      for (int ks = 0; ks < 8; ++ks) {
        const bf16x8 af = *(const LAS bf16x8*)(lds + (16 * mt + fr) * 1088 + (ks * 32 + fq * 8) * 2);
        acc0 = mfma16(bfr[0][ks], af, acc0); acc1 = mfma16(bfr[1][ks], af, acc1);
      }
      const size_t tok = tok0 + 16 * mt + fr;
#pragma unroll
      for (int nt = 0; nt < 2; ++nt) {
        const f32x4 ac = nt ? acc1 : acc0;
        const int c0 = 32 * w + nt * 16 + 4 * fq;
        const f32x4 bp = *(const f32x4*)(a.b_pw + c0);
        const u32x2 z = *(const u32x2*)(a.sza + tok * 256 + c0);
        u32x2 ov;
        ov.x = cvt_pk_bf16((ac[0] + bp[0]) * bflo(z.x), (ac[1] + bp[1]) * bfhi(z.x));
        ov.y = cvt_pk_bf16((ac[2] + bp[2]) * bflo(z.y), (ac[3] + bp[3]) * bfhi(z.y));
        *(u32x2*)(a.mixb + tok * 1024 + c0) = ov;
      }
    }
  }
  __syncthreads();
}

__device__ __forceinline__ void pool_item(const PhaseBArgs& a, LAS unsigned char* lds, int b, int chunk) {
  const int tid = tidx(), w = tid >> 6, lane = tid & 63;
  const int t0 = chunk * 128;
  constexpr int DOFF = 143 * 512;
  for (int i = tid; i < 143 * 32; i += 512) {
    const int row = i >> 5, ch = i & 31, t = t0 - 15 + row;
    u32x4 v = {0u, 0u, 0u, 0u};
    if (t >= 0) v = *(const u32x4*)(a.bin + ((size_t)b * SEQ + t) * 256 + ch * 8);
    *(LAS u32x4*)(lds + row * 512 + ch * 16) = v;
  }
  __syncthreads();
  {
    const int cp = tid & 127, tg = tid >> 7, grp = cp >> 5, wn = 2 << grp;
    const LAS unsigned* wp = (const LAS unsigned*)(lds + cp * 4);
    const int r0 = 15 + tg * 32;
    float run0 = 0.f, run1 = 0.f;
    for (int i = 1; i < wn; ++i) { const unsigned xv = wp[(r0 - i) * 128]; run0 += bflo(xv); run1 += bfhi(xv); }
#pragma unroll 4
    for (int j = 0; j < 32; ++j) {
      const int rr = r0 + j, t = t0 + tg * 32 + j;
      const unsigned xv = wp[rr * 128];
      const float x0 = bflo(xv), x1 = bfhi(xv);
      run0 += x0; run1 += x1;
      const float icnt = 1.f / (float)min(wn, t + 1);
      const unsigned dv = cvt_pk_bf16(run0 * icnt - x0, run1 * icnt - x1);
      *(LAS unsigned*)(lds + DOFF + (tg * 32 + j) * 528 + cp * 4) = dv;
      const unsigned xo = wp[(rr - wn + 1) * 128];
      run0 -= bflo(xo); run1 -= bfhi(xo);
    }
  }
  __syncthreads();
  {
    const int fr = lane & 15, fq = lane >> 4;
    const size_t tok = (size_t)b * SEQ + t0 + 16 * w + fr;
#pragma unroll
    for (int g = 0; g < 4; ++g) {
      f32x4 acc[4];
#pragma unroll
      for (int nt = 0; nt < 4; ++nt) acc[nt] = (f32x4){0.f, 0.f, 0.f, 0.f};
#pragma unroll
      for (int ks = 0; ks < 2; ++ks) {
        const bf16x8 af = *(const LAS bf16x8*)(lds + DOFF + (16 * w + fr) * 528 + (g * 64 + ks * 32 + fq * 8) * 2);
#pragma unroll
        for (int nt = 0; nt < 4; ++nt) {
          const bf16x8 bf = *(const bf16x8*)(a.WpoolT + (size_t)(g * 64 + nt * 16 + fr) * 64 + ks * 32 + fq * 8);
          acc[nt] = mfma16(bf, af, acc[nt]);
        }
      }
#pragma unroll
      for (int nt = 0; nt < 4; ++nt) {
        const int c0 = g * 64 + nt * 16 + 4 * fq;
        const f32x4 sc = *(const f32x4*)(a.pool_scale + c0);
        const u32x2 z = *(const u32x2*)(a.szb + tok * 256 + c0);
        u32x2 ov;
        ov.x = cvt_pk_bf16(acc[nt][0] * sc[0] * bflo(z.x), acc[nt][1] * sc[1] * bfhi(z.x));
        ov.y = cvt_pk_bf16(acc[nt][2] * sc[2] * bflo(z.y), acc[nt][3] * sc[3] * bfhi(z.y));
        *(u32x2*)(a.mixb + tok * 1024 + 256 + c0) = ov;
      }
    }
  }
  __syncthreads();
}

__device__ __forceinline__ void gates_item(const PhaseBArgs& a, LAS unsigned char* lds, int chunk) {
  const int tid = tidx(), w = tid >> 6, lane = tid & 63, fr = lane & 15, fq = lane >> 4;
  const size_t row = (size_t)chunk * 128 + 16 * w + fr;
  f32x4 acc[2];
  small_gemm<2>(lds, a.xb + (size_t)chunk * 128 * 1024, 1024, a.WgT, 1024, 1024, acc);
  const float rinv = rinv_from_ssq(a.ssq, row);
#pragma unroll
  for (int nt = 0; nt < 2; ++nt) {
    const int c0 = nt * 16 + 4 * fq;
    if (c0 < 24) {
      f32x4 o;
#pragma unroll
      for (int e = 0; e < 4; ++e) o[e] = fsigmoid(acc[nt][e] * rinv);
      *(f32x4*)(a.gates + row * 24 + c0) = o;
    }
  }
}

struct CmpSrc { const float* base; const int* pages; };
__device__ __forceinline__ const float* cmp_row_ptr(const CmpSrc& s, int pos) {
  if (s.pages) return s.base + ((size_t)s.pages[pos >> 7] * 128 + (pos & 127)) * 256;
  return s.base + (size_t)pos * 256;
}
__device__ __forceinline__ float gelu_tanh_f(float x) {
  const float u = 0.7978845608028654f * (x + 0.044715f * x * x * x);
  const float e = __expf(2.f * u);
  const float th = 1.f - 2.f / (e + 1.f);
  return 0.5f * x * (1.f + th);
}
template <bool VROWMAJOR>
__device__ __forceinline__ void compress_item(LAS unsigned char* lds, const CmpSrc& src, int g, int kv, const bf16_t* W1T  , const bf16_t* W2T  ,
                                              const float* cbias  , bf16_t* kc_out  , bf16_t* vcT_out  ) {
  const int tid = tidx(), w = tid >> 6, lane = tid & 63, fr = lane & 15, fq = lane >> 4;
  constexpr int BST = 272;
  constexpr int BBUF = 128 * BST;
  constexpr int POFF = 2 * BBUF;
  const float* arow = cmp_row_ptr(src, (16 * w + fr) * 16) + kv * 128 + g * 64 + fq * 8;
  const bf16_t* bsrc = W1T + (size_t)(tid >> 2) * 1024 + (tid & 3) * 32;
  LAS unsigned char* bdst = lds + (tid >> 2) * BST + (tid & 3) * 64;
  f32x4 acc[8];
#pragma unroll
  for (int nt = 0; nt < 8; ++nt) acc[nt] = (f32x4){0.f, 0.f, 0.f, 0.f};
  u32x4 breg[4]; f32x4 areg[8];
#pragma unroll
  for (int i = 0; i < 4; ++i) breg[i] = *(const u32x4*)(bsrc + i * 8);
#pragma unroll
  for (int i = 0; i < 4; ++i) { areg[2 * i] = *(const f32x4*)(arow + (i >> 1) * 256 + (i & 1) * 32); areg[2 * i + 1] = *(const f32x4*)(arow + (i >> 1) * 256 + (i & 1) * 32 + 4); }
#pragma unroll 1
  for (int c = 0; c < 8; ++c) {
    LAS unsigned char* bb = bdst + (c & 1) * BBUF;
#pragma unroll
    for (int i = 0; i < 4; ++i) *(LAS u32x4*)(bb + i * 16) = breg[i];
    bf16x8 af[4];
#pragma unroll
    for (int i = 0; i < 4; ++i) {
      union { bf16x8 v; unsigned u[4]; } t;
      t.u[0] = cvt_pk_bf16(areg[2 * i][0], areg[2 * i][1]); t.u[1] = cvt_pk_bf16(areg[2 * i][2], areg[2 * i][3]);
      t.u[2] = cvt_pk_bf16(areg[2 * i + 1][0], areg[2 * i + 1][1]); t.u[3] = cvt_pk_bf16(areg[2 * i + 1][2], areg[2 * i + 1][3]);
      af[i] = t.v;
    }
    if (c < 7) {
#pragma unroll
      for (int i = 0; i < 4; ++i) breg[i] = *(const u32x4*)(bsrc + (c + 1) * 128 + i * 8);
#pragma unroll
      for (int i = 0; i < 4; ++i) { const float* ap = arow + (2 * (c + 1) + (i >> 1)) * 256 + (i & 1) * 32; areg[2 * i] = *(const f32x4*)ap; areg[2 * i + 1] = *(const f32x4*)(ap + 4); }
    }
    __syncthreads();
    const LAS unsigned char* br = lds + (c & 1) * BBUF + fr * BST + fq * 16;
#pragma unroll
    for (int i = 0; i < 4; ++i)
#pragma unroll
      for (int nt = 0; nt < 8; ++nt) {
        const bf16x8 bf = *(const LAS bf16x8*)(br + nt * 16 * BST + i * 64);
        acc[nt] = mfma16(bf, af[i], acc[nt]);
      }
  }
#pragma unroll
  for (int nt = 0; nt < 8; ++nt) *(LAS f32x4*)(lds + POFF + (16 * w + fr) * 528 + (nt * 16 + 4 * fq) * 4) = acc[nt];
  __syncthreads();
  {
    const int i = 16 * w + fr, i1 = i < 127 ? i + 1 : 127;
    f32x4 o[4];
#pragma unroll
    for (int nt = 0; nt < 4; ++nt) o[nt] = (f32x4){0.f, 0.f, 0.f, 0.f};
#pragma unroll
    for (int ks = 0; ks < 2; ++ks) {
      const int k0 = ks * 32 + fq * 8;
      union { bf16x8 v; unsigned u[4]; } hf;
#pragma unroll
      for (int h2 = 0; h2 < 2; ++h2) {
        const f32x4 pa = *(const LAS f32x4*)(lds + POFF + i * 528 + (k0 + 4 * h2) * 4);
        const f32x4 pb = *(const LAS f32x4*)(lds + POFF + i1 * 528 + (64 + k0 + 4 * h2) * 4);
        const f32x4 cb = *(const f32x4*)(cbias + k0 + 4 * h2);
        const f32x4 x = pa + pb + cb;
        hf.u[2 * h2] = cvt_pk_bf16(gelu_tanh_f(x[0]), gelu_tanh_f(x[1]));
        hf.u[2 * h2 + 1] = cvt_pk_bf16(gelu_tanh_f(x[2]), gelu_tanh_f(x[3]));
      }
#pragma unroll
      for (int nt = 0; nt < 4; ++nt) {
        const bf16x8 bf = *(const bf16x8*)(W2T + (size_t)(nt * 16 + fr) * 64 + k0);
        o[nt] = mfma16(bf, hf.v, o[nt]);
      }
    }
    const bool real = i < 127;
#pragma unroll
    for (int nt = 0; nt < 4; ++nt) {
      const int c0 = nt * 16 + 4 * fq;
      const float v0 = real ? o[nt][0] : 0.f, v1 = real ? o[nt][1] : 0.f, v2 = real ? o[nt][2] : 0.f, v3 = real ? o[nt][3] : 0.f;
      if (kv == 0) { u32x2 pk; pk.x = cvt_pk_bf16(v0, v1); pk.y = cvt_pk_bf16(v2, v3); *(u32x2*)(kc_out + (size_t)i * 64 + c0) = pk; }
      else if (VROWMAJOR) { u32x2 pk; pk.x = cvt_pk_bf16(v0, v1); pk.y = cvt_pk_bf16(v2, v3); *(u32x2*)(vcT_out + (size_t)i * 64 + c0) = pk; }
      else { vcT_out[(size_t)(c0 + 0) * 128 + i] = f2bf(v0); vcT_out[(size_t)(c0 + 1) * 128 + i] = f2bf(v1); vcT_out[(size_t)(c0 + 2) * 128 + i] = f2bf(v2); vcT_out[(size_t)(c0 + 3) * 128 + i] = f2bf(v3); }
    }
  }
  __syncthreads();
}

__device__ __forceinline__ void phaseB(LAS unsigned char* lds, const PhaseBArgs& a) {
  const int G = gridDim.x, wg = blockIdx.x;
#ifndef NO_CONV
  REPB(0) for (int it = wg; it < 128; it += G) conv_item(a, lds, it >> 4, it & 15);
#endif
#ifndef NO_POOL
  for (int it = (wg + G - 128 % G) % G; it < 128; it += G) pool_item(a, lds, it >> 4, it & 15);
#endif
#ifndef NO_CMPR
  REPB(2) for (int it = (wg + G - 128 % G) % G; it < 32; it += G) {
    const int b = it >> 2, g = (it >> 1) & 1, kv = it & 1;
    CmpSrc src{a.cmp_rows_p + (size_t)b * SEQ * 256, nullptr};
    compress_item<false>(lds, src, g, kv, a.W1T + (size_t)kv * 128 * 1024, a.W2T + (size_t)kv * 4096, a.cbias + kv * 64,
                  a.kcP + ((size_t)b * 2 + g) * 128 * 64, a.vcPT + ((size_t)b * 2 + g) * 64 * 128);
  }
#endif
#ifndef NO_GATES
  for (int it = (wg + G - 160 % G) % G; it < 128; it += G) gates_item(a, lds, it);
#endif
}
#ifdef MULTI_LAUNCH
__global__ void __launch_bounds__(512, 2) k_phaseB(PhaseBArgs a) {
  extern __shared__ __attribute__((aligned(16))) unsigned char shm[];
  phaseB((LAS unsigned char*)shm, a);
}
#endif

struct EpiA {
  static constexpr bool PERM = true, AFTER_DRAIN = false;
  int l; int pad_;
  const float* ssq; const float* g_q; const float* g_k; const float* cs;
  bf16_t *glu, *bin, *sza, *szb, *szc, *qb, *ks, *vsT, *kw, *vwT; float* out;
  __device__ __forceinline__ void norm_rope(f32x4 (&v)[2][2], const float* gain, int t, int fq) const {
    float ss = 0.f;
#pragma unroll
    for (int bj = 0; bj < 2; ++bj)
#pragma unroll
      for (int n = 0; n < 2; ++n) ss += (v[bj][n][0] * v[bj][n][0] + v[bj][n][1] * v[bj][n][1]) + (v[bj][n][2] * v[bj][n][2] + v[bj][n][3] * v[bj][n][3]);
    ss += __shfl_xor(ss, 16); ss += __shfl_xor(ss, 32);
    const float rn = rsqrtf(ss * (1.f / 64.f) + 1e-6f);
#pragma unroll
    for (int bj = 0; bj < 2; ++bj)
#pragma unroll
      for (int n = 0; n < 2; ++n) { const f32x4 gg = *(const f32x4*)(gain + 32 * bj + 8 * fq + 4 * n); v[bj][n] = v[bj][n] * rn * gg; }
#pragma unroll
    for (int n = 0; n < 2; ++n) {
      const f32x4 c0 = *(const f32x4*)(cs + t * 16 + 8 * n), c1 = *(const f32x4*)(cs + t * 16 + 8 * n + 4);
      const float cc[4] = {c0[0], c0[2], c1[0], c1[2]}, sn[4] = {c0[1], c0[3], c1[1], c1[3]};
#pragma unroll
      for (int e = 0; e < 4; ++e) {
        const float y = v[0][n][e], pr = __shfl_xor(y, 16);
        const float r0 = y * cc[e] - pr * sn[e], r1 = y * cc[e] + pr * sn[e];
        v[0][n][e] = fq == 0 ? r0 : (fq == 1 ? r1 : y);
      }
    }
  }
  __device__ __forceinline__ void operator()(const f32x4 (&acc)[2][2][4][2], const Unit& u, int wr_, int wc_, int fr_, int fq_) const {
    const int tz = tidx(), wid_ = tz >> 6, wr = wid_ >> 2, wc = wid_ & 3, fr = tz & 15, fq = (tz >> 4) & 3;
    const int pn = u.pn;
    const int row0 = u.pm * 256 + wr * 64 + fr;
    const int jc = 32 * wc + 8 * fq;
#pragma unroll
    for (int ai = 0; ai < 2; ++ai)
#pragma unroll
      for (int m = 0; m < 4; ++m) {
        const int row = row0 + ai * 128 + m * 16;
        const size_t tok = (size_t)row;
        const int b = row >> 11, t = row & 2047;
        float rinv;
        { const f32x4 p = *(const f32x4*)(ssq + tok * 16 + fq * 4); float sq = (p[0] + p[1]) + (p[2] + p[3]); sq += __shfl_xor(sq, 16); sq += __shfl_xor(sq, 32); rinv = rsqrtf(sq * (1.f / 1024.f) + 1e-6f); }
        f32x4 v[2][2];
#pragma unroll
        for (int bj = 0; bj < 2; ++bj)
#pragma unroll
          for (int n = 0; n < 2; ++n) v[bj][n] = acc[ai][bj][m][n] * rinv;
        if (pn < 2) {
          const int c = pn * 128 + jc;
          f32x4 o0, o1;
#pragma unroll
          for (int e = 0; e < 4; ++e) { o0[e] = v[0][0][e] * fsigmoid(v[1][0][e]); o1[e] = v[0][1][e] * fsigmoid(v[1][1][e]); }
          u32x4 pk; pk.x = cvt_pk_bf16(o0[0], o0[1]); pk.y = cvt_pk_bf16(o0[2], o0[3]); pk.z = cvt_pk_bf16(o1[0], o1[1]); pk.w = cvt_pk_bf16(o1[2], o1[3]);
          *(u32x4*)(glu + tok * 256 + c) = pk;
          if (t >= 2018) { float* dst = out + O_CONVP + ((size_t)(l * 8 + b) * 30 + (t - 2018)) * 256 + c; *(f32x4*)dst = o0; *(f32x4*)(dst + 4) = o1; }
        } else if (pn == 3) {
#pragma unroll
          for (int bj = 0; bj < 2; ++bj) {
            const int c = 128 * bj + jc;
            u32x4 pk; pk.x = cvt_pk_bf16(v[bj][0][0], v[bj][0][1]); pk.y = cvt_pk_bf16(v[bj][0][2], v[bj][0][3]); pk.z = cvt_pk_bf16(v[bj][1][0], v[bj][1][1]); pk.w = cvt_pk_bf16(v[bj][1][2], v[bj][1][3]);
            *(u32x4*)(bin + tok * 256 + c) = pk;
            if (t >= 2033) { float* dst = out + O_POOLP + ((size_t)(l * 8 + b) * 15 + (t - 2033)) * 256 + c; *(f32x4*)dst = v[bj][0]; *(f32x4*)(dst + 4) = v[bj][1]; }
          }
        } else if (pn == 2 || pn == 4 || pn >= 10) {
          bf16_t* base = pn == 2 ? sza + tok * 256 : (pn == 4 ? szb + tok * 256 : szc + tok * 512 + (pn - 10) * 256);
#pragma unroll
          for (int bj = 0; bj < 2; ++bj) {
            u32x4 pk; pk.x = cvt_pk_bf16(fsilu(v[bj][0][0]), fsilu(v[bj][0][1])); pk.y = cvt_pk_bf16(fsilu(v[bj][0][2]), fsilu(v[bj][0][3]));
            pk.z = cvt_pk_bf16(fsilu(v[bj][1][0]), fsilu(v[bj][1][1])); pk.w = cvt_pk_bf16(fsilu(v[bj][1][2]), fsilu(v[bj][1][3]));
            *(u32x4*)(base + 128 * bj + jc) = pk;
          }
        } else if (pn <= 6) {
          const int head = (pn - 5) * 4 + wc;
          norm_rope(v, g_q, t, fq);
          const float sc = 0.125f * 1.4426950408889634f;
#pragma unroll
          for (int bj = 0; bj < 2; ++bj) {
            u32x4 pk; pk.x = cvt_pk_bf16(v[bj][0][0] * sc, v[bj][0][1] * sc); pk.y = cvt_pk_bf16(v[bj][0][2] * sc, v[bj][0][3] * sc);
            pk.z = cvt_pk_bf16(v[bj][1][0] * sc, v[bj][1][1] * sc); pk.w = cvt_pk_bf16(v[bj][1][2] * sc, v[bj][1][3] * sc);
            *(u32x4*)(qb + (tok * 8 + head) * 64 + 32 * bj + 8 * fq) = pk;
          }
        } else {
          const int br = pn - 7, kvsel = wc >> 1, g = wc & 1;
          if (kvsel == 0) norm_rope(v, g_k + br * 64, t, fq);
          float* fdst = nullptr;
          if (br == 0) fdst = out + O_CMPP + ((size_t)l * NPT + tok) * 256;
          else if (br == 1) fdst = out + O_SLCP + ((size_t)l * NPT + tok) * 256;
          else if (t >= 1792) fdst = out + O_WINP + ((size_t)(l * 8 + b) * 256 + (t - 1792)) * 256;
          if (fdst) {
#pragma unroll
            for (int bj = 0; bj < 2; ++bj) { float* d2 = fdst + kvsel * 128 + g * 64 + 32 * bj + 8 * fq; *(f32x4*)d2 = v[bj][0]; *(f32x4*)(d2 + 4) = v[bj][1]; }
          }
          if (br >= 1) {
            const size_t bg = (size_t)b * 2 + g;
            if (kvsel == 0) {
              bf16_t* kd = (br == 1 ? ks : kw) + (bg * SEQ + t) * 64;
#pragma unroll
              for (int bj = 0; bj < 2; ++bj) {
                u32x4 pk; pk.x = cvt_pk_bf16(v[bj][0][0], v[bj][0][1]); pk.y = cvt_pk_bf16(v[bj][0][2], v[bj][0][3]); pk.z = cvt_pk_bf16(v[bj][1][0], v[bj][1][1]); pk.w = cvt_pk_bf16(v[bj][1][2], v[bj][1][3]);
                *(u32x4*)(kd + 32 * bj + 8 * fq) = pk;
              }
            } else {
              bf16_t* vd = (br == 1 ? vsT : vwT) + bg * 64 * SEQ + t;
#pragma unroll
              for (int bj = 0; bj < 2; ++bj)
#pragma unroll
                for (int n = 0; n < 2; ++n)
#pragma unroll
                  for (int e = 0; e < 4; ++e) vd[(size_t)(32 * bj + 8 * fq + 4 * n + e) * SEQ] = f2bf(v[bj][n][e]);
            }
          }
        }
      }
  }
};
struct PhaseAArgs { EpiA epi; const bf16_t* xb; const bf16_t* WinT; };
__device__ __forceinline__ void phaseA(LAS unsigned char* lds, const PhaseAArgs& a) {
  pg8::Gemm g{a.xb, a.WinT, NPT, 3072, 1024};
  pg8::StaticOrder S; S.init(NPT, 3072, gridDim.x, blockIdx.x);
  pg8::gemm_phase<EpiA, pg8::StaticOrder, false>(lds, g, S, a.epi, nullptr);
}
#ifdef MULTI_LAUNCH
__global__ void __launch_bounds__(512, 2) k_phaseA(PhaseAArgs a) {
  extern __shared__ __attribute__((aligned(16))) unsigned char shm[];
  phaseA((LAS unsigned char*)shm, a);
}
#endif

__device__ __forceinline__ float wsum(float v) {
#pragma unroll
  for (int o = 32; o > 0; o >>= 1) v += __shfl_xor(v, o);
  return v;
}
__device__ __forceinline__ float wmax(float v) {
#pragma unroll
  for (int o = 32; o > 0; o >>= 1) v = fmaxf(v, __shfl_xor(v, o));
  return v;
}
template <int NT> __device__ __forceinline__ void thin_gemm(const bf16_t* A, int lda, const bf16_t* Bt, int ldb, int K, f32x4 (&acc)[NT], int fr, int fq) {
  const bf16_t* ap = A + (size_t)fr * lda + fq * 8;
  const bf16_t* bp = Bt + (size_t)fr * ldb + fq * 8;
#pragma unroll
  for (int nt = 0; nt < NT; ++nt) acc[nt] = (f32x4){0.f, 0.f, 0.f, 0.f};
#pragma unroll 4
  for (int k0 = 0; k0 < K; k0 += 32) {
    const bf16x8 af = *(const bf16x8*)(ap + k0);
#pragma unroll
    for (int nt = 0; nt < NT; ++nt) { const bf16x8 bf = *(const bf16x8*)(bp + (size_t)nt * 16 * ldb + k0); acc[nt] = mfma16(bf, af, acc[nt]); }
  }
}
__device__ __forceinline__ void s1_unit(LAS unsigned char* lds, const bf16_t* xb_s, const float* ssq_s, const bf16_t* WinT, float* sproj, int u) {
  const int tid = tidx(), w = tid >> 6, lane = tid & 63, fr = lane & 15, fq = lane >> 4;
  const int n0 = 64 * u, row = 16 * w + fr;
  f32x4 acc[4];
  if (u < 48) small_gemm<4>(lds, xb_s, 1024, WinT + (size_t)n0 * 1024, 1024, 1024, acc);
  else { f32x4 a2[2]; small_gemm<2>(lds, xb_s, 1024, WinT + (size_t)n0 * 1024, 1024, 1024, a2); acc[0] = a2[0]; acc[1] = a2[1]; acc[2] = acc[3] = (f32x4){0.f, 0.f, 0.f, 0.f}; }
  const float rinv = rinv_from_ssq(ssq_s, row);
#pragma unroll
  for (int nt = 0; nt < 4; ++nt) {
    const int np = n0 + nt * 16 + 4 * fq;
    if (np < 3096) { const int lc = win_logical_col(np); *(f32x4*)(sproj + (size_t)row * 3104 + lc) = acc[nt] * rinv; }
  }
}
template <bool LAST> __device__ __forceinline__ void s4_unit(LAS unsigned char* lds, const bf16_t* mix_s, const bf16_t* WoutT, const float* xs, float* xs_out, bf16_t* xb_s, float* ssq_s, int u) {
  const int tid = tidx(), w = tid >> 6, lane = tid & 63, fr = lane & 15, fq = lane >> 4;
  const int n0 = 64 * u, row = 16 * w + fr;
  f32x4 acc[4];
  small_gemm<4>(lds, mix_s, 1024, WoutT + (size_t)n0 * 1024, 1024, 1024, acc);
  float ss = 0.f;
#pragma unroll
  for (int nt = 0; nt < 4; ++nt) {
    const int c = n0 + nt * 16 + 4 * fq;
    const f32x4 v = acc[nt] + *(const f32x4*)(xs + (size_t)row * 1024 + c);
    *(f32x4*)(xs_out + (size_t)row * 1024 + c) = v;
    if (!LAST) { u32x2 pk; pk.x = cvt_pk_bf16(v[0], v[1]); pk.y = cvt_pk_bf16(v[2], v[3]); *(u32x2*)(xb_s + (size_t)row * 1024 + c) = pk; ss += (v[0] * v[0] + v[1] * v[1]) + (v[2] * v[2] + v[3] * v[3]); }
  }
  if (!LAST) { ss += __shfl_xor(ss, 16); ss += __shfl_xor(ss, 32); if (fq == 0) ssq_s[(size_t)row * 16 + u] = ss; }
}

struct SampArgs {
  int l; int pad_;
  const float* sproj;
  const float *g_q, *g_k, *cs;
  const float *state_conv_l, *state_pool_l;
  const float *w_dw, *b_dw, *ln_g, *ln_b, *w_pw, *b_pw, *w_pool, *pool_scale;
  const float *cache_slc_l, *cache_win_l; const int* page_table;
  const bf16_t *kcS, *vcST;
  float *sq, *srows, *sgates;
  bf16_t* mix_s;
  float* out;
};
__device__ __forceinline__ void s2_item(const SampArgs& a, LAS unsigned char* lds, int b) {
  const int tid = tidx(), w = tid >> 6, lane = tid & 63, l = a.l;
  const float* pr = a.sproj + (size_t)b * 3104;
  LAS float* sh = (LAS float*)lds;
  const float* csp = a.cs + 2048 * 16;
  {
    const float v = pr[C_Q + w * 64 + lane];
    const float y = v * rsqrtf(wsum(v * v) * (1.f / 64.f) + 1e-6f) * a.g_q[lane];
    const float pp = __shfl_xor(y, 8);
    float o = y;
    if (lane < 16) { const int j = lane & 7; const float c = csp[j * 2], sn = csp[j * 2 + 1]; o = lane < 8 ? y * c - pp * sn : y * c + pp * sn; }
    a.sq[(size_t)b * 512 + w * 64 + lane] = o;
  }
  if (w < 6) {
    const int br = w >> 1, g = w & 1;
    const float v = pr[C_KV + br * 256 + g * 64 + lane];
    const float y = v * rsqrtf(wsum(v * v) * (1.f / 64.f) + 1e-6f) * a.g_k[br * 64 + lane];
    const float pp = __shfl_xor(y, 8);
    float o = y;
    if (lane < 16) { const int j = lane & 7; const float c = csp[j * 2], sn = csp[j * 2 + 1]; o = lane < 8 ? y * c - pp * sn : y * c + pp * sn; }
    const float vv = pr[C_KV + br * 256 + 128 + g * 64 + lane];
    a.srows[(size_t)b * 768 + br * 256 + g * 64 + lane] = o;
    a.srows[(size_t)b * 768 + br * 256 + 128 + g * 64 + lane] = vv;
    float* dst = br == 0 ? a.out + O_CMPS + ((size_t)l * NSM + b) * 256 : (br == 1 ? a.out + O_SLCS + ((size_t)l * NSM + b) * 256 : a.out + O_WINS + (((size_t)l * NSM + b) * 256 + 255) * 256);
    dst[g * 64 + lane] = o; dst[128 + g * 64 + lane] = vv;
  }
  if (tid < 24) a.sgates[(size_t)b * 24 + tid] = fsigmoid(pr[C_GATE + tid]);
  float yv = 0.f;
  if (tid < 256) {
    const int c = tid;
    const float glu = pr[C_AVAL + c] * fsigmoid(pr[C_AGATE + c]);
    const float* st = a.state_conv_l + (size_t)b * 30 * 256 + c;
    float* cso = a.out + O_CONVS + ((size_t)l * NSM + b) * 30 * 256 + c;
    float acc = a.b_dw[c];
#pragma unroll
    for (int k = 0; k < 30; ++k) { const float sv = st[k * 256]; acc = fmaf(a.w_dw[k * 256 + c], sv, acc); if (k >= 1) cso[(k - 1) * 256] = sv; }
    acc = fmaf(a.w_dw[30 * 256 + c], glu, acc);
    cso[29 * 256] = glu;
    yv = acc;
  } else {
    const int ch = tid - 256, g = ch >> 6, wn = 2 << g;
    const float cur = pr[C_BIN + ch];
    const float* st = a.state_pool_l + (size_t)b * 15 * 256 + ch;
    float* pso = a.out + O_POOLS + ((size_t)l * NSM + b) * 15 * 256 + ch;
    float total = cur;
#pragma unroll
    for (int j = 1; j < 15; ++j) pso[(j - 1) * 256] = st[j * 256];
    pso[14 * 256] = cur;
    for (int j = 1; j < wn; ++j) total += st[(15 - j) * 256];
    sh[256 + ch] = total / (float)wn - cur;
  }
  { const float s1 = wsum(yv); if (lane == 0) sh[512 + w] = s1; }
  __syncthreads();
  const float mean = (sh[512] + sh[513] + sh[514] + sh[515]) * (1.f / 256.f);
  const float xc = yv - mean;
  { const float s2 = wsum(xc * xc); if (lane == 0) sh[520 + w] = s2; }
  __syncthreads();
  if (tid < 256) {
    const float var = (sh[520] + sh[521] + sh[522] + sh[523]) * (1.f / 256.f);
    const float z = xc * rsqrtf(var + 1e-6f) * a.ln_g[tid] + a.ln_b[tid];
    sh[tid] = fsilu(z);
  }
  __syncthreads();
  {
    const int n = tid & 255, kh = tid >> 8;
    const float* wp = a.w_pw + (size_t)(kh * 128) * 256 + n;
    float o = 0.f;
#pragma unroll 16
    for (int k = 0; k < 128; ++k) o = fmaf(sh[kh * 128 + k], wp[(size_t)k * 256], o);
    sh[528 + kh * 256 + n] = o;
  }
  __syncthreads();
  if (tid < 256) {
    const int n = tid;
    const float o = a.b_pw[n] + sh[528 + n] + sh[528 + 256 + n];
    a.mix_s[(size_t)b * 1024 + n] = f2bf(o * fsilu(pr[C_ZA + n]));
  } else {
    const int ch = tid - 256, g = ch >> 6, e = ch & 63;
    float o = 0.f;
#pragma unroll 16
    for (int c = 0; c < 64; ++c) o = fmaf(sh[256 + g * 64 + c], a.w_pool[(g * 64 + c) * 64 + e], o);
    a.mix_s[(size_t)b * 1024 + 256 + ch] = f2bf(o * a.pool_scale[ch] * fsilu(pr[C_ZB + ch]));
  }
  __syncthreads();
}
__device__ __forceinline__ float dot16(const float (&q)[16], const f32x4& k0, const f32x4& k1, const f32x4& k2, const f32x4& k3) {
  float d = 0.f;
#pragma unroll
  for (int i = 0; i < 4; ++i) { d = fmaf(q[i], k0[i], d); d = fmaf(q[4 + i], k1[i], d); d = fmaf(q[8 + i], k2[i], d); d = fmaf(q[12 + i], k3[i], d); }
  return d;
}
__device__ __forceinline__ void s3_item(const SampArgs& a, LAS unsigned char* lds, int n, int g) {
  const int tid = tidx(), w = tid >> 6, lane = tid & 63;
  const int key_l = lane >> 2, qtr = lane & 3;
  const int ksub = lane >> 4, d4 = lane & 15;
  LAS float* qs = (LAS float*)lds;
  LAS float* sc = qs + 256;
  LAS float* imp = sc + 2048;
  LAS int* sel = (LAS int*)(imp + 64);
  LAS float* red = imp + 128;
  const size_t bg = (size_t)n * 2 + g;
  const float* srow = a.srows + (size_t)n * 768;
  if (tid < 256) qs[tid] = a.sq[(size_t)n * 512 + g * 256 + tid] * 0.125f;
  __syncthreads();
  float q[4][16];
#pragma unroll
  for (int h = 0; h < 4; ++h)
#pragma unroll
    for (int i = 0; i < 16; ++i) q[h][i] = qs[h * 64 + qtr * 16 + i];
  float o_c, o_s, o_w;
#define S3_SOFTMAX(NPL)                                                                              \
  if (w < 4) {                                                                                       \
    float v_[NPL]; float m_ = NEGF;                                                                  \
    _Pragma("unroll") for (int i_ = 0; i_ < NPL; ++i_) { v_[i_] = sc[w * 512 + lane + 64 * i_]; m_ = fmaxf(m_, v_[i_]); } \
    m_ = wmax(m_); float s_ = 0.f;                                                                   \
    _Pragma("unroll") for (int i_ = 0; i_ < NPL; ++i_) { v_[i_] = v_[i_] > -1e29f ? __expf(v_[i_] - m_) : 0.f; s_ += v_[i_]; } \
    s_ = 1.f / fmaxf(wsum(s_), 1e-30f);                                                              \
    _Pragma("unroll") for (int i_ = 0; i_ < NPL; ++i_) sc[w * 512 + lane + 64 * i_] = v_[i_] * s_;   \
  }
#define S3_REDUCE(ACC, OUT)                                                                          \
  _Pragma("unroll") for (int h_ = 0; h_ < 4; ++h_) _Pragma("unroll") for (int e_ = 0; e_ < 4; ++e_) { float t_ = ACC[h_][e_]; t_ += __shfl_xor(t_, 16); t_ += __shfl_xor(t_, 32); ACC[h_][e_] = t_; } \
  if (ksub == 0) { _Pragma("unroll") for (int h_ = 0; h_ < 4; ++h_) *(LAS f32x4*)(red + (w * 4 + h_) * 64 + 4 * d4) = (f32x4){ACC[h_][0], ACC[h_][1], ACC[h_][2], ACC[h_][3]}; } \
  __syncthreads();                                                                                   \
  OUT = 0.f;                                                                                         \
  if (tid < 256) { _Pragma("unroll") for (int w_ = 0; w_ < 8; ++w_) OUT += red[w_ * 256 + tid]; }   \
  __syncthreads();
  {
    const int c = 16 * w + key_l;
    const bf16_t* kr = a.kcS + (bg * 128 + c) * 64 + qtr * 16;
    const u32x4 k0 = *(const u32x4*)kr, k1 = *(const u32x4*)(kr + 8);
    const f32x4 f0 = {bflo(k0.x), bfhi(k0.x), bflo(k0.y), bfhi(k0.y)}, f1 = {bflo(k0.z), bfhi(k0.z), bflo(k0.w), bfhi(k0.w)};
    const f32x4 f2 = {bflo(k1.x), bfhi(k1.x), bflo(k1.y), bfhi(k1.y)}, f3 = {bflo(k1.z), bfhi(k1.z), bflo(k1.w), bfhi(k1.w)};
#pragma unroll
    for (int h = 0; h < 4; ++h) {
      float d = dot16(q[h], f0, f1, f2, f3);
      d += __shfl_xor(d, 1); d += __shfl_xor(d, 2);
      if (qtr == 0) sc[h * 512 + c] = c < 127 ? d : NEGF;
    }
  }
  __syncthreads();
  S3_SOFTMAX(2)
  __syncthreads();
  if (tid < 33) {
    const int s = tid, lo = max(0, 4 * s - 1), hi = min(126, 4 * s + 3);
    float v = 0.f;
    for (int rr = 0; rr < 4; ++rr) for (int c = lo; c <= hi; ++c) v += sc[rr * 512 + c];
    const bool forced = (s == 0) || (s == 32) || (s == 31);
    imp[s] = forced ? 1e4f : v;
  }
  {
    float acc[4][4];
#pragma unroll
    for (int h = 0; h < 4; ++h)
#pragma unroll
      for (int e = 0; e < 4; ++e) acc[h][e] = 0.f;
#pragma unroll
    for (int it = 0; it < 4; ++it) {
      const int c = 16 * w + 4 * it + ksub;
      const u32x2 vv = *(const u32x2*)(a.vcST + (bg * 128 + c) * 64 + 4 * d4);
      const float v0 = bflo(vv.x), v1 = bfhi(vv.x), v2 = bflo(vv.y), v3 = bfhi(vv.y);
#pragma unroll
      for (int h = 0; h < 4; ++h) { const float p = sc[h * 512 + c]; acc[h][0] = fmaf(p, v0, acc[h][0]); acc[h][1] = fmaf(p, v1, acc[h][1]); acc[h][2] = fmaf(p, v2, acc[h][2]); acc[h][3] = fmaf(p, v3, acc[h][3]); }
    }
    S3_REDUCE(acc, o_c)
  }
  if (tid == 0) {
    unsigned long long taken = 0ull;
    for (int k = 0; k < 8; ++k) {
      int best = -1; float bv = -3e38f;
      for (int s = 0; s < 33; ++s) if (!((taken >> s) & 1ull) && imp[s] > bv) { bv = imp[s]; best = s; }
      taken |= 1ull << best; sel[k] = best;
    }
  }
  __syncthreads();
  const int blk = sel[w];
  const float* sl_base;
  if (blk < 32) sl_base = a.cache_slc_l + ((size_t)a.page_table[n * 16 + (blk >> 1)] * 128 + (blk & 1) * 64) * 256 + g * 64;
  else sl_base = srow + 256 + g * 64;
  {
    f32x4 kk[4][4];
#pragma unroll
    for (int ps = 0; ps < 4; ++ps) {
      const int j = 16 * ps + key_l;
      const bool valid = blk < 32 || j == 0;
      const float* kr = sl_base + (size_t)(valid ? j : 0) * 256 + qtr * 16;
#pragma unroll
      for (int i = 0; i < 4; ++i) kk[ps][i] = *(const f32x4*)(kr + 4 * i);
    }
#pragma unroll
    for (int ps = 0; ps < 4; ++ps) {
      const int j = 16 * ps + key_l;
      const bool valid = blk < 32 || j == 0;
#pragma unroll
      for (int h = 0; h < 4; ++h) {
        float d = dot16(q[h], kk[ps][0], kk[ps][1], kk[ps][2], kk[ps][3]);
        d += __shfl_xor(d, 1); d += __shfl_xor(d, 2);
        if (qtr == 0) sc[h * 512 + w * 64 + j] = valid ? d : NEGF;
      }
    }
  }
  __syncthreads();
  S3_SOFTMAX(8)
  __syncthreads();
  {
    float acc[4][4];
#pragma unroll
    for (int h = 0; h < 4; ++h)
#pragma unroll
      for (int e = 0; e < 4; ++e) acc[h][e] = 0.f;
    f32x4 vv[16];
#pragma unroll
    for (int it = 0; it < 16; ++it) {
      const int j = 4 * it + ksub;
      const bool valid = blk < 32 || j == 0;
      vv[it] = *(const f32x4*)(sl_base + (size_t)(valid ? j : 0) * 256 + 128 + 4 * d4);
    }
#pragma unroll
    for (int it = 0; it < 16; ++it) {
      const int j = 4 * it + ksub;
#pragma unroll
      for (int h = 0; h < 4; ++h) { const float p = sc[h * 512 + w * 64 + j];
#pragma unroll
        for (int e = 0; e < 4; ++e) acc[h][e] = fmaf(p, vv[it][e], acc[h][e]); }
    }
    S3_REDUCE(acc, o_s)
  }
  const float* wbase = a.cache_win_l + ((size_t)n * 256 + 1) * 256 + g * 64;
  {
    f32x4 kk[2][4];
#pragma unroll
    for (int ps = 0; ps < 2; ++ps) {
      const int i = 32 * w + 16 * ps + key_l;
      const float* kr = (i < 255 ? wbase + (size_t)i * 256 : srow + 512 + g * 64) + qtr * 16;
#pragma unroll
      for (int e = 0; e < 4; ++e) kk[ps][e] = *(const f32x4*)(kr + 4 * e);
    }
#pragma unroll
    for (int ps = 0; ps < 2; ++ps) {
      const int i = 32 * w + 16 * ps + key_l;
#pragma unroll
      for (int h = 0; h < 4; ++h) {
        float d = dot16(q[h], kk[ps][0], kk[ps][1], kk[ps][2], kk[ps][3]);
        d += __shfl_xor(d, 1); d += __shfl_xor(d, 2);
        if (qtr == 0) sc[h * 512 + i] = d;
      }
    }
  }
  __syncthreads();
  S3_SOFTMAX(4)
  __syncthreads();
  {
    float acc[4][4];
#pragma unroll
    for (int h = 0; h < 4; ++h)
#pragma unroll
      for (int e = 0; e < 4; ++e) acc[h][e] = 0.f;
    f32x4 vv[8];
#pragma unroll
    for (int it = 0; it < 8; ++it) {
      const int i = 32 * w + 4 * it + ksub;
      vv[it] = *(const f32x4*)((i < 255 ? wbase + (size_t)i * 256 : srow + 512 + g * 64) + 128 + 4 * d4);
    }
#pragma unroll
    for (int it = 0; it < 8; ++it) {
      const int i = 32 * w + 4 * it + ksub;
#pragma unroll
      for (int h = 0; h < 4; ++h) { const float p = sc[h * 512 + i];
#pragma unroll
        for (int e = 0; e < 4; ++e) acc[h][e] = fmaf(p, vv[it][e], acc[h][e]); }
    }
    S3_REDUCE(acc, o_w)
  }
  if (tid < 256) {
    const int h = g * 4 + (tid >> 6), d = tid & 63;
    const float* gt = a.sgates + (size_t)n * 24;
    const float o = gt[h] * o_c + gt[8 + h] * o_s + gt[16 + h] * o_w;
    a.mix_s[(size_t)n * 1024 + 512 + h * 64 + d] = f2bf(o * fsilu(a.sproj[(size_t)n * 3104 + C_ZC + h * 64 + d]));
  }
  __syncthreads();
#undef S3_SOFTMAX
#undef S3_REDUCE
}

#ifdef MULTI_LAUNCH
__global__ void __launch_bounds__(512, 2) k_s1(const bf16_t* xb_s, const float* ssq_s, const bf16_t* WinT, float* sproj) {
  extern __shared__ __attribute__((aligned(16))) unsigned char shm[];
  for (int u = blockIdx.x; u < 49; u += gridDim.x) s1_unit((LAS unsigned char*)shm, xb_s, ssq_s, WinT, sproj, u);
}
#endif
#ifdef MULTI_LAUNCH
__global__ void __launch_bounds__(512, 2) k_s2(SampArgs a) {
  extern __shared__ __attribute__((aligned(16))) unsigned char shm[];
  for (int b = blockIdx.x; b < NSM; b += gridDim.x) s2_item(a, (LAS unsigned char*)shm, b);
}
#endif
struct CmpSArgs { const float* cache_cmp_l; const int* page_table; const bf16_t *W1T, *W2T; const float* cbias; bf16_t *kcS, *vcST; };
#ifdef MULTI_LAUNCH
__global__ void __launch_bounds__(512, 2) k_cmps(CmpSArgs a) {
  extern __shared__ __attribute__((aligned(16))) unsigned char shm[];
  for (int it = blockIdx.x; it < 512; it += gridDim.x) {
    const int n = it >> 2, g = (it >> 1) & 1, kv = it & 1;
    CmpSrc src{a.cache_cmp_l, a.page_table + n * 16};
    compress_item<true>((LAS unsigned char*)shm, src, g, kv, a.W1T + (size_t)kv * 128 * 1024, a.W2T + (size_t)kv * 4096, a.cbias + kv * 64,
                  a.kcS + ((size_t)n * 2 + g) * 128 * 64, a.vcST + ((size_t)n * 2 + g) * 64 * 128);
  }
}
#endif
#ifdef MULTI_LAUNCH
__global__ void __launch_bounds__(512, 2) k_s3(SampArgs a) {
  extern __shared__ __attribute__((aligned(16))) unsigned char shm[];
  for (int it = blockIdx.x; it < 256; it += gridDim.x) s3_item(a, (LAS unsigned char*)shm, it >> 1, it & 1);
}
#endif
#ifdef MULTI_LAUNCH
template <bool LAST> __global__ void __launch_bounds__(512, 2) k_s4(const bf16_t* mix_s, const bf16_t* WoutT, const float* xs, float* xs_out, bf16_t* xb_s, float* ssq_s) {
  extern __shared__ __attribute__((aligned(16))) unsigned char shm[];
  for (int u = blockIdx.x; u < 16; u += gridDim.x) s4_unit<LAST>((LAS unsigned char*)shm, mix_s, WoutT, xs, xs_out, xb_s, ssq_s, u);
}
#endif
__device__ __forceinline__ void wins_copy(const float* cache_win_l, float* out_l, int part, int nparts) {
  const size_t total4 = (size_t)NSM * 255 * 64;
  for (size_t i = (size_t)part * 512 + tidx(); i < total4; i += (size_t)nparts * 512) {
    const size_t n = i / (255 * 64), rem = i % (255 * 64);
    *(f32x4*)(out_l + n * 65536 + rem * 4) = *(const f32x4*)(cache_win_l + n * 65536 + 256 + rem * 4);
  }
}
#ifdef MULTI_LAUNCH
__global__ void __launch_bounds__(512, 2) k_wins(const float* cache_win_l, float* out_l) { wins_copy(cache_win_l, out_l, blockIdx.x, gridDim.x); }
#endif
}
namespace fast {
constexpr size_t al256(size_t x) { return (x + 255) & ~(size_t)255; }
constexpr size_t WS_BAR = 0;
constexpr size_t WS_CS = al256(WS_BAR + XCD_BAR_WORDS * 4);
constexpr size_t WS_SSQ = al256(WS_CS + 2049 * 16 * 4);
constexpr size_t WS_GATES = al256(WS_SSQ + (size_t)NTOK * 16 * 4);
constexpr size_t WS_CBIAS = al256(WS_GATES + (size_t)NPT * 24 * 4);
constexpr size_t WS_SPROJ = al256(WS_CBIAS + 256 * 4);
constexpr size_t WS_SQ = al256(WS_SPROJ + (size_t)NSM * 3104 * 4);
constexpr size_t WS_SROWS = al256(WS_SQ + (size_t)NSM * 512 * 4);
constexpr size_t WS_SGATES = al256(WS_SROWS + (size_t)NSM * 768 * 4);
constexpr size_t WS_X1P = al256(WS_SGATES + (size_t)NSM * 24 * 4);
constexpr size_t WS_X1S = al256(WS_X1P + (size_t)NPT * 1024 * 4);
constexpr size_t WS_XB = al256(WS_X1S + (size_t)NSM * 1024 * 4);
constexpr size_t WS_MIXB = al256(WS_XB + (size_t)NTOK * 1024 * 2);
constexpr size_t WS_QB = al256(WS_MIXB + (size_t)NTOK * 1024 * 2);
constexpr size_t WS_KSB = al256(WS_QB + (size_t)NPT * 512 * 2);
constexpr size_t WS_VST = al256(WS_KSB + (size_t)NPT * 128 * 2);
constexpr size_t WS_KWB = al256(WS_VST + (size_t)NPT * 128 * 2);
constexpr size_t WS_VWT = al256(WS_KWB + (size_t)NPT * 128 * 2);
constexpr size_t WS_KCP = al256(WS_VWT + (size_t)NPT * 128 * 2);
constexpr size_t WS_VCPT = al256(WS_KCP + (size_t)8 * 2 * 128 * 64 * 2);
constexpr size_t WS_SZC = al256(WS_VCPT + (size_t)8 * 2 * 128 * 64 * 2);
constexpr size_t WS_GLUB = al256(WS_SZC + (size_t)NPT * 512 * 2);
constexpr size_t WS_BINB = al256(WS_GLUB + (size_t)NPT * 256 * 2);
constexpr size_t WS_SZA = al256(WS_BINB + (size_t)NPT * 256 * 2);
constexpr size_t WS_SZB = al256(WS_SZA + (size_t)NPT * 256 * 2);
constexpr size_t WS_WINT = al256(WS_SZB + (size_t)NPT * 256 * 2);
constexpr size_t WS_WOUTT = al256(WS_WINT + (size_t)2 * 3104 * 1024 * 2);
constexpr size_t WS_WPWT = al256(WS_WOUTT + (size_t)2 * 1024 * 1024 * 2);
constexpr size_t WS_WPOOLT = al256(WS_WPWT + (size_t)2 * 65536 * 2);
constexpr size_t WS_W1T = al256(WS_WPOOLT + (size_t)2 * 4 * 4096 * 2);
constexpr size_t WS_W2T = al256(WS_W1T + (size_t)2 * 2 * 128 * 1024 * 2);
constexpr size_t WS_KCS = al256(WS_W2T + (size_t)2 * 2 * 4096 * 2);
constexpr size_t WS_VCST = al256(WS_KCS + (size_t)NSM * 2 * 128 * 64 * 2);
constexpr size_t WS_END = al256(WS_VCST + (size_t)NSM * 2 * 128 * 64 * 2);

struct MegaArgsK {
  const float *x_prompt, *x_sample, *state_conv, *state_pool, *cache_win, *cache_cmp, *cache_slc; const int* page_table;
  const float *w_norm, *w_in, *w_out, *w_dw, *b_dw, *ln_g, *ln_b, *w_pw, *b_pw, *w_pool, *pool_scale, *g_q, *g_k, *cmp_pe, *cmp_w1, *cmp_w2;
  float* out;
  unsigned char* ws;
#ifdef PROBE_REP
  int rep[8];
#endif
};
struct MegaArgs {
  const float *x_prompt, *x_sample, *state_conv, *state_pool, *cache_win, *cache_cmp, *cache_slc; const int* page_table;
  const float *w_norm, *w_in, *w_out, *w_dw, *b_dw, *ln_g, *ln_b, *w_pw, *b_pw, *w_pool, *pool_scale, *g_q, *g_k, *cmp_pe, *cmp_w1, *cmp_w2;
  float* out;
  unsigned* bar;
  float *cs, *ssq, *gatesf, *cbias, *sproj, *sq, *srows, *sgates, *x1p, *x1s;
  bf16_t *xb, *mixb, *qb, *ksb, *vsT, *kwb, *vwT, *kcP, *vcPT, *szc, *glub, *binb, *sza, *szb, *WinT, *WoutT, *WpwT, *WpoolT, *W1T, *W2T, *kcS, *vcST;
#ifdef PROBE_REP
  int rep[8];
#endif
};
#ifdef PROBE_REP
#define REP(i) _Pragma("unroll 1") for (int rep_ = 0; rep_ < a.rep[i]; ++rep_)
#else
#define REP(i)
#endif
__device__ __forceinline__ MegaArgs expand_args(const MegaArgsK& k) {
  MegaArgs a;
  a.x_prompt = k.x_prompt; a.x_sample = k.x_sample; a.state_conv = k.state_conv; a.state_pool = k.state_pool; a.cache_win = k.cache_win; a.cache_cmp = k.cache_cmp; a.cache_slc = k.cache_slc;
  a.page_table = k.page_table; a.w_norm = k.w_norm; a.w_in = k.w_in; a.w_out = k.w_out; a.w_dw = k.w_dw; a.b_dw = k.b_dw; a.ln_g = k.ln_g; a.ln_b = k.ln_b; a.w_pw = k.w_pw; a.b_pw = k.b_pw;
  a.w_pool = k.w_pool; a.pool_scale = k.pool_scale; a.g_q = k.g_q; a.g_k = k.g_k; a.cmp_pe = k.cmp_pe; a.cmp_w1 = k.cmp_w1; a.cmp_w2 = k.cmp_w2; a.out = k.out;
  unsigned char* w = k.ws;
  a.bar = (unsigned*)(w + WS_BAR); a.cs = (float*)(w + WS_CS); a.ssq = (float*)(w + WS_SSQ); a.gatesf = (float*)(w + WS_GATES); a.cbias = (float*)(w + WS_CBIAS);
  a.sproj = (float*)(w + WS_SPROJ); a.sq = (float*)(w + WS_SQ); a.srows = (float*)(w + WS_SROWS); a.sgates = (float*)(w + WS_SGATES); a.x1p = (float*)(w + WS_X1P); a.x1s = (float*)(w + WS_X1S);
  a.xb = (bf16_t*)(w + WS_XB); a.mixb = (bf16_t*)(w + WS_MIXB); a.qb = (bf16_t*)(w + WS_QB); a.ksb = (bf16_t*)(w + WS_KSB); a.vsT = (bf16_t*)(w + WS_VST); a.kwb = (bf16_t*)(w + WS_KWB); a.vwT = (bf16_t*)(w + WS_VWT);
  a.kcP = (bf16_t*)(w + WS_KCP); a.vcPT = (bf16_t*)(w + WS_VCPT); a.szc = (bf16_t*)(w + WS_SZC); a.glub = (bf16_t*)(w + WS_GLUB); a.binb = (bf16_t*)(w + WS_BINB); a.sza = (bf16_t*)(w + WS_SZA); a.szb = (bf16_t*)(w + WS_SZB);
  a.WinT = (bf16_t*)(w + WS_WINT); a.WoutT = (bf16_t*)(w + WS_WOUTT); a.WpwT = (bf16_t*)(w + WS_WPWT); a.WpoolT = (bf16_t*)(w + WS_WPOOLT); a.W1T = (bf16_t*)(w + WS_W1T); a.W2T = (bf16_t*)(w + WS_W2T);
  a.kcS = (bf16_t*)(w + WS_KCS); a.vcST = (bf16_t*)(w + WS_VCST);
#ifdef PROBE_REP
  for (int i = 0; i < 8; ++i) a.rep[i] = k.rep[i];
#endif
  return a;
}

template <int MODE>
__device__ __forceinline__ void transpose_tile(const float* src, int ld_src, const float* scale, bf16_t* dst, int N, int K, int n0, int k0, LAS float* t) {
  const int tid = tidx();
  for (int i = tid; i < 4096; i += 512) {
    const int k = i >> 6, n = i & 63;
    const int col = MODE == 1 ? win_logical_col(n0 + n) : (n0 + n);
    float v = 0.f;
    if (n0 + n < N && col >= 0) { v = src[(size_t)(k0 + k) * ld_src + col]; if (scale) v *= scale[k0 + k]; }
    t[k * 65 + n] = v;
  }
  __syncthreads();
  for (int i = tid; i < 2048; i += 512) {
    const int n = i >> 5, k = (i & 31) * 2;
    if (n0 + n < N) *(unsigned*)(dst + (size_t)(n0 + n) * K + k0 + k) = cvt_pk_bf16(t[k * 65 + n], t[(k + 1) * 65 + n]);
  }
  __syncthreads();
}

__device__ __forceinline__ void phase0(const MegaArgs& a, LAS unsigned char* lds) {
  const int G = gridDim.x, wg = blockIdx.x, tid = tidx();
  LAS float* t = (LAS float*)lds;
  for (int it = wg; it < 2 * 1126; it += G) {
    const int l = it / 1126; int r = it % 1126;
    if (r < 784) { transpose_tile<1>(a.w_in + (size_t)l * 1024 * D_IN, D_IN, a.w_norm + l * 1024, a.WinT + (size_t)l * 3104 * 1024, 3104, 1024, (r % 49) * 64, (r / 49) * 64, t); continue; }
    r -= 784;
    if (r < 256) { transpose_tile<0>(a.w_out + (size_t)l * 1024 * 1024, 1024, nullptr, a.WoutT + (size_t)l * 1024 * 1024, 1024, 1024, (r & 15) * 64, (r >> 4) * 64, t); continue; }
    r -= 256;
    if (r < 16) { transpose_tile<0>(a.w_pw + (size_t)l * 65536, 256, nullptr, a.WpwT + (size_t)l * 65536, 256, 256, (r & 3) * 64, (r >> 2) * 64, t); continue; }
    r -= 16;
    if (r < 4) { transpose_tile<0>(a.w_pool + (size_t)(l * 4 + r) * 4096, 64, nullptr, a.WpoolT + (size_t)(l * 4 + r) * 4096, 64, 64, 0, 0, t); continue; }
    r -= 4;
    if (r < 64) { const int kv = r >> 5, half = (r >> 4) & 1, kt = r & 15;
      transpose_tile<0>(a.cmp_w1 + ((size_t)(l * 2 + kv) * 2048 + half * 1024) * 64, 64, nullptr, a.W1T + ((size_t)(l * 2 + kv) * 128 + half * 64) * 1024, 64, 1024, 0, kt * 64, t); continue; }
    r -= 64;
    transpose_tile<0>(a.cmp_w2 + (size_t)(l * 2 + r) * 4096, 64, nullptr, a.W2T + (size_t)(l * 2 + r) * 4096, 64, 64, 0, 0, t);
  }
  for (int lk = G - 1 - wg; lk >= 0 && lk < 4; lk += G) {
    const int e = tid & 63, part = tid >> 6;
    const float* pp = a.cmp_pe + (size_t)lk * 2048 + part * 256; const float* ww = a.cmp_w1 + ((size_t)lk * 2048 + part * 256) * 64 + e;
    float acc = 0.f;
    for (int k = 0; k < 256; ++k) acc = fmaf(pp[k], ww[(size_t)k * 64], acc);
    t[part * 64 + e] = acc;
    __syncthreads();
    if (tid < 64) { float s = 0.f; for (int p2 = 0; p2 < 8; ++p2) s += t[p2 * 64 + tid]; a.cbias[lk * 64 + tid] = s; }
    __syncthreads();
  }
  for (int i = wg * 512 + tid; i < 2049 * 8; i += G * 512) {
    const int pos = i >> 3, j = i & 7;
    const double ang = (double)pos * pow(500000.0, -(double)j / 8.0);
    a.cs[i * 2] = (float)cos(ang); a.cs[i * 2 + 1] = (float)sin(ang);
  }
  for (int row = wg * 8 + (tid >> 6); row < NTOK; row += G * 8) {
    const int lane = tid & 63;
    const float* x = row < NPT ? a.x_prompt + (size_t)row * 1024 : a.x_sample + (size_t)(row - NPT) * 1024;
#pragma unroll
    for (int j = 0; j < 4; ++j) {
      const f32x4 v = *(const f32x4*)(x + j * 256 + lane * 4);
      u32x2 pk; pk.x = cvt_pk_bf16(v[0], v[1]); pk.y = cvt_pk_bf16(v[2], v[3]);
      *(u32x2*)(a.xb + (size_t)row * 1024 + j * 256 + lane * 4) = pk;
      float ss = v[0] * v[0] + v[1] * v[1] + v[2] * v[2] + v[3] * v[3];
      ss += __shfl_xor(ss, 1); ss += __shfl_xor(ss, 2); ss += __shfl_xor(ss, 4); ss += __shfl_xor(ss, 8);
      if ((lane & 15) == 0) a.ssq[(size_t)row * 16 + j * 4 + (lane >> 4)] = ss;
    }
  }
  for (int l = 0; l < 2; ++l) wins_copy(a.cache_win + (size_t)l * NSM * 65536, a.out + O_WINS + (size_t)l * NSM * 65536, wg, G);
}

__global__ void __launch_bounds__(512, 2) k_mega(MegaArgsK ka) {
  const MegaArgs a = expand_args(ka);
  extern __shared__ __attribute__((aligned(16))) unsigned char shm[];
  LAS unsigned char* lds = (LAS unsigned char*)shm;
  volatile LAS unsigned* xbw = (volatile LAS unsigned*)(lds + LDS_BYTES - 16);
  if (tidx() == 0) { xbw[0] = 0u; xbw[1] = 0u; xbw[2] = 0u; xbw[3] = 0u; }
  __syncthreads();
  (void)xcd_barrier_post(a.bar, xbw);
#define GRID_BARRIER() do { XcdBarrier b_; b_.bar = a.bar; b_.x = xb_xcc_id(); b_.st = xbw; xcd_barrier(b_); } while (0)
  const int G = gridDim.x, wg = blockIdx.x;

  REP(0) phase0(a, lds);
  GRID_BARRIER();

#pragma unroll 1
  for (int l = 0; l < 2; ++l) {
    const float* xp = l == 0 ? a.x_prompt : a.x1p;
    const float* xs = l == 0 ? a.x_sample : a.x1s;
    float* xp_out = l == 0 ? a.x1p : a.out + O_YP;
    float* xs_out = l == 0 ? a.x1s : a.out + O_YS;
    const bf16_t* WinT_l = a.WinT + (size_t)l * 3104 * 1024;
    const bf16_t* W1T_l = a.W1T + (size_t)l * 2 * 128 * 1024;
    const bf16_t* W2T_l = a.W2T + (size_t)l * 2 * 4096;
    const float* cbias_l = a.cbias + l * 128;
    {
      PhaseAArgs aa;
      aa.epi.l = l; aa.epi.pad_ = 0; aa.epi.ssq = a.ssq; aa.epi.g_q = a.g_q + l * 64; aa.epi.g_k = a.g_k + l * 192; aa.epi.cs = a.cs;
      aa.epi.glu = a.glub; aa.epi.bin = a.binb; aa.epi.sza = a.sza; aa.epi.szb = a.szb; aa.epi.szc = a.szc; aa.epi.qb = a.qb;
      aa.epi.ks = a.ksb; aa.epi.vsT = a.vsT; aa.epi.kw = a.kwb; aa.epi.vwT = a.vwT; aa.epi.out = a.out;
      aa.xb = a.xb; aa.WinT = WinT_l;
      REP(1) phaseA(lds, aa);
    }
    for (int u = wg; u < 49; u += G) s1_unit(lds, a.xb + (size_t)NPT * 1024, a.ssq + (size_t)NPT * 16, WinT_l, a.sproj, u);
    REP(7) for (int it = wg; it < 512; it += G) {
      const int n = it >> 2, g = (it >> 1) & 1, kv = it & 1;
      CmpSrc src{a.cache_cmp + (size_t)l * N_PHYS * 128 * 256, a.page_table + n * 16};
      compress_item<true>(lds, src, g, kv, W1T_l + (size_t)kv * 128 * 1024, W2T_l + (size_t)kv * 4096, cbias_l + kv * 64,
                    a.kcS + ((size_t)n * 2 + g) * 128 * 64, a.vcST + ((size_t)n * 2 + g) * 64 * 128);
    }
    GRID_BARRIER();
#ifdef PROBE_REP
    for (int rx_ = 1; rx_ < a.rep[2]; ++rx_) GRID_BARRIER();
#endif
    SampArgs sa;
    sa.l = l; sa.pad_ = 0; sa.sproj = a.sproj; sa.g_q = a.g_q + l * 64; sa.g_k = a.g_k + l * 192; sa.cs = a.cs;
    sa.state_conv_l = a.state_conv + (size_t)l * NSM * 30 * 256; sa.state_pool_l = a.state_pool + (size_t)l * NSM * 15 * 256;
    sa.w_dw = a.w_dw + l * 31 * 256; sa.b_dw = a.b_dw + l * 256; sa.ln_g = a.ln_g + l * 256; sa.ln_b = a.ln_b + l * 256; sa.w_pw = a.w_pw + (size_t)l * 65536; sa.b_pw = a.b_pw + l * 256;
    sa.w_pool = a.w_pool + (size_t)l * 4 * 4096; sa.pool_scale = a.pool_scale + l * 256;
    sa.cache_slc_l = a.cache_slc + (size_t)l * N_PHYS * 128 * 256; sa.cache_win_l = a.cache_win + (size_t)l * NSM * 65536; sa.page_table = a.page_table;
    sa.kcS = a.kcS; sa.vcST = a.vcST; sa.sq = a.sq; sa.srows = a.srows; sa.sgates = a.sgates; sa.mix_s = a.mixb + (size_t)NPT * 1024; sa.out = a.out;
    {
      PhaseBArgs ba;
      ba.glu = a.glub; ba.bin = a.binb; ba.sza = a.sza; ba.szb = a.szb; ba.xb = a.xb; ba.ssq = a.ssq;
      ba.WpwT = a.WpwT + (size_t)l * 65536; ba.WpoolT = a.WpoolT + (size_t)l * 4 * 4096; ba.WgT = WinT_l + (size_t)3072 * 1024;
      ba.W1T = W1T_l; ba.W2T = W2T_l; ba.cbias = cbias_l;
      ba.w_dw = sa.w_dw; ba.b_dw = sa.b_dw; ba.ln_g = sa.ln_g; ba.ln_b = sa.ln_b; ba.b_pw = sa.b_pw; ba.pool_scale = sa.pool_scale;
      ba.cmp_rows_p = a.out + O_CMPP + (size_t)l * NPT * 256;
      ba.mixb = a.mixb; ba.kcP = a.kcP; ba.vcPT = a.vcPT; ba.gates = a.gatesf;
#ifdef PROBE_REP
      { const int rb[4] = {PROBE_REPB}; for (int i = 0; i < 4; ++i) ba.repb[i] = rb[i]; }
#endif
      REP(3) phaseB(lds, ba);
    }
    for (int b = (wg + G - 32 % G) % G; b < NSM; b += G) s2_item(sa, lds, b);
    GRID_BARRIER();
    {
      PhaseCArgs ca{a.qb, a.ksb, a.vsT, a.kwb, a.vwT, a.kcP, a.vcPT, a.szc, a.gatesf, a.mixb, a.g_k + l * 192};
      REP(4) phaseC(lds, ca);
    }
    REP(5) for (int it = wg; it < 256; it += G) s3_item(sa, lds, it >> 1, it & 1);
    GRID_BARRIER();
    {
      PhaseDArgs da{a.mixb, a.WoutT + (size_t)l * 1024 * 1024, xp, xp_out, a.xb, a.ssq};
      REP(6) { if (l == 0) phaseD<false>(lds, da); else phaseD<true>(lds, da); }
    }
    if (l == 0) { for (int u = wg; u < 16; u += G) s4_unit<false>(lds, a.mixb + (size_t)NPT * 1024, a.WoutT + (size_t)l * 1024 * 1024, xs, xs_out, a.xb + (size_t)NPT * 1024, a.ssq + (size_t)NPT * 16, u); }
    else { for (int u = wg; u < 16; u += G) s4_unit<true>(lds, a.mixb + (size_t)NPT * 1024, a.WoutT + (size_t)l * 1024 * 1024, xs, xs_out, a.xb + (size_t)NPT * 1024, a.ssq + (size_t)NPT * 16, u); }
    if (l == 0) GRID_BARRIER();
  }
}
}
extern "C" void kernel_launch(void* const* d_in, const int* in_sizes, int n_in, void* d_out, int out_size, void* d_ws, size_t ws_size, hipStream_t stream) {
  using fast::bf16_t;
  static int grid = 0;
  if (grid == 0) {
    int dev = 0, cus = 0, per_cu = 0;
    (void)hipGetDevice(&dev);
    (void)hipDeviceGetAttribute(&cus, hipDeviceAttributeMultiprocessorCount, dev);
    (void)hipFuncSetAttribute((const void*)fast::k_mega, hipFuncAttributeMaxDynamicSharedMemorySize, fast::LDS_BYTES);
    if (hipOccupancyMaxActiveBlocksPerMultiprocessor(&per_cu, (const void*)fast::k_mega, 512, fast::LDS_BYTES) != hipSuccess || per_cu < 1) per_cu = 1;
    (void)hipGetLastError();
    grid = cus > 0 ? cus : 256;
  }
  fast::MegaArgsK a{};
  a.x_prompt = (const float*)d_in[0]; a.x_sample = (const float*)d_in[1]; a.state_conv = (const float*)d_in[2]; a.state_pool = (const float*)d_in[3];
  a.cache_win = (const float*)d_in[4]; a.cache_cmp = (const float*)d_in[5]; a.cache_slc = (const float*)d_in[6]; a.page_table = (const int*)d_in[7];
  a.w_norm = (const float*)d_in[8]; a.w_in = (const float*)d_in[9]; a.w_out = (const float*)d_in[10]; a.w_dw = (const float*)d_in[11]; a.b_dw = (const float*)d_in[12];
  a.ln_g = (const float*)d_in[13]; a.ln_b = (const float*)d_in[14]; a.w_pw = (const float*)d_in[15]; a.b_pw = (const float*)d_in[16]; a.w_pool = (const float*)d_in[17];
  a.pool_scale = (const float*)d_in[18]; a.g_q = (const float*)d_in[19]; a.g_k = (const float*)d_in[20]; a.cmp_pe = (const float*)d_in[21]; a.cmp_w1 = (const float*)d_in[22]; a.cmp_w2 = (const float*)d_in[23];
  a.out = (float*)d_out;
  a.ws = (unsigned char*)d_ws;
#ifdef PROBE_REP
  { const int rr[8] = {PROBE_REP}; for (int i = 0; i < 8; ++i) a.rep[i] = rr[i]; }
#endif
  (void)hipMemsetAsync((unsigned char*)d_ws + fast::WS_BAR, 0, XCD_BAR_WORDS * 4, stream);
  hipLaunchKernelGGL(fast::k_mega, dim3(grid), dim3(512), fast::LDS_BYTES, stream, a);
}
```

```cpp
#include <hip/hip_runtime.h>
#include <stdint.h>
#include <stdio.h>
__device__ __forceinline__ int tidx() { int t = threadIdx.x; asm volatile("" : "+v"(t)); return t; }

constexpr int NPT = 16384, NSM = 128, NTOK = NPT + NSM, SEQ = 2048;
constexpr int D_IN = 3096;
constexpr int C_AVAL = 0, C_AGATE = 256, C_ZA = 512, C_BIN = 768, C_ZB = 1024, C_Q = 1280, C_KV = 1792, C_GATE = 2560, C_ZC = 2584;
constexpr int N_PHYS = 2560;
constexpr float NEGF = -1e30f;

constexpr size_t O_YP = 0;
constexpr size_t O_YS = O_YP + (size_t)NPT * 1024;
constexpr size_t O_CONVP = O_YS + (size_t)NSM * 1024;
constexpr size_t O_POOLP = O_CONVP + 2ull * 8 * 30 * 256;
constexpr size_t O_WINP = O_POOLP + 2ull * 8 * 15 * 256;
constexpr size_t O_CMPP = O_WINP + 2ull * 8 * 256 * 256;
constexpr size_t O_SLCP = O_CMPP + 2ull * 8 * 2048 * 256;
constexpr size_t O_CONVS = O_SLCP + 2ull * 8 * 2048 * 256;
constexpr size_t O_POOLS = O_CONVS + 2ull * 128 * 30 * 256;
constexpr size_t O_WINS = O_POOLS + 2ull * 128 * 15 * 256;
constexpr size_t O_CMPS = O_WINS + 2ull * 128 * 256 * 256;
constexpr size_t O_SLCS = O_CMPS + 2ull * 128 * 256;
constexpr size_t O_END = O_SLCS + 2ull * 128 * 256;


namespace pg8 {
#define PG8_LAS __attribute__((address_space(3)))
typedef unsigned short bf16_t;
typedef short bf16x8 __attribute__((ext_vector_type(8)));
typedef float f32x4 __attribute__((ext_vector_type(4)));
typedef unsigned u32x4 __attribute__((ext_vector_type(4)));
constexpr int BM = 256, BK = 64, HALF = 128, HTB = HALF * BK * 2  , STAGE_BYTES = 8 * HTB, NXCD = 8, WGM = 8;

__host__ __device__ __forceinline__ int lds_byte(int r, int c) { const int st = (r >> 4) * 2 + (c >> 5), rr = r & 15, cc = c & 31, ob = rr * 64 + cc * 2; return st * 1024 + (ob ^ (((ob >> 9) & 1) << 5)); }
__host__ __device__ __forceinline__ void stage_rc(int b, int& R, int& C) { const int st = b / 1024, sb = b % 1024, swz = sb ^ (((sb >> 9) & 1) << 5); R = (st >> 1) * 16 + swz / 64; C = (st & 1) * 32 + (swz % 64) / 2; }
__host__ __device__ __forceinline__ int perm32(int rho) { const int n = rho >> 4, i = rho & 15; return 8 * (i >> 2) + 4 * n + (i & 3); }

struct Unit { int pm, pn; };
struct Gemm { const bf16_t* A; const bf16_t* Bt; int M, N, K; };

struct StaticOrder {
    int nM, nN, nwg, G, c;
    __host__ __device__ void init(int M, int N, int G_, int c_) { nM = M / BM; nN = N / BM; nwg = nM * nN; G = G_; c = c_; }
    __host__ __device__ bool next(int i, Unit& u) const {
        const long L = (long)i * G + c; if (L >= nwg) return false;
        int wgid = (int)L; { const int q = nwg / NXCD, r = nwg % NXCD, xcd = wgid % NXCD, off = wgid / NXCD; wgid = (xcd < r ? xcd * (q + 1) : r * (q + 1) + (xcd - r) * q) + off; }
        const int nig = WGM * nN, gid = wgid / nig, fm = gid * WGM, gsz = (nM - fm) < WGM ? (nM - fm) : WGM;
        u.pm = fm + ((wgid % nig) % gsz); u.pn = (wgid % nig) / gsz; return true;
    }
    __device__ __forceinline__ void a_ready(const Unit&) const {}
    __device__ __forceinline__ void done(const Unit&) const {}
};
__device__ __forceinline__ unsigned cvt_pk_bf16(float lo, float hi) { unsigned r; asm volatile("v_cvt_pk_bf16_f32 %0, %1, %2" : "=v"(r) : "v"(lo), "v"(hi)); return r; }

template <class Epi, class Sched, bool STAMP = false>
__device__ __forceinline__ void gemm_phase(PG8_LAS unsigned char* lds, const Gemm g, const Sched& S, const Epi& E, unsigned long long* stamps) {
    const int tid = tidx(), wid = __builtin_amdgcn_readfirstlane(tid >> 6), lane = tid & 63, wr = wid >> 2, wc = wid & 3, fr = lane & 15, fq = lane >> 4;
    const int K = g.K, nt = K / BK;
    int ts_lo = 0, ts_hi = 0, nts = 0; const unsigned long long rt_entry = STAMP ? (unsigned long long)wall_clock64() : 0ull;
#define PG8_STAMP() do { if (STAMP && wid == 0 && nts < 64) { const unsigned long long _c = (unsigned long long)clock64(); \
        ts_lo = (lane == nts) ? (int)(unsigned)_c : ts_lo; ts_hi = (lane == nts) ? (int)(unsigned)(_c >> 32) : ts_hi; ++nts; } } while (0)
    PG8_STAMP();
    unsigned voffA[2], voffB[2];
#pragma unroll
    for (int i = 0; i < 2; ++i) { int R, C; stage_rc(tid * 16 + i * 8192, R, C); const int Rb = Epi::PERM ? ((R & ~31) + perm32(R & 31)) : R;
        voffA[i] = (unsigned)(R * K + C) * 2u; voffB[i] = (unsigned)(Rb * K + C) * 2u; }
    const size_t kstep = (size_t)(BK * 2);
    const size_t hstep = (size_t)HALF * K * 2;
    const size_t tstep = 2 * hstep;
    const unsigned ldsw = (unsigned)wid * 1024u;
    const int aoff = lds_byte(wr * 64 + fr, fq * 8), boff = lds_byte(wc * 32 + fr, fq * 8);
#define PG8_SA(b, h) (((b) * 2 + (h)) * HTB)
#define PG8_SB(b, h) ((4 + (b) * 2 + (h)) * HTB)
#define PG8_STAGE(bufoff, gbase, voff) do { _Pragma("unroll") for (int _i = 0; _i < 2; ++_i) \
        __builtin_amdgcn_global_load_lds((const unsigned*)((const char*)(gbase) + (voff)[_i]), (PG8_LAS unsigned*)(lds + (bufoff) + ldsw + _i * 8192), 16, 0, 0); } while (0)
#define PG8_LDA(dst, b, h) do { _Pragma("unroll") for (int m = 0; m < 4; ++m) _Pragma("unroll") for (int k = 0; k < 2; ++k) dst[m][k] = *(const PG8_LAS bf16x8*)(lds + PG8_SA(b, h) + aoff + m * 2048 + k * 1024); } while (0)
#define PG8_LDB(dst, b, h) do { _Pragma("unroll") for (int n = 0; n < 2; ++n) _Pragma("unroll") for (int k = 0; k < 2; ++k) dst[n][k] = *(const PG8_LAS bf16x8*)(lds + PG8_SB(b, h) + boff + n * 2048 + k * 1024); } while (0)
#define PG8_MMA(ai, bj, At, Bt) do { __builtin_amdgcn_s_setprio(1); _Pragma("unroll") for (int m = 0; m < 4; ++m) _Pragma("unroll") for (int n = 0; n < 2; ++n) _Pragma("unroll") for (int k = 0; k < 2; ++k) \
        acc[ai][bj][m][n] = __builtin_amdgcn_mfma_f32_16x16x32_bf16(Bt[n][k], At[m][k], acc[ai][bj][m][n], 0, 0, 0); __builtin_amdgcn_s_setprio(0); } while (0)
#define PG8_WAIT_V(n) asm volatile("s_waitcnt vmcnt(" #n ")" ::: "memory")
#define PG8_WAIT_L(n) asm volatile("s_waitcnt lgkmcnt(" #n ")" ::: "memory")
#define PG8_BAR __builtin_amdgcn_s_barrier()
#define PG8_SCHED __builtin_amdgcn_sched_barrier(0)
    Unit cur, nxt; int ui = 0;
    if (!S.next(0, cur)) return;
    f32x4 acc[2][2][4][2];
#pragma unroll
    for (int a = 0; a < 2; ++a)
#pragma unroll
        for (int b = 0; b < 2; ++b)
#pragma unroll
            for (int m = 0; m < 4; ++m)
#pragma unroll
                for (int n = 0; n < 2; ++n) acc[a][b][m][n] = (f32x4){0.f, 0.f, 0.f, 0.f};
    bf16x8 At[4][2], B0[2][2], B1[2][2];
    const char* cA = (const char*)g.A + (size_t)cur.pm * tstep; const char* cB = (const char*)g.Bt + (size_t)cur.pn * tstep;
    S.a_ready(cur);
    PG8_STAGE(PG8_SB(0, 0), cB, voffB); PG8_STAGE(PG8_SA(0, 0), cA, voffA); PG8_STAGE(PG8_SB(0, 1), cB + hstep, voffB); PG8_STAGE(PG8_SA(0, 1), cA + hstep, voffA);
    if (wr == 1) PG8_BAR;
    PG8_WAIT_V(4); PG8_BAR;
    PG8_STAGE(PG8_SB(1, 0), cB + kstep, voffB); PG8_STAGE(PG8_SA(1, 0), cA + kstep, voffA); PG8_STAGE(PG8_SB(1, 1), cB + hstep + kstep, voffB);
    PG8_WAIT_V(6); PG8_BAR;
    PG8_STAMP();
    for (;;) {
        const bool has_next = S.next(ui + 1, nxt);
        const char* nA = has_next ? (const char*)g.A + (size_t)nxt.pm * tstep : cA; const char* nB = has_next ? (const char*)g.Bt + (size_t)nxt.pn * tstep : cB;
        for (int t = 0; t < nt; t += 2) {
            const bool last = (t == nt - 2);
            const char* a1 = cA + (size_t)(t + 1) * kstep;
            const char* a2 = last ? nA : cA + (size_t)(t + 2) * kstep; const char* b2 = last ? nB : cB + (size_t)(t + 2) * kstep;
            const char* a3 = a2 + kstep; const char* b3 = b2 + kstep;
            if (last && has_next) S.a_ready(nxt);
            PG8_LDB(B0, 0, 0); PG8_SCHED; PG8_LDA(At, 0, 0); PG8_STAGE(PG8_SA(1, 1), a1 + hstep, voffA);
            PG8_WAIT_L(8); PG8_BAR; PG8_WAIT_L(0); PG8_MMA(0, 0, At, B0); PG8_BAR; PG8_SCHED;
            PG8_LDB(B1, 0, 1); PG8_STAGE(PG8_SB(0, 0), b2, voffB);
            PG8_BAR; PG8_WAIT_L(0); PG8_MMA(0, 1, At, B1); PG8_BAR;
            PG8_LDA(At, 0, 1); PG8_STAGE(PG8_SA(0, 0), a2, voffA);
            PG8_BAR; PG8_WAIT_L(0); PG8_MMA(1, 0, At, B0); PG8_BAR; PG8_SCHED;
            PG8_STAGE(PG8_SB(0, 1), b2 + hstep, voffB);
            PG8_WAIT_V(6); PG8_BAR; PG8_MMA(1, 1, At, B1); PG8_BAR;
            PG8_LDB(B0, 1, 0); PG8_SCHED; PG8_LDA(At, 1, 0); PG8_STAGE(PG8_SA(0, 1), a2 + hstep, voffA);
            PG8_WAIT_L(8); PG8_BAR; PG8_WAIT_L(0); PG8_MMA(0, 0, At, B0); PG8_BAR; PG8_SCHED;
            PG8_LDB(B1, 1, 1); PG8_STAGE(PG8_SB(1, 0), b3, voffB);
            PG8_BAR; PG8_WAIT_L(0); PG8_MMA(0, 1, At, B1); PG8_BAR;
            PG8_LDA(At, 1, 1); PG8_STAGE(PG8_SA(1, 0), a3, voffA);
            PG8_BAR; PG8_WAIT_L(0); PG8_MMA(1, 0, At, B0); PG8_BAR; PG8_SCHED;
            PG8_STAGE(PG8_SB(1, 1), b3 + hstep, voffB);
            PG8_WAIT_V(6); PG8_BAR; PG8_MMA(1, 1, At, B1); PG8_BAR;
        }
        PG8_STAMP();
        if constexpr (!Epi::AFTER_DRAIN) { E(acc, cur, wr, wc, fr, fq); S.done(cur); }
        PG8_STAMP();
        if (!has_next) break;
#pragma unroll
        for (int a = 0; a < 2; ++a)
#pragma unroll
            for (int b = 0; b < 2; ++b)
#pragma unroll
                for (int m = 0; m < 4; ++m)
#pragma unroll
                    for (int n = 0; n < 2; ++n) acc[a][b][m][n] = (f32x4){0.f, 0.f, 0.f, 0.f};
        cur = nxt; cA = nA; cB = nB; ++ui;
    }
    PG8_WAIT_V(0);
    if (wr == 0) PG8_BAR;
    PG8_BAR;
    if constexpr (Epi::AFTER_DRAIN) { E.fused(acc, cur, wr, wc, fr, fq, lds, wid, lane); S.done(cur); }
    PG8_STAMP();
    if (STAMP && wid == 0) { stamps[lane] = lane < nts ? (((unsigned long long)(unsigned)ts_hi << 32) | (unsigned)ts_lo) : 0ull;
        if (lane == 62) stamps[62] = rt_entry; if (lane == 63) stamps[63] = (unsigned long long)wall_clock64(); }
#undef PG8_STAMP
#undef PG8_SA
#undef PG8_SB
#undef PG8_STAGE
#undef PG8_LDA
#undef PG8_LDB
#undef PG8_MMA
#undef PG8_WAIT_V
#undef PG8_WAIT_L
#undef PG8_BAR
#undef PG8_SCHED
}
}
#define XB_TMO      128
#define XB_XCNT(j)  (256  + 64 * (j))
#define XB_XSUB(j)  (1280 + 64 * (j))
#define XB_XGEN(j)  (2304 + 64 * (j))
#define XB_TOP      3328
#define XB_TOPGEN   3392
#define XCD_BAR_WORDS 3456
#define XB_SPIN_CAP (1u << 18)
#ifndef LAS
#define LAS __attribute__((address_space(3)))
#endif

__device__ __forceinline__ unsigned xb_ld(unsigned* p)              { return __hip_atomic_load(p, __ATOMIC_RELAXED, __HIP_MEMORY_SCOPE_AGENT); }
__device__ __forceinline__ unsigned xb_add(unsigned* p, unsigned v) { return __hip_atomic_fetch_add(p, v, __ATOMIC_RELAXED, __HIP_MEMORY_SCOPE_AGENT); }
__device__ __forceinline__ unsigned xb_xcc_id() { return (unsigned)__builtin_amdgcn_s_getreg((3 << 11) | 20) & 0xFu; }
#define XB_SPIN(cond, bar) do { unsigned _sp = 0; while (cond) { __builtin_amdgcn_s_sleep(1); \
    if ((++_sp & 255u) == 0u) { if (xb_ld(&(bar)[XB_TMO])) break; if (_sp > XB_SPIN_CAP) { atomicAdd(&(bar)[XB_TMO], 1u); break; } } } } while (0)

struct XcdBarrier {
    unsigned* bar; unsigned x;
    volatile LAS unsigned* st;
};

__device__ __forceinline__ XcdBarrier xcd_barrier_post(unsigned* bar, volatile LAS unsigned* st) {
    XcdBarrier b; b.bar = bar; b.x = xb_xcc_id(); b.st = st;
    if (threadIdx.x == 0) (void)xb_add(&bar[XB_XCNT(b.x)], 1u);
    return b;
}
__device__ __forceinline__ void xcd_barrier_complete(unsigned* bar, unsigned x, unsigned& nloc, unsigned& nx) {
    const unsigned G = gridDim.x * gridDim.y * gridDim.z;
    unsigned sum, cnt, mine, sp = 0u;
    for (;;) {
        sum = 0u; cnt = 0u; mine = 0u;
#pragma unroll
        for (unsigned j = 0; j < 16; ++j) { const unsigned c = xb_ld(&bar[XB_XCNT(j)]); sum += c; cnt += (c > 0u) ? 1u : 0u; mine = (j == x) ? c : mine; }
        if (sum == G) break;
        __builtin_amdgcn_s_sleep(1);
        if ((++sp & 255u) == 0u) { if (xb_ld(&bar[XB_TMO])) break; if (sp > XB_SPIN_CAP) { atomicAdd(&bar[XB_TMO], 1u); break; } }
    }
    nloc = mine > 0u ? mine : 1u; nx = cnt > 0u ? cnt : 1u;
}

__device__ __forceinline__ void xcd_barrier(const XcdBarrier& b) {
    asm volatile("s_waitcnt vmcnt(0)" ::: "memory");
    __syncthreads();
    if (threadIdx.x == 0) {
        unsigned* bar = b.bar;
        __builtin_amdgcn_s_waitcnt(0);
        unsigned nloc = b.st[0], nx = b.st[1];
        if (nloc == 0u) { xcd_barrier_complete(bar, b.x, nloc, nx); b.st[0] = nloc; b.st[1] = nx; }
        const unsigned old = xb_add(&bar[XB_XSUB(b.x)], 1u);
        const unsigned gen = old / nloc;
        if (old + 1u == (gen + 1u) * nloc) {
            __builtin_amdgcn_fence(__ATOMIC_RELEASE, "agent");
            asm volatile("s_waitcnt vmcnt(0)" ::: "memory");
            const unsigned og = xb_add(&bar[XB_TOP], 1u);
            const unsigned tg = og / nx;
            if (og + 1u == (tg + 1u) * nx) xb_add(&bar[XB_TOPGEN], 1u);
            else XB_SPIN(xb_ld(&bar[XB_TOPGEN]) == tg, bar);
            __builtin_amdgcn_fence(__ATOMIC_ACQUIRE, "agent");
            xb_add(&bar[XB_XGEN(b.x)], 1u);
            asm volatile("s_waitcnt vmcnt(0)" ::: "memory");
        } else {
            XB_SPIN(xb_ld(&bar[XB_XGEN(b.x)]) == gen, bar);
            __builtin_amdgcn_fence(__ATOMIC_ACQUIRE, "agent");
            asm volatile("s_waitcnt vmcnt(0)" ::: "memory");
        }
    }
    __syncthreads();
}

namespace fast {
using pg8::bf16_t; using pg8::bf16x8; using pg8::f32x4; using pg8::Unit;
typedef float f32x2_c __attribute__((ext_vector_type(2)));
typedef __bf16 bf16x2_c __attribute__((ext_vector_type(2)));
__device__ __forceinline__ unsigned cvt_pk_bf16(float lo, float hi) { const f32x2_c v = {lo, hi}; return __builtin_bit_cast(unsigned, __builtin_convertvector(v, bf16x2_c)); }
typedef unsigned u32x2 __attribute__((ext_vector_type(2)));
typedef float f32x2 __attribute__((ext_vector_type(2)));
typedef unsigned u32x4 __attribute__((ext_vector_type(4)));
#ifndef LAS
#define LAS __attribute__((address_space(3)))
#endif
constexpr int LDS_BYTES = 144 * 1024;
__device__ __forceinline__ void lds_barrier() { asm volatile("s_waitcnt lgkmcnt(0)" ::: "memory"); __builtin_amdgcn_s_barrier(); asm volatile("" ::: "memory"); }
__device__ __forceinline__ float bf2f(bf16_t b) { return __uint_as_float(((unsigned)b) << 16); }
__device__ __forceinline__ float bflo(unsigned u) { return __uint_as_float(u << 16); }
__device__ __forceinline__ float bfhi(unsigned u) { return __uint_as_float(u & 0xffff0000u); }
__device__ __forceinline__ bf16_t f2bf(float f) { return (bf16_t)(cvt_pk_bf16(f, 0.f) & 0xffffu); }

#ifdef MULTI_LAUNCH
__global__ void k_bridge_mix(const float* mix, bf16_t* mixb, size_t n) {
  size_t i = ((size_t)blockIdx.x * blockDim.x + tidx()) * 2;
  if (i < n) *(unsigned*)(mixb + i) = cvt_pk_bf16(mix[i], mix[i + 1]);
}
#endif

template <bool LAST> struct EpiD {
  static constexpr bool PERM = true, AFTER_DRAIN = false;
  const float* resid; float* xout; bf16_t* xb; float* ssq;
  __device__ __forceinline__ void operator()(const f32x4 (&acc)[2][2][4][2], const Unit& u, int wr_, int wc_, int fr_, int fq_) const {
    const int tz = tidx(), wid_ = tz >> 6, wr = wid_ >> 2, wc = wid_ & 3, fr = tz & 15, fq = (tz >> 4) & 3;
    const int row0 = u.pm * 256 + wr * 64 + fr, col0 = u.pn * 256 + wc * 32 + 8 * fq;
#pragma unroll
    for (int ai = 0; ai < 2; ++ai)
#pragma unroll
      for (int m = 0; m < 4; ++m) {
        const size_t row = (size_t)(row0 + ai * 128 + m * 16);
        float ss = 0.f;
#pragma unroll
        for (int bj = 0; bj < 2; ++bj) {
          const size_t o = row * 1024 + col0 + bj * 128;
          const f32x4 r0 = *(const f32x4*)(resid + o), r1 = *(const f32x4*)(resid + o + 4);
          const f32x4 v0 = acc[ai][bj][m][0] + r0, v1 = acc[ai][bj][m][1] + r1;
          *(f32x4*)(xout + o) = v0; *(f32x4*)(xout + o + 4) = v1;
          if (!LAST) {
            u32x4 pk; pk.x = cvt_pk_bf16(v0[0], v0[1]); pk.y = cvt_pk_bf16(v0[2], v0[3]); pk.z = cvt_pk_bf16(v1[0], v1[1]); pk.w = cvt_pk_bf16(v1[2], v1[3]);
            *(u32x4*)(xb + o) = pk;
            ss += v0[0] * v0[0] + v0[1] * v0[1] + v0[2] * v0[2] + v0[3] * v0[3] + v1[0] * v1[0] + v1[1] * v1[1] + v1[2] * v1[2] + v1[3] * v1[3];
          }
        }
        if (!LAST) {
          ss += __shfl_xor(ss, 16); ss += __shfl_xor(ss, 32);
          if (fq == 0) ssq[row * 16 + u.pn * 4 + wc] = ss;
        }
      }
  }
};
struct PhaseDArgs { const bf16_t* mixb; const bf16_t* WoutT; const float* resid; float* xout; bf16_t* xb; float* ssq; };
template <bool LAST> __device__ __forceinline__ void phaseD(LAS unsigned char* lds, const PhaseDArgs& a) {
  pg8::Gemm g{a.mixb, a.WoutT, NPT, 1024, 1024};
  pg8::StaticOrder S; S.init(NPT, 1024, gridDim.x, blockIdx.x);
  EpiD<LAST> E{a.resid, a.xout, a.xb, a.ssq};
  pg8::gemm_phase<EpiD<LAST>, pg8::StaticOrder, false>(lds, g, S, E, nullptr);
}
#ifdef MULTI_LAUNCH
template <bool LAST> __global__ void __launch_bounds__(512, 2) k_phaseD(PhaseDArgs a) {
  extern __shared__ __attribute__((aligned(16))) unsigned char shm[];
  phaseD<LAST>((LAS unsigned char*)shm, a);
}
#endif

__device__ __forceinline__ int win_logical_col(int np) {
  if (np >= 3072) return np < 3096 ? C_GATE + (np - 3072) : -1;
  const int tile = np >> 8, j = np & 255, bj = j >> 7, wc = (j >> 5) & 3, i = j & 31, jj = j & 127;
  switch (tile) {
    case 0: case 1: return (bj ? C_AGATE : C_AVAL) + tile * 128 + jj;
    case 2: return C_ZA + j;
    case 3: return C_BIN + j;
    case 4: return C_ZB + j;
    case 5: case 6: return C_Q + ((tile - 5) * 4 + wc) * 64 + bj * 32 + i;
    case 7: case 8: case 9: return C_KV + (tile - 7) * 256 + wc * 64 + bj * 32 + i;
    default: return C_ZC + (tile - 10) * 256 + j;
  }
}
#ifdef MULTI_LAUNCH
template <int MODE  >
__global__ void __launch_bounds__(256) k_transpose_w(const float* src, int ld_src, const float* scale, bf16_t* dst, int N, int K) {
  __shared__ float t[64][65];
  const int n0 = blockIdx.x * 64, k0 = blockIdx.y * 64, tid = tidx();
  for (int i = tid; i < 4096; i += 256) {
    const int k = i >> 6, n = i & 63;
    int col = MODE == 1 ? win_logical_col(n0 + n) : (n0 + n);
    float v = 0.f;
    if (n0 + n < N && col >= 0) { v = src[(size_t)(k0 + k) * ld_src + col]; if (scale) v *= scale[k0 + k]; }
    t[k][n] = v;
  }
  __syncthreads();
  for (int i = tid; i < 2048; i += 256) {
    const int n = i >> 5, k = (i & 31) * 2;
    if (n0 + n < N) *(unsigned*)(dst + (size_t)(n0 + n) * K + k0 + k) = cvt_pk_bf16(t[k][n], t[k + 1][n]);
  }
}
#endif

#ifdef MULTI_LAUNCH
__global__ void k_bridge_q(const float* qbuf, bf16_t* qb, size_t n) {
  size_t i = ((size_t)blockIdx.x * blockDim.x + tidx()) * 2;
  const float sc = 0.125f * 1.4426950408889634f;
  if (i < n) *(unsigned*)(qb + i) = cvt_pk_bf16(qbuf[i] * sc, qbuf[i + 1] * sc);
}
#endif
#ifdef MULTI_LAUNCH
__global__ void k_bridge_kv(const float* rows, int br, bf16_t* kk, bf16_t* vT) {
  size_t i = (size_t)blockIdx.x * blockDim.x + tidx();
  if (i >= (size_t)NPT * 128) return;
  const int d = (int)(i & 63), g = (int)((i >> 6) & 1); const size_t tok = i >> 7; const int b = (int)(tok / SEQ), t = (int)(tok % SEQ);
  kk[(((size_t)b * 2 + g) * SEQ + t) * 64 + d] = f2bf(rows[tok * 768 + br * 256 + g * 64 + d]);
  vT[(((size_t)b * 2 + g) * 64 + d) * SEQ + t] = f2bf(rows[tok * 768 + br * 256 + 128 + g * 64 + d]);
}
#endif
#ifdef MULTI_LAUNCH
__global__ void k_bridge_kc(const float* kc, const float* vc, bf16_t* kcP, bf16_t* vcPT, int nseq) {
  size_t i = (size_t)blockIdx.x * blockDim.x + tidx();
  if (i >= (size_t)nseq * 128 * 128) return;
  const int d = (int)(i & 63), g = (int)((i >> 6) & 1), c = (int)((i >> 7) & 127), b = (int)(i >> 14);
  const float kv = c < 127 ? kc[i] : 0.f, vv = c < 127 ? vc[i] : 0.f;
  kcP[(((size_t)b * 2 + g) * 128 + c) * 64 + d] = f2bf(kv);
  vcPT[(((size_t)b * 2 + g) * 64 + d) * 128 + c] = f2bf(vv);
}
#endif
#ifdef MULTI_LAUNCH
__global__ void k_bridge_silu(const float* proj, int col0, int ncol, bf16_t* dst, size_t ntok) {
  size_t i = (size_t)blockIdx.x * blockDim.x + tidx();
  if (i >= ntok * ncol) return;
  const size_t tok = i / ncol; const int c = (int)(i % ncol);
  const float z = proj[tok * D_IN + col0 + c];
  dst[i] = f2bf(z / (1.f + __expf(-z)));
}
#endif

#ifndef SKIPCOND
#define SKIPCOND __any(mine)
#endif
typedef float f32x16 __attribute__((ext_vector_type(16)));
typedef short bf16x4 __attribute__((ext_vector_type(4)));
struct PhaseCArgs { const bf16_t *qb, *ks, *vsT, *kw, *vwT, *kcP, *vcPT, *szc; const float* gates; bf16_t* mixb; const float* g_k;
#ifdef PROBE_REP
  int repc[2];
#endif
};
#define REPC

__device__ __forceinline__ f32x16 qk_tile(const bf16_t* krows, const bf16x8 (&qf)[4], int c32, int hh) {
  f32x16 s;
#pragma unroll
  for (int i = 0; i < 16; ++i) s[i] = 0.f;
  const bf16_t* kp = krows + (size_t)c32 * 64 + 8 * hh;
  bf16x8 kf[4];
#pragma unroll
  for (int ks = 0; ks < 4; ++ks) kf[ks] = *(const bf16x8*)(kp + 16 * ks);
#pragma unroll
  for (int ks = 0; ks < 4; ++ks) s = __builtin_amdgcn_mfma_f32_32x32x16_bf16(kf[ks], qf[ks], s, 0, 0, 0);
  return s;
}
__device__ __forceinline__ void pv_tile(f32x16 (&o)[2], const bf16_t* vT, int ldv, const f32x16& p, int c32, int hh) {
#pragma unroll
  for (int s = 0; s < 2; ++s) {
    union { bf16x8 v; unsigned u[4]; } pf;
#pragma unroll
    for (int j = 0; j < 4; ++j) pf.u[j] = cvt_pk_bf16(p[8 * s + 2 * j], p[8 * s + 2 * j + 1]);
#pragma unroll
    for (int dt = 0; dt < 2; ++dt) {
      const bf16_t* vp = vT + (size_t)(32 * dt + c32) * ldv + 16 * s + 4 * hh;
      union { bf16x8 v; bf16x4 h[2]; } vf;
      vf.h[0] = *(const bf16x4*)(vp);
      vf.h[1] = *(const bf16x4*)(vp + 8);
      o[dt] = __builtin_amdgcn_mfma_f32_32x32x16_bf16(vf.v, pf.v, o[dt], 0, 0, 0);
    }
  }
}

constexpr int AT_KB = 64 * 144, AT_VB = 64 * 136, AT_STAGE = AT_KB + AT_VB;
constexpr int AT_NBUF = 3;
constexpr int AT_IMP = AT_NBUF * AT_STAGE;
constexpr int AT_OT = AT_IMP + 8192;
struct StageRegs { u32x4 k; u32x4 v; };
__device__ __forceinline__ StageRegs stage_load(const bf16_t* ksrc, const bf16_t* vsrc, int ldv, int tid) {
  StageRegs r;
  r.k = *(const u32x4*)(ksrc + (size_t)(tid >> 3) * 64 + (tid & 7) * 8);
  r.v = *(const u32x4*)(vsrc + (size_t)(tid >> 3) * ldv + (tid & 7) * 8);
  return r;
}
__device__ __forceinline__ void stage_store(LAS unsigned char* buf, const StageRegs& r, int tid) {
  *(LAS u32x4*)(buf + (tid >> 3) * 144 + (tid & 7) * 16) = r.k;
  LAS unsigned char* vp = buf + AT_KB + (tid >> 3) * 136 + (tid & 7) * 16;
  *(LAS u32x2*)vp = (u32x2){r.v.x, r.v.y}; *(LAS u32x2*)(vp + 8) = (u32x2){r.v.z, r.v.w};
}
__device__ __forceinline__ f32x16 qk_lds(const LAS unsigned char* buf, int tt, const bf16x8 (&qf)[4], int c32, int hh) {
  f32x16 s;
#pragma unroll
  for (int i = 0; i < 16; ++i) s[i] = 0.f;
  const LAS unsigned char* kp = buf + (32 * tt + c32) * 144 + 16 * hh;
#pragma unroll
  for (int ks = 0; ks < 4; ++ks) { const bf16x8 kf = *(const LAS bf16x8*)(kp + 32 * ks); s = __builtin_amdgcn_mfma_f32_32x32x16_bf16(kf, qf[ks], s, 0, 0, 0); }
  return s;
}
__device__ __forceinline__ void pv_lds(f32x16 (&o)[2], const LAS unsigned char* buf, int tt, const f32x16& p, int c32, int hh) {
#pragma unroll
  for (int s = 0; s < 2; ++s) {
    union { bf16x8 v; unsigned u[4]; } pf;
#pragma unroll
    for (int j = 0; j < 4; ++j) pf.u[j] = cvt_pk_bf16(p[8 * s + 2 * j], p[8 * s + 2 * j + 1]);
#pragma unroll
    for (int dt = 0; dt < 2; ++dt) {
      const LAS unsigned char* vp = buf + AT_KB + (32 * dt + c32) * 136 + (32 * tt + 16 * s + 4 * hh) * 2;
      union { bf16x8 v; u32x2 h[2]; } vf;
      vf.h[0] = *(const LAS u32x2*)vp; vf.h[1] = *(const LAS u32x2*)(vp + 16);
      o[dt] = __builtin_amdgcn_mfma_f32_32x32x16_bf16(vf.v, pf.v, o[dt], 0, 0, 0);
    }
  }
}
__device__ __forceinline__ f32x16 qk_lds_init(const LAS unsigned char* buf, int tt, const bf16x8 (&qf)[4], int c32, int hh, float cinit) {
  f32x16 s;
#pragma unroll
  for (int i = 0; i < 16; ++i) s[i] = cinit;
  const LAS unsigned char* kp = buf + (32 * tt + c32) * 144 + 16 * hh;
#pragma unroll
  for (int ks = 0; ks < 4; ++ks) { const bf16x8 kf = *(const LAS bf16x8*)(kp + 32 * ks); s = __builtin_amdgcn_mfma_f32_32x32x16_bf16(kf, qf[ks], s, 0, 0, 0); }
  return s;
}
template <bool MASKED>
__device__ __forceinline__ void stage_pv_ref(f32x16 (&o)[2], float& l, const LAS unsigned char* buf, const bf16x8 (&qf)[4], int c32, int hh, float cinit, int klim0, int klo0) {
  f32x16 s0 = qk_lds_init(buf, 0, qf, c32, hh, cinit), s1 = qk_lds_init(buf, 1, qf, c32, hh, cinit);
  float ps = 0.f;
#pragma unroll
  for (int i = 0; i < 16; ++i) {
    float p0 = __builtin_amdgcn_exp2f(s0[i]), p1 = __builtin_amdgcn_exp2f(s1[i]);
    if (MASKED) {
      const int x = (i & 3) + 8 * (i >> 2);
      p0 = (x <= klim0 && x > klo0) ? p0 : 0.f;
      p1 = (x <= klim0 - 32 && x > klo0 - 32) ? p1 : 0.f;
    }
    s0[i] = p0; s1[i] = p1; ps += p0 + p1;
  }
  l += ps;
  pv_lds(o, buf, 0, s0, c32, hh);
  pv_lds(o, buf, 1, s1, c32, hh);
}

#ifdef ATTN_ONLINE
template <bool MASKED>
__device__ __forceinline__ void stage_softmax_pv(f32x16 (&o)[2], float& m, float& l, const LAS unsigned char* buf, const bf16x8 (&qf)[4], int c32, int hh, int klim0, int klo0, bool mine) {
  f32x16 s0 = qk_lds(buf, 0, qf, c32, hh), s1 = qk_lds(buf, 1, qf, c32, hh);
  float mt = NEGF;
  if (MASKED) {
#pragma unroll
    for (int i = 0; i < 16; ++i) {
      const int x = (i & 3) + 8 * (i >> 2);
      s0[i] = (x <= klim0 && x > klo0) ? s0[i] : NEGF;
      s1[i] = (x <= klim0 - 32 && x > klo0 - 32) ? s1[i] : NEGF;
      mt = fmaxf(mt, fmaxf(s0[i], s1[i]));
    }
  } else {
#pragma unroll
    for (int i = 0; i < 16; ++i) mt = fmaxf(mt, fmaxf(s0[i], s1[i]));
    mt = mine ? mt : NEGF;
  }
  mt = fmaxf(mt, __shfl_xor(mt, 32));
  const float mn = fmaxf(m, mt);
  const float alpha = __builtin_amdgcn_exp2f(m - mn);
  float ps = 0.f;
  if (MASKED) {
#pragma unroll
    for (int i = 0; i < 16; ++i) {
      const float p0 = (s0[i] > -1e29f) ? __builtin_amdgcn_exp2f(s0[i] - mn) : 0.f, p1 = (s1[i] > -1e29f) ? __builtin_amdgcn_exp2f(s1[i] - mn) : 0.f;
      s0[i] = p0; s1[i] = p1; ps += p0 + p1;
    }
  } else {
    const float msub = mine ? mn : 1e30f;
#pragma unroll
    for (int i = 0; i < 16; ++i) { s0[i] = __builtin_amdgcn_exp2f(s0[i] - msub); s1[i] = __builtin_amdgcn_exp2f(s1[i] - msub); ps += s0[i] + s1[i]; }
  }
  l = l * alpha + ps; m = mn;
  if (!__all(alpha == 1.f)) {
#pragma unroll
    for (int i = 0; i < 16; ++i) { o[0][i] *= alpha; o[1][i] *= alpha; }
  }
  pv_lds(o, buf, 0, s0, c32, hh);
  pv_lds(o, buf, 1, s1, c32, hh);
}

#endif
__device__ __forceinline__ void attn_item(const PhaseCArgs& a, LAS unsigned char* lds, int b, int qbi, int g) {
  const int tid = tidx(), w = tid >> 6, lane = tid & 63, c32 = lane & 31, hh = lane >> 5;
  const int t0 = qbi * 64, tl = c32 >> 2, r = c32 & 3;
  const int t = t0 + 8 * w + tl, head = 4 * g + r;
  const size_t tok = (size_t)b * SEQ + t;
  const size_t bg = (size_t)b * 2 + g;
  LAS float* impl = (LAS float*)(lds + AT_IMP) + w * 256;
  bf16x8 qf[4];
  {
    const bf16_t* qp = a.qb + (tok * 8 + head) * 64 + 8 * hh;
#pragma unroll
    for (int ks = 0; ks < 4; ++ks) qf[ks] = *(const bf16x8*)(qp + 16 * ks);
  }
  const float* gt = a.gates + tok * 24;
  const float gate_c = gt[head], gate_s = gt[8 + head], gate_w = gt[16 + head];
  float ref_s, ref_w;
  {
    float gs = fabsf(a.g_k[64 + lane]), gw = fabsf(a.g_k[128 + lane]);
#pragma unroll
    for (int o_ = 32; o_ > 0; o_ >>= 1) { gs = fmaxf(gs, __shfl_xor(gs, o_)); gw = fmaxf(gw, __shfl_xor(gw, o_)); }
    float qq = 0.f;
#pragma unroll
    for (int ks = 0; ks < 4; ++ks)
#pragma unroll
      for (int j = 0; j < 8; ++j) { const float qv = bf2f((bf16_t)qf[ks][j]); qq = fmaf(qv, qv, qq); }
    qq += __shfl_xor(qq, 32);
    const float qn = sqrtf(qq) * 8.f * 1.02f;
    ref_s = qn * gs; ref_w = qn * gw;
  }
  asm volatile("" : "+v"(ref_s), "+v"(ref_w));
  const int wj0 = qbi >= 4 ? qbi - 4 : 0;
  const int n_slc = qbi + 1, n_win = qbi - wj0 + 1, n_st = 4 + n_slc + n_win;
  const bf16_t* kcb = a.kcP + bg * 128 * 64; const bf16_t* vcb = a.vcPT + bg * 64 * 128;
  const bf16_t* ksb = a.ks + bg * SEQ * 64;  const bf16_t* vsb = a.vsT + bg * 64 * SEQ;
  const bf16_t* kwb = a.kw + bg * SEQ * 64;  const bf16_t* vwb = a.vwT + bg * 64 * SEQ;
#define AT_SRC(s_, KP, VP, LDV) do { const int s__ = (s_);                                                        \
    if (s__ < 4) { KP = kcb + (size_t)(s__ & 1) * 64 * 64; VP = vcb + (s__ & 1) * 64; LDV = 128; }                 \
    else if (s__ < 4 + n_slc) { const int j__ = s__ - 4; KP = ksb + (size_t)j__ * 64 * 64; VP = vsb + j__ * 64; LDV = SEQ; } \
    else { const int j__ = wj0 + (s__ - 4 - n_slc); KP = kwb + (size_t)j__ * 64 * 64; VP = vwb + j__ * 64; LDV = SEQ; } } while (0)
  StageRegs sr0, sr1;
  { const bf16_t* kp; const bf16_t* vp; int ldv; AT_SRC(0, kp, vp, ldv); sr0 = stage_load(kp, vp, ldv, tid); }
  { const bf16_t* kp; const bf16_t* vp; int ldv; AT_SRC(1, kp, vp, ldv); sr1 = stage_load(kp, vp, ldv, tid); }
  stage_store(lds, sr0, tid);
  sr0 = sr1;
  lds_barrier();
  f32x16 o[2];
#pragma unroll
  for (int i = 0; i < 16; ++i) { o[0][i] = 0.f; o[1][i] = 0.f; }
  LAS f32x4* otl = (LAS f32x4*)(lds + AT_OT) + (w * 8) * 64 + lane;
  float m = NEGF, l = 0.f, inv = 0.f, prev = 0.f;
  unsigned selmask = 0u;
  const int clim = ((t - 31) >> 4) - 4 * hh;
#pragma unroll 1
  for (int s = 0; s < n_st; ++s) {
    const LAS unsigned char* buf = lds + (s % AT_NBUF) * AT_STAGE;
    if (s + 2 < n_st) { const bf16_t* kp; const bf16_t* vp; int ldv; AT_SRC(s + 2, kp, vp, ldv); sr1 = stage_load(kp, vp, ldv, tid); }
    if (s < 2) {
      f32x16 s0 = qk_lds(buf, 0, qf, c32, hh), s1 = qk_lds(buf, 1, qf, c32, hh);
      const int cl = clim - 64 * s;
      float mt = NEGF;
#pragma unroll
      for (int i = 0; i < 16; ++i) { const int x = (i & 3) + 8 * (i >> 2); s0[i] = x <= cl ? s0[i] : NEGF; s1[i] = x <= cl - 32 ? s1[i] : NEGF; mt = fmaxf(mt, fmaxf(s0[i], s1[i])); }
      mt = fmaxf(mt, __shfl_xor(mt, 32));
      const float mn = fmaxf(m, mt);
      float ps = 0.f;
#pragma unroll
      for (int i = 0; i < 16; ++i) { ps += (s0[i] > -1e29f) ? __builtin_amdgcn_exp2f(s0[i] - mn) : 0.f; ps += (s1[i] > -1e29f) ? __builtin_amdgcn_exp2f(s1[i] - mn) : 0.f; }
      l = l * __builtin_amdgcn_exp2f(m - mn) + ps; m = mn;
      if (s == 1) { l += __shfl_xor(l, 32); inv = l > 0.f ? 1.f / l : 0.f; }
    } else if (s < 4) {
#pragma unroll
      for (int tt = 0; tt < 2; ++tt) {
        f32x16 sc = qk_lds(buf, tt, qf, c32, hh);
        const int cl = clim - 64 * (s - 2) - 32 * tt;
#pragma unroll
        for (int i = 0; i < 16; ++i) { const bool valid = ((i & 3) + 8 * (i >> 2)) <= cl; sc[i] = valid ? __builtin_amdgcn_exp2f(sc[i] - m) * inv : 0.f; }
#pragma unroll
        for (int ii = 0; ii < 4; ++ii) {
          const float q4 = (sc[4 * ii] + sc[4 * ii + 1]) + (sc[4 * ii + 2] + sc[4 * ii + 3]);
          const float pp = __shfl_xor(sc[4 * ii + 3], 32);
          float v = q4 + (hh ? pp : prev);
          prev = pp;
          v += __shfl_xor(v, 1); v += __shfl_xor(v, 2);
          if (r == 0) impl[tl * 32 + 2 * (4 * (2 * (s - 2) + tt) + ii) + hh] = v;
        }
        pv_lds(o, buf, tt, sc, c32, hh);
      }
      if (s == 3) {
#pragma unroll
        for (int dt = 0; dt < 2; ++dt)
#pragma unroll
          for (int i4 = 0; i4 < 4; ++i4) otl[(dt * 4 + i4) * 64] = (f32x4){gate_c * o[dt][4 * i4], gate_c * o[dt][4 * i4 + 1], gate_c * o[dt][4 * i4 + 2], gate_c * o[dt][4 * i4 + 3]};
#pragma unroll
        for (int i = 0; i < 16; ++i) { o[0][i] = 0.f; o[1][i] = 0.f; }
        m = NEGF; l = 0.f;
      }
    } else if (s < 4 + n_slc) {
      const int j = s - 4;
      const bool mine = (selmask >> j) & 1u;
      if (__any(mine)) {
#ifdef ATTN_ONLINE
        if (j < qbi) stage_softmax_pv<false>(o, m, l, buf, qf, c32, hh, 0, 0, mine);
        else { const int klim = mine ? (t - 64 * j - 4 * hh) : -1; stage_softmax_pv<true>(o, m, l, buf, qf, c32, hh, klim, -1000000, mine); }
#else
        const float cinit = mine ? -ref_s : -1e30f;
        REPC
        if (j < qbi) stage_pv_ref<false>(o, l, buf, qf, c32, hh, cinit, 0, 0);
        else stage_pv_ref<true>(o, l, buf, qf, c32, hh, cinit, t - 64 * j - 4 * hh, -1000000);
#endif
      }
      if (j == qbi) {
        l += __shfl_xor(l, 32);
        const float sc = gate_s / fmaxf(l, 1e-37f);
#pragma unroll
        for (int dt = 0; dt < 2; ++dt)
#pragma unroll
          for (int i4 = 0; i4 < 4; ++i4) { f32x4 v = otl[(dt * 4 + i4) * 64]; v[0] += sc * o[dt][4 * i4]; v[1] += sc * o[dt][4 * i4 + 1]; v[2] += sc * o[dt][4 * i4 + 2]; v[3] += sc * o[dt][4 * i4 + 3]; otl[(dt * 4 + i4) * 64] = v; }
#pragma unroll
        for (int i = 0; i < 16; ++i) { o[0][i] = 0.f; o[1][i] = 0.f; }
        m = NEGF; l = 0.f;
      }
    } else {
      const int j = wj0 + (s - 4 - n_slc);
      const int tmin = t0 + 8 * w;
      if (64 * j + 63 > tmin - 256) {
#ifdef ATTN_ONLINE
        if (j < qbi && j >= qbi - 3) stage_softmax_pv<false>(o, m, l, buf, qf, c32, hh, 0, 0, true);
        else { const int khi = t - 64 * j - 4 * hh; stage_softmax_pv<true>(o, m, l, buf, qf, c32, hh, khi, khi - 256, true); }
#else
        REPC
        if (j < qbi && j >= qbi - 3) stage_pv_ref<false>(o, l, buf, qf, c32, hh, -ref_w, 0, 0);
        else { const int khi = t - 64 * j - 4 * hh; stage_pv_ref<true>(o, l, buf, qf, c32, hh, -ref_w, khi, khi - 256); }
#endif
      }
    }
    if (s + 1 < n_st) stage_store(lds + ((s + 1) % AT_NBUF) * AT_STAGE, sr0, tid);
    sr0 = sr1;
    lds_barrier();
    if (s == 3) {
      const int tl2 = lane >> 3, sg = lane & 7, cur = qbi;
      float scv[32];
#pragma unroll
      for (int s2 = 0; s2 < 32; ++s2) {
        const float v = impl[tl2 * 32 + s2];
        const bool forced = (s2 == 0) || (s2 == cur) || (s2 == cur - 1);
        scv[s2] = (s2 <= cur) ? (forced ? 1e4f : v) : -1e4f;
      }
      unsigned mk = 0u;
#pragma unroll
      for (int e = 0; e < 4; ++e) {
        const int sx = sg * 4 + e;
        float mine = 0.f;
#pragma unroll
        for (int s2 = 0; s2 < 32; ++s2) mine = (s2 == sx) ? scv[s2] : mine;
        int rank = 0;
#pragma unroll
        for (int s2 = 0; s2 < 32; ++s2) rank += (scv[s2] > mine || (scv[s2] == mine && s2 < sx)) ? 1 : 0;
        if (rank < 8 && sx <= cur) mk |= 1u << sx;
      }
      mk |= __shfl_xor(mk, 1); mk |= __shfl_xor(mk, 2); mk |= __shfl_xor(mk, 4);
      selmask = __shfl(mk, tl * 8);
    }
  }
#undef AT_SRC
  l += __shfl_xor(l, 32);
  const float scw = gate_w / fmaxf(l, 1e-37f);
#pragma unroll
  for (int dt = 0; dt < 2; ++dt)
#pragma unroll
    for (int ii = 0; ii < 4; ++ii) {
      const int d0 = 32 * dt + 8 * ii + 4 * hh;
      const f32x4 pk = otl[(dt * 4 + ii) * 64];
      const u32x2 z = *(const u32x2*)(a.szc + tok * 512 + head * 64 + d0);
      u32x2 ov;
      ov.x = cvt_pk_bf16((pk[0] + scw * o[dt][4 * ii]) * bflo(z.x), (pk[1] + scw * o[dt][4 * ii + 1]) * bfhi(z.x));
      ov.y = cvt_pk_bf16((pk[2] + scw * o[dt][4 * ii + 2]) * bflo(z.y), (pk[3] + scw * o[dt][4 * ii + 3]) * bfhi(z.y));
      *(u32x2*)(a.mixb + tok * 1024 + 512 + head * 64 + d0) = ov;
    }
}
__device__ __forceinline__ void phaseC(LAS unsigned char* lds, const PhaseCArgs& a) {
  for (int p0 = blockIdx.x; p0 < 256; p0 += gridDim.x) {
    const int p = gridDim.x == 256 ? ((p0 & 7) * 32 + (p0 >> 3)) : p0;
    const int b = p >> 5, g = (p >> 4) & 1, qlo = p & 15;
    attn_item(a, lds, b, qlo, g);
    __syncthreads();
    attn_item(a, lds, b, 31 - qlo, g);
    __syncthreads();
  }
}
#ifdef MULTI_LAUNCH
__global__ void __launch_bounds__(512, 2) k_phaseC(PhaseCArgs a) {
  extern __shared__ __attribute__((aligned(16))) unsigned char shm[];
  phaseC((LAS unsigned char*)shm, a);
}
#endif

#ifdef MULTI_LAUNCH
__global__ void k_bridge_cvt(const float* src, int ld_src, int col0, int ncol, bf16_t* dst, size_t ntok) {
  size_t i = (size_t)blockIdx.x * blockDim.x + tidx();
  if (i >= ntok * ncol) return;
  const size_t tok = i / ncol; const int c = (int)(i % ncol);
  dst[i] = f2bf(src[tok * ld_src + col0 + c]);
}
#endif
#ifdef MULTI_LAUNCH
__global__ void __launch_bounds__(256) k_prep_x(const float* xp, const float* xs, bf16_t* xb, float* ssq) {
  const int row = blockIdx.x * 4 + (tidx() >> 6), lane = tidx() & 63;
  if (row >= NTOK) return;
  const float* x = row < NPT ? xp + (size_t)row * 1024 : xs + (size_t)(row - NPT) * 1024;
#pragma unroll
  for (int j = 0; j < 4; ++j) {
    const f32x4 v = *(const f32x4*)(x + j * 256 + lane * 4);
    u32x2 pk; pk.x = cvt_pk_bf16(v[0], v[1]); pk.y = cvt_pk_bf16(v[2], v[3]);
    *(u32x2*)(xb + (size_t)row * 1024 + j * 256 + lane * 4) = pk;
    float ss = v[0] * v[0] + v[1] * v[1] + v[2] * v[2] + v[3] * v[3];
    ss += __shfl_xor(ss, 1); ss += __shfl_xor(ss, 2); ss += __shfl_xor(ss, 4); ss += __shfl_xor(ss, 8);
    if ((lane & 15) == 0) ssq[(size_t)row * 16 + j * 4 + (lane >> 4)] = ss;
  }
}
#endif
#ifdef MULTI_LAUNCH
__global__ void __launch_bounds__(64) k_prep_cbias(const float* pe, const float* w1, float* cbias) {
  const int lk = blockIdx.x, e = tidx();
  const float* pp = pe + (size_t)lk * 2048; const float* ww = w1 + (size_t)lk * 2048 * 64;
  float acc = 0.f;
  for (int k = 0; k < 2048; ++k) acc = fmaf(pp[k], ww[(size_t)k * 64 + e], acc);
  cbias[lk * 64 + e] = acc;
}
#endif
__device__ __forceinline__ float rinv_from_ssq(const float* ssq, size_t row) {
  const f32x4* p = (const f32x4*)(ssq + row * 16);
  const f32x4 a = p[0], b = p[1], c = p[2], d = p[3];
  const float s = ((a[0] + a[1]) + (a[2] + a[3])) + ((b[0] + b[1]) + (b[2] + b[3])) + ((c[0] + c[1]) + (c[2] + c[3])) + ((d[0] + d[1]) + (d[2] + d[3]));
  return rsqrtf(s * (1.f / 1024.f) + 1e-6f);
}
__device__ __forceinline__ f32x4 mfma16(bf16x8 a, bf16x8 b, f32x4 c) { return __builtin_amdgcn_mfma_f32_16x16x32_bf16(a, b, c, 0, 0, 0); }
__device__ __forceinline__ float fsilu(float z) { return z / (1.f + __expf(-z)); }
__device__ __forceinline__ float fsigmoid(float z) { return 1.f / (1.f + __expf(-z)); }

template <int NT> __device__ __forceinline__ void small_gemm(LAS unsigned char* lds, const bf16_t* A, int lda, const bf16_t* Bt, int ldb, int K, f32x4 (&acc)[NT]) {
  const int tid = tidx(), w = tid >> 6, lane = tid & 63, fr = lane & 15, fq = lane >> 4;
  constexpr int ST = 272, BUF = (128 + 16 * NT) * ST, NB = (16 * NT * 16 + 511) / 512;
  const int ar = tid >> 4, ap = tid & 15;
  const bf16_t* asrc = A + (size_t)ar * lda + ap * 8;
  u32x4 areg[2][4], breg[2][NB];
#pragma unroll
  for (int nt = 0; nt < NT; ++nt) acc[nt] = (f32x4){0.f, 0.f, 0.f, 0.f};
  const int nc = K / 128;
#define SG_LOAD(SET, c_) do { _Pragma("unroll") for (int i = 0; i < 4; ++i) areg[SET][i] = *(const u32x4*)(asrc + (size_t)(32 * i) * lda + (c_) * 128);                                   \
    _Pragma("unroll") for (int i = 0; i < NB; ++i) { const int pc = tid + i * 512; if (pc < 16 * NT * 16) breg[SET][i] = *(const u32x4*)(Bt + (size_t)(pc >> 4) * ldb + (c_) * 128 + (pc & 15) * 8); } } while (0)
#define SG_STORE(SET, c_) do { LAS unsigned char* base_ = lds + ((c_) & 1) * BUF;                                                                                        \
    _Pragma("unroll") for (int i = 0; i < 4; ++i) *(LAS u32x4*)(base_ + (ar + 32 * i) * ST + ap * 16) = areg[SET][i];                                                       \
    _Pragma("unroll") for (int i = 0; i < NB; ++i) { const int pc = tid + i * 512; if (pc < 16 * NT * 16) *(LAS u32x4*)(base_ + (128 + (pc >> 4)) * ST + (pc & 15) * 16) = breg[SET][i]; } } while (0)
#define SG_COMPUTE(c_) do { const LAS unsigned char* base_ = lds + ((c_) & 1) * BUF;                                                                                     \
    _Pragma("unroll") for (int i = 0; i < 4; ++i) { const bf16x8 af = *(const LAS bf16x8*)(base_ + (16 * w + fr) * ST + i * 64 + fq * 16);                                \
      _Pragma("unroll") for (int nt = 0; nt < NT; ++nt) { const bf16x8 bf = *(const LAS bf16x8*)(base_ + (128 + nt * 16 + fr) * ST + i * 64 + fq * 16); acc[nt] = mfma16(bf, af, acc[nt]); } } } while (0)
  SG_LOAD(0, 0);
  if (nc > 1) SG_LOAD(1, 1);
  SG_STORE(0, 0);
  lds_barrier();
#pragma unroll 1
  for (int c = 0; c < nc; c += 2) {
    if (c + 2 < nc) SG_LOAD(0, c + 2);
    SG_COMPUTE(c);
    SG_STORE(1, c + 1);
    lds_barrier();
    if (c + 3 < nc) SG_LOAD(1, c + 3);
    SG_COMPUTE(c + 1);
    if (c + 2 < nc) SG_STORE(0, c + 2);
    lds_barrier();
  }
#undef SG_LOAD
#undef SG_STORE
#undef SG_COMPUTE
}

struct PhaseBArgs {
  const bf16_t *glu, *bin, *sza, *szb, *xb; const float* ssq;
  const bf16_t *WpwT, *WpoolT, *WgT, *W1T, *W2T; const float* cbias;
  const float *w_dw, *b_dw, *ln_g, *ln_b, *b_pw, *pool_scale;
  const float* cmp_rows_p;
  bf16_t *mixb, *kcP, *vcPT; float* gates;
#ifdef PROBE_REP
  int repb[4];
#endif
};
#ifdef PROBE_REP
#define REPB(i) _Pragma("unroll 1") for (int repb_ = 0; repb_ < a.repb[i]; ++repb_)
#else
#define REPB(i)
#endif

template <int NT_>
__device__ __forceinline__ void conv_item(const PhaseBArgs& a, LAS unsigned char* lds, int b, int chunk) {
  const int tid = tidx(), w = tid >> 6, lane = tid & 63;
  const int t0 = chunk * NT_;
  constexpr int TPT = NT_ / 4;
  for (int i = tid; i < (NT_ + 30) * 32; i += 512) {
    const int row = i >> 5, ch = i & 31, t = t0 - 30 + row;
    u32x4 v = {0u, 0u, 0u, 0u};
    if (t >= 0) v = *(const u32x4*)(a.glu + ((size_t)b * SEQ + t) * 256 + ch * 8);
    *(LAS u32x4*)(lds + row * 512 + ch * 16) = v;
  }
  __syncthreads();
  const int cp = tid & 127, tg = tid >> 7;
  f32x2 res[TPT];
  {
    const f32x2 bd = *(const f32x2*)(a.b_dw + 2 * cp);
    f32x2 wt[31];
#pragma unroll
    for (int k = 0; k < 31; ++k) wt[k] = *(const f32x2*)(a.w_dw + k * 256 + 2 * cp);
    const LAS unsigned* wp = (const LAS unsigned*)(lds + (tg * TPT) * 512 + cp * 4);
#pragma unroll
    for (int blk = 0; blk < TPT / 8; ++blk) {
      f32x2 xw[38];
#pragma unroll
      for (int i = 0; i < 38; ++i) { const unsigned xv = wp[(blk * 8 + i) * 128]; xw[i] = (f32x2){bflo(xv), bfhi(xv)}; }
      f32x2 ac[8];
#pragma unroll
      for (int j = 0; j < 8; ++j) ac[j] = bd;
#pragma unroll
      for (int k = 0; k < 31; ++k)
#pragma unroll
        for (int j = 0; j < 8; ++j) ac[j] = __builtin_elementwise_fma(wt[k], xw[j + k], ac[j]);
#pragma unroll
      for (int j = 0; j < 8; ++j) res[blk * 8 + j] = ac[j];
    }
  }
  __syncthreads();
#pragma unroll
  for (int j = 0; j < TPT; ++j) *(LAS f32x2*)(lds + (tg * TPT + j) * 1088 + cp * 8) = res[j];
  __syncthreads();
  if ((tid >> 2) < NT_) {
    const int tok = tid >> 2, q = tid & 3;
    f32x4 v[16]; float s = 0.f;
#pragma unroll
    for (int i = 0; i < 16; ++i) { v[i] = *(const LAS f32x4*)(lds + tok * 1088 + (4 * i + q) * 16); s += (v[i][0] + v[i][1]) + (v[i][2] + v[i][3]); }
    s += __shfl_xor(s, 1); s += __shfl_xor(s, 2);
    const float mean = s * (1.f / 256.f);
    float s2 = 0.f;
#pragma unroll
    for (int i = 0; i < 16; ++i) { v[i] = v[i] - mean; s2 += (v[i][0] * v[i][0] + v[i][1] * v[i][1]) + (v[i][2] * v[i][2] + v[i][3] * v[i][3]); }
    s2 += __shfl_xor(s2, 1); s2 += __shfl_xor(s2, 2);
    const float rstd = rsqrtf(s2 * (1.f / 256.f) + 1e-6f);
#pragma unroll
    for (int i = 0; i < 16; ++i) {
      const int c0 = (4 * i + q) * 4;
      const f32x4 gg = *(const f32x4*)(a.ln_g + c0), bb = *(const f32x4*)(a.ln_b + c0);
      f32x4 z = v[i] * rstd * gg + bb;
      u32x2 pk; pk.x = cvt_pk_bf16(fsilu(z[0]), fsilu(z[1])); pk.y = cvt_pk_bf16(fsilu(z[2]), fsilu(z[3]));
      *(LAS u32x2*)(lds + tok * 1088 + c0 * 2) = pk;
    }
  }
  __syncthreads();
  {
    const int fr = lane & 15, fq = lane >> 4;
    bf16x8 bfr[2][8];
#pragma unroll
    for (int nt = 0; nt < 2; ++nt)
#pragma unroll
      for (int ks = 0; ks < 8; ++ks) bfr[nt][ks] = *(const bf16x8*)(a.WpwT + (size_t)(32 * w + nt * 16 + fr) * 256 + ks * 32 + fq * 8);
    const size_t tok0 = (size_t)b * SEQ + t0;
#pragma unroll 2
    for (int mt = 0; mt < NT_ / 16; ++mt) {
      f32x4 acc0 = {0.f, 0.f, 0.f, 0.f}, acc1 = {0.f, 0.f, 0.f, 0.f};
#pragma unroll
      for (int ks = 0; ks < 8; ++ks) {
        const bf16x8 af = *(const LAS bf16x8*)(lds + (16 * mt + fr) * 1088 + (ks * 32 + fq * 8) * 2);
        acc0 = mfma16(bfr[0][ks], af, acc0); acc1 = mfma16(bfr[1][ks], af, acc1);
      }
      const size_t tok = tok0 + 16 * mt + fr;
#pragma unroll
      for (int nt = 0; nt < 2; ++nt) {
        const f32x4 ac = nt ? acc1 : acc0;
        const int c0 = 32 * w + nt * 16 + 4 * fq;
        const f32x4 bp = *(const f32x4*)(a.b_pw + c0);
        const u32x2 z = *(const u32x2*)(a.sza + tok * 256 + c0);
        u32x2 ov;
        ov.x = cvt_pk_bf16((ac[0] + bp[0]) * bflo(z.x), (ac[1] + bp[1]) * bfhi(z.x));
        ov.y = cvt_pk_bf16((ac[2] + bp[2]) * bflo(z.y), (ac[3] + bp[3]) * bfhi(z.y));
        *(u32x2*)(a.mixb + tok * 1024 + c0) = ov;
      }
    }
  }
  __syncthreads();
}

__device__ __forceinline__ void pool_item(const PhaseBArgs& a, LAS unsigned char* lds, int b, int chunk) {
  const int tid = tidx(), w = tid >> 6, lane = tid & 63;
  const int t0 = chunk * 128;
  constexpr int DOFF = 143 * 512;
  for (int i = tid; i < 143 * 32; i += 512) {
    const int row = i >> 5, ch = i & 31, t = t0 - 15 + row;
    u32x4 v = {0u, 0u, 0u, 0u};
    if (t >= 0) v = *(const u32x4*)(a.bin + ((size_t)b * SEQ + t) * 256 + ch * 8);
    *(LAS u32x4*)(lds + row * 512 + ch * 16) = v;
  }
  __syncthreads();
  {
    const int cp = tid & 127, tg = tid >> 7, grp = cp >> 5, wn = 2 << grp;
    const LAS unsigned* wp = (const LAS unsigned*)(lds + cp * 4);
    const int r0 = 15 + tg * 32;
    float run0 = 0.f, run1 = 0.f;
    for (int i = 1; i < wn; ++i) { const unsigned xv = wp[(r0 - i) * 128]; run0 += bflo(xv); run1 += bfhi(xv); }
#pragma unroll 4
    for (int j = 0; j < 32; ++j) {
      const int rr = r0 + j, t = t0 + tg * 32 + j;
      const unsigned xv = wp[rr * 128];
      const float x0 = bflo(xv), x1 = bfhi(xv);
      run0 += x0; run1 += x1;
      const float icnt = 1.f / (float)min(wn, t + 1);
      const unsigned dv = cvt_pk_bf16(run0 * icnt - x0, run1 * icnt - x1);
      *(LAS unsigned*)(lds + DOFF + (tg * 32 + j) * 528 + cp * 4) = dv;
      const unsigned xo = wp[(rr - wn + 1) * 128];
      run0 -= bflo(xo); run1 -= bfhi(xo);
    }
  }
  __syncthreads();
  {
    const int fr = lane & 15, fq = lane >> 4;
    const size_t tok = (size_t)b * SEQ + t0 + 16 * w + fr;
#pragma unroll
    for (int g = 0; g < 4; ++g) {
      f32x4 acc[4];
#pragma unroll
      for (int nt = 0; nt < 4; ++nt) acc[nt] = (f32x4){0.f, 0.f, 0.f, 0.f};
#pragma unroll
      for (int ks = 0; ks < 2; ++ks) {
        const bf16x8 af = *(const LAS bf16x8*)(lds + DOFF + (16 * w + fr) * 528 + (g * 64 + ks * 32 + fq * 8) * 2);
#pragma unroll
        for (int nt = 0; nt < 4; ++nt) {
          const bf16x8 bf = *(const bf16x8*)(a.WpoolT + (size_t)(g * 64 + nt * 16 + fr) * 64 + ks * 32 + fq * 8);
          acc[nt] = mfma16(bf, af, acc[nt]);
        }
      }
#pragma unroll
      for (int nt = 0; nt < 4; ++nt) {
        const int c0 = g * 64 + nt * 16 + 4 * fq;
        const f32x4 sc = *(const f32x4*)(a.pool_scale + c0);
        const u32x2 z = *(const u32x2*)(a.szb + tok * 256 + c0);
        u32x2 ov;
        ov.x = cvt_pk_bf16(acc[nt][0] * sc[0] * bflo(z.x), acc[nt][1] * sc[1] * bfhi(z.x));
        ov.y = cvt_pk_bf16(acc[nt][2] * sc[2] * bflo(z.y), acc[nt][3] * sc[3] * bfhi(z.y));
        *(u32x2*)(a.mixb + tok * 1024 + 256 + c0) = ov;
      }
    }
  }
  __syncthreads();
}

__device__ __forceinline__ void gates_item(const PhaseBArgs& a, LAS unsigned char* lds, int chunk) {
  const int tid = tidx(), w = tid >> 6, lane = tid & 63, fr = lane & 15, fq = lane >> 4;
  const size_t row = (size_t)chunk * 128 + 16 * w + fr;
  f32x4 acc[2];
  small_gemm<2>(lds, a.xb + (size_t)chunk * 128 * 1024, 1024, a.WgT, 1024, 1024, acc);
  const float rinv = rinv_from_ssq(a.ssq, row);
#pragma unroll
  for (int nt = 0; nt < 2; ++nt) {
    const int c0 = nt * 16 + 4 * fq;
    if (c0 < 24) {
      f32x4 o;
#pragma unroll
      for (int e = 0; e < 4; ++e) o[e] = fsigmoid(acc[nt][e] * rinv);
      *(f32x4*)(a.gates + row * 24 + c0) = o;
    }
  }
}

struct CmpSrc { const float* base; const int* pages; };
__device__ __forceinline__ const float* cmp_row_ptr(const CmpSrc& s, int pos) {
  if (s.pages) return s.base + ((size_t)s.pages[pos >> 7] * 128 + (pos & 127)) * 256;
  return s.base + (size_t)pos * 256;
}
__device__ __forceinline__ float gelu_tanh_f(float x) {
  const float u = 0.7978845608028654f * (x + 0.044715f * x * x * x);
  const float e = __expf(2.f * u);
  const float th = 1.f - 2.f / (e + 1.f);
  return 0.5f * x * (1.f + th);
}
template <bool VROWMAJOR>
__device__ __forceinline__ void compress_item(LAS unsigned char* lds, const CmpSrc& src, int g, int kv, const bf16_t* W1T  , const bf16_t* W2T  ,
                                              const float* cbias  , bf16_t* kc_out  , bf16_t* vcT_out  ) {
  const int tid = tidx(), w = tid >> 6, lane = tid & 63, fr = lane & 15, fq = lane >> 4;
  constexpr int ST = 272;
  constexpr int ABUF = 128 * ST;
  constexpr int BUF = 2 * ABUF;
  constexpr int POFF = 0;
  const float* arow[8];
#pragma unroll
  for (int i = 0; i < 8; ++i) { const int idx = i * 512 + tid, piece = idx >> 5, pos = (idx >> 4) & 1; arow[i] = cmp_row_ptr(src, piece * 16 + pos) + kv * 128 + g * 64 + (idx & 15) * 4; }
  const int a_lds = (tid >> 5) * ST + (((tid >> 4) & 1) * 64 + (tid & 15) * 4) * 2;
  const bf16_t* bsrc = W1T + (size_t)(tid >> 4) * 1024 + (tid & 15) * 8;
  const int b_lds = ABUF + (tid >> 4) * ST + (tid & 15) * 16;
  f32x4 acc[8];
#pragma unroll
  for (int nt = 0; nt < 8; ++nt) acc[nt] = (f32x4){0.f, 0.f, 0.f, 0.f};
  u32x4 breg[4]; f32x4 areg[8];
#pragma unroll
  for (int i = 0; i < 4; ++i) breg[i] = *(const u32x4*)(bsrc + (size_t)(32 * i) * 1024);
#pragma unroll
  for (int i = 0; i < 8; ++i) areg[i] = *(const f32x4*)arow[i];
#pragma unroll 1
  for (int c = 0; c < 8; ++c) {
    LAS unsigned char* base = lds + (c & 1) * BUF;
#pragma unroll
    for (int i = 0; i < 4; ++i) *(LAS u32x4*)(base + b_lds + 32 * i * ST) = breg[i];
#pragma unroll
    for (int i = 0; i < 8; ++i) { u32x2 pk; pk.x = cvt_pk_bf16(areg[i][0], areg[i][1]); pk.y = cvt_pk_bf16(areg[i][2], areg[i][3]); *(LAS u32x2*)(base + a_lds + i * 16 * ST) = pk; }
    if (c < 7) {
#pragma unroll
      for (int i = 0; i < 4; ++i) breg[i] = *(const u32x4*)(bsrc + (size_t)(32 * i) * 1024 + (c + 1) * 128);
#pragma unroll
      for (int i = 0; i < 8; ++i) areg[i] = *(const f32x4*)(arow[i] + (size_t)(2 * (c + 1)) * 256);
    }
    lds_barrier();
#pragma unroll
    for (int i = 0; i < 4; ++i) {
      const bf16x8 af = *(const LAS bf16x8*)(base + (16 * w + fr) * ST + i * 64 + fq * 16);
#pragma unroll
      for (int nt = 0; nt < 8; ++nt) {
        const bf16x8 bf = *(const LAS bf16x8*)(base + ABUF + (nt * 16 + fr) * ST + i * 64 + fq * 16);
        acc[nt] = mfma16(bf, af, acc[nt]);
      }
    }
  }
  __syncthreads();
#pragma unroll
  for (int nt = 0; nt < 8; ++nt) *(LAS f32x4*)(lds + POFF + (16 * w + fr) * 528 + (nt * 16 + 4 * fq) * 4) = acc[nt];
  __syncthreads();
  {
    const int i = 16 * w + fr, i1 = i < 127 ? i + 1 : 127;
    f32x4 o[4];
#pragma unroll
    for (int nt = 0; nt < 4; ++nt) o[nt] = (f32x4){0.f, 0.f, 0.f, 0.f};
#pragma unroll
    for (int ks = 0; ks < 2; ++ks) {
      const int k0 = ks * 32 + fq * 8;
      union { bf16x8 v; unsigned u[4]; } hf;
#pragma unroll
      for (int h2 = 0; h2 < 2; ++h2) {
        const f32x4 pa = *(const LAS f32x4*)(lds + POFF + i * 528 + (k0 + 4 * h2) * 4);
        const f32x4 pb = *(const LAS f32x4*)(lds + POFF + i1 * 528 + (64 + k0 + 4 * h2) * 4);
        const f32x4 cb = *(const f32x4*)(cbias + k0 + 4 * h2);
        const f32x4 x = pa + pb + cb;
        hf.u[2 * h2] = cvt_pk_bf16(gelu_tanh_f(x[0]), gelu_tanh_f(x[1]));
        hf.u[2 * h2 + 1] = cvt_pk_bf16(gelu_tanh_f(x[2]), gelu_tanh_f(x[3]));
      }
#pragma unroll
      for (int nt = 0; nt < 4; ++nt) {
        const bf16x8 bf = *(const bf16x8*)(W2T + (size_t)(nt * 16 + fr) * 64 + k0);
        o[nt] = mfma16(bf, hf.v, o[nt]);
      }
    }
    const bool real = i < 127;
#pragma unroll
    for (int nt = 0; nt < 4; ++nt) {
      const int c0 = nt * 16 + 4 * fq;
      const float v0 = real ? o[nt][0] : 0.f, v1 = real ? o[nt][1] : 0.f, v2 = real ? o[nt][2] : 0.f, v3 = real ? o[nt][3] : 0.f;
      if (kv == 0) { u32x2 pk; pk.x = cvt_pk_bf16(v0, v1); pk.y = cvt_pk_bf16(v2, v3); *(u32x2*)(kc_out + (size_t)i * 64 + c0) = pk; }
      else if (VROWMAJOR) { u32x2 pk; pk.x = cvt_pk_bf16(v0, v1); pk.y = cvt_pk_bf16(v2, v3); *(u32x2*)(vcT_out + (size_t)i * 64 + c0) = pk; }
      else { vcT_out[(size_t)(c0 + 0) * 128 + i] = f2bf(v0); vcT_out[(size_t)(c0 + 1) * 128 + i] = f2bf(v1); vcT_out[(size_t)(c0 + 2) * 128 + i] = f2bf(v2); vcT_out[(size_t)(c0 + 3) * 128 + i] = f2bf(v3); }
    }
  }
  __syncthreads();
}

__device__ __forceinline__ void phaseB(LAS unsigned char* lds, const PhaseBArgs& a) {
  const int G = gridDim.x, wg = blockIdx.x;
#ifndef NO_CONV
  REPB(0) for (int it = wg; it < 256; it += G) conv_item<64>(a, lds, it >> 5, it & 31);
#endif
#ifndef NO_CMPR
  REPB(2) for (int it = wg; it < 32; it += G) {
    const int b = it >> 2, g = (it >> 1) & 1, kv = it & 1;
    CmpSrc src{a.cmp_rows_p + (size_t)b * SEQ * 256, nullptr};
    compress_item<false>(lds, src, g, kv, a.W1T + (size_t)kv * 128 * 1024, a.W2T + (size_t)kv * 4096, a.cbias + kv * 64,
                  a.kcP + ((size_t)b * 2 + g) * 128 * 64, a.vcPT + ((size_t)b * 2 + g) * 64 * 128);
  }
#endif
#ifndef NO_POOL
  REPB(1) for (int it = (wg + G - 32 % G) % G; it < 128; it += G) pool_item(a, lds, it >> 4, it & 15);
#endif
#ifndef NO_GATES
  REPB(3) for (int it = (wg + G - 128 % G) % G; it < 128; it += G) gates_item(a, lds, it);
#endif
}
#ifdef MULTI_LAUNCH
__global__ void __launch_bounds__(512, 2) k_phaseB(PhaseBArgs a) {
  extern __shared__ __attribute__((aligned(16))) unsigned char shm[];
  phaseB((LAS unsigned char*)shm, a);
}
#endif

struct EpiA {
  static constexpr bool PERM = true, AFTER_DRAIN = false;
  int l; int pad_;
  const float* ssq; const float* g_q; const float* g_k; const float* cs;
  bf16_t *glu, *bin, *sza, *szb, *szc, *qb, *ks, *vsT, *kw, *vwT; float* out;
  __device__ __forceinline__ void norm_rope(f32x4 (&v)[2][2], const float* gain, int t, int fq) const {
    float ss = 0.f;
#pragma unroll
    for (int bj = 0; bj < 2; ++bj)
#pragma unroll
      for (int n = 0; n < 2; ++n) ss += (v[bj][n][0] * v[bj][n][0] + v[bj][n][1] * v[bj][n][1]) + (v[bj][n][2] * v[bj][n][2] + v[bj][n][3] * v[bj][n][3]);
    ss += __shfl_xor(ss, 16); ss += __shfl_xor(ss, 32);
    const float rn = rsqrtf(ss * (1.f / 64.f) + 1e-6f);
#pragma unroll
    for (int bj = 0; bj < 2; ++bj)
#pragma unroll
      for (int n = 0; n < 2; ++n) { const f32x4 gg = *(const f32x4*)(gain + 32 * bj + 8 * fq + 4 * n); v[bj][n] = v[bj][n] * rn * gg; }
#pragma unroll
    for (int n = 0; n < 2; ++n) {
      const f32x4 c0 = *(const f32x4*)(cs + t * 16 + 8 * n), c1 = *(const f32x4*)(cs + t * 16 + 8 * n + 4);
      const float cc[4] = {c0[0], c0[2], c1[0], c1[2]}, sn[4] = {c0[1], c0[3], c1[1], c1[3]};
#pragma unroll
      for (int e = 0; e < 4; ++e) {
        const float y = v[0][n][e], pr = __shfl_xor(y, 16);
        const float r0 = y * cc[e] - pr * sn[e], r1 = y * cc[e] + pr * sn[e];
        v[0][n][e] = fq == 0 ? r0 : (fq == 1 ? r1 : y);
      }
    }
  }
  __device__ __forceinline__ void operator()(const f32x4 (&acc)[2][2][4][2], const Unit& u, int wr_, int wc_, int fr_, int fq_) const {
    const int tz = tidx(), wid_ = tz >> 6, wr = wid_ >> 2, wc = wid_ & 3, fr = tz & 15, fq = (tz >> 4) & 3;
    const int pn = u.pn;
    const int row0 = u.pm * 256 + wr * 64 + fr;
    const int jc = 32 * wc + 8 * fq;
#pragma unroll
    for (int ai = 0; ai < 2; ++ai)
#pragma unroll
      for (int m = 0; m < 4; ++m) {
        const int row = row0 + ai * 128 + m * 16;
        const size_t tok = (size_t)row;
        const int b = row >> 11, t = row & 2047;
        float rinv;
        { const f32x4 p = *(const f32x4*)(ssq + tok * 16 + fq * 4); float sq = (p[0] + p[1]) + (p[2] + p[3]); sq += __shfl_xor(sq, 16); sq += __shfl_xor(sq, 32); rinv = rsqrtf(sq * (1.f / 1024.f) + 1e-6f); }
        f32x4 v[2][2];
#pragma unroll
        for (int bj = 0; bj < 2; ++bj)
#pragma unroll
          for (int n = 0; n < 2; ++n) v[bj][n] = acc[ai][bj][m][n] * rinv;
        if (pn < 2) {
          const int c = pn * 128 + jc;
          f32x4 o0, o1;
#pragma unroll
          for (int e = 0; e < 4; ++e) { o0[e] = v[0][0][e] * fsigmoid(v[1][0][e]); o1[e] = v[0][1][e] * fsigmoid(v[1][1][e]); }
          u32x4 pk; pk.x = cvt_pk_bf16(o0[0], o0[1]); pk.y = cvt_pk_bf16(o0[2], o0[3]); pk.z = cvt_pk_bf16(o1[0], o1[1]); pk.w = cvt_pk_bf16(o1[2], o1[3]);
          *(u32x4*)(glu + tok * 256 + c) = pk;
          if (t >= 2018) { float* dst = out + O_CONVP + ((size_t)(l * 8 + b) * 30 + (t - 2018)) * 256 + c; *(f32x4*)dst = o0; *(f32x4*)(dst + 4) = o1; }
        } else if (pn == 3) {
#pragma unroll
          for (int bj = 0; bj < 2; ++bj) {
            const int c = 128 * bj + jc;
            u32x4 pk; pk.x = cvt_pk_bf16(v[bj][0][0], v[bj][0][1]); pk.y = cvt_pk_bf16(v[bj][0][2], v[bj][0][3]); pk.z = cvt_pk_bf16(v[bj][1][0], v[bj][1][1]); pk.w = cvt_pk_bf16(v[bj][1][2], v[bj][1][3]);
            *(u32x4*)(bin + tok * 256 + c) = pk;
            if (t >= 2033) { float* dst = out + O_POOLP + ((size_t)(l * 8 + b) * 15 + (t - 2033)) * 256 + c; *(f32x4*)dst = v[bj][0]; *(f32x4*)(dst + 4) = v[bj][1]; }
          }
        } else if (pn == 2 || pn == 4 || pn >= 10) {
          bf16_t* base = pn == 2 ? sza + tok * 256 : (pn == 4 ? szb + tok * 256 : szc + tok * 512 + (pn - 10) * 256);
#pragma unroll
          for (int bj = 0; bj < 2; ++bj) {
            u32x4 pk; pk.x = cvt_pk_bf16(fsilu(v[bj][0][0]), fsilu(v[bj][0][1])); pk.y = cvt_pk_bf16(fsilu(v[bj][0][2]), fsilu(v[bj][0][3]));
            pk.z = cvt_pk_bf16(fsilu(v[bj][1][0]), fsilu(v[bj][1][1])); pk.w = cvt_pk_bf16(fsilu(v[bj][1][2]), fsilu(v[bj][1][3]));
            *(u32x4*)(base + 128 * bj + jc) = pk;
          }
        } else if (pn <= 6) {
          const int head = (pn - 5) * 4 + wc;
          norm_rope(v, g_q, t, fq);
          const float sc = 0.125f * 1.4426950408889634f;
#pragma unroll
          for (int bj = 0; bj < 2; ++bj) {
            u32x4 pk; pk.x = cvt_pk_bf16(v[bj][0][0] * sc, v[bj][0][1] * sc); pk.y = cvt_pk_bf16(v[bj][0][2] * sc, v[bj][0][3] * sc);
            pk.z = cvt_pk_bf16(v[bj][1][0] * sc, v[bj][1][1] * sc); pk.w = cvt_pk_bf16(v[bj][1][2] * sc, v[bj][1][3] * sc);
            *(u32x4*)(qb + (tok * 8 + head) * 64 + 32 * bj + 8 * fq) = pk;
          }
        } else {
          const int br = pn - 7, kvsel = wc >> 1, g = wc & 1;
          if (kvsel == 0) norm_rope(v, g_k + br * 64, t, fq);
          float* fdst = nullptr;
          if (br == 0) fdst = out + O_CMPP + ((size_t)l * NPT + tok) * 256;
          else if (br == 1) fdst = out + O_SLCP + ((size_t)l * NPT + tok) * 256;
          else if (t >= 1792) fdst = out + O_WINP + ((size_t)(l * 8 + b) * 256 + (t - 1792)) * 256;
          if (fdst) {
#pragma unroll
            for (int bj = 0; bj < 2; ++bj) { float* d2 = fdst + kvsel * 128 + g * 64 + 32 * bj + 8 * fq; *(f32x4*)d2 = v[bj][0]; *(f32x4*)(d2 + 4) = v[bj][1]; }
          }
          if (br >= 1) {
            const size_t bg = (size_t)b * 2 + g;
            if (kvsel == 0) {
              bf16_t* kd = (br == 1 ? ks : kw) + (bg * SEQ + t) * 64;
#pragma unroll
              for (int bj = 0; bj < 2; ++bj) {
                u32x4 pk; pk.x = cvt_pk_bf16(v[bj][0][0], v[bj][0][1]); pk.y = cvt_pk_bf16(v[bj][0][2], v[bj][0][3]); pk.z = cvt_pk_bf16(v[bj][1][0], v[bj][1][1]); pk.w = cvt_pk_bf16(v[bj][1][2], v[bj][1][3]);
                *(u32x4*)(kd + 32 * bj + 8 * fq) = pk;
              }
            } else {
              bf16_t* vd = (br == 1 ? vsT : vwT) + bg * 64 * SEQ + t;
#pragma unroll
              for (int bj = 0; bj < 2; ++bj)
#pragma unroll
                for (int n = 0; n < 2; ++n)
#pragma unroll
                  for (int e = 0; e < 4; ++e) vd[(size_t)(32 * bj + 8 * fq + 4 * n + e) * SEQ] = f2bf(v[bj][n][e]);
            }
          }
        }
      }
  }
};
struct PhaseAArgs { EpiA epi; const bf16_t* xb; const bf16_t* WinT; };
__device__ __forceinline__ void phaseA(LAS unsigned char* lds, const PhaseAArgs& a) {
  pg8::Gemm g{a.xb, a.WinT, NPT, 3072, 1024};
  pg8::StaticOrder S; S.init(NPT, 3072, gridDim.x, blockIdx.x);
  pg8::gemm_phase<EpiA, pg8::StaticOrder, false>(lds, g, S, a.epi, nullptr);
}
#ifdef MULTI_LAUNCH
__global__ void __launch_bounds__(512, 2) k_phaseA(PhaseAArgs a) {
  extern __shared__ __attribute__((aligned(16))) unsigned char shm[];
  phaseA((LAS unsigned char*)shm, a);
}
#endif

__device__ __forceinline__ float wsum(float v) {
#pragma unroll
  for (int o = 32; o > 0; o >>= 1) v += __shfl_xor(v, o);
  return v;
}
__device__ __forceinline__ float wmax(float v) {
#pragma unroll
  for (int o = 32; o > 0; o >>= 1) v = fmaxf(v, __shfl_xor(v, o));
  return v;
}
template <int NT> __device__ __forceinline__ void thin_gemm(const bf16_t* A, int lda, const bf16_t* Bt, int ldb, int K, f32x4 (&acc)[NT], int fr, int fq) {
  const bf16_t* ap = A + (size_t)fr * lda + fq * 8;
  const bf16_t* bp = Bt + (size_t)fr * ldb + fq * 8;
#pragma unroll
  for (int nt = 0; nt < NT; ++nt) acc[nt] = (f32x4){0.f, 0.f, 0.f, 0.f};
#pragma unroll 4
  for (int k0 = 0; k0 < K; k0 += 32) {
    const bf16x8 af = *(const bf16x8*)(ap + k0);
#pragma unroll
    for (int nt = 0; nt < NT; ++nt) { const bf16x8 bf = *(const bf16x8*)(bp + (size_t)nt * 16 * ldb + k0); acc[nt] = mfma16(bf, af, acc[nt]); }
  }
}
__device__ __forceinline__ void s1_unit(LAS unsigned char* lds, const bf16_t* xb_s, const float* ssq_s, const bf16_t* WinT, float* sproj, int u) {
  const int tid = tidx(), w = tid >> 6, lane = tid & 63, fr = lane & 15, fq = lane >> 4;
  const int n0 = 16 * u, row = 16 * w + fr;
  f32x4 acc[1];
  small_gemm<1>(lds, xb_s, 1024, WinT + (size_t)n0 * 1024, 1024, 1024, acc);
  const float rinv = rinv_from_ssq(ssq_s, row);
  const int np = n0 + 4 * fq;
  if (np < 3096) { const int lc = win_logical_col(np); *(f32x4*)(sproj + (size_t)row * 3104 + lc) = acc[0] * rinv; }
}
template <bool LAST> __device__ __forceinline__ void s4_unit(LAS unsigned char* lds, const bf16_t* mix_s, const bf16_t* WoutT, const float* xs, float* xs_out, bf16_t* xb_s, float* ssq_s, int u) {
  const int tid = tidx(), w = tid >> 6, lane = tid & 63, fr = lane & 15, fq = lane >> 4;
  const int n0 = 64 * u, row = 16 * w + fr;
  f32x4 acc[4];
  small_gemm<4>(lds, mix_s, 1024, WoutT + (size_t)n0 * 1024, 1024, 1024, acc);
  float ss = 0.f;
#pragma unroll
  for (int nt = 0; nt < 4; ++nt) {
    const int c = n0 + nt * 16 + 4 * fq;
    const f32x4 v = acc[nt] + *(const f32x4*)(xs + (size_t)row * 1024 + c);
    *(f32x4*)(xs_out + (size_t)row * 1024 + c) = v;
    if (!LAST) { u32x2 pk; pk.x = cvt_pk_bf16(v[0], v[1]); pk.y = cvt_pk_bf16(v[2], v[3]); *(u32x2*)(xb_s + (size_t)row * 1024 + c) = pk; ss += (v[0] * v[0] + v[1] * v[1]) + (v[2] * v[2] + v[3] * v[3]); }
  }
  if (!LAST) { ss += __shfl_xor(ss, 16); ss += __shfl_xor(ss, 32); if (fq == 0) ssq_s[(size_t)row * 16 + u] = ss; }
}

struct SampArgs {
  int l; int pad_;
  const float* sproj;
  const float *g_q, *g_k, *cs;
  const float *state_conv_l, *state_pool_l;
  const float *w_dw, *b_dw, *ln_g, *ln_b, *w_pw, *b_pw, *w_pool, *pool_scale;
  const float *cache_slc_l, *cache_win_l; const int* page_table;
  const bf16_t *kcS, *vcST;
  float *sq, *srows, *sgates;
  bf16_t* mix_s;
  float* out;
};
__device__ __forceinline__ void s2_item(const SampArgs& a, LAS unsigned char* lds, int b) {
  const int tid = tidx(), w = tid >> 6, lane = tid & 63, l = a.l;
  const float* pr = a.sproj + (size_t)b * 3104;
  LAS float* sh = (LAS float*)lds;
  const float* csp = a.cs + 2048 * 16;
  {
    const float v = pr[C_Q + w * 64 + lane];
    const float y = v * rsqrtf(wsum(v * v) * (1.f / 64.f) + 1e-6f) * a.g_q[lane];
    const float pp = __shfl_xor(y, 8);
    float o = y;
    if (lane < 16) { const int j = lane & 7; const float c = csp[j * 2], sn = csp[j * 2 + 1]; o = lane < 8 ? y * c - pp * sn : y * c + pp * sn; }
    a.sq[(size_t)b * 512 + w * 64 + lane] = o;
  }
  if (w < 6) {
    const int br = w >> 1, g = w & 1;
    const float v = pr[C_KV + br * 256 + g * 64 + lane];
    const float y = v * rsqrtf(wsum(v * v) * (1.f / 64.f) + 1e-6f) * a.g_k[br * 64 + lane];
    const float pp = __shfl_xor(y, 8);
    float o = y;
    if (lane < 16) { const int j = lane & 7; const float c = csp[j * 2], sn = csp[j * 2 + 1]; o = lane < 8 ? y * c - pp * sn : y * c + pp * sn; }
    const float vv = pr[C_KV + br * 256 + 128 + g * 64 + lane];
    a.srows[(size_t)b * 768 + br * 256 + g * 64 + lane] = o;
    a.srows[(size_t)b * 768 + br * 256 + 128 + g * 64 + lane] = vv;
    float* dst = br == 0 ? a.out + O_CMPS + ((size_t)l * NSM + b) * 256 : (br == 1 ? a.out + O_SLCS + ((size_t)l * NSM + b) * 256 : a.out + O_WINS + (((size_t)l * NSM + b) * 256 + 255) * 256);
    dst[g * 64 + lane] = o; dst[128 + g * 64 + lane] = vv;
  }
  if (tid < 24) a.sgates[(size_t)b * 24 + tid] = fsigmoid(pr[C_GATE + tid]);
  float yv = 0.f;
  if (tid < 256) {
    const int c = tid;
    const float glu = pr[C_AVAL + c] * fsigmoid(pr[C_AGATE + c]);
    const float* st = a.state_conv_l + (size_t)b * 30 * 256 + c;
    float* cso = a.out + O_CONVS + ((size_t)l * NSM + b) * 30 * 256 + c;
    float acc = a.b_dw[c];
#pragma unroll
    for (int k = 0; k < 30; ++k) { const float sv = st[k * 256]; acc = fmaf(a.w_dw[k * 256 + c], sv, acc); if (k >= 1) cso[(k - 1) * 256] = sv; }
    acc = fmaf(a.w_dw[30 * 256 + c], glu, acc);
    cso[29 * 256] = glu;
    yv = acc;
  } else {
    const int ch = tid - 256, g = ch >> 6, wn = 2 << g;
    const float cur = pr[C_BIN + ch];
    const float* st = a.state_pool_l + (size_t)b * 15 * 256 + ch;
    float* pso = a.out + O_POOLS + ((size_t)l * NSM + b) * 15 * 256 + ch;
    float total = cur;
#pragma unroll
    for (int j = 1; j < 15; ++j) pso[(j - 1) * 256] = st[j * 256];
    pso[14 * 256] = cur;
    for (int j = 1; j < wn; ++j) total += st[(15 - j) * 256];
    sh[256 + ch] = total / (float)wn - cur;
  }
  { const float s1 = wsum(yv); if (lane == 0) sh[512 + w] = s1; }
  __syncthreads();
  const float mean = (sh[512] + sh[513] + sh[514] + sh[515]) * (1.f / 256.f);
  const float xc = yv - mean;
  { const float s2 = wsum(xc * xc); if (lane == 0) sh[520 + w] = s2; }
  __syncthreads();
  if (tid < 256) {
    const float var = (sh[520] + sh[521] + sh[522] + sh[523]) * (1.f / 256.f);
    const float z = xc * rsqrtf(var + 1e-6f) * a.ln_g[tid] + a.ln_b[tid];
    sh[tid] = fsilu(z);
  }
  __syncthreads();
  {
    const int n = tid & 255, kh = tid >> 8;
    const float* wp = a.w_pw + (size_t)(kh * 128) * 256 + n;
    float o = 0.f;
#pragma unroll 16
    for (int k = 0; k < 128; ++k) o = fmaf(sh[kh * 128 + k], wp[(size_t)k * 256], o);
    sh[528 + kh * 256 + n] = o;
  }
  __syncthreads();
  if (tid < 256) {
    const int n = tid;
    const float o = a.b_pw[n] + sh[528 + n] + sh[528 + 256 + n];
    a.mix_s[(size_t)b * 1024 + n] = f2bf(o * fsilu(pr[C_ZA + n]));
  } else {
    const int ch = tid - 256, g = ch >> 6, e = ch & 63;
    float o = 0.f;
#pragma unroll 16
    for (int c = 0; c < 64; ++c) o = fmaf(sh[256 + g * 64 + c], a.w_pool[(g * 64 + c) * 64 + e], o);
    a.mix_s[(size_t)b * 1024 + 256 + ch] = f2bf(o * a.pool_scale[ch] * fsilu(pr[C_ZB + ch]));
  }
  __syncthreads();
}
__device__ __forceinline__ float dot16(const float (&q)[16], const f32x4& k0, const f32x4& k1, const f32x4& k2, const f32x4& k3) {
  float d = 0.f;
#pragma unroll
  for (int i = 0; i < 4; ++i) { d = fmaf(q[i], k0[i], d); d = fmaf(q[4 + i], k1[i], d); d = fmaf(q[8 + i], k2[i], d); d = fmaf(q[12 + i], k3[i], d); }
  return d;
}
__device__ __forceinline__ void s3_item(const SampArgs& a, LAS unsigned char* lds, int n, int g) {
  const int tid = tidx(), w = tid >> 6, lane = tid & 63;
  const int key_l = lane >> 2, qtr = lane & 3;
  const int ksub = lane >> 4, d4 = lane & 15;
  LAS float* qs = (LAS float*)lds;
  LAS float* sc = qs + 256;
  LAS float* imp = sc + 2048;
  LAS int* sel = (LAS int*)(imp + 64);
  LAS float* red = imp + 128;
  const size_t bg = (size_t)n * 2 + g;
  const float* srow = a.srows + (size_t)n * 768;
  if (tid < 256) qs[tid] = a.sq[(size_t)n * 512 + g * 256 + tid] * 0.125f;
  __syncthreads();
  float q[4][16];
#pragma unroll
  for (int h = 0; h < 4; ++h)
#pragma unroll
    for (int i = 0; i < 16; ++i) q[h][i] = qs[h * 64 + qtr * 16 + i];
  float o_c, o_s, o_w;
#define S3_SOFTMAX(NPL)                                                                              \
  if (w < 4) {                                                                                       \
    float v_[NPL]; float m_ = NEGF;                                                                  \
    _Pragma("unroll") for (int i_ = 0; i_ < NPL; ++i_) { v_[i_] = sc[w * 512 + lane + 64 * i_]; m_ = fmaxf(m_, v_[i_]); } \
    m_ = wmax(m_); float s_ = 0.f;                                                                   \
    _Pragma("unroll") for (int i_ = 0; i_ < NPL; ++i_) { v_[i_] = v_[i_] > -1e29f ? __expf(v_[i_] - m_) : 0.f; s_ += v_[i_]; } \
    s_ = 1.f / fmaxf(wsum(s_), 1e-30f);                                                              \
    _Pragma("unroll") for (int i_ = 0; i_ < NPL; ++i_) sc[w * 512 + lane + 64 * i_] = v_[i_] * s_;   \
  }
#define S3_REDUCE(ACC, OUT)                                                                          \
  _Pragma("unroll") for (int h_ = 0; h_ < 4; ++h_) _Pragma("unroll") for (int e_ = 0; e_ < 4; ++e_) { float t_ = ACC[h_][e_]; t_ += __shfl_xor(t_, 16); t_ += __shfl_xor(t_, 32); ACC[h_][e_] = t_; } \
  if (ksub == 0) { _Pragma("unroll") for (int h_ = 0; h_ < 4; ++h_) *(LAS f32x4*)(red + (w * 4 + h_) * 64 + 4 * d4) = (f32x4){ACC[h_][0], ACC[h_][1], ACC[h_][2], ACC[h_][3]}; } \
  __syncthreads();                                                                                   \
  OUT = 0.f;                                                                                         \
  if (tid < 256) { _Pragma("unroll") for (int w_ = 0; w_ < 8; ++w_) OUT += red[w_ * 256 + tid]; }   \
  __syncthreads();
  {
    const int c = 16 * w + key_l;
    const bf16_t* kr = a.kcS + (bg * 128 + c) * 64 + qtr * 16;
    const u32x4 k0 = *(const u32x4*)kr, k1 = *(const u32x4*)(kr + 8);
    const f32x4 f0 = {bflo(k0.x), bfhi(k0.x), bflo(k0.y), bfhi(k0.y)}, f1 = {bflo(k0.z), bfhi(k0.z), bflo(k0.w), bfhi(k0.w)};
    const f32x4 f2 = {bflo(k1.x), bfhi(k1.x), bflo(k1.y), bfhi(k1.y)}, f3 = {bflo(k1.z), bfhi(k1.z), bflo(k1.w), bfhi(k1.w)};
#pragma unroll
    for (int h = 0; h < 4; ++h) {
      float d = dot16(q[h], f0, f1, f2, f3);
      d += __shfl_xor(d, 1); d += __shfl_xor(d, 2);
      if (qtr == 0) sc[h * 512 + c] = c < 127 ? d : NEGF;
    }
  }
  __syncthreads();
  S3_SOFTMAX(2)
  __syncthreads();
  if (tid < 33) {
    const int s = tid, lo = max(0, 4 * s - 1), hi = min(126, 4 * s + 3);
    float v = 0.f;
    for (int rr = 0; rr < 4; ++rr) for (int c = lo; c <= hi; ++c) v += sc[rr * 512 + c];
    const bool forced = (s == 0) || (s == 32) || (s == 31);
    imp[s] = forced ? 1e4f : v;
  }
  {
    float acc[4][4];
#pragma unroll
    for (int h = 0; h < 4; ++h)
#pragma unroll
      for (int e = 0; e < 4; ++e) acc[h][e] = 0.f;
#pragma unroll
    for (int it = 0; it < 4; ++it) {
      const int c = 16 * w + 4 * it + ksub;
      const u32x2 vv = *(const u32x2*)(a.vcST + (bg * 128 + c) * 64 + 4 * d4);
      const float v0 = bflo(vv.x), v1 = bfhi(vv.x), v2 = bflo(vv.y), v3 = bfhi(vv.y);
#pragma unroll
      for (int h = 0; h < 4; ++h) { const float p = sc[h * 512 + c]; acc[h][0] = fmaf(p, v0, acc[h][0]); acc[h][1] = fmaf(p, v1, acc[h][1]); acc[h][2] = fmaf(p, v2, acc[h][2]); acc[h][3] = fmaf(p, v3, acc[h][3]); }
    }
    S3_REDUCE(acc, o_c)
  }
  if (tid == 0) {
    unsigned long long taken = 0ull;
    for (int k = 0; k < 8; ++k) {
      int best = -1; float bv = -3e38f;
      for (int s = 0; s < 33; ++s) if (!((taken >> s) & 1ull) && imp[s] > bv) { bv = imp[s]; best = s; }
      taken |= 1ull << best; sel[k] = best;
    }
  }
  __syncthreads();
  const int blk = sel[w];
  const float* sl_base;
  if (blk < 32) sl_base = a.cache_slc_l + ((size_t)a.page_table[n * 16 + (blk >> 1)] * 128 + (blk & 1) * 64) * 256 + g * 64;
  else sl_base = srow + 256 + g * 64;
  {
    f32x4 kk[4][4];
#pragma unroll
    for (int ps = 0; ps < 4; ++ps) {
      const int j = 16 * ps + key_l;
      const bool valid = blk < 32 || j == 0;
      const float* kr = sl_base + (size_t)(valid ? j : 0) * 256 + qtr * 16;
#pragma unroll
      for (int i = 0; i < 4; ++i) kk[ps][i] = *(const f32x4*)(kr + 4 * i);
    }
#pragma unroll
    for (int ps = 0; ps < 4; ++ps) {
      const int j = 16 * ps + key_l;
      const bool valid = blk < 32 || j == 0;
#pragma unroll
      for (int h = 0; h < 4; ++h) {
        float d = dot16(q[h], kk[ps][0], kk[ps][1], kk[ps][2], kk[ps][3]);
        d += __shfl_xor(d, 1); d += __shfl_xor(d, 2);
        if (qtr == 0) sc[h * 512 + w * 64 + j] = valid ? d : NEGF;
      }
    }
  }
  __syncthreads();
  S3_SOFTMAX(8)
  __syncthreads();
  {
    float acc[4][4];
#pragma unroll
    for (int h = 0; h < 4; ++h)
#pragma unroll
      for (int e = 0; e < 4; ++e) acc[h][e] = 0.f;
    f32x4 vv[16];
#pragma unroll
    for (int it = 0; it < 16; ++it) {
      const int j = 4 * it + ksub;
      const bool valid = blk < 32 || j == 0;
      vv[it] = *(const f32x4*)(sl_base + (size_t)(valid ? j : 0) * 256 + 128 + 4 * d4);
    }
#pragma unroll
    for (int it = 0; it < 16; ++it) {
      const int j = 4 * it + ksub;
#pragma unroll
      for (int h = 0; h < 4; ++h) { const float p = sc[h * 512 + w * 64 + j];
#pragma unroll
        for (int e = 0; e < 4; ++e) acc[h][e] = fmaf(p, vv[it][e], acc[h][e]); }
    }
    S3_REDUCE(acc, o_s)
  }
  const float* wbase = a.cache_win_l + ((size_t)n * 256 + 1) * 256 + g * 64;
  {
    f32x4 kk[2][4];
#pragma unroll
    for (int ps = 0; ps < 2; ++ps) {
      const int i = 32 * w + 16 * ps + key_l;
      const float* kr = (i < 255 ? wbase + (size_t)i * 256 : srow + 512 + g * 64) + qtr * 16;
#pragma unroll
      for (int e = 0; e < 4; ++e) kk[ps][e] = *(const f32x4*)(kr + 4 * e);
    }
#pragma unroll
    for (int ps = 0; ps < 2; ++ps) {
      const int i = 32 * w + 16 * ps + key_l;
#pragma unroll
      for (int h = 0; h < 4; ++h) {
        float d = dot16(q[h], kk[ps][0], kk[ps][1], kk[ps][2], kk[ps][3]);
        d += __shfl_xor(d, 1); d += __shfl_xor(d, 2);
        if (qtr == 0) sc[h * 512 + i] = d;
      }
    }
  }
  __syncthreads();
  S3_SOFTMAX(4)
  __syncthreads();
  {
    float acc[4][4];
#pragma unroll
    for (int h = 0; h < 4; ++h)
#pragma unroll
      for (int e = 0; e < 4; ++e) acc[h][e] = 0.f;
    f32x4 vv[8];
#pragma unroll
    for (int it = 0; it < 8; ++it) {
      const int i = 32 * w + 4 * it + ksub;
      vv[it] = *(const f32x4*)((i < 255 ? wbase + (size_t)i * 256 : srow + 512 + g * 64) + 128 + 4 * d4);
    }
#pragma unroll
    for (int it = 0; it < 8; ++it) {
      const int i = 32 * w + 4 * it + ksub;
#pragma unroll
      for (int h = 0; h < 4; ++h) { const float p = sc[h * 512 + i];
#pragma unroll
        for (int e = 0; e < 4; ++e) acc[h][e] = fmaf(p, vv[it][e], acc[h][e]); }
    }
    S3_REDUCE(acc, o_w)
  }
  if (tid < 256) {
    const int h = g * 4 + (tid >> 6), d = tid & 63;
    const float* gt = a.sgates + (size_t)n * 24;
    const float o = gt[h] * o_c + gt[8 + h] * o_s + gt[16 + h] * o_w;
    a.mix_s[(size_t)n * 1024 + 512 + h * 64 + d] = f2bf(o * fsilu(a.sproj[(size_t)n * 3104 + C_ZC + h * 64 + d]));
  }
  __syncthreads();
#undef S3_SOFTMAX
#undef S3_REDUCE
}

#ifdef MULTI_LAUNCH
__global__ void __launch_bounds__(512, 2) k_s1(const bf16_t* xb_s, const float* ssq_s, const bf16_t* WinT, float* sproj) {
  extern __shared__ __attribute__((aligned(16))) unsigned char shm[];
  for (int u = blockIdx.x; u < 194; u += gridDim.x) s1_unit((LAS unsigned char*)shm, xb_s, ssq_s, WinT, sproj, u);
}
#endif
#ifdef MULTI_LAUNCH
__global__ void __launch_bounds__(512, 2) k_s2(SampArgs a) {
  extern __shared__ __attribute__((aligned(16))) unsigned char shm[];
  for (int b = blockIdx.x; b < NSM; b += gridDim.x) s2_item(a, (LAS unsigned char*)shm, b);
}
#endif
struct CmpSArgs { const float* cache_cmp_l; const int* page_table; const bf16_t *W1T, *W2T; const float* cbias; bf16_t *kcS, *vcST; };
#ifdef MULTI_LAUNCH
__global__ void __launch_bounds__(512, 2) k_cmps(CmpSArgs a) {
  extern __shared__ __attribute__((aligned(16))) unsigned char shm[];
  for (int it = blockIdx.x; it < 512; it += gridDim.x) {
    const int n = it >> 2, g = (it >> 1) & 1, kv = it & 1;
    CmpSrc src{a.cache_cmp_l, a.page_table + n * 16};
    compress_item<true>((LAS unsigned char*)shm, src, g, kv, a.W1T + (size_t)kv * 128 * 1024, a.W2T + (size_t)kv * 4096, a.cbias + kv * 64,
                  a.kcS + ((size_t)n * 2 + g) * 128 * 64, a.vcST + ((size_t)n * 2 + g) * 64 * 128);
  }
}
#endif
#ifdef MULTI_LAUNCH
__global__ void __launch_bounds__(512, 2) k_s3(SampArgs a) {
  extern __shared__ __attribute__((aligned(16))) unsigned char shm[];
  for (int it = blockIdx.x; it < 256; it += gridDim.x) s3_item(a, (LAS unsigned char*)shm, it >> 1, it & 1);
}
#endif
#ifdef MULTI_LAUNCH
template <bool LAST> __global__ void __launch_bounds__(512, 2) k_s4(const bf16_t* mix_s, const bf16_t* WoutT, const float* xs, float* xs_out, bf16_t* xb_s, float* ssq_s) {
  extern __shared__ __attribute__((aligned(16))) unsigned char shm[];
  for (int u = blockIdx.x; u < 16; u += gridDim.x) s4_unit<LAST>((LAS unsigned char*)shm, mix_s, WoutT, xs, xs_out, xb_s, ssq_s, u);
}
#endif
__device__ __forceinline__ void wins_copy(const float* cache_win_l, float* out_l, int part, int nparts) {
  const size_t total4 = (size_t)NSM * 255 * 64;
  for (size_t i = (size_t)part * 512 + tidx(); i < total4; i += (size_t)nparts * 512) {
    const size_t n = i / (255 * 64), rem = i % (255 * 64);
    *(f32x4*)(out_l + n * 65536 + rem * 4) = *(const f32x4*)(cache_win_l + n * 65536 + 256 + rem * 4);
  }
}
#ifdef MULTI_LAUNCH
__global__ void __launch_bounds__(512, 2) k_wins(const float* cache_win_l, float* out_l) { wins_copy(cache_win_l, out_l, blockIdx.x, gridDim.x); }
#endif
}
namespace fast {
constexpr size_t al256(size_t x) { return (x + 255) & ~(size_t)255; }
constexpr size_t WS_BAR = 0;
constexpr size_t WS_CS = al256(WS_BAR + XCD_BAR_WORDS * 4);
constexpr size_t WS_SSQ = al256(WS_CS + 2049 * 16 * 4);
constexpr size_t WS_GATES = al256(WS_SSQ + (size_t)NTOK * 16 * 4);
constexpr size_t WS_CBIAS = al256(WS_GATES + (size_t)NPT * 24 * 4);
constexpr size_t WS_SPROJ = al256(WS_CBIAS + 256 * 4);
constexpr size_t WS_SQ = al256(WS_SPROJ + (size_t)NSM * 3104 * 4);
constexpr size_t WS_SROWS = al256(WS_SQ + (size_t)NSM * 512 * 4);
constexpr size_t WS_SGATES = al256(WS_SROWS + (size_t)NSM * 768 * 4);
constexpr size_t WS_X1P = al256(WS_SGATES + (size_t)NSM * 24 * 4);
constexpr size_t WS_X1S = al256(WS_X1P + (size_t)NPT * 1024 * 4);
constexpr size_t WS_XB = al256(WS_X1S + (size_t)NSM * 1024 * 4);
constexpr size_t WS_MIXB = al256(WS_XB + (size_t)NTOK * 1024 * 2);
constexpr size_t WS_QB = al256(WS_MIXB + (size_t)NTOK * 1024 * 2);
constexpr size_t WS_KSB = al256(WS_QB + (size_t)NPT * 512 * 2);
constexpr size_t WS_VST = al256(WS_KSB + (size_t)NPT * 128 * 2);
constexpr size_t WS_KWB = al256(WS_VST + (size_t)NPT * 128 * 2);
constexpr size_t WS_VWT = al256(WS_KWB + (size_t)NPT * 128 * 2);
constexpr size_t WS_KCP = al256(WS_VWT + (size_t)NPT * 128 * 2);
constexpr size_t WS_VCPT = al256(WS_KCP + (size_t)8 * 2 * 128 * 64 * 2);
constexpr size_t WS_SZC = al256(WS_VCPT + (size_t)8 * 2 * 128 * 64 * 2);
constexpr size_t WS_GLUB = al256(WS_SZC + (size_t)NPT * 512 * 2);
constexpr size_t WS_BINB = al256(WS_GLUB + (size_t)NPT * 256 * 2);
constexpr size_t WS_SZA = al256(WS_BINB + (size_t)NPT * 256 * 2);
constexpr size_t WS_SZB = al256(WS_SZA + (size_t)NPT * 256 * 2);
constexpr size_t WS_WINT = al256(WS_SZB + (size_t)NPT * 256 * 2);
constexpr size_t WS_WOUTT = al256(WS_WINT + (size_t)2 * 3104 * 1024 * 2);
constexpr size_t WS_WPWT = al256(WS_WOUTT + (size_t)2 * 1024 * 1024 * 2);
constexpr size_t WS_WPOOLT = al256(WS_WPWT + (size_t)2 * 65536 * 2);
constexpr size_t WS_W1T = al256(WS_WPOOLT + (size_t)2 * 4 * 4096 * 2);
constexpr size_t WS_W2T = al256(WS_W1T + (size_t)2 * 2 * 128 * 1024 * 2);
constexpr size_t WS_KCS = al256(WS_W2T + (size_t)2 * 2 * 4096 * 2);
constexpr size_t WS_VCST = al256(WS_KCS + (size_t)NSM * 2 * 128 * 64 * 2);
constexpr size_t WS_END = al256(WS_VCST + (size_t)NSM * 2 * 128 * 64 * 2);

struct MegaArgsK {
  const float *x_prompt, *x_sample, *state_conv, *state_pool, *cache_win, *cache_cmp, *cache_slc; const int* page_table;
  const float *w_norm, *w_in, *w_out, *w_dw, *b_dw, *ln_g, *ln_b, *w_pw, *b_pw, *w_pool, *pool_scale, *g_q, *g_k, *cmp_pe, *cmp_w1, *cmp_w2;
  float* out;
  unsigned char* ws;
#ifdef PROBE_REP
  int rep[8];
#endif
};
struct MegaArgs {
  const float *x_prompt, *x_sample, *state_conv, *state_pool, *cache_win, *cache_cmp, *cache_slc; const int* page_table;
  const float *w_norm, *w_in, *w_out, *w_dw, *b_dw, *ln_g, *ln_b, *w_pw, *b_pw, *w_pool, *pool_scale, *g_q, *g_k, *cmp_pe, *cmp_w1, *cmp_w2;
  float* out;
  unsigned* bar;
  float *cs, *ssq, *gatesf, *cbias, *sproj, *sq, *srows, *sgates, *x1p, *x1s;
  bf16_t *xb, *mixb, *qb, *ksb, *vsT, *kwb, *vwT, *kcP, *vcPT, *szc, *glub, *binb, *sza, *szb, *WinT, *WoutT, *WpwT, *WpoolT, *W1T, *W2T, *kcS, *vcST;
#ifdef PROBE_REP
  int rep[8];
#endif
};
#ifdef PROBE_REP
#define REP(i) _Pragma("unroll 1") for (int rep_ = 0; rep_ < a.rep[i]; ++rep_)
#else
#define REP(i)
#endif
#ifdef PROBE_REPX
#define REPX(i) _Pragma("unroll 1") for (int repx_ = 0; repx_ < ((PROBE_REPX >> (4 * (i))) & 15); ++repx_)
#else
#define REPX(i)
#endif
__device__ __forceinline__ MegaArgs expand_args(const MegaArgsK& k) {
  MegaArgs a;
  a.x_prompt = k.x_prompt; a.x_sample = k.x_sample; a.state_conv = k.state_conv; a.state_pool = k.state_pool; a.cache_win = k.cache_win; a.cache_cmp = k.cache_cmp; a.cache_slc = k.cache_slc;
  a.page_table = k.page_table; a.w_norm = k.w_norm; a.w_in = k.w_in; a.w_out = k.w_out; a.w_dw = k.w_dw; a.b_dw = k.b_dw; a.ln_g = k.ln_g; a.ln_b = k.ln_b; a.w_pw = k.w_pw; a.b_pw = k.b_pw;
  a.w_pool = k.w_pool; a.pool_scale = k.pool_scale; a.g_q = k.g_q; a.g_k = k.g_k; a.cmp_pe = k.cmp_pe; a.cmp_w1 = k.cmp_w1; a.cmp_w2 = k.cmp_w2; a.out = k.out;
  unsigned char* w = k.ws;
  a.bar = (unsigned*)(w + WS_BAR); a.cs = (float*)(w + WS_CS); a.ssq = (float*)(w + WS_SSQ); a.gatesf = (float*)(w + WS_GATES); a.cbias = (float*)(w + WS_CBIAS);
  a.sproj = (float*)(w + WS_SPROJ); a.sq = (float*)(w + WS_SQ); a.srows = (float*)(w + WS_SROWS); a.sgates = (float*)(w + WS_SGATES); a.x1p = (float*)(w + WS_X1P); a.x1s = (float*)(w + WS_X1S);
  a.xb = (bf16_t*)(w + WS_XB); a.mixb = (bf16_t*)(w + WS_MIXB); a.qb = (bf16_t*)(w + WS_QB); a.ksb = (bf16_t*)(w + WS_KSB); a.vsT = (bf16_t*)(w + WS_VST); a.kwb = (bf16_t*)(w + WS_KWB); a.vwT = (bf16_t*)(w + WS_VWT);
  a.kcP = (bf16_t*)(w + WS_KCP); a.vcPT = (bf16_t*)(w + WS_VCPT); a.szc = (bf16_t*)(w + WS_SZC); a.glub = (bf16_t*)(w + WS_GLUB); a.binb = (bf16_t*)(w + WS_BINB); a.sza = (bf16_t*)(w + WS_SZA); a.szb = (bf16_t*)(w + WS_SZB);
  a.WinT = (bf16_t*)(w + WS_WINT); a.WoutT = (bf16_t*)(w + WS_WOUTT); a.WpwT = (bf16_t*)(w + WS_WPWT); a.WpoolT = (bf16_t*)(w + WS_WPOOLT); a.W1T = (bf16_t*)(w + WS_W1T); a.W2T = (bf16_t*)(w + WS_W2T);
  a.kcS = (bf16_t*)(w + WS_KCS); a.vcST = (bf16_t*)(w + WS_VCST);
#ifdef PROBE_REP
  for (int i = 0; i < 8; ++i) a.rep[i] = k.rep[i];
#endif
  return a;
}

template <int MODE>
__device__ __forceinline__ void transpose_tile(const float* src, int ld_src, const float* scale, bf16_t* dst, int N, int K, int n0, int k0, LAS float* t) {
  const int tid = tidx();
  for (int i = tid; i < 1024; i += 512) {
    const int k = i >> 4, n = (i & 15) * 4;
    const int col = MODE == 1 ? win_logical_col(n0 + n) : (n0 + n);
    f32x4 v = {0.f, 0.f, 0.f, 0.f};
    if (n0 + n < N && col >= 0) { v = *(const f32x4*)(src + (size_t)(k0 + k) * ld_src + col); if (scale) v = v * scale[k0 + k]; }
    t[k * 65 + n] = v[0]; t[k * 65 + n + 1] = v[1]; t[k * 65 + n + 2] = v[2]; t[k * 65 + n + 3] = v[3];
  }
  __syncthreads();
  for (int i = tid; i < 512; i += 512) {
    const int n = i >> 3, k = (i & 7) * 8;
    if (n0 + n < N) {
      u32x4 pk;
      pk.x = cvt_pk_bf16(t[k * 65 + n], t[(k + 1) * 65 + n]); pk.y = cvt_pk_bf16(t[(k + 2) * 65 + n], t[(k + 3) * 65 + n]);
      pk.z = cvt_pk_bf16(t[(k + 4) * 65 + n], t[(k + 5) * 65 + n]); pk.w = cvt_pk_bf16(t[(k + 6) * 65 + n], t[(k + 7) * 65 + n]);
      *(u32x4*)(dst + (size_t)(n0 + n) * K + k0 + k) = pk;
    }
  }
  __syncthreads();
}

__device__ __forceinline__ void phase0(const MegaArgs& a, LAS unsigned char* lds) {
  const int G = gridDim.x, wg = blockIdx.x, tid = tidx();
  LAS float* t = (LAS float*)lds;
  for (int it = wg; it < 2 * 1126; it += G) {
    const int l = it / 1126; int r = it % 1126;
    if (r < 784) { transpose_tile<1>(a.w_in + (size_t)l * 1024 * D_IN, D_IN, a.w_norm + l * 1024, a.WinT + (size_t)l * 3104 * 1024, 3104, 1024, (r % 49) * 64, (r / 49) * 64, t); continue; }
    r -= 784;
    if (r < 256) { transpose_tile<0>(a.w_out + (size_t)l * 1024 * 1024, 1024, nullptr, a.WoutT + (size_t)l * 1024 * 1024, 1024, 1024, (r & 15) * 64, (r >> 4) * 64, t); continue; }
    r -= 256;
    if (r < 16) { transpose_tile<0>(a.w_pw + (size_t)l * 65536, 256, nullptr, a.WpwT + (size_t)l * 65536, 256, 256, (r & 3) * 64, (r >> 2) * 64, t); continue; }
    r -= 16;
    if (r < 4) { transpose_tile<0>(a.w_pool + (size_t)(l * 4 + r) * 4096, 64, nullptr, a.WpoolT + (size_t)(l * 4 + r) * 4096, 64, 64, 0, 0, t); continue; }
    r -= 4;
    if (r < 64) { const int kv = r >> 5, half = (r >> 4) & 1, kt = r & 15;
      transpose_tile<0>(a.cmp_w1 + ((size_t)(l * 2 + kv) * 2048 + half * 1024) * 64, 64, nullptr, a.W1T + ((size_t)(l * 2 + kv) * 128 + half * 64) * 1024, 64, 1024, 0, kt * 64, t); continue; }
    r -= 64;
    transpose_tile<0>(a.cmp_w2 + (size_t)(l * 2 + r) * 4096, 64, nullptr, a.W2T + (size_t)(l * 2 + r) * 4096, 64, 64, 0, 0, t);
  }
  for (int lk = G - 1 - wg; lk >= 0 && lk < 4; lk += G) {
    const int e = tid & 63, part = tid >> 6;
    const float* pp = a.cmp_pe + (size_t)lk * 2048 + part * 256; const float* ww = a.cmp_w1 + ((size_t)lk * 2048 + part * 256) * 64 + e;
    float acc = 0.f;
    for (int k = 0; k < 256; ++k) acc = fmaf(pp[k], ww[(size_t)k * 64], acc);
    t[part * 64 + e] = acc;
    __syncthreads();
    if (tid < 64) { float s = 0.f; for (int p2 = 0; p2 < 8; ++p2) s += t[p2 * 64 + tid]; a.cbias[lk * 64 + tid] = s; }
    __syncthreads();
  }
  for (int i = wg * 512 + tid; i < 2049 * 8; i += G * 512) {
    const int pos = i >> 3, j = i & 7;
    const double ang = (double)pos * pow(500000.0, -(double)j / 8.0);
    a.cs[i * 2] = (float)cos(ang); a.cs[i * 2 + 1] = (float)sin(ang);
  }
  for (int row = wg * 8 + (tid >> 6); row < NTOK; row += G * 8) {
    const int lane = tid & 63;
    const float* x = row < NPT ? a.x_prompt + (size_t)row * 1024 : a.x_sample + (size_t)(row - NPT) * 1024;
#pragma unroll
    for (int j = 0; j < 4; ++j) {
      const f32x4 v = *(const f32x4*)(x + j * 256 + lane * 4);
      u32x2 pk; pk.x = cvt_pk_bf16(v[0], v[1]); pk.y = cvt_pk_bf16(v[2], v[3]);
      *(u32x2*)(a.xb + (size_t)row * 1024 + j * 256 + lane * 4) = pk;
      float ss = v[0] * v[0] + v[1] * v[1] + v[2] * v[2] + v[3] * v[3];
      ss += __shfl_xor(ss, 1); ss += __shfl_xor(ss, 2); ss += __shfl_xor(ss, 4); ss += __shfl_xor(ss, 8);
      if ((lane & 15) == 0) a.ssq[(size_t)row * 16 + j * 4 + (lane >> 4)] = ss;
    }
  }
}

#ifdef PROBE_TS
#ifndef PROBE_TS_LO
#define PROBE_TS_LO 0
#define PROBE_TS_HI 100000
#endif
#define TS_MARK(i) do { if (threadIdx.x == 0 && (int)blockIdx.x >= PROBE_TS_LO && (int)blockIdx.x < PROBE_TS_HI) { const unsigned long long now_ = __builtin_amdgcn_s_memrealtime(); if ((i) == PROBE_TS_SEL) ts_begin = now_; \
    if ((i) == PROBE_TS_SEL + 1) { const unsigned dt_ = (unsigned)(now_ - ts_begin); if (PROBE_TS_MIN) atomicMin(ts_word, dt_); else atomicMax(ts_word, dt_); } } } while (0)
#else
#define TS_MARK(i)
#endif
__global__ void __launch_bounds__(512, 2) k_mega(MegaArgsK ka) {
  const MegaArgs a = expand_args(ka);
#ifdef PROBE_TS
  unsigned long long ts_begin = 0ull; unsigned* ts_word = a.bar + 64;
  if (PROBE_TS_MIN && blockIdx.x == 0 && threadIdx.x == 0) atomicExch(ts_word, 0x7fffffffu);
#endif
  extern __shared__ __attribute__((aligned(16))) unsigned char shm[];
  LAS unsigned char* lds = (LAS unsigned char*)shm;
  volatile LAS unsigned* xbw = (volatile LAS unsigned*)(lds + LDS_BYTES - 16);
  if (tidx() == 0) { xbw[0] = 0u; xbw[1] = 0u; xbw[2] = 0u; xbw[3] = 0u; }
  __syncthreads();
  (void)xcd_barrier_post(a.bar, xbw);
#define GRID_BARRIER() do { XcdBarrier b_; b_.bar = a.bar; b_.x = xb_xcc_id(); b_.st = xbw; xcd_barrier(b_); } while (0)
  const int G = gridDim.x, wg = blockIdx.x;

  TS_MARK(0);
  REP(0) phase0(a, lds);
  TS_MARK(1);
  GRID_BARRIER();

#pragma unroll 1
  for (int l = 0; l < 2; ++l) {
    const float* xp = l == 0 ? a.x_prompt : a.x1p;
    const float* xs = l == 0 ? a.x_sample : a.x1s;
    float* xp_out = l == 0 ? a.x1p : a.out + O_YP;
    float* xs_out = l == 0 ? a.x1s : a.out + O_YS;
    const bf16_t* WinT_l = a.WinT + (size_t)l * 3104 * 1024;
    const bf16_t* W1T_l = a.W1T + (size_t)l * 2 * 128 * 1024;
    const bf16_t* W2T_l = a.W2T + (size_t)l * 2 * 4096;
    const float* cbias_l = a.cbias + l * 128;
    TS_MARK(2 + 10 * l);
    REPX(0) {
    {
      PhaseAArgs aa;
      aa.epi.l = l; aa.epi.pad_ = 0; aa.epi.ssq = a.ssq; aa.epi.g_q = a.g_q + l * 64; aa.epi.g_k = a.g_k + l * 192; aa.epi.cs = a.cs;
      aa.epi.glu = a.glub; aa.epi.bin = a.binb; aa.epi.sza = a.sza; aa.epi.szb = a.szb; aa.epi.szc = a.szc; aa.epi.qb = a.qb;
      aa.epi.ks = a.ksb; aa.epi.vsT = a.vsT; aa.epi.kw = a.kwb; aa.epi.vwT = a.vwT; aa.epi.out = a.out;
      aa.xb = a.xb; aa.WinT = WinT_l;
      REP(1) phaseA(lds, aa);
    }
    TS_MARK(3 + 10 * l);
    for (int u = wg; u < 194; u += G) s1_unit(lds, a.xb + (size_t)NPT * 1024, a.ssq + (size_t)NPT * 16, WinT_l, a.sproj, u);
    REP(7) for (int it = wg; it < 512; it += G) {
      const int n = it >> 2, g = (it >> 1) & 1, kv = it & 1;
      CmpSrc src{a.cache_cmp + (size_t)l * N_PHYS * 128 * 256, a.page_table + n * 16};
      compress_item<true>(lds, src, g, kv, W1T_l + (size_t)kv * 128 * 1024, W2T_l + (size_t)kv * 4096, cbias_l + kv * 64,
                    a.kcS + ((size_t)n * 2 + g) * 128 * 64, a.vcST + ((size_t)n * 2 + g) * 64 * 128);
    }
    }
    TS_MARK(4 + 10 * l);
    GRID_BARRIER();
    TS_MARK(5 + 10 * l);
    SampArgs sa;
    sa.l = l; sa.pad_ = 0; sa.sproj = a.sproj; sa.g_q = a.g_q + l * 64; sa.g_k = a.g_k + l * 192; sa.cs = a.cs;
    sa.state_conv_l = a.state_conv + (size_t)l * NSM * 30 * 256; sa.state_pool_l = a.state_pool + (size_t)l * NSM * 15 * 256;
    sa.w_dw = a.w_dw + l * 31 * 256; sa.b_dw = a.b_dw + l * 256; sa.ln_g = a.ln_g + l * 256; sa.ln_b = a.ln_b + l * 256; sa.w_pw = a.w_pw + (size_t)l * 65536; sa.b_pw = a.b_pw + l * 256;
    sa.w_pool = a.w_pool + (size_t)l * 4 * 4096; sa.pool_scale = a.pool_scale + l * 256;
    sa.cache_slc_l = a.cache_slc + (size_t)l * N_PHYS * 128 * 256; sa.cache_win_l = a.cache_win + (size_t)l * NSM * 65536; sa.page_table = a.page_table;
    sa.kcS = a.kcS; sa.vcST = a.vcST; sa.sq = a.sq; sa.srows = a.srows; sa.sgates = a.sgates; sa.mix_s = a.mixb + (size_t)NPT * 1024; sa.out = a.out;
    REPX(1) {
    {
      PhaseBArgs ba;
      ba.glu = a.glub; ba.bin = a.binb; ba.sza = a.sza; ba.szb = a.szb; ba.xb = a.xb; ba.ssq = a.ssq;
      ba.WpwT = a.WpwT + (size_t)l * 65536; ba.WpoolT = a.WpoolT + (size_t)l * 4 * 4096; ba.WgT = WinT_l + (size_t)3072 * 1024;
      ba.W1T = W1T_l; ba.W2T = W2T_l; ba.cbias = cbias_l;
      ba.w_dw = sa.w_dw; ba.b_dw = sa.b_dw; ba.ln_g = sa.ln_g; ba.ln_b = sa.ln_b; ba.b_pw = sa.b_pw; ba.pool_scale = sa.pool_scale;
      ba.cmp_rows_p = a.out + O_CMPP + (size_t)l * NPT * 256;
      ba.mixb = a.mixb; ba.kcP = a.kcP; ba.vcPT = a.vcPT; ba.gates = a.gatesf;
#ifdef PROBE_REP
      { const int rb[4] = {PROBE_REPB}; for (int i = 0; i < 4; ++i) ba.repb[i] = rb[i]; }
#endif
      REP(3) phaseB(lds, ba);
    }
    if (G == 256) {
      const int b = wg >= 160 ? wg - 160 : (wg >= 32 && wg < 64 ? 96 + wg - 32 : -1);
      if (b >= 0) { REP(2) s2_item(sa, lds, b); }
    } else {
      for (int b = wg; b < NSM; b += G) s2_item(sa, lds, b);
    }
    }
    TS_MARK(6 + 10 * l);
    GRID_BARRIER();
    TS_MARK(7 + 10 * l);
    REPX(2) {
    {
      PhaseCArgs ca{a.qb, a.ksb, a.vsT, a.kwb, a.vwT, a.kcP, a.vcPT, a.szc, a.gatesf, a.mixb, a.g_k + l * 192};
#ifdef PROBE_REP
      ca.repc[0] = a.rep[2]; ca.repc[1] = 0;
#endif
      REP(4) phaseC(lds, ca);
    }
    TS_MARK(8 + 10 * l);
    REP(5) for (int it = wg; it < 256; it += G) s3_item(sa, lds, it >> 1, it & 1);
    }
    TS_MARK(9 + 10 * l);
    GRID_BARRIER();
    TS_MARK(10 + 10 * l);
    REPX(3) {
    {
      PhaseDArgs da{a.mixb, a.WoutT + (size_t)l * 1024 * 1024, xp, xp_out, a.xb, a.ssq};
      REP(6) { if (l == 0) phaseD<false>(lds, da); else phaseD<true>(lds, da); }
    }
    if (G > 16 && wg >= 16) wins_copy(a.cache_win + (size_t)l * NSM * 65536, a.out + O_WINS + (size_t)l * NSM * 65536, wg - 16, G - 16);
    else if (G <= 16) wins_copy(a.cache_win + (size_t)l * NSM * 65536, a.out + O_WINS + (size_t)l * NSM * 65536, wg, G);
    if (l == 0) { for (int u = wg; u < 16; u += G) s4_unit<false>(lds, a.mixb + (size_t)NPT * 1024, a.WoutT + (size_t)l * 1024 * 1024, xs, xs_out, a.xb + (size_t)NPT * 1024, a.ssq + (size_t)NPT * 16, u); }
    else { for (int u = wg; u < 16; u += G) s4_unit<true>(lds, a.mixb + (size_t)NPT * 1024, a.WoutT + (size_t)l * 1024 * 1024, xs, xs_out, a.xb + (size_t)NPT * 1024, a.ssq + (size_t)NPT * 16, u); }
    }
    TS_MARK(11 + 10 * l);
    if (l == 0) GRID_BARRIER();
  }
#ifdef PROBE_TS
  GRID_BARRIER();
  if (blockIdx.x == 0 && threadIdx.x == 0) {
    const unsigned v = __hip_atomic_load(ts_word, __ATOMIC_RELAXED, __HIP_MEMORY_SCOPE_AGENT);
    const unsigned long long t0 = __builtin_amdgcn_s_memrealtime();
    while (__builtin_amdgcn_s_memrealtime() - t0 < (unsigned long long)v * PROBE_TS_K) __builtin_amdgcn_s_sleep(8);
  }
#endif
}
}
extern "C" void kernel_launch(void* const* d_in, const int* in_sizes, int n_in, void* d_out, int out_size, void* d_ws, size_t ws_size, hipStream_t stream) {
  using fast::bf16_t;
  static int grid = 0;
  if (grid == 0) {
    int dev = 0, cus = 0, per_cu = 0;
    (void)hipGetDevice(&dev);
    (void)hipDeviceGetAttribute(&cus, hipDeviceAttributeMultiprocessorCount, dev);
    (void)hipFuncSetAttribute((const void*)fast::k_mega, hipFuncAttributeMaxDynamicSharedMemorySize, fast::LDS_BYTES);
    if (hipOccupancyMaxActiveBlocksPerMultiprocessor(&per_cu, (const void*)fast::k_mega, 512, fast::LDS_BYTES) != hipSuccess || per_cu < 1) per_cu = 1;
    (void)hipGetLastError();
    grid = cus > 0 ? cus : 256;
  }
  fast::MegaArgsK a{};
  a.x_prompt = (const float*)d_in[0]; a.x_sample = (const float*)d_in[1]; a.state_conv = (const float*)d_in[2]; a.state_pool = (const float*)d_in[3];
  a.cache_win = (const float*)d_in[4]; a.cache_cmp = (const float*)d_in[5]; a.cache_slc = (const float*)d_in[6]; a.page_table = (const int*)d_in[7];
  a.w_norm = (const float*)d_in[8]; a.w_in = (const float*)d_in[9]; a.w_out = (const float*)d_in[10]; a.w_dw = (const float*)d_in[11]; a.b_dw = (const float*)d_in[12];
  a.ln_g = (const float*)d_in[13]; a.ln_b = (const float*)d_in[14]; a.w_pw = (const float*)d_in[15]; a.b_pw = (const float*)d_in[16]; a.w_pool = (const float*)d_in[17];
  a.pool_scale = (const float*)d_in[18]; a.g_q = (const float*)d_in[19]; a.g_k = (const float*)d_in[20]; a.cmp_pe = (const float*)d_in[21]; a.cmp_w1 = (const float*)d_in[22]; a.cmp_w2 = (const float*)d_in[23];
  a.out = (float*)d_out;
  a.ws = (unsigned char*)d_ws;
#ifdef PROBE_REP
  { const int rr[8] = {PROBE_REP}; for (int i = 0; i < 8; ++i) a.rep[i] = rr[i]; }
#endif
  (void)hipMemsetAsync((unsigned char*)d_ws + fast::WS_BAR, 0, XCD_BAR_WORDS * 4, stream);
  hipLaunchKernelGGL(fast::k_mega, dim3(grid), dim3(512), fast::LDS_BYTES, stream, a);
}
```

```cpp
#include <hip/hip_runtime.h>
#include <stdint.h>
#include <stdio.h>
__device__ __forceinline__ int tidx() { int t = threadIdx.x; asm volatile("" : "+v"(t)); return t; }

constexpr int NPT = 16384, NSM = 128, NTOK = NPT + NSM, SEQ = 2048;
constexpr int D_IN = 3096;
constexpr int C_AVAL = 0, C_AGATE = 256, C_ZA = 512, C_BIN = 768, C_ZB = 1024, C_Q = 1280, C_KV = 1792, C_GATE = 2560, C_ZC = 2584;
constexpr int N_PHYS = 2560;
constexpr float NEGF = -1e30f;

constexpr size_t O_YP = 0;
constexpr size_t O_YS = O_YP + (size_t)NPT * 1024;
constexpr size_t O_CONVP = O_YS + (size_t)NSM * 1024;
constexpr size_t O_POOLP = O_CONVP + 2ull * 8 * 30 * 256;
constexpr size_t O_WINP = O_POOLP + 2ull * 8 * 15 * 256;
constexpr size_t O_CMPP = O_WINP + 2ull * 8 * 256 * 256;
constexpr size_t O_SLCP = O_CMPP + 2ull * 8 * 2048 * 256;
constexpr size_t O_CONVS = O_SLCP + 2ull * 8 * 2048 * 256;
constexpr size_t O_POOLS = O_CONVS + 2ull * 128 * 30 * 256;
constexpr size_t O_WINS = O_POOLS + 2ull * 128 * 15 * 256;
constexpr size_t O_CMPS = O_WINS + 2ull * 128 * 256 * 256;
constexpr size_t O_SLCS = O_CMPS + 2ull * 128 * 256;
constexpr size_t O_END = O_SLCS + 2ull * 128 * 256;


namespace pg8 {
#define PG8_LAS __attribute__((address_space(3)))
typedef unsigned short bf16_t;
typedef short bf16x8 __attribute__((ext_vector_type(8)));
typedef float f32x4 __attribute__((ext_vector_type(4)));
typedef unsigned u32x4 __attribute__((ext_vector_type(4)));
constexpr int BM = 256, BK = 64, HALF = 128, HTB = HALF * BK * 2  , STAGE_BYTES = 8 * HTB, NXCD = 8, WGM = 8;

__host__ __device__ __forceinline__ int lds_byte(int r, int c) { const int st = (r >> 4) * 2 + (c >> 5), rr = r & 15, cc = c & 31, ob = rr * 64 + cc * 2; return st * 1024 + (ob ^ (((ob >> 9) & 1) << 5)); }
__host__ __device__ __forceinline__ void stage_rc(int b, int& R, int& C) { const int st = b / 1024, sb = b % 1024, swz = sb ^ (((sb >> 9) & 1) << 5); R = (st >> 1) * 16 + swz / 64; C = (st & 1) * 32 + (swz % 64) / 2; }
__host__ __device__ __forceinline__ int perm32(int rho) { const int n = rho >> 4, i = rho & 15; return 8 * (i >> 2) + 4 * n + (i & 3); }

struct Unit { int pm, pn; };
struct Gemm { const bf16_t* A; const bf16_t* Bt; int M, N, K; };

struct StaticOrder {
    int nM, nN, nwg, G, c;
    __host__ __device__ void init(int M, int N, int G_, int c_) { nM = M / BM; nN = N / BM; nwg = nM * nN; G = G_; c = c_; }
    __host__ __device__ bool next(int i, Unit& u) const {
        const long L = (long)i * G + c; if (L >= nwg) return false;
        int wgid = (int)L; { const int q = nwg / NXCD, r = nwg % NXCD, xcd = wgid % NXCD, off = wgid / NXCD; wgid = (xcd < r ? xcd * (q + 1) : r * (q + 1) + (xcd - r) * q) + off; }
        const int nig = WGM * nN, gid = wgid / nig, fm = gid * WGM, gsz = (nM - fm) < WGM ? (nM - fm) : WGM;
        u.pm = fm + ((wgid % nig) % gsz); u.pn = (wgid % nig) / gsz; return true;
    }
    __device__ __forceinline__ void a_ready(const Unit&) const {}
    __device__ __forceinline__ void done(const Unit&) const {}
};
__device__ __forceinline__ unsigned cvt_pk_bf16(float lo, float hi) { unsigned r; asm volatile("v_cvt_pk_bf16_f32 %0, %1, %2" : "=v"(r) : "v"(lo), "v"(hi)); return r; }

template <class Epi, class Sched, bool STAMP = false>
__device__ __forceinline__ void gemm_phase(PG8_LAS unsigned char* lds, const Gemm g, const Sched& S, const Epi& E, unsigned long long* stamps) {
    const int tid = tidx(), wid = __builtin_amdgcn_readfirstlane(tid >> 6), lane = tid & 63, wr = wid >> 2, wc = wid & 3, fr = lane & 15, fq = lane >> 4;
    const int K = g.K, nt = K / BK;
    int ts_lo = 0, ts_hi = 0, nts = 0; const unsigned long long rt_entry = STAMP ? (unsigned long long)wall_clock64() : 0ull;
#define PG8_STAMP() do { if (STAMP && wid == 0 && nts < 64) { const unsigned long long _c = (unsigned long long)clock64(); \
        ts_lo = (lane == nts) ? (int)(unsigned)_c : ts_lo; ts_hi = (lane == nts) ? (int)(unsigned)(_c >> 32) : ts_hi; ++nts; } } while (0)
    PG8_STAMP();
    unsigned voffA[2], voffB[2];
#pragma unroll
    for (int i = 0; i < 2; ++i) { int R, C; stage_rc(tid * 16 + i * 8192, R, C); const int Rb = Epi::PERM ? ((R & ~31) + perm32(R & 31)) : R;
        voffA[i] = (unsigned)(R * K + C) * 2u; voffB[i] = (unsigned)(Rb * K + C) * 2u; }
    const size_t kstep = (size_t)(BK * 2);
    const size_t hstep = (size_t)HALF * K * 2;
    const size_t tstep = 2 * hstep;
    const unsigned ldsw = (unsigned)wid * 1024u;
    const int aoff = lds_byte(wr * 64 + fr, fq * 8), boff = lds_byte(wc * 32 + fr, fq * 8);
#define PG8_SA(b, h) (((b) * 2 + (h)) * HTB)
#define PG8_SB(b, h) ((4 + (b) * 2 + (h)) * HTB)
#define PG8_STAGE(bufoff, gbase, voff) do { _Pragma("unroll") for (int _i = 0; _i < 2; ++_i) \
        __builtin_amdgcn_global_load_lds((const unsigned*)((const char*)(gbase) + (voff)[_i]), (PG8_LAS unsigned*)(lds + (bufoff) + ldsw + _i * 8192), 16, 0, 0); } while (0)
#define PG8_LDA(dst, b, h) do { _Pragma("unroll") for (int m = 0; m < 4; ++m) _Pragma("unroll") for (int k = 0; k < 2; ++k) dst[m][k] = *(const PG8_LAS bf16x8*)(lds + PG8_SA(b, h) + aoff + m * 2048 + k * 1024); } while (0)
#define PG8_LDB(dst, b, h) do { _Pragma("unroll") for (int n = 0; n < 2; ++n) _Pragma("unroll") for (int k = 0; k < 2; ++k) dst[n][k] = *(const PG8_LAS bf16x8*)(lds + PG8_SB(b, h) + boff + n * 2048 + k * 1024); } while (0)
#define PG8_MMA(ai, bj, At, Bt) do { __builtin_amdgcn_s_setprio(1); _Pragma("unroll") for (int m = 0; m < 4; ++m) _Pragma("unroll") for (int n = 0; n < 2; ++n) _Pragma("unroll") for (int k = 0; k < 2; ++k) \
        acc[ai][bj][m][n] = __builtin_amdgcn_mfma_f32_16x16x32_bf16(Bt[n][k], At[m][k], acc[ai][bj][m][n], 0, 0, 0); __builtin_amdgcn_s_setprio(0); } while (0)
#define PG8_WAIT_V(n) asm volatile("s_waitcnt vmcnt(" #n ")" ::: "memory")
#define PG8_WAIT_L(n) asm volatile("s_waitcnt lgkmcnt(" #n ")" ::: "memory")
#define PG8_BAR __builtin_amdgcn_s_barrier()
#define PG8_SCHED __builtin_amdgcn_sched_barrier(0)
    Unit cur, nxt; int ui = 0;
    if (!S.next(0, cur)) return;
    f32x4 acc[2][2][4][2];
#pragma unroll
    for (int a = 0; a < 2; ++a)
#pragma unroll
        for (int b = 0; b < 2; ++b)
#pragma unroll
            for (int m = 0; m < 4; ++m)
#pragma unroll
                for (int n = 0; n < 2; ++n) acc[a][b][m][n] = (f32x4){0.f, 0.f, 0.f, 0.f};
    bf16x8 At[4][2], B0[2][2], B1[2][2];
    const char* cA = (const char*)g.A + (size_t)cur.pm * tstep; const char* cB = (const char*)g.Bt + (size_t)cur.pn * tstep;
    S.a_ready(cur);
    PG8_STAGE(PG8_SB(0, 0), cB, voffB); PG8_STAGE(PG8_SA(0, 0), cA, voffA); PG8_STAGE(PG8_SB(0, 1), cB + hstep, voffB); PG8_STAGE(PG8_SA(0, 1), cA + hstep, voffA);
    if (wr == 1) PG8_BAR;
    PG8_WAIT_V(4); PG8_BAR;
    PG8_STAGE(PG8_SB(1, 0), cB + kstep, voffB); PG8_STAGE(PG8_SA(1, 0), cA + kstep, voffA); PG8_STAGE(PG8_SB(1, 1), cB + hstep + kstep, voffB);
    PG8_WAIT_V(6); PG8_BAR;
    PG8_STAMP();
    for (;;) {
        const bool has_next = S.next(ui + 1, nxt);
        const char* nA = has_next ? (const char*)g.A + (size_t)nxt.pm * tstep : cA; const char* nB = has_next ? (const char*)g.Bt + (size_t)nxt.pn * tstep : cB;
        for (int t = 0; t < nt; t += 2) {
            const bool last = (t == nt - 2);
            const char* a1 = cA + (size_t)(t + 1) * kstep;
            const char* a2 = last ? nA : cA + (size_t)(t + 2) * kstep; const char* b2 = last ? nB : cB + (size_t)(t + 2) * kstep;
            const char* a3 = a2 + kstep; const char* b3 = b2 + kstep;
            if (last && has_next) S.a_ready(nxt);
            PG8_LDB(B0, 0, 0); PG8_SCHED; PG8_LDA(At, 0, 0); PG8_STAGE(PG8_SA(1, 1), a1 + hstep, voffA);
            PG8_WAIT_L(8); PG8_BAR; PG8_WAIT_L(0); PG8_MMA(0, 0, At, B0); PG8_BAR; PG8_SCHED;
            PG8_LDB(B1, 0, 1); PG8_STAGE(PG8_SB(0, 0), b2, voffB);
            PG8_BAR; PG8_WAIT_L(0); PG8_MMA(0, 1, At, B1); PG8_BAR;
            PG8_LDA(At, 0, 1); PG8_STAGE(PG8_SA(0, 0), a2, voffA);
            PG8_BAR; PG8_WAIT_L(0); PG8_MMA(1, 0, At, B0); PG8_BAR; PG8_SCHED;
            PG8_STAGE(PG8_SB(0, 1), b2 + hstep, voffB);
            PG8_WAIT_V(6); PG8_BAR; PG8_MMA(1, 1, At, B1); PG8_BAR;
            PG8_LDB(B0, 1, 0); PG8_SCHED; PG8_LDA(At, 1, 0); PG8_STAGE(PG8_SA(0, 1), a2 + hstep, voffA);
            PG8_WAIT_L(8); PG8_BAR; PG8_WAIT_L(0); PG8_MMA(0, 0, At, B0); PG8_BAR; PG8_SCHED;
            PG8_LDB(B1, 1, 1); PG8_STAGE(PG8_SB(1, 0), b3, voffB);
            PG8_BAR; PG8_WAIT_L(0); PG8_MMA(0, 1, At, B1); PG8_BAR;
            PG8_LDA(At, 1, 1); PG8_STAGE(PG8_SA(1, 0), a3, voffA);
            PG8_BAR; PG8_WAIT_L(0); PG8_MMA(1, 0, At, B0); PG8_BAR; PG8_SCHED;
            PG8_STAGE(PG8_SB(1, 1), b3 + hstep, voffB);
            PG8_WAIT_V(6); PG8_BAR; PG8_MMA(1, 1, At, B1); PG8_BAR;
        }
        PG8_STAMP();
        if constexpr (!Epi::AFTER_DRAIN) { E(acc, cur, wr, wc, fr, fq); S.done(cur); }
        PG8_STAMP();
        if (!has_next) break;
#pragma unroll
        for (int a = 0; a < 2; ++a)
#pragma unroll
            for (int b = 0; b < 2; ++b)
#pragma unroll
                for (int m = 0; m < 4; ++m)
#pragma unroll
                    for (int n = 0; n < 2; ++n) acc[a][b][m][n] = (f32x4){0.f, 0.f, 0.f, 0.f};
        cur = nxt; cA = nA; cB = nB; ++ui;
    }
    PG8_WAIT_V(0);
    if (wr == 0) PG8_BAR;
    PG8_BAR;
    if constexpr (Epi::AFTER_DRAIN) { E.fused(acc, cur, wr, wc, fr, fq, lds, wid, lane); S.done(cur); }
    PG8_STAMP();
    if (STAMP && wid == 0) { stamps[lane] = lane < nts ? (((unsigned long long)(unsigned)ts_hi << 32) | (unsigned)ts_lo) : 0ull;
        if (lane == 62) stamps[62] = rt_entry; if (lane == 63) stamps[63] = (unsigned long long)wall_clock64(); }
#undef PG8_STAMP
#undef PG8_SA
#undef PG8_SB
#undef PG8_STAGE
#undef PG8_LDA
#undef PG8_LDB
#undef PG8_MMA
#undef PG8_WAIT_V
#undef PG8_WAIT_L
#undef PG8_BAR
#undef PG8_SCHED
}
}
#define XB_TMO      128
#define XB_XCNT(j)  (256  + 64 * (j))
#define XB_XSUB(j)  (1280 + 64 * (j))
#define XB_XGEN(j)  (2304 + 64 * (j))
#define XB_TOP      3328
#define XB_TOPGEN   3392
#define XCD_BAR_WORDS 3456
#define XB_SPIN_CAP (1u << 18)
#ifndef LAS
#define LAS __attribute__((address_space(3)))
#endif

__device__ __forceinline__ unsigned xb_ld(unsigned* p)              { return __hip_atomic_load(p, __ATOMIC_RELAXED, __HIP_MEMORY_SCOPE_AGENT); }
__device__ __forceinline__ unsigned xb_add(unsigned* p, unsigned v) { return __hip_atomic_fetch_add(p, v, __ATOMIC_RELAXED, __HIP_MEMORY_SCOPE_AGENT); }
__device__ __forceinline__ unsigned xb_xcc_id() { return (unsigned)__builtin_amdgcn_s_getreg((3 << 11) | 20) & 0xFu; }
#define XB_SPIN(cond, bar) do { unsigned _sp = 0; while (cond) { __builtin_amdgcn_s_sleep(1); \
    if ((++_sp & 255u) == 0u) { if (xb_ld(&(bar)[XB_TMO])) break; if (_sp > XB_SPIN_CAP) { atomicAdd(&(bar)[XB_TMO], 1u); break; } } } } while (0)

struct XcdBarrier {
    unsigned* bar; unsigned x;
    volatile LAS unsigned* st;
};

__device__ __forceinline__ XcdBarrier xcd_barrier_post(unsigned* bar, volatile LAS unsigned* st) {
    XcdBarrier b; b.bar = bar; b.x = xb_xcc_id(); b.st = st;
    if (threadIdx.x == 0) (void)xb_add(&bar[XB_XCNT(b.x)], 1u);
    return b;
}
__device__ __forceinline__ void xcd_barrier_complete(unsigned* bar, unsigned x, unsigned& nloc, unsigned& nx) {
    const unsigned G = gridDim.x * gridDim.y * gridDim.z;
    unsigned sum, cnt, mine, sp = 0u;
    for (;;) {
        sum = 0u; cnt = 0u; mine = 0u;
#pragma unroll
        for (unsigned j = 0; j < 16; ++j) { const unsigned c = xb_ld(&bar[XB_XCNT(j)]); sum += c; cnt += (c > 0u) ? 1u : 0u; mine = (j == x) ? c : mine; }
        if (sum == G) break;
        __builtin_amdgcn_s_sleep(1);
        if ((++sp & 255u) == 0u) { if (xb_ld(&bar[XB_TMO])) break; if (sp > XB_SPIN_CAP) { atomicAdd(&bar[XB_TMO], 1u); break; } }
    }
    nloc = mine > 0u ? mine : 1u; nx = cnt > 0u ? cnt : 1u;
}

__device__ __forceinline__ void xcd_barrier(const XcdBarrier& b) {
    asm volatile("s_waitcnt vmcnt(0)" ::: "memory");
    __syncthreads();
    if (threadIdx.x == 0) {
        unsigned* bar = b.bar;
        __builtin_amdgcn_s_waitcnt(0);
        unsigned nloc = b.st[0], nx = b.st[1];
        if (nloc == 0u) { xcd_barrier_complete(bar, b.x, nloc, nx); b.st[0] = nloc; b.st[1] = nx; }
        const unsigned old = xb_add(&bar[XB_XSUB(b.x)], 1u);
        const unsigned gen = old / nloc;
        if (old + 1u == (gen + 1u) * nloc) {
            __builtin_amdgcn_fence(__ATOMIC_RELEASE, "agent");
            asm volatile("s_waitcnt vmcnt(0)" ::: "memory");
            const unsigned og = xb_add(&bar[XB_TOP], 1u);
            const unsigned tg = og / nx;
            if (og + 1u == (tg + 1u) * nx) xb_add(&bar[XB_TOPGEN], 1u);
            else XB_SPIN(xb_ld(&bar[XB_TOPGEN]) == tg, bar);
            __builtin_amdgcn_fence(__ATOMIC_ACQUIRE, "agent");
            xb_add(&bar[XB_XGEN(b.x)], 1u);
            asm volatile("s_waitcnt vmcnt(0)" ::: "memory");
        } else {
            XB_SPIN(xb_ld(&bar[XB_XGEN(b.x)]) == gen, bar);
            __builtin_amdgcn_fence(__ATOMIC_ACQUIRE, "agent");
            asm volatile("s_waitcnt vmcnt(0)" ::: "memory");
        }
    }
    __syncthreads();
}

namespace fast {
using pg8::bf16_t; using pg8::bf16x8; using pg8::f32x4; using pg8::Unit;
typedef float f32x2_c __attribute__((ext_vector_type(2)));
typedef __bf16 bf16x2_c __attribute__((ext_vector_type(2)));
__device__ __forceinline__ unsigned cvt_pk_bf16(float lo, float hi) { const f32x2_c v = {lo, hi}; return __builtin_bit_cast(unsigned, __builtin_convertvector(v, bf16x2_c)); }
typedef unsigned u32x2 __attribute__((ext_vector_type(2)));
typedef float f32x2 __attribute__((ext_vector_type(2)));
typedef unsigned u32x4 __attribute__((ext_vector_type(4)));
#ifndef LAS
#define LAS __attribute__((address_space(3)))
#endif
constexpr int LDS_BYTES = 144 * 1024;
__device__ __forceinline__ void lds_barrier() { asm volatile("s_waitcnt lgkmcnt(0)" ::: "memory"); __builtin_amdgcn_s_barrier(); asm volatile("" ::: "memory"); }
__device__ __forceinline__ float bf2f(bf16_t b) { return __uint_as_float(((unsigned)b) << 16); }
__device__ __forceinline__ float bflo(unsigned u) { return __uint_as_float(u << 16); }
__device__ __forceinline__ float bfhi(unsigned u) { return __uint_as_float(u & 0xffff0000u); }
__device__ __forceinline__ bf16_t f2bf(float f) { return (bf16_t)(cvt_pk_bf16(f, 0.f) & 0xffffu); }

#ifdef MULTI_LAUNCH
__global__ void k_bridge_mix(const float* mix, bf16_t* mixb, size_t n) {
  size_t i = ((size_t)blockIdx.x * blockDim.x + tidx()) * 2;
  if (i < n) *(unsigned*)(mixb + i) = cvt_pk_bf16(mix[i], mix[i + 1]);
}
#endif

template <bool LAST> struct EpiD {
  static constexpr bool PERM = true, AFTER_DRAIN = false;
  const float* resid; float* xout; bf16_t* xb; float* ssq;
  __device__ __forceinline__ void operator()(const f32x4 (&acc)[2][2][4][2], const Unit& u, int wr_, int wc_, int fr_, int fq_) const {
    const int tz = tidx(), wid_ = tz >> 6, wr = wid_ >> 2, wc = wid_ & 3, fr = tz & 15, fq = (tz >> 4) & 3;
    const int row0 = u.pm * 256 + wr * 64 + fr, col0 = u.pn * 256 + wc * 32 + 8 * fq;
#pragma unroll
    for (int ai = 0; ai < 2; ++ai)
#pragma unroll
      for (int m = 0; m < 4; ++m) {
        const size_t row = (size_t)(row0 + ai * 128 + m * 16);
        float ss = 0.f;
#pragma unroll
        for (int bj = 0; bj < 2; ++bj) {
          const size_t o = row * 1024 + col0 + bj * 128;
          const f32x4 r0 = *(const f32x4*)(resid + o), r1 = *(const f32x4*)(resid + o + 4);
          const f32x4 v0 = acc[ai][bj][m][0] + r0, v1 = acc[ai][bj][m][1] + r1;
          *(f32x4*)(xout + o) = v0; *(f32x4*)(xout + o + 4) = v1;
          if (!LAST) {
            u32x4 pk; pk.x = cvt_pk_bf16(v0[0], v0[1]); pk.y = cvt_pk_bf16(v0[2], v0[3]); pk.z = cvt_pk_bf16(v1[0], v1[1]); pk.w = cvt_pk_bf16(v1[2], v1[3]);
            *(u32x4*)(xb + o) = pk;
            ss += v0[0] * v0[0] + v0[1] * v0[1] + v0[2] * v0[2] + v0[3] * v0[3] + v1[0] * v1[0] + v1[1] * v1[1] + v1[2] * v1[2] + v1[3] * v1[3];
          }
        }
        if (!LAST) {
          ss += __shfl_xor(ss, 16); ss += __shfl_xor(ss, 32);
          if (fq == 0) ssq[row * 16 + u.pn * 4 + wc] = ss;
        }
      }
  }
};
struct PhaseDArgs { const bf16_t* mixb; const bf16_t* WoutT; const float* resid; float* xout; bf16_t* xb; float* ssq; };
template <bool LAST> __device__ __forceinline__ void phaseD(LAS unsigned char* lds, const PhaseDArgs& a) {
  pg8::Gemm g{a.mixb, a.WoutT, NPT, 1024, 1024};
  pg8::StaticOrder S; S.init(NPT, 1024, gridDim.x, blockIdx.x);
  EpiD<LAST> E{a.resid, a.xout, a.xb, a.ssq};
  pg8::gemm_phase<EpiD<LAST>, pg8::StaticOrder, false>(lds, g, S, E, nullptr);
}
#ifdef MULTI_LAUNCH
template <bool LAST> __global__ void __launch_bounds__(512, 2) k_phaseD(PhaseDArgs a) {
  extern __shared__ __attribute__((aligned(16))) unsigned char shm[];
  phaseD<LAST>((LAS unsigned char*)shm, a);
}
#endif

__device__ __forceinline__ int win_logical_col(int np) {
  if (np >= 3072) return np < 3096 ? C_GATE + (np - 3072) : -1;
  const int tile = np >> 8, j = np & 255, bj = j >> 7, wc = (j >> 5) & 3, i = j & 31, jj = j & 127;
  switch (tile) {
    case 0: case 1: return (bj ? C_AGATE : C_AVAL) + tile * 128 + jj;
    case 2: return C_ZA + j;
    case 3: return C_BIN + j;
    case 4: return C_ZB + j;
    case 5: case 6: return C_Q + ((tile - 5) * 4 + wc) * 64 + bj * 32 + i;
    case 7: case 8: case 9: return C_KV + (tile - 7) * 256 + wc * 64 + bj * 32 + i;
    default: return C_ZC + (tile - 10) * 256 + j;
  }
}
#ifdef MULTI_LAUNCH
template <int MODE  >
__global__ void __launch_bounds__(256) k_transpose_w(const float* src, int ld_src, const float* scale, bf16_t* dst, int N, int K) {
  __shared__ float t[64][65];
  const int n0 = blockIdx.x * 64, k0 = blockIdx.y * 64, tid = tidx();
  for (int i = tid; i < 4096; i += 256) {
    const int k = i >> 6, n = i & 63;
    int col = MODE == 1 ? win_logical_col(n0 + n) : (n0 + n);
    float v = 0.f;
    if (n0 + n < N && col >= 0) { v = src[(size_t)(k0 + k) * ld_src + col]; if (scale) v *= scale[k0 + k]; }
    t[k][n] = v;
  }
  __syncthreads();
  for (int i = tid; i < 2048; i += 256) {
    const int n = i >> 5, k = (i & 31) * 2;
    if (n0 + n < N) *(unsigned*)(dst + (size_t)(n0 + n) * K + k0 + k) = cvt_pk_bf16(t[k][n], t[k + 1][n]);
  }
}
#endif

#ifdef MULTI_LAUNCH
__global__ void k_bridge_q(const float* qbuf, bf16_t* qb, size_t n) {
  size_t i = ((size_t)blockIdx.x * blockDim.x + tidx()) * 2;
  const float sc = 0.125f * 1.4426950408889634f;
  if (i < n) *(unsigned*)(qb + i) = cvt_pk_bf16(qbuf[i] * sc, qbuf[i + 1] * sc);
}
#endif
#ifdef MULTI_LAUNCH
__global__ void k_bridge_kv(const float* rows, int br, bf16_t* kk, bf16_t* vT) {
  size_t i = (size_t)blockIdx.x * blockDim.x + tidx();
  if (i >= (size_t)NPT * 128) return;
  const int d = (int)(i & 63), g = (int)((i >> 6) & 1); const size_t tok = i >> 7; const int b = (int)(tok / SEQ), t = (int)(tok % SEQ);
  kk[(((size_t)b * 2 + g) * SEQ + t) * 64 + d] = f2bf(rows[tok * 768 + br * 256 + g * 64 + d]);
  vT[(((size_t)b * 2 + g) * 64 + d) * SEQ + t] = f2bf(rows[tok * 768 + br * 256 + 128 + g * 64 + d]);
}
#endif
#ifdef MULTI_LAUNCH
__global__ void k_bridge_kc(const float* kc, const float* vc, bf16_t* kcP, bf16_t* vcPT, int nseq) {
  size_t i = (size_t)blockIdx.x * blockDim.x + tidx();
  if (i >= (size_t)nseq * 128 * 128) return;
  const int d = (int)(i & 63), g = (int)((i >> 6) & 1), c = (int)((i >> 7) & 127), b = (int)(i >> 14);
  const float kv = c < 127 ? kc[i] : 0.f, vv = c < 127 ? vc[i] : 0.f;
  kcP[(((size_t)b * 2 + g) * 128 + c) * 64 + d] = f2bf(kv);
  vcPT[(((size_t)b * 2 + g) * 64 + d) * 128 + c] = f2bf(vv);
}
#endif
#ifdef MULTI_LAUNCH
__global__ void k_bridge_silu(const float* proj, int col0, int ncol, bf16_t* dst, size_t ntok) {
  size_t i = (size_t)blockIdx.x * blockDim.x + tidx();
  if (i >= ntok * ncol) return;
  const size_t tok = i / ncol; const int c = (int)(i % ncol);
  const float z = proj[tok * D_IN + col0 + c];
  dst[i] = f2bf(z / (1.f + __expf(-z)));
}
#endif

#ifndef SKIPCOND
#define SKIPCOND __any(mine)
#endif
typedef float f32x16 __attribute__((ext_vector_type(16)));
typedef short bf16x4 __attribute__((ext_vector_type(4)));
struct PhaseCArgs { const bf16_t *qb, *ks, *vsT, *kw, *vwT, *kcP, *vcPT, *szc; const float* gates; bf16_t* mixb; const float* g_k;
#ifdef PROBE_REP
  int repc[2];
#endif
};
#define REPC

__device__ __forceinline__ f32x16 qk_tile(const bf16_t* krows, const bf16x8 (&qf)[4], int c32, int hh) {
  f32x16 s;
#pragma unroll
  for (int i = 0; i < 16; ++i) s[i] = 0.f;
  const bf16_t* kp = krows + (size_t)c32 * 64 + 8 * hh;
  bf16x8 kf[4];
#pragma unroll
  for (int ks = 0; ks < 4; ++ks) kf[ks] = *(const bf16x8*)(kp + 16 * ks);
#pragma unroll
  for (int ks = 0; ks < 4; ++ks) s = __builtin_amdgcn_mfma_f32_32x32x16_bf16(kf[ks], qf[ks], s, 0, 0, 0);
  return s;
}
__device__ __forceinline__ void pv_tile(f32x16 (&o)[2], const bf16_t* vT, int ldv, const f32x16& p, int c32, int hh) {
#pragma unroll
  for (int s = 0; s < 2; ++s) {
    union { bf16x8 v; unsigned u[4]; } pf;
#pragma unroll
    for (int j = 0; j < 4; ++j) pf.u[j] = cvt_pk_bf16(p[8 * s + 2 * j], p[8 * s + 2 * j + 1]);
#pragma unroll
    for (int dt = 0; dt < 2; ++dt) {
      const bf16_t* vp = vT + (size_t)(32 * dt + c32) * ldv + 16 * s + 4 * hh;
      union { bf16x8 v; bf16x4 h[2]; } vf;
      vf.h[0] = *(const bf16x4*)(vp);
      vf.h[1] = *(const bf16x4*)(vp + 8);
      o[dt] = __builtin_amdgcn_mfma_f32_32x32x16_bf16(vf.v, pf.v, o[dt], 0, 0, 0);
    }
  }
}

constexpr int AT_KB = 64 * 144, AT_VB = 64 * 136, AT_STAGE = AT_KB + AT_VB;
constexpr int AT_NBUF = 3;
constexpr int AT_IMP = AT_NBUF * AT_STAGE;
constexpr int AT_OT = AT_IMP + 8192;
struct StageRegs { u32x4 k; u32x4 v; };
__device__ __forceinline__ StageRegs stage_load(const bf16_t* ksrc, const bf16_t* vsrc, int ldv, int tid) {
  StageRegs r;
  r.k = *(const u32x4*)(ksrc + (size_t)(tid >> 3) * 64 + (tid & 7) * 8);
  r.v = *(const u32x4*)(vsrc + (size_t)(tid >> 3) * ldv + (tid & 7) * 8);
  return r;
}
__device__ __forceinline__ void stage_store(LAS unsigned char* buf, const StageRegs& r, int tid) {
  *(LAS u32x4*)(buf + (tid >> 3) * 144 + (tid & 7) * 16) = r.k;
  LAS unsigned char* vp = buf + AT_KB + (tid >> 3) * 136 + (tid & 7) * 16;
  *(LAS u32x2*)vp = (u32x2){r.v.x, r.v.y}; *(LAS u32x2*)(vp + 8) = (u32x2){r.v.z, r.v.w};
}
__device__ __forceinline__ f32x16 qk_lds(const LAS unsigned char* buf, int tt, const bf16x8 (&qf)[4], int c32, int hh) {
  f32x16 s;
#pragma unroll
  for (int i = 0; i < 16; ++i) s[i] = 0.f;
  const LAS unsigned char* kp = buf + (32 * tt + c32) * 144 + 16 * hh;
#pragma unroll
  for (int ks = 0; ks < 4; ++ks) { const bf16x8 kf = *(const LAS bf16x8*)(kp + 32 * ks); s = __builtin_amdgcn_mfma_f32_32x32x16_bf16(kf, qf[ks], s, 0, 0, 0); }
  return s;
}
__device__ __forceinline__ void pv_lds(f32x16 (&o)[2], const LAS unsigned char* buf, int tt, const f32x16& p, int c32, int hh) {
#pragma unroll
  for (int s = 0; s < 2; ++s) {
    union { bf16x8 v; unsigned u[4]; } pf;
#pragma unroll
    for (int j = 0; j < 4; ++j) pf.u[j] = cvt_pk_bf16(p[8 * s + 2 * j], p[8 * s + 2 * j + 1]);
#pragma unroll
    for (int dt = 0; dt < 2; ++dt) {
      const LAS unsigned char* vp = buf + AT_KB + (32 * dt + c32) * 136 + (32 * tt + 16 * s + 4 * hh) * 2;
      union { bf16x8 v; u32x2 h[2]; } vf;
      vf.h[0] = *(const LAS u32x2*)vp; vf.h[1] = *(const LAS u32x2*)(vp + 16);
      o[dt] = __builtin_amdgcn_mfma_f32_32x32x16_bf16(vf.v, pf.v, o[dt], 0, 0, 0);
    }
  }
}
__device__ __forceinline__ f32x16 qk_lds_init(const LAS unsigned char* buf, int tt, const bf16x8 (&qf)[4], int c32, int hh, float cinit) {
  f32x16 s;
#pragma unroll
  for (int i = 0; i < 16; ++i) s[i] = cinit;
  const LAS unsigned char* kp = buf + (32 * tt + c32) * 144 + 16 * hh;
#pragma unroll
  for (int ks = 0; ks < 4; ++ks) { const bf16x8 kf = *(const LAS bf16x8*)(kp + 32 * ks); s = __builtin_amdgcn_mfma_f32_32x32x16_bf16(kf, qf[ks], s, 0, 0, 0); }
  return s;
}
template <bool MASKED>
__device__ __forceinline__ void stage_pv_ref(f32x16 (&o)[2], float& l, const LAS unsigned char* buf, const bf16x8 (&qf)[4], int c32, int hh, float cinit, int klim0, int klo0) {
  f32x16 s0 = qk_lds_init(buf, 0, qf, c32, hh, cinit), s1 = qk_lds_init(buf, 1, qf, c32, hh, cinit);
  float ps = 0.f;
#pragma unroll
  for (int i = 0; i < 16; ++i) {
    float p0 = __builtin_amdgcn_exp2f(s0[i]), p1 = __builtin_amdgcn_exp2f(s1[i]);
    if (MASKED) {
      const int x = (i & 3) + 8 * (i >> 2);
      p0 = (x <= klim0 && x > klo0) ? p0 : 0.f;
      p1 = (x <= klim0 - 32 && x > klo0 - 32) ? p1 : 0.f;
    }
    s0[i] = p0; s1[i] = p1; ps += p0 + p1;
  }
  l += ps;
  pv_lds(o, buf, 0, s0, c32, hh);
  pv_lds(o, buf, 1, s1, c32, hh);
}

#ifdef ATTN_ONLINE
template <bool MASKED>
__device__ __forceinline__ void stage_softmax_pv(f32x16 (&o)[2], float& m, float& l, const LAS unsigned char* buf, const bf16x8 (&qf)[4], int c32, int hh, int klim0, int klo0, bool mine) {
  f32x16 s0 = qk_lds(buf, 0, qf, c32, hh), s1 = qk_lds(buf, 1, qf, c32, hh);
  float mt = NEGF;
  if (MASKED) {
#pragma unroll
    for (int i = 0; i < 16; ++i) {
      const int x = (i & 3) + 8 * (i >> 2);
      s0[i] = (x <= klim0 && x > klo0) ? s0[i] : NEGF;
      s1[i] = (x <= klim0 - 32 && x > klo0 - 32) ? s1[i] : NEGF;
      mt = fmaxf(mt, fmaxf(s0[i], s1[i]));
    }
  } else {
#pragma unroll
    for (int i = 0; i < 16; ++i) mt = fmaxf(mt, fmaxf(s0[i], s1[i]));
    mt = mine ? mt : NEGF;
  }
  mt = fmaxf(mt, __shfl_xor(mt, 32));
  const float mn = fmaxf(m, mt);
  const float alpha = __builtin_amdgcn_exp2f(m - mn);
  float ps = 0.f;
  if (MASKED) {
#pragma unroll
    for (int i = 0; i < 16; ++i) {
      const float p0 = (s0[i] > -1e29f) ? __builtin_amdgcn_exp2f(s0[i] - mn) : 0.f, p1 = (s1[i] > -1e29f) ? __builtin_amdgcn_exp2f(s1[i] - mn) : 0.f;
      s0[i] = p0; s1[i] = p1; ps += p0 + p1;
    }
  } else {
    const float msub = mine ? mn : 1e30f;
#pragma unroll
    for (int i = 0; i < 16; ++i) { s0[i] = __builtin_amdgcn_exp2f(s0[i] - msub); s1[i] = __builtin_amdgcn_exp2f(s1[i] - msub); ps += s0[i] + s1[i]; }
  }
  l = l * alpha + ps; m = mn;
  if (!__all(alpha == 1.f)) {
#pragma unroll
    for (int i = 0; i < 16; ++i) { o[0][i] *= alpha; o[1][i] *= alpha; }
  }
  pv_lds(o, buf, 0, s0, c32, hh);
  pv_lds(o, buf, 1, s1, c32, hh);
}

#endif
__device__ __forceinline__ void attn_item(const PhaseCArgs& a, LAS unsigned char* lds, int b, int qbi, int g) {
  const int tid = tidx(), w = tid >> 6, lane = tid & 63, c32 = lane & 31, hh = lane >> 5;
  const int t0 = qbi * 64, tl = c32 >> 2, r = c32 & 3;
  const int t = t0 + 8 * w + tl, head = 4 * g + r;
  const size_t tok = (size_t)b * SEQ + t;
  const size_t bg = (size_t)b * 2 + g;
  LAS float* impl = (LAS float*)(lds + AT_IMP) + w * 256;
  bf16x8 qf[4];
  {
    const bf16_t* qp = a.qb + (tok * 8 + head) * 64 + 8 * hh;
#pragma unroll
    for (int ks = 0; ks < 4; ++ks) qf[ks] = *(const bf16x8*)(qp + 16 * ks);
  }
  const float* gt = a.gates + tok * 24;
  const float gate_c = gt[head], gate_s = gt[8 + head], gate_w = gt[16 + head];
  float ref_s, ref_w;
  {
    float gs = fabsf(a.g_k[64 + lane]), gw = fabsf(a.g_k[128 + lane]);
#pragma unroll
    for (int o_ = 32; o_ > 0; o_ >>= 1) { gs = fmaxf(gs, __shfl_xor(gs, o_)); gw = fmaxf(gw, __shfl_xor(gw, o_)); }
    float qq = 0.f;
#pragma unroll
    for (int ks = 0; ks < 4; ++ks)
#pragma unroll
      for (int j = 0; j < 8; ++j) { const float qv = bf2f((bf16_t)qf[ks][j]); qq = fmaf(qv, qv, qq); }
    qq += __shfl_xor(qq, 32);
    const float qn = sqrtf(qq) * 8.f * 1.02f;
    ref_s = qn * gs; ref_w = qn * gw;
  }
  asm volatile("" : "+v"(ref_s), "+v"(ref_w));
  const int wj0 = qbi >= 4 ? qbi - 4 : 0;
  const int n_slc = qbi + 1, n_win = qbi - wj0 + 1, n_st = 4 + n_slc + n_win;
  const bf16_t* kcb = a.kcP + bg * 128 * 64; const bf16_t* vcb = a.vcPT + bg * 64 * 128;
  const bf16_t* ksb = a.ks + bg * SEQ * 64;  const bf16_t* vsb = a.vsT + bg * 64 * SEQ;
  const bf16_t* kwb = a.kw + bg * SEQ * 64;  const bf16_t* vwb = a.vwT + bg * 64 * SEQ;
#define AT_SRC(s_, KP, VP, LDV) do { const int s__ = (s_);                                                        \
    if (s__ < 4) { KP = kcb + (size_t)(s__ & 1) * 64 * 64; VP = vcb + (s__ & 1) * 64; LDV = 128; }                 \
    else if (s__ < 4 + n_slc) { const int j__ = s__ - 4; KP = ksb + (size_t)j__ * 64 * 64; VP = vsb + j__ * 64; LDV = SEQ; } \
    else { const int j__ = wj0 + (s__ - 4 - n_slc); KP = kwb + (size_t)j__ * 64 * 64; VP = vwb + j__ * 64; LDV = SEQ; } } while (0)
  StageRegs sr0, sr1;
  { const bf16_t* kp; const bf16_t* vp; int ldv; AT_SRC(0, kp, vp, ldv); sr0 = stage_load(kp, vp, ldv, tid); }
  { const bf16_t* kp; const bf16_t* vp; int ldv; AT_SRC(1, kp, vp, ldv); sr1 = stage_load(kp, vp, ldv, tid); }
  stage_store(lds, sr0, tid);
  sr0 = sr1;
  lds_barrier();
  f32x16 o[2];
#pragma unroll
  for (int i = 0; i < 16; ++i) { o[0][i] = 0.f; o[1][i] = 0.f; }
  LAS f32x4* otl = (LAS f32x4*)(lds + AT_OT) + (w * 8) * 64 + lane;
  float m = NEGF, l = 0.f, inv = 0.f, prev = 0.f;
  unsigned selmask = 0u;
  const int clim = ((t - 31) >> 4) - 4 * hh;
#pragma unroll 1
  for (int s = 0; s < n_st; ++s) {
    const LAS unsigned char* buf = lds + (s % AT_NBUF) * AT_STAGE;
    if (s + 2 < n_st) { const bf16_t* kp; const bf16_t* vp; int ldv; AT_SRC(s + 2, kp, vp, ldv); sr1 = stage_load(kp, vp, ldv, tid); }
    if (s < 2) {
      f32x16 s0 = qk_lds(buf, 0, qf, c32, hh), s1 = qk_lds(buf, 1, qf, c32, hh);
      const int cl = clim - 64 * s;
      float mt = NEGF;
#pragma unroll
      for (int i = 0; i < 16; ++i) { const int x = (i & 3) + 8 * (i >> 2); s0[i] = x <= cl ? s0[i] : NEGF; s1[i] = x <= cl - 32 ? s1[i] : NEGF; mt = fmaxf(mt, fmaxf(s0[i], s1[i])); }
      mt = fmaxf(mt, __shfl_xor(mt, 32));
      const float mn = fmaxf(m, mt);
      float ps = 0.f;
#pragma unroll
      for (int i = 0; i < 16; ++i) { ps += (s0[i] > -1e29f) ? __builtin_amdgcn_exp2f(s0[i] - mn) : 0.f; ps += (s1[i] > -1e29f) ? __builtin_amdgcn_exp2f(s1[i] - mn) : 0.f; }
      l = l * __builtin_amdgcn_exp2f(m - mn) + ps; m = mn;
      if (s == 1) { l += __shfl_xor(l, 32); inv = l > 0.f ? 1.f / l : 0.f; }
    } else if (s < 4) {
#pragma unroll
      for (int tt = 0; tt < 2; ++tt) {
        f32x16 sc = qk_lds(buf, tt, qf, c32, hh);
        const int cl = clim - 64 * (s - 2) - 32 * tt;
#pragma unroll
        for (int i = 0; i < 16; ++i) { const bool valid = ((i & 3) + 8 * (i >> 2)) <= cl; sc[i] = valid ? __builtin_amdgcn_exp2f(sc[i] - m) * inv : 0.f; }
#pragma unroll
        for (int ii = 0; ii < 4; ++ii) {
          const float q4 = (sc[4 * ii] + sc[4 * ii + 1]) + (sc[4 * ii + 2] + sc[4 * ii + 3]);
          const float pp = __shfl_xor(sc[4 * ii + 3], 32);
          float v = q4 + (hh ? pp : prev);
          prev = pp;
          v += __shfl_xor(v, 1); v += __shfl_xor(v, 2);
          if (r == 0) impl[tl * 32 + 2 * (4 * (2 * (s - 2) + tt) + ii) + hh] = v;
        }
        pv_lds(o, buf, tt, sc, c32, hh);
      }
      if (s == 3) {
#pragma unroll
        for (int dt = 0; dt < 2; ++dt)
#pragma unroll
          for (int i4 = 0; i4 < 4; ++i4) otl[(dt * 4 + i4) * 64] = (f32x4){gate_c * o[dt][4 * i4], gate_c * o[dt][4 * i4 + 1], gate_c * o[dt][4 * i4 + 2], gate_c * o[dt][4 * i4 + 3]};
#pragma unroll
        for (int i = 0; i < 16; ++i) { o[0][i] = 0.f; o[1][i] = 0.f; }
        m = NEGF; l = 0.f;
      }
    } else if (s < 4 + n_slc) {
      const int j = s - 4;
      const bool mine = (selmask >> j) & 1u;
      if (__any(mine)) {
#ifdef ATTN_ONLINE
        if (j < qbi) stage_softmax_pv<false>(o, m, l, buf, qf, c32, hh, 0, 0, mine);
        else { const int klim = mine ? (t - 64 * j - 4 * hh) : -1; stage_softmax_pv<true>(o, m, l, buf, qf, c32, hh, klim, -1000000, mine); }
#else
        const float cinit = mine ? -ref_s : -1e30f;
        REPC
        if (j < qbi) stage_pv_ref<false>(o, l, buf, qf, c32, hh, cinit, 0, 0);
        else stage_pv_ref<true>(o, l, buf, qf, c32, hh, cinit, t - 64 * j - 4 * hh, -1000000);
#endif
      }
      if (j == qbi) {
        l += __shfl_xor(l, 32);
        const float sc = gate_s / fmaxf(l, 1e-37f);
#pragma unroll
        for (int dt = 0; dt < 2; ++dt)
#pragma unroll
          for (int i4 = 0; i4 < 4; ++i4) { f32x4 v = otl[(dt * 4 + i4) * 64]; v[0] += sc * o[dt][4 * i4]; v[1] += sc * o[dt][4 * i4 + 1]; v[2] += sc * o[dt][4 * i4 + 2]; v[3] += sc * o[dt][4 * i4 + 3]; otl[(dt * 4 + i4) * 64] = v; }
#pragma unroll
        for (int i = 0; i < 16; ++i) { o[0][i] = 0.f; o[1][i] = 0.f; }
        m = NEGF; l = 0.f;
      }
    } else {
      const int j = wj0 + (s - 4 - n_slc);
      const int tmin = t0 + 8 * w;
      if (64 * j + 63 > tmin - 256) {
#ifdef ATTN_ONLINE
        if (j < qbi && j >= qbi - 3) stage_softmax_pv<false>(o, m, l, buf, qf, c32, hh, 0, 0, true);
        else { const int khi = t - 64 * j - 4 * hh; stage_softmax_pv<true>(o, m, l, buf, qf, c32, hh, khi, khi - 256, true); }
#else
        REPC
        if (j < qbi && j >= qbi - 3) stage_pv_ref<false>(o, l, buf, qf, c32, hh, -ref_w, 0, 0);
        else { const int khi = t - 64 * j - 4 * hh; stage_pv_ref<true>(o, l, buf, qf, c32, hh, -ref_w, khi, khi - 256); }
#endif
      }
    }
    if (s + 1 < n_st) stage_store(lds + ((s + 1) % AT_NBUF) * AT_STAGE, sr0, tid);
    sr0 = sr1;
    lds_barrier();
    if (s == 3) {
      const int tl2 = lane >> 3, sg = lane & 7, cur = qbi;
      float scv[32];
#pragma unroll
      for (int s2 = 0; s2 < 32; ++s2) {
        const float v = impl[tl2 * 32 + s2];
        const bool forced = (s2 == 0) || (s2 == cur) || (s2 == cur - 1);
        scv[s2] = (s2 <= cur) ? (forced ? 1e4f : v) : -1e4f;
      }
      unsigned mk = 0u;
#pragma unroll
      for (int e = 0; e < 4; ++e) {
        const int sx = sg * 4 + e;
        float mine = 0.f;
#pragma unroll
        for (int s2 = 0; s2 < 32; ++s2) mine = (s2 == sx) ? scv[s2] : mine;
        int rank = 0;
#pragma unroll
        for (int s2 = 0; s2 < 32; ++s2) rank += (scv[s2] > mine || (scv[s2] == mine && s2 < sx)) ? 1 : 0;
        if (rank < 8 && sx <= cur) mk |= 1u << sx;
      }
      mk |= __shfl_xor(mk, 1); mk |= __shfl_xor(mk, 2); mk |= __shfl_xor(mk, 4);
      selmask = __shfl(mk, tl * 8);
    }
  }
#undef AT_SRC
  l += __shfl_xor(l, 32);
  const float scw = gate_w / fmaxf(l, 1e-37f);
#pragma unroll
  for (int dt = 0; dt < 2; ++dt)
#pragma unroll
    for (int ii = 0; ii < 4; ++ii) {
      const int d0 = 32 * dt + 8 * ii + 4 * hh;
      const f32x4 pk = otl[(dt * 4 + ii) * 64];
      const u32x2 z = *(const u32x2*)(a.szc + tok * 512 + head * 64 + d0);
      u32x2 ov;
      ov.x = cvt_pk_bf16((pk[0] + scw * o[dt][4 * ii]) * bflo(z.x), (pk[1] + scw * o[dt][4 * ii + 1]) * bfhi(z.x));
      ov.y = cvt_pk_bf16((pk[2] + scw * o[dt][4 * ii + 2]) * bflo(z.y), (pk[3] + scw * o[dt][4 * ii + 3]) * bfhi(z.y));
      *(u32x2*)(a.mixb + tok * 1024 + 512 + head * 64 + d0) = ov;
    }
}
__device__ __forceinline__ void phaseC(LAS unsigned char* lds, const PhaseCArgs& a) {
  for (int p0 = blockIdx.x; p0 < 256; p0 += gridDim.x) {
    const int p = gridDim.x == 256 ? ((p0 & 7) * 32 + (p0 >> 3)) : p0;
    const int b = p >> 5, g = (p >> 4) & 1, qlo = p & 15;
    attn_item(a, lds, b, qlo, g);
    __syncthreads();
    attn_item(a, lds, b, 31 - qlo, g);
    __syncthreads();
  }
}
#ifdef MULTI_LAUNCH
__global__ void __launch_bounds__(512, 2) k_phaseC(PhaseCArgs a) {
  extern __shared__ __attribute__((aligned(16))) unsigned char shm[];
  phaseC((LAS unsigned char*)shm, a);
}
#endif

#ifdef MULTI_LAUNCH
__global__ void k_bridge_cvt(const float* src, int ld_src, int col0, int ncol, bf16_t* dst, size_t ntok) {
  size_t i = (size_t)blockIdx.x * blockDim.x + tidx();
  if (i >= ntok * ncol) return;
  const size_t tok = i / ncol; const int c = (int)(i % ncol);
  dst[i] = f2bf(src[tok * ld_src + col0 + c]);
}
#endif
#ifdef MULTI_LAUNCH
__global__ void __launch_bounds__(256) k_prep_x(const float* xp, const float* xs, bf16_t* xb, float* ssq) {
  const int row = blockIdx.x * 4 + (tidx() >> 6), lane = tidx() & 63;
  if (row >= NTOK) return;
  const float* x = row < NPT ? xp + (size_t)row * 1024 : xs + (size_t)(row - NPT) * 1024;
#pragma unroll
  for (int j = 0; j < 4; ++j) {
    const f32x4 v = *(const f32x4*)(x + j * 256 + lane * 4);
    u32x2 pk; pk.x = cvt_pk_bf16(v[0], v[1]); pk.y = cvt_pk_bf16(v[2], v[3]);
    *(u32x2*)(xb + (size_t)row * 1024 + j * 256 + lane * 4) = pk;
    float ss = v[0] * v[0] + v[1] * v[1] + v[2] * v[2] + v[3] * v[3];
    ss += __shfl_xor(ss, 1); ss += __shfl_xor(ss, 2); ss += __shfl_xor(ss, 4); ss += __shfl_xor(ss, 8);
    if ((lane & 15) == 0) ssq[(size_t)row * 16 + j * 4 + (lane >> 4)] = ss;
  }
}
#endif
#ifdef MULTI_LAUNCH
__global__ void __launch_bounds__(64) k_prep_cbias(const float* pe, const float* w1, float* cbias) {
  const int lk = blockIdx.x, e = tidx();
  const float* pp = pe + (size_t)lk * 2048; const float* ww = w1 + (size_t)lk * 2048 * 64;
  float acc = 0.f;
  for (int k = 0; k < 2048; ++k) acc = fmaf(pp[k], ww[(size_t)k * 64 + e], acc);
  cbias[lk * 64 + e] = acc;
}
#endif
__device__ __forceinline__ float rinv_from_ssq(const float* ssq, size_t row) {
  const f32x4* p = (const f32x4*)(ssq + row * 16);
  const f32x4 a = p[0], b = p[1], c = p[2], d = p[3];
  const float s = ((a[0] + a[1]) + (a[2] + a[3])) + ((b[0] + b[1]) + (b[2] + b[3])) + ((c[0] + c[1]) + (c[2] + c[3])) + ((d[0] + d[1]) + (d[2] + d[3]));
  return rsqrtf(s * (1.f / 1024.f) + 1e-6f);
}
__device__ __forceinline__ f32x4 mfma16(bf16x8 a, bf16x8 b, f32x4 c) { return __builtin_amdgcn_mfma_f32_16x16x32_bf16(a, b, c, 0, 0, 0); }
__device__ __forceinline__ float fsigmoid(float z) { return __builtin_amdgcn_rcpf(1.f + __builtin_amdgcn_exp2f(-1.4426950408889634f * z)); }
__device__ __forceinline__ float fsilu(float z) { return z * fsigmoid(z); }

template <int NT> __device__ __forceinline__ void small_gemm(LAS unsigned char* lds, const bf16_t* A, int lda, const bf16_t* Bt, int ldb, int K, f32x4 (&acc)[NT]) {
  const int tid = tidx(), w = tid >> 6, lane = tid & 63, fr = lane & 15, fq = lane >> 4;
  constexpr int ST = 272, BUF = (128 + 16 * NT) * ST, NB = (16 * NT * 16 + 511) / 512;
  const int ar = tid >> 4, ap = tid & 15;
  const bf16_t* asrc = A + (size_t)ar * lda + ap * 8;
  u32x4 areg[2][4], breg[2][NB];
#pragma unroll
  for (int nt = 0; nt < NT; ++nt) acc[nt] = (f32x4){0.f, 0.f, 0.f, 0.f};
  const int nc = K / 128;
#define SG_LOAD(SET, c_) do { _Pragma("unroll") for (int i = 0; i < 4; ++i) areg[SET][i] = *(const u32x4*)(asrc + (size_t)(32 * i) * lda + (c_) * 128);                                   \
    _Pragma("unroll") for (int i = 0; i < NB; ++i) { const int pc = tid + i * 512; if (pc < 16 * NT * 16) breg[SET][i] = *(const u32x4*)(Bt + (size_t)(pc >> 4) * ldb + (c_) * 128 + (pc & 15) * 8); } } while (0)
#define SG_STORE(SET, c_) do { LAS unsigned char* base_ = lds + ((c_) & 1) * BUF;                                                                                        \
    _Pragma("unroll") for (int i = 0; i < 4; ++i) *(LAS u32x4*)(base_ + (ar + 32 * i) * ST + ap * 16) = areg[SET][i];                                                       \
    _Pragma("unroll") for (int i = 0; i < NB; ++i) { const int pc = tid + i * 512; if (pc < 16 * NT * 16) *(LAS u32x4*)(base_ + (128 + (pc >> 4)) * ST + (pc & 15) * 16) = breg[SET][i]; } } while (0)
#define SG_COMPUTE(c_) do { const LAS unsigned char* base_ = lds + ((c_) & 1) * BUF;                                                                                     \
    _Pragma("unroll") for (int i = 0; i < 4; ++i) { const bf16x8 af = *(const LAS bf16x8*)(base_ + (16 * w + fr) * ST + i * 64 + fq * 16);                                \
      _Pragma("unroll") for (int nt = 0; nt < NT; ++nt) { const bf16x8 bf = *(const LAS bf16x8*)(base_ + (128 + nt * 16 + fr) * ST + i * 64 + fq * 16); acc[nt] = mfma16(bf, af, acc[nt]); } } } while (0)
  SG_LOAD(0, 0);
  if (nc > 1) SG_LOAD(1, 1);
  SG_STORE(0, 0);
  lds_barrier();
#pragma unroll 1
  for (int c = 0; c < nc; c += 2) {
    if (c + 2 < nc) SG_LOAD(0, c + 2);
    SG_COMPUTE(c);
    SG_STORE(1, c + 1);
    lds_barrier();
    if (c + 3 < nc) SG_LOAD(1, c + 3);
    SG_COMPUTE(c + 1);
    if (c + 2 < nc) SG_STORE(0, c + 2);
    lds_barrier();
  }
#undef SG_LOAD
#undef SG_STORE
#undef SG_COMPUTE
}

struct PhaseBArgs {
  const bf16_t *glu, *bin, *sza, *szb, *xb; const float* ssq;
  const bf16_t *WpwT, *WpoolT, *WgT, *W1T, *W2T; const float* cbias;
  const float *w_dw, *b_dw, *ln_g, *ln_b, *b_pw, *pool_scale;
  const float* cmp_rows_p;
  bf16_t *mixb, *kcP, *vcPT; float* gates;
#ifdef PROBE_REP
  int repb[4];
#endif
};
#ifdef PROBE_REP
#define REPB(i) _Pragma("unroll 1") for (int repb_ = 0; repb_ < a.repb[i]; ++repb_)
#else
#define REPB(i)
#endif

template <int NT_>
__device__ __forceinline__ void conv_item(const PhaseBArgs& a, LAS unsigned char* lds, int b, int chunk) {
  const int tid = tidx(), w = tid >> 6, lane = tid & 63;
  const int fr = lane & 15, fq = lane >> 4;
  const int t0 = chunk * NT_;
  constexpr int TPT = NT_ / 4;
  constexpr int ZOFF = NT_ * 1088;
  constexpr int POFF = ZOFF + NT_ * 512;
  const size_t tok0 = (size_t)b * SEQ + t0;
  const int cp = tid & 127, tg = tid >> 7;
  f32x2 wt[31];
#pragma unroll
  for (int k = 0; k < 31; ++k) wt[k] = *(const f32x2*)(a.w_dw + k * 256 + 2 * cp);
  const f32x2 bd = *(const f32x2*)(a.b_dw + 2 * cp);
  for (int i = tid; i < (NT_ + 30) * 32; i += 512) {
    const int row = i >> 5, ch = i & 31, t = t0 - 30 + row;
    u32x4 v = {0u, 0u, 0u, 0u};
    if (t >= 0) v = *(const u32x4*)(a.glu + ((size_t)b * SEQ + t) * 256 + ch * 8);
    *(LAS u32x4*)(lds + row * 512 + ch * 16) = v;
  }
  for (int i = tid; i < NT_ * 32; i += 512) *(LAS u32x4*)(lds + ZOFF + i * 16) = *(const u32x4*)(a.sza + tok0 * 256 + (size_t)i * 8);
  if (w == 0) *(LAS f32x4*)(lds + POFF + tid * 16) = *(const f32x4*)(a.ln_g + (tid & 63) * 4);
  else if (w == 1) *(LAS f32x4*)(lds + POFF + tid * 16) = *(const f32x4*)(a.ln_b + (tid & 63) * 4);
  else if (w == 2) *(LAS f32x4*)(lds + POFF + tid * 16) = *(const f32x4*)(a.b_pw + (tid & 63) * 4);
  __syncthreads();
  f32x2 res[TPT];
  {
    const LAS unsigned* wp = (const LAS unsigned*)(lds + (tg * TPT) * 512 + cp * 4);
#pragma unroll
    for (int blk = 0; blk < TPT / 8; ++blk) {
      f32x2 xw[38];
#pragma unroll
      for (int i = 0; i < 38; ++i) { const unsigned xv = wp[(blk * 8 + i) * 128]; xw[i] = (f32x2){bflo(xv), bfhi(xv)}; }
      f32x2 ac[8];
#pragma unroll
      for (int j = 0; j < 8; ++j) ac[j] = bd;
#pragma unroll
      for (int k = 0; k < 31; ++k)
#pragma unroll
        for (int j = 0; j < 8; ++j) ac[j] = __builtin_elementwise_fma(wt[k], xw[j + k], ac[j]);
#pragma unroll
      for (int j = 0; j < 8; ++j) res[blk * 8 + j] = ac[j];
    }
  }
  bf16x8 bfr[2][8];
#pragma unroll
  for (int nt = 0; nt < 2; ++nt)
#pragma unroll
    for (int ks = 0; ks < 8; ++ks) bfr[nt][ks] = *(const bf16x8*)(a.WpwT + (size_t)(32 * w + nt * 16 + fr) * 256 + ks * 32 + fq * 8);
  __syncthreads();
#pragma unroll
  for (int j = 0; j < TPT; ++j) *(LAS f32x2*)(lds + (tg * TPT + j) * 1088 + cp * 8) = res[j];
  __syncthreads();
  if ((tid >> 2) < NT_) {
    const int tok = tid >> 2, q = tid & 3;
    f32x4 v[16]; float s = 0.f;
#pragma unroll
    for (int i = 0; i < 16; ++i) { v[i] = *(const LAS f32x4*)(lds + tok * 1088 + (4 * i + q) * 16); s += (v[i][0] + v[i][1]) + (v[i][2] + v[i][3]); }
    s += __shfl_xor(s, 1); s += __shfl_xor(s, 2);
    const float mean = s * (1.f / 256.f);
    float s2 = 0.f;
#pragma unroll
    for (int i = 0; i < 16; ++i) { v[i] = v[i] - mean; s2 += (v[i][0] * v[i][0] + v[i][1] * v[i][1]) + (v[i][2] * v[i][2] + v[i][3] * v[i][3]); }
    s2 += __shfl_xor(s2, 1); s2 += __shfl_xor(s2, 2);
    const float rstd = rsqrtf(s2 * (1.f / 256.f) + 1e-6f);
#pragma unroll
    for (int i = 0; i < 16; ++i) {
      const int c0 = (4 * i + q) * 4;
      const f32x4 gg = *(const LAS f32x4*)(lds + POFF + c0 * 4), bb = *(const LAS f32x4*)(lds + POFF + 1024 + c0 * 4);
      f32x4 z = v[i] * rstd * gg + bb;
      u32x2 pk; pk.x = cvt_pk_bf16(fsilu(z[0]), fsilu(z[1])); pk.y = cvt_pk_bf16(fsilu(z[2]), fsilu(z[3]));
      *(LAS u32x2*)(lds + tok * 1088 + c0 * 2) = pk;
    }
  }
  __syncthreads();
  {
#pragma unroll 2
    for (int mt = 0; mt < NT_ / 16; ++mt) {
      f32x4 acc0 = {0.f, 0.f, 0.f, 0.f}, acc1 = {0.f, 0.f, 0.f, 0.f};
#pragma unroll
      for (int ks = 0; ks < 8; ++ks) {
        const bf16x8 af = *(const LAS bf16x8*)(lds + (16 * mt + fr) * 1088 + (ks * 32 + fq * 8) * 2);
        acc0 = mfma16(bfr[0][ks], af, acc0); acc1 = mfma16(bfr[1][ks], af, acc1);
      }
      const size_t tok = tok0 + 16 * mt + fr;
#pragma unroll
      for (int nt = 0; nt < 2; ++nt) {
        const f32x4 ac = nt ? acc1 : acc0;
        const int c0 = 32 * w + nt * 16 + 4 * fq;
        const f32x4 bp = *(const LAS f32x4*)(lds + POFF + 2048 + c0 * 4);
        const u32x2 z = *(const LAS u32x2*)(lds + ZOFF + (16 * mt + fr) * 512 + c0 * 2);
        u32x2 ov;
        ov.x = cvt_pk_bf16((ac[0] + bp[0]) * bflo(z.x), (ac[1] + bp[1]) * bfhi(z.x));
        ov.y = cvt_pk_bf16((ac[2] + bp[2]) * bflo(z.y), (ac[3] + bp[3]) * bfhi(z.y));
        *(u32x2*)(a.mixb + tok * 1024 + c0) = ov;
      }
    }
  }
  __syncthreads();
}

__device__ __forceinline__ void pool_item(const PhaseBArgs& a, LAS unsigned char* lds, int b, int chunk) {
  const int tid = tidx(), w = tid >> 6, lane = tid & 63;
  const int t0 = chunk * 128;
  constexpr int DOFF = 143 * 512;
  for (int i = tid; i < 143 * 32; i += 512) {
    const int row = i >> 5, ch = i & 31, t = t0 - 15 + row;
    u32x4 v = {0u, 0u, 0u, 0u};
    if (t >= 0) v = *(const u32x4*)(a.bin + ((size_t)b * SEQ + t) * 256 + ch * 8);
    *(LAS u32x4*)(lds + row * 512 + ch * 16) = v;
  }
  __syncthreads();
  {
    const int cp = tid & 127, tg = tid >> 7, grp = cp >> 5, wn = 2 << grp;
    const LAS unsigned* wp = (const LAS unsigned*)(lds + cp * 4);
    const int r0 = 15 + tg * 32;
    float run0 = 0.f, run1 = 0.f;
    for (int i = 1; i < wn; ++i) { const unsigned xv = wp[(r0 - i) * 128]; run0 += bflo(xv); run1 += bfhi(xv); }
#pragma unroll 4
    for (int j = 0; j < 32; ++j) {
      const int rr = r0 + j, t = t0 + tg * 32 + j;
      const unsigned xv = wp[rr * 128];
      const float x0 = bflo(xv), x1 = bfhi(xv);
      run0 += x0; run1 += x1;
      const float icnt = 1.f / (float)min(wn, t + 1);
      const unsigned dv = cvt_pk_bf16(run0 * icnt - x0, run1 * icnt - x1);
      *(LAS unsigned*)(lds + DOFF + (tg * 32 + j) * 528 + cp * 4) = dv;
      const unsigned xo = wp[(rr - wn + 1) * 128];
      run0 -= bflo(xo); run1 -= bfhi(xo);
    }
  }
  __syncthreads();
  {
    const int fr = lane & 15, fq = lane >> 4;
    const size_t tok = (size_t)b * SEQ + t0 + 16 * w + fr;
#pragma unroll
    for (int g = 0; g < 4; ++g) {
      f32x4 acc[4];
#pragma unroll
      for (int nt = 0; nt < 4; ++nt) acc[nt] = (f32x4){0.f, 0.f, 0.f, 0.f};
#pragma unroll
      for (int ks = 0; ks < 2; ++ks) {
        const bf16x8 af = *(const LAS bf16x8*)(lds + DOFF + (16 * w + fr) * 528 + (g * 64 + ks * 32 + fq * 8) * 2);
#pragma unroll
        for (int nt = 0; nt < 4; ++nt) {
          const bf16x8 bf = *(const bf16x8*)(a.WpoolT + (size_t)(g * 64 + nt * 16 + fr) * 64 + ks * 32 + fq * 8);
          acc[nt] = mfma16(bf, af, acc[nt]);
        }
      }
#pragma unroll
      for (int nt = 0; nt < 4; ++nt) {
        const int c0 = g * 64 + nt * 16 + 4 * fq;
        const f32x4 sc = *(const f32x4*)(a.pool_scale + c0);
        const u32x2 z = *(const u32x2*)(a.szb + tok * 256 + c0);
        u32x2 ov;
        ov.x = cvt_pk_bf16(acc[nt][0] * sc[0] * bflo(z.x), acc[nt][1] * sc[1] * bfhi(z.x));
        ov.y = cvt_pk_bf16(acc[nt][2] * sc[2] * bflo(z.y), acc[nt][3] * sc[3] * bfhi(z.y));
        *(u32x2*)(a.mixb + tok * 1024 + 256 + c0) = ov;
      }
    }
  }
  __syncthreads();
}

__device__ __forceinline__ void gates_item(const PhaseBArgs& a, LAS unsigned char* lds, int chunk) {
  const int tid = tidx(), w = tid >> 6, lane = tid & 63, fr = lane & 15, fq = lane >> 4;
  const size_t row = (size_t)chunk * 128 + 16 * w + fr;
  f32x4 acc[2];
  small_gemm<2>(lds, a.xb + (size_t)chunk * 128 * 1024, 1024, a.WgT, 1024, 1024, acc);
  const float rinv = rinv_from_ssq(a.ssq, row);
#pragma unroll
  for (int nt = 0; nt < 2; ++nt) {
    const int c0 = nt * 16 + 4 * fq;
    if (c0 < 24) {
      f32x4 o;
#pragma unroll
      for (int e = 0; e < 4; ++e) o[e] = fsigmoid(acc[nt][e] * rinv);
      *(f32x4*)(a.gates + row * 24 + c0) = o;
    }
  }
}

struct CmpSrc { const float* base; const int* pages; };
__device__ __forceinline__ const float* cmp_row_ptr(const CmpSrc& s, int pos) {
  if (s.pages) return s.base + ((size_t)s.pages[pos >> 7] * 128 + (pos & 127)) * 256;
  return s.base + (size_t)pos * 256;
}
__device__ __forceinline__ float gelu_tanh_f(float x) {
  const float u = 0.7978845608028654f * (x + 0.044715f * x * x * x);
  const float e = __expf(2.f * u);
  const float th = 1.f - 2.f / (e + 1.f);
  return 0.5f * x * (1.f + th);
}
template <bool VROWMAJOR>
__device__ __forceinline__ void compress_item(LAS unsigned char* lds, const CmpSrc& src, int g, int kv, const bf16_t* W1T  , const bf16_t* W2T  ,
                                              const float* cbias  , bf16_t* kc_out  , bf16_t* vcT_out  ) {
  const int tid = tidx(), w = tid >> 6, lane = tid & 63, fr = lane & 15, fq = lane >> 4;
  constexpr int ST = 272;
  constexpr int ABUF = 128 * ST;
  constexpr int BUF = 2 * ABUF;
  constexpr int POFF = 0;
  const float* arow[8];
#pragma unroll
  for (int i = 0; i < 8; ++i) { const int idx = i * 512 + tid, piece = idx >> 5, pos = (idx >> 4) & 1; arow[i] = cmp_row_ptr(src, piece * 16 + pos) + kv * 128 + g * 64 + (idx & 15) * 4; }
  const int a_lds = (tid >> 5) * ST + (((tid >> 4) & 1) * 64 + (tid & 15) * 4) * 2;
  const bf16_t* bsrc = W1T + (size_t)(tid >> 4) * 1024 + (tid & 15) * 8;
  const int b_lds = ABUF + (tid >> 4) * ST + (tid & 15) * 16;
  f32x4 acc[8];
#pragma unroll
  for (int nt = 0; nt < 8; ++nt) acc[nt] = (f32x4){0.f, 0.f, 0.f, 0.f};
  u32x4 breg[4]; f32x4 areg[8];
#pragma unroll
  for (int i = 0; i < 4; ++i) breg[i] = *(const u32x4*)(bsrc + (size_t)(32 * i) * 1024);
#pragma unroll
  for (int i = 0; i < 8; ++i) areg[i] = *(const f32x4*)arow[i];
#pragma unroll 1
  for (int c = 0; c < 8; ++c) {
    LAS unsigned char* base = lds + (c & 1) * BUF;
#pragma unroll
    for (int i = 0; i < 4; ++i) *(LAS u32x4*)(base + b_lds + 32 * i * ST) = breg[i];
#pragma unroll
    for (int i = 0; i < 8; ++i) { u32x2 pk; pk.x = cvt_pk_bf16(areg[i][0], areg[i][1]); pk.y = cvt_pk_bf16(areg[i][2], areg[i][3]); *(LAS u32x2*)(base + a_lds + i * 16 * ST) = pk; }
    if (c < 7) {
#pragma unroll
      for (int i = 0; i < 4; ++i) breg[i] = *(const u32x4*)(bsrc + (size_t)(32 * i) * 1024 + (c + 1) * 128);
#pragma unroll
      for (int i = 0; i < 8; ++i) areg[i] = *(const f32x4*)(arow[i] + (size_t)(2 * (c + 1)) * 256);
    }
    lds_barrier();
#pragma unroll
    for (int i = 0; i < 4; ++i) {
      const bf16x8 af = *(const LAS bf16x8*)(base + (16 * w + fr) * ST + i * 64 + fq * 16);
#pragma unroll
      for (int nt = 0; nt < 8; ++nt) {
        const bf16x8 bf = *(const LAS bf16x8*)(base + ABUF + (nt * 16 + fr) * ST + i * 64 + fq * 16);
        acc[nt] = mfma16(bf, af, acc[nt]);
      }
    }
  }
  __syncthreads();
#pragma unroll
  for (int nt = 0; nt < 8; ++nt) *(LAS f32x4*)(lds + POFF + (16 * w + fr) * 528 + (nt * 16 + 4 * fq) * 4) = acc[nt];
  __syncthreads();
  {
    const int i = 16 * w + fr, i1 = i < 127 ? i + 1 : 127;
    f32x4 o[4];
#pragma unroll
    for (int nt = 0; nt < 4; ++nt) o[nt] = (f32x4){0.f, 0.f, 0.f, 0.f};
#pragma unroll
    for (int ks = 0; ks < 2; ++ks) {
      const int k0 = ks * 32 + fq * 8;
      union { bf16x8 v; unsigned u[4]; } hf;
#pragma unroll
      for (int h2 = 0; h2 < 2; ++h2) {
        const f32x4 pa = *(const LAS f32x4*)(lds + POFF + i * 528 + (k0 + 4 * h2) * 4);
        const f32x4 pb = *(const LAS f32x4*)(lds + POFF + i1 * 528 + (64 + k0 + 4 * h2) * 4);
        const f32x4 cb = *(const f32x4*)(cbias + k0 + 4 * h2);
        const f32x4 x = pa + pb + cb;
        hf.u[2 * h2] = cvt_pk_bf16(gelu_tanh_f(x[0]), gelu_tanh_f(x[1]));
        hf.u[2 * h2 + 1] = cvt_pk_bf16(gelu_tanh_f(x[2]), gelu_tanh_f(x[3]));
      }
#pragma unroll
      for (int nt = 0; nt < 4; ++nt) {
        const bf16x8 bf = *(const bf16x8*)(W2T + (size_t)(nt * 16 + fr) * 64 + k0);
        o[nt] = mfma16(bf, hf.v, o[nt]);
      }
    }
    const bool real = i < 127;
#pragma unroll
    for (int nt = 0; nt < 4; ++nt) {
      const int c0 = nt * 16 + 4 * fq;
      const float v0 = real ? o[nt][0] : 0.f, v1 = real ? o[nt][1] : 0.f, v2 = real ? o[nt][2] : 0.f, v3 = real ? o[nt][3] : 0.f;
      if (kv == 0) { u32x2 pk; pk.x = cvt_pk_bf16(v0, v1); pk.y = cvt_pk_bf16(v2, v3); *(u32x2*)(kc_out + (size_t)i * 64 + c0) = pk; }
      else if (VROWMAJOR) { u32x2 pk; pk.x = cvt_pk_bf16(v0, v1); pk.y = cvt_pk_bf16(v2, v3); *(u32x2*)(vcT_out + (size_t)i * 64 + c0) = pk; }
      else { vcT_out[(size_t)(c0 + 0) * 128 + i] = f2bf(v0); vcT_out[(size_t)(c0 + 1) * 128 + i] = f2bf(v1); vcT_out[(size_t)(c0 + 2) * 128 + i] = f2bf(v2); vcT_out[(size_t)(c0 + 3) * 128 + i] = f2bf(v3); }
    }
  }
  __syncthreads();
}

__device__ __forceinline__ void phaseB(LAS unsigned char* lds, const PhaseBArgs& a) {
  const int G = gridDim.x, wg = blockIdx.x;
  REPB(0) for (int it = wg; it < 256; it += G) conv_item<64>(a, lds, it >> 5, it & 31);
  REPB(2) for (int it = wg; it < 32; it += G) {
    const int b = it >> 2, g = (it >> 1) & 1, kv = it & 1;
    CmpSrc src{a.cmp_rows_p + (size_t)b * SEQ * 256, nullptr};
    compress_item<false>(lds, src, g, kv, a.W1T + (size_t)kv * 128 * 1024, a.W2T + (size_t)kv * 4096, a.cbias + kv * 64,
                  a.kcP + ((size_t)b * 2 + g) * 128 * 64, a.vcPT + ((size_t)b * 2 + g) * 64 * 128);
  }
  REPB(1) for (int it = (wg + G - 32 % G) % G; it < 128; it += G) pool_item(a, lds, it >> 4, it & 15);
  REPB(3) for (int it = (wg + G - 128 % G) % G; it < 128; it += G) gates_item(a, lds, it);
}
#ifdef MULTI_LAUNCH
__global__ void __launch_bounds__(512, 2) k_phaseB(PhaseBArgs a) {
  extern __shared__ __attribute__((aligned(16))) unsigned char shm[];
  phaseB((LAS unsigned char*)shm, a);
}
#endif

struct EpiA {
  static constexpr bool PERM = true, AFTER_DRAIN = false;
  int l; int pad_;
  const float* ssq; const float* g_q; const float* g_k; const float* cs;
  bf16_t *glu, *bin, *sza, *szb, *szc, *qb, *ks, *vsT, *kw, *vwT; float* out;
  __device__ __forceinline__ void norm_rope(f32x4 (&v)[2][2], const float* gain, int t, int fq) const {
    float ss = 0.f;
#pragma unroll
    for (int bj = 0; bj < 2; ++bj)
#pragma unroll
      for (int n = 0; n < 2; ++n) ss += (v[bj][n][0] * v[bj][n][0] + v[bj][n][1] * v[bj][n][1]) + (v[bj][n][2] * v[bj][n][2] + v[bj][n][3] * v[bj][n][3]);
    ss += __shfl_xor(ss, 16); ss += __shfl_xor(ss, 32);
    const float rn = rsqrtf(ss * (1.f / 64.f) + 1e-6f);
#pragma unroll
    for (int bj = 0; bj < 2; ++bj)
#pragma unroll
      for (int n = 0; n < 2; ++n) { const f32x4 gg = *(const f32x4*)(gain + 32 * bj + 8 * fq + 4 * n); v[bj][n] = v[bj][n] * rn * gg; }
#pragma unroll
    for (int n = 0; n < 2; ++n) {
      const f32x4 c0 = *(const f32x4*)(cs + t * 16 + 8 * n), c1 = *(const f32x4*)(cs + t * 16 + 8 * n + 4);
      const float cc[4] = {c0[0], c0[2], c1[0], c1[2]}, sn[4] = {c0[1], c0[3], c1[1], c1[3]};
#pragma unroll
      for (int e = 0; e < 4; ++e) {
        const float y = v[0][n][e], pr = __shfl_xor(y, 16);
        const float r0 = y * cc[e] - pr * sn[e], r1 = y * cc[e] + pr * sn[e];
        v[0][n][e] = fq == 0 ? r0 : (fq == 1 ? r1 : y);
      }
    }
  }
  __device__ __forceinline__ void operator()(const f32x4 (&acc)[2][2][4][2], const Unit& u, int wr_, int wc_, int fr_, int fq_) const {
    const int tz = tidx(), wid_ = tz >> 6, wr = wid_ >> 2, wc = wid_ & 3, fr = tz & 15, fq = (tz >> 4) & 3;
    const int pn = u.pn;
    const int row0 = u.pm * 256 + wr * 64 + fr;
    const int jc = 32 * wc + 8 * fq;
#pragma unroll
    for (int ai = 0; ai < 2; ++ai)
#pragma unroll
      for (int m = 0; m < 4; ++m) {
        const int row = row0 + ai * 128 + m * 16;
        const size_t tok = (size_t)row;
        const int b = row >> 11, t = row & 2047;
        float rinv;
        { const f32x4 p = *(const f32x4*)(ssq + tok * 16 + fq * 4); float sq = (p[0] + p[1]) + (p[2] + p[3]); sq += __shfl_xor(sq, 16); sq += __shfl_xor(sq, 32); rinv = rsqrtf(sq * (1.f / 1024.f) + 1e-6f); }
        f32x4 v[2][2];
#pragma unroll
        for (int bj = 0; bj < 2; ++bj)
#pragma unroll
          for (int n = 0; n < 2; ++n) v[bj][n] = acc[ai][bj][m][n] * rinv;
        if (pn < 2) {
          const int c = pn * 128 + jc;
          f32x4 o0, o1;
#pragma unroll
          for (int e = 0; e < 4; ++e) { o0[e] = v[0][0][e] * fsigmoid(v[1][0][e]); o1[e] = v[0][1][e] * fsigmoid(v[1][1][e]); }
          u32x4 pk; pk.x = cvt_pk_bf16(o0[0], o0[1]); pk.y = cvt_pk_bf16(o0[2], o0[3]); pk.z = cvt_pk_bf16(o1[0], o1[1]); pk.w = cvt_pk_bf16(o1[2], o1[3]);
          *(u32x4*)(glu + tok * 256 + c) = pk;
          if (t >= 2018) { float* dst = out + O_CONVP + ((size_t)(l * 8 + b) * 30 + (t - 2018)) * 256 + c; *(f32x4*)dst = o0; *(f32x4*)(dst + 4) = o1; }
        } else if (pn == 3) {
#pragma unroll
          for (int bj = 0; bj < 2; ++bj) {
            const int c = 128 * bj + jc;
            u32x4 pk; pk.x = cvt_pk_bf16(v[bj][0][0], v[bj][0][1]); pk.y = cvt_pk_bf16(v[bj][0][2], v[bj][0][3]); pk.z = cvt_pk_bf16(v[bj][1][0], v[bj][1][1]); pk.w = cvt_pk_bf16(v[bj][1][2], v[bj][1][3]);
            *(u32x4*)(bin + tok * 256 + c) = pk;
            if (t >= 2033) { float* dst = out + O_POOLP + ((size_t)(l * 8 + b) * 15 + (t - 2033)) * 256 + c; *(f32x4*)dst = v[bj][0]; *(f32x4*)(dst + 4) = v[bj][1]; }
          }
        } else if (pn == 2 || pn == 4 || pn >= 10) {
          bf16_t* base = pn == 2 ? sza + tok * 256 : (pn == 4 ? szb + tok * 256 : szc + tok * 512 + (pn - 10) * 256);
#pragma unroll
          for (int bj = 0; bj < 2; ++bj) {
            u32x4 pk; pk.x = cvt_pk_bf16(fsilu(v[bj][0][0]), fsilu(v[bj][0][1])); pk.y = cvt_pk_bf16(fsilu(v[bj][0][2]), fsilu(v[bj][0][3]));
            pk.z = cvt_pk_bf16(fsilu(v[bj][1][0]), fsilu(v[bj][1][1])); pk.w = cvt_pk_bf16(fsilu(v[bj][1][2]), fsilu(v[bj][1][3]));
            *(u32x4*)(base + 128 * bj + jc) = pk;
          }
        } else if (pn <= 6) {
          const int head = (pn - 5) * 4 + wc;
          norm_rope(v, g_q, t, fq);
          const float sc = 0.125f * 1.4426950408889634f;
#pragma unroll
          for (int bj = 0; bj < 2; ++bj) {
            u32x4 pk; pk.x = cvt_pk_bf16(v[bj][0][0] * sc, v[bj][0][1] * sc); pk.y = cvt_pk_bf16(v[bj][0][2] * sc, v[bj][0][3] * sc);
            pk.z = cvt_pk_bf16(v[bj][1][0] * sc, v[bj][1][1] * sc); pk.w = cvt_pk_bf16(v[bj][1][2] * sc, v[bj][1][3] * sc);
            *(u32x4*)(qb + (tok * 8 + head) * 64 + 32 * bj + 8 * fq) = pk;
          }
        } else {
          const int br = pn - 7, kvsel = wc >> 1, g = wc & 1;
          if (kvsel == 0) norm_rope(v, g_k + br * 64, t, fq);
          float* fdst = nullptr;
          if (br == 0) fdst = out + O_CMPP + ((size_t)l * NPT + tok) * 256;
          else if (br == 1) fdst = out + O_SLCP + ((size_t)l * NPT + tok) * 256;
          else if (t >= 1792) fdst = out + O_WINP + ((size_t)(l * 8 + b) * 256 + (t - 1792)) * 256;
          if (fdst) {
#pragma unroll
            for (int bj = 0; bj < 2; ++bj) { float* d2 = fdst + kvsel * 128 + g * 64 + 32 * bj + 8 * fq; *(f32x4*)d2 = v[bj][0]; *(f32x4*)(d2 + 4) = v[bj][1]; }
          }
          if (br >= 1) {
            const size_t bg = (size_t)b * 2 + g;
            if (kvsel == 0) {
              bf16_t* kd = (br == 1 ? ks : kw) + (bg * SEQ + t) * 64;
#pragma unroll
              for (int bj = 0; bj < 2; ++bj) {
                u32x4 pk; pk.x = cvt_pk_bf16(v[bj][0][0], v[bj][0][1]); pk.y = cvt_pk_bf16(v[bj][0][2], v[bj][0][3]); pk.z = cvt_pk_bf16(v[bj][1][0], v[bj][1][1]); pk.w = cvt_pk_bf16(v[bj][1][2], v[bj][1][3]);
                *(u32x4*)(kd + 32 * bj + 8 * fq) = pk;
              }
            } else {
              bf16_t* vd = (br == 1 ? vsT : vwT) + bg * 64 * SEQ + t;
#pragma unroll
              for (int bj = 0; bj < 2; ++bj)
#pragma unroll
                for (int n = 0; n < 2; ++n)
#pragma unroll
                  for (int e = 0; e < 4; ++e) vd[(size_t)(32 * bj + 8 * fq + 4 * n + e) * SEQ] = f2bf(v[bj][n][e]);
            }
          }
        }
      }
  }
};
struct PhaseAArgs { EpiA epi; const bf16_t* xb; const bf16_t* WinT; };
__device__ __forceinline__ void phaseA(LAS unsigned char* lds, const PhaseAArgs& a) {
  pg8::Gemm g{a.xb, a.WinT, NPT, 3072, 1024};
  pg8::StaticOrder S; S.init(NPT, 3072, gridDim.x, blockIdx.x);
  pg8::gemm_phase<EpiA, pg8::StaticOrder, false>(lds, g, S, a.epi, nullptr);
}
#ifdef MULTI_LAUNCH
__global__ void __launch_bounds__(512, 2) k_phaseA(PhaseAArgs a) {
  extern __shared__ __attribute__((aligned(16))) unsigned char shm[];
  phaseA((LAS unsigned char*)shm, a);
}
#endif

__device__ __forceinline__ float wsum(float v) {
#pragma unroll
  for (int o = 32; o > 0; o >>= 1) v += __shfl_xor(v, o);
  return v;
}
__device__ __forceinline__ float wmax(float v) {
#pragma unroll
  for (int o = 32; o > 0; o >>= 1) v = fmaxf(v, __shfl_xor(v, o));
  return v;
}
template <int NT> __device__ __forceinline__ void thin_gemm(const bf16_t* A, int lda, const bf16_t* Bt, int ldb, int K, f32x4 (&acc)[NT], int fr, int fq) {
  const bf16_t* ap = A + (size_t)fr * lda + fq * 8;
  const bf16_t* bp = Bt + (size_t)fr * ldb + fq * 8;
#pragma unroll
  for (int nt = 0; nt < NT; ++nt) acc[nt] = (f32x4){0.f, 0.f, 0.f, 0.f};
#pragma unroll 4
  for (int k0 = 0; k0 < K; k0 += 32) {
    const bf16x8 af = *(const bf16x8*)(ap + k0);
#pragma unroll
    for (int nt = 0; nt < NT; ++nt) { const bf16x8 bf = *(const bf16x8*)(bp + (size_t)nt * 16 * ldb + k0); acc[nt] = mfma16(bf, af, acc[nt]); }
  }
}
__device__ __forceinline__ void s1_unit(LAS unsigned char* lds, const bf16_t* xb_s, const float* ssq_s, const bf16_t* WinT, float* sproj, int u) {
  const int tid = tidx(), w = tid >> 6, lane = tid & 63, fr = lane & 15, fq = lane >> 4;
  const int n0 = 16 * u, row = 16 * w + fr;
  f32x4 acc[1];
  small_gemm<1>(lds, xb_s, 1024, WinT + (size_t)n0 * 1024, 1024, 1024, acc);
  float rinv;
  { const f32x4* pp = (const f32x4*)(ssq_s + (size_t)row * 64); float sq = 0.f;
#pragma unroll
    for (int i = 0; i < 16; ++i) { const f32x4 v = pp[i]; sq += (v[0] + v[1]) + (v[2] + v[3]); }
    rinv = rsqrtf(sq * (1.f / 1024.f) + 1e-6f); }
  const int np = n0 + 4 * fq;
  if (np < 3096) { const int lc = win_logical_col(np); *(f32x4*)(sproj + (size_t)row * 3104 + lc) = acc[0] * rinv; }
}
template <bool LAST> __device__ __forceinline__ void s4_unit(LAS unsigned char* lds, const bf16_t* mix_s, const bf16_t* WoutT, const float* xs, float* xs_out, bf16_t* xb_s, float* ssq_s, int u) {
  const int tid = tidx(), w = tid >> 6, lane = tid & 63, fr = lane & 15, fq = lane >> 4;
  const int n0 = 16 * u, row = 16 * w + fr;
  f32x4 acc[1];
  small_gemm<1>(lds, mix_s, 1024, WoutT + (size_t)n0 * 1024, 1024, 1024, acc);
  const int c = n0 + 4 * fq;
  const f32x4 v = acc[0] + *(const f32x4*)(xs + (size_t)row * 1024 + c);
  *(f32x4*)(xs_out + (size_t)row * 1024 + c) = v;
  if (!LAST) {
    u32x2 pk; pk.x = cvt_pk_bf16(v[0], v[1]); pk.y = cvt_pk_bf16(v[2], v[3]); *(u32x2*)(xb_s + (size_t)row * 1024 + c) = pk;
    float ss = (v[0] * v[0] + v[1] * v[1]) + (v[2] * v[2] + v[3] * v[3]);
    ss += __shfl_xor(ss, 16); ss += __shfl_xor(ss, 32);
    if (fq == 0) ssq_s[(size_t)row * 64 + u] = ss;
  }
}

struct SampArgs {
  int l; int pad_;
  const float* sproj;
  const float *g_q, *g_k, *cs;
  const float *state_conv_l, *state_pool_l;
  const float *w_dw, *b_dw, *ln_g, *ln_b, *w_pw, *b_pw, *w_pool, *pool_scale;
  const float *cache_slc_l, *cache_win_l; const int* page_table;
  const bf16_t *kcS, *vcST;
  float *sq, *srows, *sgates;
  bf16_t* mix_s;
  float* out;
};
__device__ __forceinline__ void s2_item(const SampArgs& a, LAS unsigned char* lds, int b) {
  const int tid = tidx(), w = tid >> 6, lane = tid & 63, l = a.l;
  const float* pr = a.sproj + (size_t)b * 3104;
  LAS float* sh = (LAS float*)lds;
  const float* csp = a.cs + 2048 * 16;
  {
    const float v = pr[C_Q + w * 64 + lane];
    const float y = v * rsqrtf(wsum(v * v) * (1.f / 64.f) + 1e-6f) * a.g_q[lane];
    const float pp = __shfl_xor(y, 8);
    float o = y;
    if (lane < 16) { const int j = lane & 7; const float c = csp[j * 2], sn = csp[j * 2 + 1]; o = lane < 8 ? y * c - pp * sn : y * c + pp * sn; }
    a.sq[(size_t)b * 512 + w * 64 + lane] = o;
  }
  if (w < 6) {
    const int br = w >> 1, g = w & 1;
    const float v = pr[C_KV + br * 256 + g * 64 + lane];
    const float y = v * rsqrtf(wsum(v * v) * (1.f / 64.f) + 1e-6f) * a.g_k[br * 64 + lane];
    const float pp = __shfl_xor(y, 8);
    float o = y;
    if (lane < 16) { const int j = lane & 7; const float c = csp[j * 2], sn = csp[j * 2 + 1]; o = lane < 8 ? y * c - pp * sn : y * c + pp * sn; }
    const float vv = pr[C_KV + br * 256 + 128 + g * 64 + lane];
    a.srows[(size_t)b * 768 + br * 256 + g * 64 + lane] = o;
    a.srows[(size_t)b * 768 + br * 256 + 128 + g * 64 + lane] = vv;
    float* dst = br == 0 ? a.out + O_CMPS + ((size_t)l * NSM + b) * 256 : (br == 1 ? a.out + O_SLCS + ((size_t)l * NSM + b) * 256 : a.out + O_WINS + (((size_t)l * NSM + b) * 256 + 255) * 256);
    dst[g * 64 + lane] = o; dst[128 + g * 64 + lane] = vv;
  }
  if (tid < 24) a.sgates[(size_t)b * 24 + tid] = fsigmoid(pr[C_GATE + tid]);
  float yv = 0.f;
  if (tid < 256) {
    const int c = tid;
    const float glu = pr[C_AVAL + c] * fsigmoid(pr[C_AGATE + c]);
    const float* st = a.state_conv_l + (size_t)b * 30 * 256 + c;
    float* cso = a.out + O_CONVS + ((size_t)l * NSM + b) * 30 * 256 + c;
    float acc = a.b_dw[c];
#pragma unroll
    for (int k = 0; k < 30; ++k) { const float sv = st[k * 256]; acc = fmaf(a.w_dw[k * 256 + c], sv, acc); if (k >= 1) cso[(k - 1) * 256] = sv; }
    acc = fmaf(a.w_dw[30 * 256 + c], glu, acc);
    cso[29 * 256] = glu;
    yv = acc;
  } else {
    const int ch = tid - 256, g = ch >> 6, wn = 2 << g;
    const float cur = pr[C_BIN + ch];
    const float* st = a.state_pool_l + (size_t)b * 15 * 256 + ch;
    float* pso = a.out + O_POOLS + ((size_t)l * NSM + b) * 15 * 256 + ch;
    float total = cur;
#pragma unroll
    for (int j = 1; j < 15; ++j) pso[(j - 1) * 256] = st[j * 256];
    pso[14 * 256] = cur;
    for (int j = 1; j < wn; ++j) total += st[(15 - j) * 256];
    sh[256 + ch] = total / (float)wn - cur;
  }
  { const float s1 = wsum(yv); if (lane == 0) sh[512 + w] = s1; }
  __syncthreads();
  const float mean = (sh[512] + sh[513] + sh[514] + sh[515]) * (1.f / 256.f);
  const float xc = yv - mean;
  { const float s2 = wsum(xc * xc); if (lane == 0) sh[520 + w] = s2; }
  __syncthreads();
  if (tid < 256) {
    const float var = (sh[520] + sh[521] + sh[522] + sh[523]) * (1.f / 256.f);
    const float z = xc * rsqrtf(var + 1e-6f) * a.ln_g[tid] + a.ln_b[tid];
    sh[tid] = fsilu(z);
  }
  __syncthreads();
  {
    const int n = tid & 255, kh = tid >> 8;
    const float* wp = a.w_pw + (size_t)(kh * 128) * 256 + n;
    float o = 0.f;
#pragma unroll 16
    for (int k = 0; k < 128; ++k) o = fmaf(sh[kh * 128 + k], wp[(size_t)k * 256], o);
    sh[528 + kh * 256 + n] = o;
  }
  __syncthreads();
  if (tid < 256) {
    const int n = tid;
    const float o = a.b_pw[n] + sh[528 + n] + sh[528 + 256 + n];
    a.mix_s[(size_t)b * 1024 + n] = f2bf(o * fsilu(pr[C_ZA + n]));
  } else {
    const int ch = tid - 256, g = ch >> 6, e = ch & 63;
    float o = 0.f;
#pragma unroll 16
    for (int c = 0; c < 64; ++c) o = fmaf(sh[256 + g * 64 + c], a.w_pool[(g * 64 + c) * 64 + e], o);
    a.mix_s[(size_t)b * 1024 + 256 + ch] = f2bf(o * a.pool_scale[ch] * fsilu(pr[C_ZB + ch]));
  }
  __syncthreads();
}
__device__ __forceinline__ float dot16(const float (&q)[16], const f32x4& k0, const f32x4& k1, const f32x4& k2, const f32x4& k3) {
  float d = 0.f;
#pragma unroll
  for (int i = 0; i < 4; ++i) { d = fmaf(q[i], k0[i], d); d = fmaf(q[4 + i], k1[i], d); d = fmaf(q[8 + i], k2[i], d); d = fmaf(q[12 + i], k3[i], d); }
  return d;
}
__device__ __forceinline__ void s3_item(const SampArgs& a, LAS unsigned char* lds, int n, int g) {
  const int tid = tidx(), w = tid >> 6, lane = tid & 63;
  const int key_l = lane >> 2, qtr = lane & 3;
  const int ksub = lane >> 4, d4 = lane & 15;
  LAS float* qs = (LAS float*)lds;
  LAS float* sc = qs + 256;
  LAS float* imp = sc + 2048;
  LAS int* sel = (LAS int*)(imp + 64);
  LAS float* red = imp + 128;
  const size_t bg = (size_t)n * 2 + g;
  const float* srow = a.srows + (size_t)n * 768;
  if (tid < 256) qs[tid] = a.sq[(size_t)n * 512 + g * 256 + tid] * 0.125f;
  __syncthreads();
  float q[4][16];
#pragma unroll
  for (int h = 0; h < 4; ++h)
#pragma unroll
    for (int i = 0; i < 16; ++i) q[h][i] = qs[h * 64 + qtr * 16 + i];
  float o_c, o_s, o_w;
#define S3_SOFTMAX(NPL)                                                                              \
  if (w < 4) {                                                                                       \
    float v_[NPL]; float m_ = NEGF;                                                                  \
    _Pragma("unroll") for (int i_ = 0; i_ < NPL; ++i_) { v_[i_] = sc[w * 512 + lane + 64 * i_]; m_ = fmaxf(m_, v_[i_]); } \
    m_ = wmax(m_); float s_ = 0.f;                                                                   \
    _Pragma("unroll") for (int i_ = 0; i_ < NPL; ++i_) { v_[i_] = v_[i_] > -1e29f ? __expf(v_[i_] - m_) : 0.f; s_ += v_[i_]; } \
    s_ = 1.f / fmaxf(wsum(s_), 1e-30f);                                                              \
    _Pragma("unroll") for (int i_ = 0; i_ < NPL; ++i_) sc[w * 512 + lane + 64 * i_] = v_[i_] * s_;   \
  }
#define S3_REDUCE(ACC, OUT)                                                                          \
  _Pragma("unroll") for (int h_ = 0; h_ < 4; ++h_) _Pragma("unroll") for (int e_ = 0; e_ < 4; ++e_) { float t_ = ACC[h_][e_]; t_ += __shfl_xor(t_, 16); t_ += __shfl_xor(t_, 32); ACC[h_][e_] = t_; } \
  if (ksub == 0) { _Pragma("unroll") for (int h_ = 0; h_ < 4; ++h_) *(LAS f32x4*)(red + (w * 4 + h_) * 64 + 4 * d4) = (f32x4){ACC[h_][0], ACC[h_][1], ACC[h_][2], ACC[h_][3]}; } \
  __syncthreads();                                                                                   \
  OUT = 0.f;                                                                                         \
  if (tid < 256) { _Pragma("unroll") for (int w_ = 0; w_ < 8; ++w_) OUT += red[w_ * 256 + tid]; }   \
  __syncthreads();
  {
    const int c = 16 * w + key_l;
    const bf16_t* kr = a.kcS + (bg * 128 + c) * 64 + qtr * 16;
    const u32x4 k0 = *(const u32x4*)kr, k1 = *(const u32x4*)(kr + 8);
    const f32x4 f0 = {bflo(k0.x), bfhi(k0.x), bflo(k0.y), bfhi(k0.y)}, f1 = {bflo(k0.z), bfhi(k0.z), bflo(k0.w), bfhi(k0.w)};
    const f32x4 f2 = {bflo(k1.x), bfhi(k1.x), bflo(k1.y), bfhi(k1.y)}, f3 = {bflo(k1.z), bfhi(k1.z), bflo(k1.w), bfhi(k1.w)};
#pragma unroll
    for (int h = 0; h < 4; ++h) {
      float d = dot16(q[h], f0, f1, f2, f3);
      d += __shfl_xor(d, 1); d += __shfl_xor(d, 2);
      if (qtr == 0) sc[h * 512 + c] = c < 127 ? d : NEGF;
    }
  }
  __syncthreads();
  S3_SOFTMAX(2)
  __syncthreads();
  if (tid < 33) {
    const int s = tid, lo = max(0, 4 * s - 1), hi = min(126, 4 * s + 3);
    float v = 0.f;
    for (int rr = 0; rr < 4; ++rr) for (int c = lo; c <= hi; ++c) v += sc[rr * 512 + c];
    const bool forced = (s == 0) || (s == 32) || (s == 31);
    imp[s] = forced ? 1e4f : v;
  }
  {
    float acc[4][4];
#pragma unroll
    for (int h = 0; h < 4; ++h)
#pragma unroll
      for (int e = 0; e < 4; ++e) acc[h][e] = 0.f;
#pragma unroll
    for (int it = 0; it < 4; ++it) {
      const int c = 16 * w + 4 * it + ksub;
      const u32x2 vv = *(const u32x2*)(a.vcST + (bg * 128 + c) * 64 + 4 * d4);
      const float v0 = bflo(vv.x), v1 = bfhi(vv.x), v2 = bflo(vv.y), v3 = bfhi(vv.y);
#pragma unroll
      for (int h = 0; h < 4; ++h) { const float p = sc[h * 512 + c]; acc[h][0] = fmaf(p, v0, acc[h][0]); acc[h][1] = fmaf(p, v1, acc[h][1]); acc[h][2] = fmaf(p, v2, acc[h][2]); acc[h][3] = fmaf(p, v3, acc[h][3]); }
    }
    S3_REDUCE(acc, o_c)
  }
  if (tid == 0) {
    unsigned long long taken = 0ull;
    for (int k = 0; k < 8; ++k) {
      int best = -1; float bv = -3e38f;
      for (int s = 0; s < 33; ++s) if (!((taken >> s) & 1ull) && imp[s] > bv) { bv = imp[s]; best = s; }
      taken |= 1ull << best; sel[k] = best;
    }
  }
  __syncthreads();
  const int blk = sel[w];
  const float* sl_base;
  if (blk < 32) sl_base = a.cache_slc_l + ((size_t)a.page_table[n * 16 + (blk >> 1)] * 128 + (blk & 1) * 64) * 256 + g * 64;
  else sl_base = srow + 256 + g * 64;
  const float* wbase = a.cache_win_l + ((size_t)n * 256 + 1) * 256 + g * 64;
  f32x4 kk[4][4], vv[16];
#pragma unroll
  for (int ps = 0; ps < 4; ++ps) {
    const int j = 16 * ps + key_l;
    const bool valid = blk < 32 || j == 0;
    const float* kr = sl_base + (size_t)(valid ? j : 0) * 256 + qtr * 16;
#pragma unroll
    for (int i = 0; i < 4; ++i) kk[ps][i] = *(const f32x4*)(kr + 4 * i);
  }
#pragma unroll
  for (int it = 0; it < 16; ++it) {
    const int j = 4 * it + ksub;
    const bool valid = blk < 32 || j == 0;
    vv[it] = *(const f32x4*)(sl_base + (size_t)(valid ? j : 0) * 256 + 128 + 4 * d4);
  }
#pragma unroll
  for (int ps = 0; ps < 4; ++ps) {
    const int j = 16 * ps + key_l;
    const bool valid = blk < 32 || j == 0;
#pragma unroll
    for (int h = 0; h < 4; ++h) {
      float d = dot16(q[h], kk[ps][0], kk[ps][1], kk[ps][2], kk[ps][3]);
      d += __shfl_xor(d, 1); d += __shfl_xor(d, 2);
      if (qtr == 0) sc[h * 512 + w * 64 + j] = valid ? d : NEGF;
    }
  }
  f32x4 wk[2][4];
#pragma unroll
  for (int ps = 0; ps < 2; ++ps) {
    const int i = 32 * w + 16 * ps + key_l;
    const float* kr = (i < 255 ? wbase + (size_t)i * 256 : srow + 512 + g * 64) + qtr * 16;
#pragma unroll
    for (int e = 0; e < 4; ++e) wk[ps][e] = *(const f32x4*)(kr + 4 * e);
  }
  __syncthreads();
  S3_SOFTMAX(8)
  __syncthreads();
  {
    float acc[4][4];
#pragma unroll
    for (int h = 0; h < 4; ++h)
#pragma unroll
      for (int e = 0; e < 4; ++e) acc[h][e] = 0.f;
#pragma unroll
    for (int it = 0; it < 16; ++it) {
      const int j = 4 * it + ksub;
#pragma unroll
      for (int h = 0; h < 4; ++h) { const float p = sc[h * 512 + w * 64 + j];
#pragma unroll
        for (int e = 0; e < 4; ++e) acc[h][e] = fmaf(p, vv[it][e], acc[h][e]); }
    }
    S3_REDUCE(acc, o_s)
  }
  f32x4 wv[8];
#pragma unroll
  for (int it = 0; it < 8; ++it) {
    const int i = 32 * w + 4 * it + ksub;
    wv[it] = *(const f32x4*)((i < 255 ? wbase + (size_t)i * 256 : srow + 512 + g * 64) + 128 + 4 * d4);
  }
#pragma unroll
  for (int ps = 0; ps < 2; ++ps) {
    const int i = 32 * w + 16 * ps + key_l;
#pragma unroll
    for (int h = 0; h < 4; ++h) {
      float d = dot16(q[h], wk[ps][0], wk[ps][1], wk[ps][2], wk[ps][3]);
      d += __shfl_xor(d, 1); d += __shfl_xor(d, 2);
      if (qtr == 0) sc[h * 512 + i] = d;
    }
  }
  __syncthreads();
  S3_SOFTMAX(4)
  __syncthreads();
  {
    float acc[4][4];
#pragma unroll
    for (int h = 0; h < 4; ++h)
#pragma unroll
      for (int e = 0; e < 4; ++e) acc[h][e] = 0.f;
#pragma unroll
    for (int it = 0; it < 8; ++it) {
      const int i = 32 * w + 4 * it + ksub;
#pragma unroll
      for (int h = 0; h < 4; ++h) { const float p = sc[h * 512 + i];
#pragma unroll
        for (int e = 0; e < 4; ++e) acc[h][e] = fmaf(p, wv[it][e], acc[h][e]); }
    }
    S3_REDUCE(acc, o_w)
  }
  if (tid < 256) {
    const int h = g * 4 + (tid >> 6), d = tid & 63;
    const float* gt = a.sgates + (size_t)n * 24;
    const float o = gt[h] * o_c + gt[8 + h] * o_s + gt[16 + h] * o_w;
    a.mix_s[(size_t)n * 1024 + 512 + h * 64 + d] = f2bf(o * fsilu(a.sproj[(size_t)n * 3104 + C_ZC + h * 64 + d]));
  }
  __syncthreads();
#undef S3_SOFTMAX
#undef S3_REDUCE
}

#ifdef MULTI_LAUNCH
__global__ void __launch_bounds__(512, 2) k_s1(const bf16_t* xb_s, const float* ssq_s, const bf16_t* WinT, float* sproj) {
  extern __shared__ __attribute__((aligned(16))) unsigned char shm[];
  for (int u = blockIdx.x; u < 194; u += gridDim.x) s1_unit((LAS unsigned char*)shm, xb_s, ssq_s, WinT, sproj, u);
}
#endif
#ifdef MULTI_LAUNCH
__global__ void __launch_bounds__(512, 2) k_s2(SampArgs a) {
  extern __shared__ __attribute__((aligned(16))) unsigned char shm[];
  for (int b = blockIdx.x; b < NSM; b += gridDim.x) s2_item(a, (LAS unsigned char*)shm, b);
}
#endif
struct CmpSArgs { const float* cache_cmp_l; const int* page_table; const bf16_t *W1T, *W2T; const float* cbias; bf16_t *kcS, *vcST; };
#ifdef MULTI_LAUNCH
__global__ void __launch_bounds__(512, 2) k_cmps(CmpSArgs a) {
  extern __shared__ __attribute__((aligned(16))) unsigned char shm[];
  for (int it = blockIdx.x; it < 512; it += gridDim.x) {
    const int n = it >> 2, g = (it >> 1) & 1, kv = it & 1;
    CmpSrc src{a.cache_cmp_l, a.page_table + n * 16};
    compress_item<true>((LAS unsigned char*)shm, src, g, kv, a.W1T + (size_t)kv * 128 * 1024, a.W2T + (size_t)kv * 4096, a.cbias + kv * 64,
                  a.kcS + ((size_t)n * 2 + g) * 128 * 64, a.vcST + ((size_t)n * 2 + g) * 64 * 128);
  }
}
#endif
#ifdef MULTI_LAUNCH
__global__ void __launch_bounds__(512, 2) k_s3(SampArgs a) {
  extern __shared__ __attribute__((aligned(16))) unsigned char shm[];
  for (int it = blockIdx.x; it < 256; it += gridDim.x) s3_item(a, (LAS unsigned char*)shm, it >> 1, it & 1);
}
#endif
#ifdef MULTI_LAUNCH
template <bool LAST> __global__ void __launch_bounds__(512, 2) k_s4(const bf16_t* mix_s, const bf16_t* WoutT, const float* xs, float* xs_out, bf16_t* xb_s, float* ssq_s) {
  extern __shared__ __attribute__((aligned(16))) unsigned char shm[];
  for (int u = blockIdx.x; u < 64; u += gridDim.x) s4_unit<LAST>((LAS unsigned char*)shm, mix_s, WoutT, xs, xs_out, xb_s, ssq_s, u);
}
#endif
__device__ __forceinline__ void wins_copy(const float* cache_win_l, float* out_l, int part, int nparts) {
  const size_t total4 = (size_t)NSM * 255 * 64;
  for (size_t i = (size_t)part * 512 + tidx(); i < total4; i += (size_t)nparts * 512) {
    const size_t n = i / (255 * 64), rem = i % (255 * 64);
    *(f32x4*)(out_l + n * 65536 + rem * 4) = *(const f32x4*)(cache_win_l + n * 65536 + 256 + rem * 4);
  }
}
#ifdef MULTI_LAUNCH
__global__ void __launch_bounds__(512, 2) k_wins(const float* cache_win_l, float* out_l) { wins_copy(cache_win_l, out_l, blockIdx.x, gridDim.x); }
#endif
}
namespace fast {
constexpr size_t al256(size_t x) { return (x + 255) & ~(size_t)255; }
constexpr size_t WS_BAR = 0;
constexpr size_t WS_CS = al256(WS_BAR + XCD_BAR_WORDS * 4);
constexpr size_t WS_SSQ = al256(WS_CS + 2049 * 16 * 4);
constexpr size_t WS_GATES = al256(WS_SSQ + (size_t)NTOK * 16 * 4);
constexpr size_t WS_CBIAS = al256(WS_GATES + (size_t)NPT * 24 * 4);
constexpr size_t WS_SPROJ = al256(WS_CBIAS + 256 * 4);
constexpr size_t WS_SQ = al256(WS_SPROJ + (size_t)NSM * 3104 * 4);
constexpr size_t WS_SROWS = al256(WS_SQ + (size_t)NSM * 512 * 4);
constexpr size_t WS_SGATES = al256(WS_SROWS + (size_t)NSM * 768 * 4);
constexpr size_t WS_X1P = al256(WS_SGATES + (size_t)NSM * 24 * 4);
constexpr size_t WS_X1S = al256(WS_X1P + (size_t)NPT * 1024 * 4);
constexpr size_t WS_XB = al256(WS_X1S + (size_t)NSM * 1024 * 4);
constexpr size_t WS_MIXB = al256(WS_XB + (size_t)NTOK * 1024 * 2);
constexpr size_t WS_QB = al256(WS_MIXB + (size_t)NTOK * 1024 * 2);
constexpr size_t WS_KSB = al256(WS_QB + (size_t)NPT * 512 * 2);
constexpr size_t WS_VST = al256(WS_KSB + (size_t)NPT * 128 * 2);
constexpr size_t WS_KWB = al256(WS_VST + (size_t)NPT * 128 * 2);
constexpr size_t WS_VWT = al256(WS_KWB + (size_t)NPT * 128 * 2);
constexpr size_t WS_KCP = al256(WS_VWT + (size_t)NPT * 128 * 2);
constexpr size_t WS_VCPT = al256(WS_KCP + (size_t)8 * 2 * 128 * 64 * 2);
constexpr size_t WS_SZC = al256(WS_VCPT + (size_t)8 * 2 * 128 * 64 * 2);
constexpr size_t WS_GLUB = al256(WS_SZC + (size_t)NPT * 512 * 2);
constexpr size_t WS_BINB = al256(WS_GLUB + (size_t)NPT * 256 * 2);
constexpr size_t WS_SZA = al256(WS_BINB + (size_t)NPT * 256 * 2);
constexpr size_t WS_SZB = al256(WS_SZA + (size_t)NPT * 256 * 2);
constexpr size_t WS_WINT = al256(WS_SZB + (size_t)NPT * 256 * 2);
constexpr size_t WS_WOUTT = al256(WS_WINT + (size_t)2 * 3104 * 1024 * 2);
constexpr size_t WS_WPWT = al256(WS_WOUTT + (size_t)2 * 1024 * 1024 * 2);
constexpr size_t WS_WPOOLT = al256(WS_WPWT + (size_t)2 * 65536 * 2);
constexpr size_t WS_W1T = al256(WS_WPOOLT + (size_t)2 * 4 * 4096 * 2);
constexpr size_t WS_W2T = al256(WS_W1T + (size_t)2 * 2 * 128 * 1024 * 2);
constexpr size_t WS_KCS = al256(WS_W2T + (size_t)2 * 2 * 4096 * 2);
constexpr size_t WS_VCST = al256(WS_KCS + (size_t)NSM * 2 * 128 * 64 * 2);
constexpr size_t WS_SSQS = al256(WS_VCST + (size_t)NSM * 2 * 128 * 64 * 2);
constexpr size_t WS_END = al256(WS_SSQS + (size_t)NSM * 64 * 4);

struct MegaArgsK {
  const float *x_prompt, *x_sample, *state_conv, *state_pool, *cache_win, *cache_cmp, *cache_slc; const int* page_table;
  const float *w_norm, *w_in, *w_out, *w_dw, *b_dw, *ln_g, *ln_b, *w_pw, *b_pw, *w_pool, *pool_scale, *g_q, *g_k, *cmp_pe, *cmp_w1, *cmp_w2;
  float* out;
  unsigned char* ws;
#ifdef PROBE_REP
  int rep[8];
#endif
};
struct MegaArgs {
  const float *x_prompt, *x_sample, *state_conv, *state_pool, *cache_win, *cache_cmp, *cache_slc; const int* page_table;
  const float *w_norm, *w_in, *w_out, *w_dw, *b_dw, *ln_g, *ln_b, *w_pw, *b_pw, *w_pool, *pool_scale, *g_q, *g_k, *cmp_pe, *cmp_w1, *cmp_w2;
  float* out;
  unsigned* bar;
  float *cs, *ssq, *ssqs, *gatesf, *cbias, *sproj, *sq, *srows, *sgates, *x1p, *x1s;
  bf16_t *xb, *mixb, *qb, *ksb, *vsT, *kwb, *vwT, *kcP, *vcPT, *szc, *glub, *binb, *sza, *szb, *WinT, *WoutT, *WpwT, *WpoolT, *W1T, *W2T, *kcS, *vcST;
#ifdef PROBE_REP
  int rep[8];
#endif
};
#ifdef PROBE_REP
#define REP(i) _Pragma("unroll 1") for (int rep_ = 0; rep_ < a.rep[i]; ++rep_)
#else
#define REP(i)
#endif
#ifdef PROBE_REPX
#define REPX(i) _Pragma("unroll 1") for (int repx_ = 0; repx_ < ((PROBE_REPX >> (4 * (i))) & 15); ++repx_)
#else
#define REPX(i)
#endif
__device__ __forceinline__ MegaArgs expand_args(const MegaArgsK& k) {
  MegaArgs a;
  a.x_prompt = k.x_prompt; a.x_sample = k.x_sample; a.state_conv = k.state_conv; a.state_pool = k.state_pool; a.cache_win = k.cache_win; a.cache_cmp = k.cache_cmp; a.cache_slc = k.cache_slc;
  a.page_table = k.page_table; a.w_norm = k.w_norm; a.w_in = k.w_in; a.w_out = k.w_out; a.w_dw = k.w_dw; a.b_dw = k.b_dw; a.ln_g = k.ln_g; a.ln_b = k.ln_b; a.w_pw = k.w_pw; a.b_pw = k.b_pw;
  a.w_pool = k.w_pool; a.pool_scale = k.pool_scale; a.g_q = k.g_q; a.g_k = k.g_k; a.cmp_pe = k.cmp_pe; a.cmp_w1 = k.cmp_w1; a.cmp_w2 = k.cmp_w2; a.out = k.out;
  unsigned char* w = k.ws;
  asm volatile("" : "+s"(w));
  a.bar = (unsigned*)(w + WS_BAR); a.cs = (float*)(w + WS_CS); a.ssq = (float*)(w + WS_SSQ); a.ssqs = (float*)(w + WS_SSQS); a.gatesf = (float*)(w + WS_GATES); a.cbias = (float*)(w + WS_CBIAS);
  a.sproj = (float*)(w + WS_SPROJ); a.sq = (float*)(w + WS_SQ); a.srows = (float*)(w + WS_SROWS); a.sgates = (float*)(w + WS_SGATES); a.x1p = (float*)(w + WS_X1P); a.x1s = (float*)(w + WS_X1S);
  a.xb = (bf16_t*)(w + WS_XB); a.mixb = (bf16_t*)(w + WS_MIXB); a.qb = (bf16_t*)(w + WS_QB); a.ksb = (bf16_t*)(w + WS_KSB); a.vsT = (bf16_t*)(w + WS_VST); a.kwb = (bf16_t*)(w + WS_KWB); a.vwT = (bf16_t*)(w + WS_VWT);
  a.kcP = (bf16_t*)(w + WS_KCP); a.vcPT = (bf16_t*)(w + WS_VCPT); a.szc = (bf16_t*)(w + WS_SZC); a.glub = (bf16_t*)(w + WS_GLUB); a.binb = (bf16_t*)(w + WS_BINB); a.sza = (bf16_t*)(w + WS_SZA); a.szb = (bf16_t*)(w + WS_SZB);
  a.WinT = (bf16_t*)(w + WS_WINT); a.WoutT = (bf16_t*)(w + WS_WOUTT); a.WpwT = (bf16_t*)(w + WS_WPWT); a.WpoolT = (bf16_t*)(w + WS_WPOOLT); a.W1T = (bf16_t*)(w + WS_W1T); a.W2T = (bf16_t*)(w + WS_W2T);
  a.kcS = (bf16_t*)(w + WS_KCS); a.vcST = (bf16_t*)(w + WS_VCST);
#ifdef PROBE_REP
  for (int i = 0; i < 8; ++i) a.rep[i] = k.rep[i];
#endif
  return a;
}

template <int MODE>
__device__ __forceinline__ void transpose_tile(const float* src, int ld_src, const float* scale, bf16_t* dst, int N, int K, int n0, int k0, LAS float* t) {
  const int tid = tidx();
#pragma unroll
  for (int j = 0; j < 8; ++j) {
    const int i = tid + j * 512, k = i >> 5, n = (i & 31) * 4;
    const int col = MODE == 1 ? win_logical_col(n0 + n) : (n0 + n);
    f32x4 v = {0.f, 0.f, 0.f, 0.f};
    if (n0 + n < N && k0 + k < K && col >= 0) { v = *(const f32x4*)(src + (size_t)(k0 + k) * ld_src + col); if (scale) v = v * scale[k0 + k]; }
    t[k * 129 + n] = v[0]; t[k * 129 + n + 1] = v[1]; t[k * 129 + n + 2] = v[2]; t[k * 129 + n + 3] = v[3];
  }
  __syncthreads();
#pragma unroll
  for (int j = 0; j < 4; ++j) {
    const int i = tid + j * 512, n = i >> 4, k = (i & 15) * 8;
    if (n0 + n < N && k0 + k < K) {
      u32x4 pk;
      pk.x = cvt_pk_bf16(t[k * 129 + n], t[(k + 1) * 129 + n]); pk.y = cvt_pk_bf16(t[(k + 2) * 129 + n], t[(k + 3) * 129 + n]);
      pk.z = cvt_pk_bf16(t[(k + 4) * 129 + n], t[(k + 5) * 129 + n]); pk.w = cvt_pk_bf16(t[(k + 6) * 129 + n], t[(k + 7) * 129 + n]);
      *(u32x4*)(dst + (size_t)(n0 + n) * K + k0 + k) = pk;
    }
  }
  __syncthreads();
}

#ifdef PROBE_P0CUT
#define P0_MARK() do { if (threadIdx.x == 0) { const unsigned dt_ = (unsigned)(__builtin_amdgcn_s_memrealtime() - p0_t0); atomicMax(a.bar + 64, dt_); } } while (0)
#endif
__device__ __forceinline__ void phase0(const MegaArgs& a, LAS unsigned char* lds) {
#ifdef PROBE_P0CUT
  const unsigned long long p0_t0 = __builtin_amdgcn_s_memrealtime();
#endif
  const int G = gridDim.x, wg = blockIdx.x, tid = tidx();
  LAS float* t = (LAS float*)lds;
  for (int it = wg; it < 2 * 306; it += G) {
    const int l = it / 306; int r = it % 306;
    if (r < 200) { transpose_tile<1>(a.w_in + (size_t)l * 1024 * D_IN, D_IN, a.w_norm + l * 1024, a.WinT + (size_t)l * 3104 * 1024, 3104, 1024, (r % 25) * 128, (r / 25) * 128, t); continue; }
    r -= 200;
    if (r < 64) { transpose_tile<0>(a.w_out + (size_t)l * 1024 * 1024, 1024, nullptr, a.WoutT + (size_t)l * 1024 * 1024, 1024, 1024, (r & 7) * 128, (r >> 3) * 128, t); continue; }
    r -= 64;
    if (r < 4) { transpose_tile<0>(a.w_pw + (size_t)l * 65536, 256, nullptr, a.WpwT + (size_t)l * 65536, 256, 256, (r & 1) * 128, (r >> 1) * 128, t); continue; }
    r -= 4;
    if (r < 4) { transpose_tile<0>(a.w_pool + (size_t)(l * 4 + r) * 4096, 64, nullptr, a.WpoolT + (size_t)(l * 4 + r) * 4096, 64, 64, 0, 0, t); continue; }
    r -= 4;
    if (r < 32) { const int kv = r >> 4, half = (r >> 3) & 1, kt = r & 7;
      transpose_tile<0>(a.cmp_w1 + ((size_t)(l * 2 + kv) * 2048 + half * 1024) * 64, 64, nullptr, a.W1T + ((size_t)(l * 2 + kv) * 128 + half * 64) * 1024, 64, 1024, 0, kt * 128, t); continue; }
    r -= 32;
    transpose_tile<0>(a.cmp_w2 + (size_t)(l * 2 + r) * 4096, 64, nullptr, a.W2T + (size_t)(l * 2 + r) * 4096, 64, 64, 0, 0, t);
  }
#if defined(PROBE_P0CUT) && PROBE_P0CUT == 1
  P0_MARK();
#endif
  for (int lk = G - 1 - wg; lk >= 0 && lk < 4; lk += G) {
    const int e = tid & 63, part = tid >> 6;
    const float* pp = a.cmp_pe + (size_t)lk * 2048 + part * 256; const float* ww = a.cmp_w1 + ((size_t)lk * 2048 + part * 256) * 64 + e;
    float acc = 0.f;
    for (int k = 0; k < 256; ++k) acc = fmaf(pp[k], ww[(size_t)k * 64], acc);
    t[part * 64 + e] = acc;
    __syncthreads();
    if (tid < 64) { float s = 0.f; for (int p2 = 0; p2 < 8; ++p2) s += t[p2 * 64 + tid]; a.cbias[lk * 64 + tid] = s; }
    __syncthreads();
  }
  for (int i = wg * 512 + tid; i < 2049 * 8; i += G * 512) {
    const int pos = i >> 3, j = i & 7;
    const double ang = (double)pos * pow(500000.0, -(double)j / 8.0);
    a.cs[i * 2] = (float)cos(ang); a.cs[i * 2 + 1] = (float)sin(ang);
  }
#if defined(PROBE_P0CUT) && PROBE_P0CUT == 2
  P0_MARK();
#endif
  for (int r0 = (wg * 8 + (tid >> 6)) * 4; r0 < NTOK; r0 += G * 32) {
    const int lane = tid & 63;
    f32x4 v[4][4];
#pragma unroll
    for (int rr = 0; rr < 4; ++rr) {
      const int row = r0 + rr;
      const float* x = row < NPT ? a.x_prompt + (size_t)row * 1024 : a.x_sample + (size_t)(row - NPT) * 1024;
#pragma unroll
      for (int j = 0; j < 4; ++j) v[rr][j] = *(const f32x4*)(x + j * 256 + lane * 4);
    }
#pragma unroll
    for (int rr = 0; rr < 4; ++rr) {
      const int row = r0 + rr;
#pragma unroll
      for (int j = 0; j < 4; ++j) {
        const f32x4 vv = v[rr][j];
        u32x2 pk; pk.x = cvt_pk_bf16(vv[0], vv[1]); pk.y = cvt_pk_bf16(vv[2], vv[3]);
        *(u32x2*)(a.xb + (size_t)row * 1024 + j * 256 + lane * 4) = pk;
        float ss = vv[0] * vv[0] + vv[1] * vv[1] + vv[2] * vv[2] + vv[3] * vv[3];
        ss += __shfl_xor(ss, 1); ss += __shfl_xor(ss, 2);
        if (row >= NPT && (lane & 3) == 0) a.ssqs[(size_t)(row - NPT) * 64 + j * 16 + (lane >> 2)] = ss;
        ss += __shfl_xor(ss, 4); ss += __shfl_xor(ss, 8);
        if (row < NPT && (lane & 15) == 0) a.ssq[(size_t)row * 16 + j * 4 + (lane >> 4)] = ss;
      }
    }
  }
}

#ifdef PROBE_TS
#ifndef PROBE_TS_LO
#define PROBE_TS_LO 0
#define PROBE_TS_HI 100000
#endif
#define TS_MARK(i) do { if (threadIdx.x == 0 && (int)blockIdx.x >= PROBE_TS_LO && (int)blockIdx.x < PROBE_TS_HI) { const unsigned long long now_ = __builtin_amdgcn_s_memrealtime(); if ((i) == PROBE_TS_SEL) ts_begin = now_; \
    if ((i) == PROBE_TS_SEL + 1) { const unsigned dt_ = (unsigned)(now_ - ts_begin); if (PROBE_TS_MIN) atomicMin(ts_word, dt_); else atomicMax(ts_word, dt_); } } } while (0)
#else
#define TS_MARK(i)
#endif
__global__ void __launch_bounds__(512, 2) k_mega(MegaArgsK ka) {
  const MegaArgs a = expand_args(ka);
#ifdef PROBE_TS
  unsigned long long ts_begin = 0ull; unsigned* ts_word = a.bar + 64;
  if (PROBE_TS_MIN && blockIdx.x == 0 && threadIdx.x == 0) atomicExch(ts_word, 0x7fffffffu);
#endif
  extern __shared__ __attribute__((aligned(16))) unsigned char shm[];
  LAS unsigned char* lds = (LAS unsigned char*)shm;
  volatile LAS unsigned* xbw = (volatile LAS unsigned*)(lds + LDS_BYTES - 16);
  if (tidx() == 0) { xbw[0] = 0u; xbw[1] = 0u; xbw[2] = 0u; xbw[3] = 0u; }
  __syncthreads();
  (void)xcd_barrier_post(a.bar, xbw);
#define GRID_BARRIER() do { XcdBarrier b_; b_.bar = (unsigned*)(ka.ws + WS_BAR); b_.x = xb_xcc_id(); b_.st = xbw; xcd_barrier(b_); } while (0)
  const int G = gridDim.x, wg = blockIdx.x;

  TS_MARK(0);
  { const MegaArgs a0 = expand_args(ka); REP(0) phase0(a0, lds); }
  TS_MARK(1);
  GRID_BARRIER();

#define MAKE_SA()                                                                                                                                   \
    SampArgs sa;                                                                                                                                  \
    sa.l = l; sa.pad_ = 0; sa.sproj = a.sproj; sa.g_q = a.g_q + l * 64; sa.g_k = a.g_k + l * 192; sa.cs = a.cs;                                   \
    sa.state_conv_l = a.state_conv + (size_t)l * NSM * 30 * 256; sa.state_pool_l = a.state_pool + (size_t)l * NSM * 15 * 256;                     \
    sa.w_dw = a.w_dw + l * 31 * 256; sa.b_dw = a.b_dw + l * 256; sa.ln_g = a.ln_g + l * 256; sa.ln_b = a.ln_b + l * 256; sa.w_pw = a.w_pw + (size_t)l * 65536; sa.b_pw = a.b_pw + l * 256; \
    sa.w_pool = a.w_pool + (size_t)l * 4 * 4096; sa.pool_scale = a.pool_scale + l * 256;                                                          \
    sa.cache_slc_l = a.cache_slc + (size_t)l * N_PHYS * 128 * 256; sa.cache_win_l = a.cache_win + (size_t)l * NSM * 65536; sa.page_table = a.page_table; \
    sa.kcS = a.kcS; sa.vcST = a.vcST; sa.sq = a.sq; sa.srows = a.srows; sa.sgates = a.sgates; sa.mix_s = a.mixb + (size_t)NPT * 1024; sa.out = a.out;
#ifdef PROBE_REP
#define BA_PROBE() { const int rb[4] = {PROBE_REPB}; for (int i = 0; i < 4; ++i) ba.repb[i] = rb[i]; }
#else
#define BA_PROBE()
#endif
#define MAKE_BA()                                                                                                                                   \
      PhaseBArgs ba;                                                                                                                              \
      ba.glu = a.glub; ba.bin = a.binb; ba.sza = a.sza; ba.szb = a.szb; ba.xb = a.xb; ba.ssq = a.ssq;                                              \
      ba.WpwT = a.WpwT + (size_t)l * 65536; ba.WpoolT = a.WpoolT + (size_t)l * 4 * 4096; ba.WgT = a.WinT + ((size_t)l * 3104 + 3072) * 1024;       \
      ba.W1T = a.W1T + (size_t)l * 2 * 128 * 1024; ba.W2T = a.W2T + (size_t)l * 2 * 4096; ba.cbias = a.cbias + l * 128;                           \
      ba.w_dw = a.w_dw + l * 31 * 256; ba.b_dw = a.b_dw + l * 256; ba.ln_g = a.ln_g + l * 256; ba.ln_b = a.ln_b + l * 256; ba.b_pw = a.b_pw + l * 256; ba.pool_scale = a.pool_scale + l * 256; \
      ba.cmp_rows_p = a.out + O_CMPP + (size_t)l * NPT * 256;                                                                                     \
      ba.mixb = a.mixb; ba.kcP = a.kcP; ba.vcPT = a.vcPT; ba.gates = a.gatesf;                                                                    \
      BA_PROBE()
#pragma unroll 1
  for (int l = 0; l < 2; ++l) {
    TS_MARK(2 + 10 * l);
    REPX(0) {
    const MegaArgs a = expand_args(ka);
    const bf16_t* WinT_l = a.WinT + (size_t)l * 3104 * 1024;
    {
      PhaseAArgs aa;
      aa.epi.l = l; aa.epi.pad_ = 0; aa.epi.ssq = a.ssq; aa.epi.g_q = a.g_q + l * 64; aa.epi.g_k = a.g_k + l * 192; aa.epi.cs = a.cs;
      aa.epi.glu = a.glub; aa.epi.bin = a.binb; aa.epi.sza = a.sza; aa.epi.szb = a.szb; aa.epi.szc = a.szc; aa.epi.qb = a.qb;
      aa.epi.ks = a.ksb; aa.epi.vsT = a.vsT; aa.epi.kw = a.kwb; aa.epi.vwT = a.vwT; aa.epi.out = a.out;
      aa.xb = a.xb; aa.WinT = WinT_l;
      REP(1) phaseA(lds, aa);
    }
    TS_MARK(3 + 10 * l);
    for (int u = wg; u < 194; u += G) s1_unit(lds, a.xb + (size_t)NPT * 1024, a.ssqs, WinT_l, a.sproj, u);
    REP(7) for (int it = wg; it < 512; it += G) {
      const int n = it >> 2, g = (it >> 1) & 1, kv = it & 1;
      CmpSrc src{a.cache_cmp + (size_t)l * N_PHYS * 128 * 256, a.page_table + n * 16};
      compress_item<true>(lds, src, g, kv, a.W1T + ((size_t)l * 2 + kv) * 128 * 1024, a.W2T + ((size_t)l * 2 + kv) * 4096, a.cbias + l * 128 + kv * 64,
                    a.kcS + ((size_t)n * 2 + g) * 128 * 64, a.vcST + ((size_t)n * 2 + g) * 64 * 128);
    }
    }
    TS_MARK(4 + 10 * l);
    GRID_BARRIER();
    TS_MARK(5 + 10 * l);
    REPX(1) {
    const MegaArgs a = expand_args(ka);
    MAKE_SA()
    {
      MAKE_BA()
      REP(3) phaseB(lds, ba);
    }
    if (G == 256) {
      const int b = wg >= 160 ? wg - 160 : (wg >= 32 && wg < 64 ? 96 + wg - 32 : -1);
      if (b >= 0) { REP(2) s2_item(sa, lds, b); }
    } else {
      for (int b = wg; b < NSM; b += G) s2_item(sa, lds, b);
    }
    }
    TS_MARK(6 + 10 * l);
    GRID_BARRIER();
    TS_MARK(7 + 10 * l);
    REPX(2) {
    const MegaArgs a = expand_args(ka);
    {
      PhaseCArgs ca{a.qb, a.ksb, a.vsT, a.kwb, a.vwT, a.kcP, a.vcPT, a.szc, a.gatesf, a.mixb, a.g_k + l * 192};
      REP(4) phaseC(lds, ca);
    }
    TS_MARK(8 + 10 * l);
    MAKE_SA()
    REP(5) for (int it = wg; it < 256; it += G) s3_item(sa, lds, it >> 1, it & 1);
    }
    TS_MARK(9 + 10 * l);
    GRID_BARRIER();
    TS_MARK(10 + 10 * l);
    REPX(3) {
    const MegaArgs a = expand_args(ka);
    const float* xp = l == 0 ? a.x_prompt : a.x1p;
    const float* xs = l == 0 ? a.x_sample : a.x1s;
    float* xp_out = l == 0 ? a.x1p : a.out + O_YP;
    float* xs_out = l == 0 ? a.x1s : a.out + O_YS;
    {
      PhaseDArgs da{a.mixb, a.WoutT + (size_t)l * 1024 * 1024, xp, xp_out, a.xb, a.ssq};
      REP(6) { if (l == 0) phaseD<false>(lds, da); else phaseD<true>(lds, da); }
    }
    if (G > 64 && wg >= 64) wins_copy(a.cache_win + (size_t)l * NSM * 65536, a.out + O_WINS + (size_t)l * NSM * 65536, wg - 64, G - 64);
    else if (G <= 64) wins_copy(a.cache_win + (size_t)l * NSM * 65536, a.out + O_WINS + (size_t)l * NSM * 65536, wg, G);
    if (l == 0) { for (int u = wg; u < 64; u += G) s4_unit<false>(lds, a.mixb + (size_t)NPT * 1024, a.WoutT + (size_t)l * 1024 * 1024, xs, xs_out, a.xb + (size_t)NPT * 1024, a.ssqs, u); }
    else { for (int u = wg; u < 64; u += G) s4_unit<true>(lds, a.mixb + (size_t)NPT * 1024, a.WoutT + (size_t)l * 1024 * 1024, xs, xs_out, a.xb + (size_t)NPT * 1024, a.ssqs, u); }
    }
    TS_MARK(11 + 10 * l);
    if (l == 0) GRID_BARRIER();
  }
#undef MAKE_SA
#undef MAKE_BA
#ifdef PROBE_TS
  GRID_BARRIER();
  if (blockIdx.x == 0 && threadIdx.x == 0) {
    const unsigned v = __hip_atomic_load(ts_word, __ATOMIC_RELAXED, __HIP_MEMORY_SCOPE_AGENT);
    const unsigned long long t0 = __builtin_amdgcn_s_memrealtime();
    while (__builtin_amdgcn_s_memrealtime() - t0 < (unsigned long long)v * PROBE_TS_K) __builtin_amdgcn_s_sleep(8);
  }
#endif
}
}
extern "C" void kernel_launch(void* const* d_in, const int* in_sizes, int n_in, void* d_out, int out_size, void* d_ws, size_t ws_size, hipStream_t stream) {
  using fast::bf16_t;
  static int grid = 0;
  if (grid == 0) {
    int dev = 0, cus = 0, per_cu = 0;
    (void)hipGetDevice(&dev);
    (void)hipDeviceGetAttribute(&cus, hipDeviceAttributeMultiprocessorCount, dev);
    (void)hipFuncSetAttribute((const void*)fast::k_mega, hipFuncAttributeMaxDynamicSharedMemorySize, fast::LDS_BYTES);
    if (hipOccupancyMaxActiveBlocksPerMultiprocessor(&per_cu, (const void*)fast::k_mega, 512, fast::LDS_BYTES) != hipSuccess || per_cu < 1) per_cu = 1;
    (void)hipGetLastError();
    grid = cus > 0 ? cus : 256;
  }
  fast::MegaArgsK a{};
  a.x_prompt = (const float*)d_in[0]; a.x_sample = (const float*)d_in[1]; a.state_conv = (const float*)d_in[2]; a.state_pool = (const float*)d_in[3];
  a.cache_win = (const float*)d_in[4]; a.cache_cmp = (const float*)d_in[5]; a.cache_slc = (const float*)d_in[6]; a.page_table = (const int*)d_in[7];
  a.w_norm = (const float*)d_in[8]; a.w_in = (const float*)d_in[9]; a.w_out = (const float*)d_in[10]; a.w_dw = (const float*)d_in[11]; a.b_dw = (const float*)d_in[12];
  a.ln_g = (const float*)d_in[13]; a.ln_b = (const float*)d_in[14]; a.w_pw = (const float*)d_in[15]; a.b_pw = (const float*)d_in[16]; a.w_pool = (const float*)d_in[17];
  a.pool_scale = (const float*)d_in[18]; a.g_q = (const float*)d_in[19]; a.g_k = (const float*)d_in[20]; a.cmp_pe = (const float*)d_in[21]; a.cmp_w1 = (const float*)d_in[22]; a.cmp_w2 = (const float*)d_in[23];
  a.out = (float*)d_out;
  a.ws = (unsigned char*)d_ws;
#ifdef PROBE_REP
  { const int rr[8] = {PROBE_REP}; for (int i = 0; i < 8; ++i) a.rep[i] = rr[i]; }
#endif
  (void)hipMemsetAsync((unsigned char*)d_ws + fast::WS_BAR, 0, XCD_BAR_WORDS * 4, stream);
  hipLaunchKernelGGL(fast::k_mega, dim3(grid), dim3(512), fast::LDS_BYTES, stream, a);
}
```

```cpp
#include <hip/hip_runtime.h>
#include <stdint.h>
#include <stdio.h>
__device__ __forceinline__ int tidx() { int t = threadIdx.x; asm volatile("" : "+v"(t)); return t; }

constexpr int NPT = 16384, NSM = 128, NTOK = NPT + NSM, SEQ = 2048;
constexpr int D_IN = 3096;
constexpr int C_AVAL = 0, C_AGATE = 256, C_ZA = 512, C_BIN = 768, C_ZB = 1024, C_Q = 1280, C_KV = 1792, C_GATE = 2560, C_ZC = 2584;
constexpr int N_PHYS = 2560;
constexpr float NEGF = -1e30f;

constexpr size_t O_YP = 0;
constexpr size_t O_YS = O_YP + (size_t)NPT * 1024;
constexpr size_t O_CONVP = O_YS + (size_t)NSM * 1024;
constexpr size_t O_POOLP = O_CONVP + 2ull * 8 * 30 * 256;
constexpr size_t O_WINP = O_POOLP + 2ull * 8 * 15 * 256;
constexpr size_t O_CMPP = O_WINP + 2ull * 8 * 256 * 256;
constexpr size_t O_SLCP = O_CMPP + 2ull * 8 * 2048 * 256;
constexpr size_t O_CONVS = O_SLCP + 2ull * 8 * 2048 * 256;
constexpr size_t O_POOLS = O_CONVS + 2ull * 128 * 30 * 256;
constexpr size_t O_WINS = O_POOLS + 2ull * 128 * 15 * 256;
constexpr size_t O_CMPS = O_WINS + 2ull * 128 * 256 * 256;
constexpr size_t O_SLCS = O_CMPS + 2ull * 128 * 256;
constexpr size_t O_END = O_SLCS + 2ull * 128 * 256;


namespace pg8 {
#define PG8_LAS __attribute__((address_space(3)))
typedef unsigned short bf16_t;
typedef short bf16x8 __attribute__((ext_vector_type(8)));
typedef float f32x4 __attribute__((ext_vector_type(4)));
typedef unsigned u32x4 __attribute__((ext_vector_type(4)));
constexpr int BM = 256, BK = 64, HALF = 128, HTB = HALF * BK * 2  , STAGE_BYTES = 8 * HTB, NXCD = 8, WGM = 8;

__host__ __device__ __forceinline__ int lds_byte(int r, int c) { const int st = (r >> 4) * 2 + (c >> 5), rr = r & 15, cc = c & 31, ob = rr * 64 + cc * 2; return st * 1024 + (ob ^ (((ob >> 9) & 1) << 5)); }
__host__ __device__ __forceinline__ void stage_rc(int b, int& R, int& C) { const int st = b / 1024, sb = b % 1024, swz = sb ^ (((sb >> 9) & 1) << 5); R = (st >> 1) * 16 + swz / 64; C = (st & 1) * 32 + (swz % 64) / 2; }
__host__ __device__ __forceinline__ int perm32(int rho) { const int n = rho >> 4, i = rho & 15; return 8 * (i >> 2) + 4 * n + (i & 3); }

struct Unit { int pm, pn; };
struct Gemm { const bf16_t* A; const bf16_t* Bt; int M, N, K; };

struct StaticOrder {
    int nM, nN, nwg, G, c;
    __host__ __device__ void init(int M, int N, int G_, int c_) { nM = M / BM; nN = N / BM; nwg = nM * nN; G = G_; c = c_; }
    __host__ __device__ bool next(int i, Unit& u) const {
        const long L = (long)i * G + c; if (L >= nwg) return false;
        int wgid = (int)L; { const int q = nwg / NXCD, r = nwg % NXCD, xcd = wgid % NXCD, off = wgid / NXCD; wgid = (xcd < r ? xcd * (q + 1) : r * (q + 1) + (xcd - r) * q) + off; }
        const int nig = WGM * nN, gid = wgid / nig, fm = gid * WGM, gsz = (nM - fm) < WGM ? (nM - fm) : WGM;
        u.pm = fm + ((wgid % nig) % gsz); u.pn = (wgid % nig) / gsz; return true;
    }
    __device__ __forceinline__ void a_ready(const Unit&) const {}
    __device__ __forceinline__ void done(const Unit&) const {}
};
__device__ __forceinline__ unsigned cvt_pk_bf16(float lo, float hi) { unsigned r; asm volatile("v_cvt_pk_bf16_f32 %0, %1, %2" : "=v"(r) : "v"(lo), "v"(hi)); return r; }

template <class Epi, class Sched, bool STAMP = false>
__device__ __forceinline__ void gemm_phase(PG8_LAS unsigned char* lds, const Gemm g, const Sched& S, const Epi& E, unsigned long long* stamps) {
    const int tid = tidx(), wid = __builtin_amdgcn_readfirstlane(tid >> 6), lane = tid & 63, wr = wid >> 2, wc = wid & 3, fr = lane & 15, fq = lane >> 4;
    const int K = g.K, nt = K / BK;
    int ts_lo = 0, ts_hi = 0, nts = 0; const unsigned long long rt_entry = STAMP ? (unsigned long long)wall_clock64() : 0ull;
#define PG8_STAMP() do { if (STAMP && wid == 0 && nts < 64) { const unsigned long long _c = (unsigned long long)clock64(); \
        ts_lo = (lane == nts) ? (int)(unsigned)_c : ts_lo; ts_hi = (lane == nts) ? (int)(unsigned)(_c >> 32) : ts_hi; ++nts; } } while (0)
    PG8_STAMP();
    unsigned voffA[2], voffB[2];
#pragma unroll
    for (int i = 0; i < 2; ++i) { int R, C; stage_rc(tid * 16 + i * 8192, R, C); const int Rb = Epi::PERM ? ((R & ~31) + perm32(R & 31)) : R;
        voffA[i] = (unsigned)(R * K + C) * 2u; voffB[i] = (unsigned)(Rb * K + C) * 2u; }
    const size_t kstep = (size_t)(BK * 2);
    const size_t hstep = (size_t)HALF * K * 2;
    const size_t tstep = 2 * hstep;
    const unsigned ldsw = (unsigned)wid * 1024u;
    const int aoff = lds_byte(wr * 64 + fr, fq * 8), boff = lds_byte(wc * 32 + fr, fq * 8);
#define PG8_SA(b, h) (((b) * 2 + (h)) * HTB)
#define PG8_SB(b, h) ((4 + (b) * 2 + (h)) * HTB)
#define PG8_STAGE(bufoff, gbase, voff) do { _Pragma("unroll") for (int _i = 0; _i < 2; ++_i) \
        __builtin_amdgcn_global_load_lds((const unsigned*)((const char*)(gbase) + (voff)[_i]), (PG8_LAS unsigned*)(lds + (bufoff) + ldsw + _i * 8192), 16, 0, 0); } while (0)
#define PG8_LDA(dst, b, h) do { _Pragma("unroll") for (int m = 0; m < 4; ++m) _Pragma("unroll") for (int k = 0; k < 2; ++k) dst[m][k] = *(const PG8_LAS bf16x8*)(lds + PG8_SA(b, h) + aoff + m * 2048 + k * 1024); } while (0)
#define PG8_LDB(dst, b, h) do { _Pragma("unroll") for (int n = 0; n < 2; ++n) _Pragma("unroll") for (int k = 0; k < 2; ++k) dst[n][k] = *(const PG8_LAS bf16x8*)(lds + PG8_SB(b, h) + boff + n * 2048 + k * 1024); } while (0)
#define PG8_MMA(ai, bj, At, Bt) do { __builtin_amdgcn_s_setprio(1); _Pragma("unroll") for (int m = 0; m < 4; ++m) _Pragma("unroll") for (int n = 0; n < 2; ++n) _Pragma("unroll") for (int k = 0; k < 2; ++k) \
        acc[ai][bj][m][n] = __builtin_amdgcn_mfma_f32_16x16x32_bf16(Bt[n][k], At[m][k], acc[ai][bj][m][n], 0, 0, 0); __builtin_amdgcn_s_setprio(0); } while (0)
#define PG8_WAIT_V(n) asm volatile("s_waitcnt vmcnt(" #n ")" ::: "memory")
#define PG8_WAIT_L(n) asm volatile("s_waitcnt lgkmcnt(" #n ")" ::: "memory")
#define PG8_BAR __builtin_amdgcn_s_barrier()
#define PG8_SCHED __builtin_amdgcn_sched_barrier(0)
    Unit cur, nxt; int ui = 0;
    if (!S.next(0, cur)) return;
    f32x4 acc[2][2][4][2];
#pragma unroll
    for (int a = 0; a < 2; ++a)
#pragma unroll
        for (int b = 0; b < 2; ++b)
#pragma unroll
            for (int m = 0; m < 4; ++m)
#pragma unroll
                for (int n = 0; n < 2; ++n) acc[a][b][m][n] = (f32x4){0.f, 0.f, 0.f, 0.f};
    bf16x8 At[4][2], B0[2][2], B1[2][2];
    const char* cA = (const char*)g.A + (size_t)cur.pm * tstep; const char* cB = (const char*)g.Bt + (size_t)cur.pn * tstep;
    S.a_ready(cur);
    PG8_STAGE(PG8_SB(0, 0), cB, voffB); PG8_STAGE(PG8_SA(0, 0), cA, voffA); PG8_STAGE(PG8_SB(0, 1), cB + hstep, voffB); PG8_STAGE(PG8_SA(0, 1), cA + hstep, voffA);
    if (wr == 1) PG8_BAR;
    PG8_WAIT_V(4); PG8_BAR;
    PG8_STAGE(PG8_SB(1, 0), cB + kstep, voffB); PG8_STAGE(PG8_SA(1, 0), cA + kstep, voffA); PG8_STAGE(PG8_SB(1, 1), cB + hstep + kstep, voffB);
    PG8_WAIT_V(6); PG8_BAR;
    PG8_STAMP();
    for (;;) {
        const bool has_next = S.next(ui + 1, nxt);
        const char* nA = has_next ? (const char*)g.A + (size_t)nxt.pm * tstep : cA; const char* nB = has_next ? (const char*)g.Bt + (size_t)nxt.pn * tstep : cB;
        for (int t = 0; t < nt; t += 2) {
            const bool last = (t == nt - 2);
            const char* a1 = cA + (size_t)(t + 1) * kstep;
            const char* a2 = last ? nA : cA + (size_t)(t + 2) * kstep; const char* b2 = last ? nB : cB + (size_t)(t + 2) * kstep;
            const char* a3 = a2 + kstep; const char* b3 = b2 + kstep;
            if (last && has_next) S.a_ready(nxt);
            PG8_LDB(B0, 0, 0); PG8_SCHED; PG8_LDA(At, 0, 0); PG8_STAGE(PG8_SA(1, 1), a1 + hstep, voffA);
            PG8_WAIT_L(8); PG8_BAR; PG8_WAIT_L(0); PG8_MMA(0, 0, At, B0); PG8_BAR; PG8_SCHED;
            PG8_LDB(B1, 0, 1); PG8_STAGE(PG8_SB(0, 0), b2, voffB);
            PG8_BAR; PG8_WAIT_L(0); PG8_MMA(0, 1, At, B1); PG8_BAR;
            PG8_LDA(At, 0, 1); PG8_STAGE(PG8_SA(0, 0), a2, voffA);
            PG8_BAR; PG8_WAIT_L(0); PG8_MMA(1, 0, At, B0); PG8_BAR; PG8_SCHED;
            PG8_STAGE(PG8_SB(0, 1), b2 + hstep, voffB);
            PG8_WAIT_V(6); PG8_BAR; PG8_MMA(1, 1, At, B1); PG8_BAR;
            PG8_LDB(B0, 1, 0); PG8_SCHED; PG8_LDA(At, 1, 0); PG8_STAGE(PG8_SA(0, 1), a2 + hstep, voffA);
            PG8_WAIT_L(8); PG8_BAR; PG8_WAIT_L(0); PG8_MMA(0, 0, At, B0); PG8_BAR; PG8_SCHED;
            PG8_LDB(B1, 1, 1); PG8_STAGE(PG8_SB(1, 0), b3, voffB);
            PG8_BAR; PG8_WAIT_L(0); PG8_MMA(0, 1, At, B1); PG8_BAR;
            PG8_LDA(At, 1, 1); PG8_STAGE(PG8_SA(1, 0), a3, voffA);
            PG8_BAR; PG8_WAIT_L(0); PG8_MMA(1, 0, At, B0); PG8_BAR; PG8_SCHED;
            PG8_STAGE(PG8_SB(1, 1), b3 + hstep, voffB);
            PG8_WAIT_V(6); PG8_BAR; PG8_MMA(1, 1, At, B1); PG8_BAR;
        }
        PG8_STAMP();
        if constexpr (!Epi::AFTER_DRAIN) { E(acc, cur, wr, wc, fr, fq); S.done(cur); }
        PG8_STAMP();
        if (!has_next) break;
#pragma unroll
        for (int a = 0; a < 2; ++a)
#pragma unroll
            for (int b = 0; b < 2; ++b)
#pragma unroll
                for (int m = 0; m < 4; ++m)
#pragma unroll
                    for (int n = 0; n < 2; ++n) acc[a][b][m][n] = (f32x4){0.f, 0.f, 0.f, 0.f};
        cur = nxt; cA = nA; cB = nB; ++ui;
    }
    PG8_WAIT_V(0);
    if (wr == 0) PG8_BAR;
    PG8_BAR;
    if constexpr (Epi::AFTER_DRAIN) { E.fused(acc, cur, wr, wc, fr, fq, lds, wid, lane); S.done(cur); }
    PG8_STAMP();
    if (STAMP && wid == 0) { stamps[lane] = lane < nts ? (((unsigned long long)(unsigned)ts_hi << 32) | (unsigned)ts_lo) : 0ull;
        if (lane == 62) stamps[62] = rt_entry; if (lane == 63) stamps[63] = (unsigned long long)wall_clock64(); }
#undef PG8_STAMP
#undef PG8_SA
#undef PG8_SB
#undef PG8_STAGE
#undef PG8_LDA
#undef PG8_LDB
#undef PG8_MMA
#undef PG8_WAIT_V
#undef PG8_WAIT_L
#undef PG8_BAR
#undef PG8_SCHED
}
}
#define XB_TMO      128
#define XB_XCNT(j)  (256  + 64 * (j))
#define XB_XSUB(j)  (1280 + 64 * (j))
#define XB_XGEN(j)  (2304 + 64 * (j))
#define XB_TOP      3328
#define XB_TOPGEN   3392
#define XCD_BAR_WORDS 3456
#define XB_SPIN_CAP (1u << 18)
#ifndef LAS
#define LAS __attribute__((address_space(3)))
#endif

__device__ __forceinline__ unsigned xb_ld(unsigned* p)              { return __hip_atomic_load(p, __ATOMIC_RELAXED, __HIP_MEMORY_SCOPE_AGENT); }
__device__ __forceinline__ unsigned xb_add(unsigned* p, unsigned v) { return __hip_atomic_fetch_add(p, v, __ATOMIC_RELAXED, __HIP_MEMORY_SCOPE_AGENT); }
__device__ __forceinline__ unsigned xb_xcc_id() { return (unsigned)__builtin_amdgcn_s_getreg((3 << 11) | 20) & 0xFu; }
#define XB_SPIN(cond, bar) do { unsigned _sp = 0; while (cond) { __builtin_amdgcn_s_sleep(1); \
    if ((++_sp & 255u) == 0u) { if (xb_ld(&(bar)[XB_TMO])) break; if (_sp > XB_SPIN_CAP) { atomicAdd(&(bar)[XB_TMO], 1u); break; } } } } while (0)

struct XcdBarrier {
    unsigned* bar; unsigned x;
    volatile LAS unsigned* st;
};

__device__ __forceinline__ XcdBarrier xcd_barrier_post(unsigned* bar, volatile LAS unsigned* st) {
    XcdBarrier b; b.bar = bar; b.x = xb_xcc_id(); b.st = st;
    if (threadIdx.x == 0) (void)xb_add(&bar[XB_XCNT(b.x)], 1u);
    return b;
}
__device__ __forceinline__ void xcd_barrier_complete(unsigned* bar, unsigned x, unsigned& nloc, unsigned& nx) {
    const unsigned G = gridDim.x * gridDim.y * gridDim.z;
    unsigned sum, cnt, mine, sp = 0u;
    for (;;) {
        sum = 0u; cnt = 0u; mine = 0u;
#pragma unroll
        for (unsigned j = 0; j < 16; ++j) { const unsigned c = xb_ld(&bar[XB_XCNT(j)]); sum += c; cnt += (c > 0u) ? 1u : 0u; mine = (j == x) ? c : mine; }
        if (sum == G) break;
        __builtin_amdgcn_s_sleep(1);
        if ((++sp & 255u) == 0u) { if (xb_ld(&bar[XB_TMO])) break; if (sp > XB_SPIN_CAP) { atomicAdd(&bar[XB_TMO], 1u); break; } }
    }
    nloc = mine > 0u ? mine : 1u; nx = cnt > 0u ? cnt : 1u;
}

__device__ __forceinline__ void xcd_barrier(const XcdBarrier& b) {
    asm volatile("s_waitcnt vmcnt(0)" ::: "memory");
    __syncthreads();
    if (threadIdx.x == 0) {
        unsigned* bar = b.bar;
        __builtin_amdgcn_s_waitcnt(0);
        unsigned nloc = b.st[0], nx = b.st[1];
        if (nloc == 0u) { xcd_barrier_complete(bar, b.x, nloc, nx); b.st[0] = nloc; b.st[1] = nx; }
        const unsigned old = xb_add(&bar[XB_XSUB(b.x)], 1u);
        const unsigned gen = old / nloc;
        if (old + 1u == (gen + 1u) * nloc) {
            __builtin_amdgcn_fence(__ATOMIC_RELEASE, "agent");
            asm volatile("s_waitcnt vmcnt(0)" ::: "memory");
            const unsigned og = xb_add(&bar[XB_TOP], 1u);
            const unsigned tg = og / nx;
            if (og + 1u == (tg + 1u) * nx) xb_add(&bar[XB_TOPGEN], 1u);
            else XB_SPIN(xb_ld(&bar[XB_TOPGEN]) == tg, bar);
            __builtin_amdgcn_fence(__ATOMIC_ACQUIRE, "agent");
            xb_add(&bar[XB_XGEN(b.x)], 1u);
            asm volatile("s_waitcnt vmcnt(0)" ::: "memory");
        } else {
            XB_SPIN(xb_ld(&bar[XB_XGEN(b.x)]) == gen, bar);
            __builtin_amdgcn_fence(__ATOMIC_ACQUIRE, "agent");
            asm volatile("s_waitcnt vmcnt(0)" ::: "memory");
        }
    }
    __syncthreads();
}

namespace fast {
using pg8::bf16_t; using pg8::bf16x8; using pg8::f32x4; using pg8::Unit;
typedef float f32x2_c __attribute__((ext_vector_type(2)));
typedef __bf16 bf16x2_c __attribute__((ext_vector_type(2)));
__device__ __forceinline__ unsigned cvt_pk_bf16(float lo, float hi) { const f32x2_c v = {lo, hi}; return __builtin_bit_cast(unsigned, __builtin_convertvector(v, bf16x2_c)); }
typedef unsigned u32x2 __attribute__((ext_vector_type(2)));
typedef float f32x2 __attribute__((ext_vector_type(2)));
typedef unsigned u32x4 __attribute__((ext_vector_type(4)));
#ifndef LAS
#define LAS __attribute__((address_space(3)))
#endif
constexpr int LDS_BYTES = 144 * 1024;
__device__ __forceinline__ void lds_barrier() { asm volatile("s_waitcnt lgkmcnt(0)" ::: "memory"); __builtin_amdgcn_s_barrier(); asm volatile("" ::: "memory"); }
__device__ __forceinline__ float bf2f(bf16_t b) { return __uint_as_float(((unsigned)b) << 16); }
__device__ __forceinline__ float bflo(unsigned u) { return __uint_as_float(u << 16); }
__device__ __forceinline__ float bfhi(unsigned u) { return __uint_as_float(u & 0xffff0000u); }
__device__ __forceinline__ bf16_t f2bf(float f) { return (bf16_t)(cvt_pk_bf16(f, 0.f) & 0xffffu); }

#ifdef MULTI_LAUNCH
__global__ void k_bridge_mix(const float* mix, bf16_t* mixb, size_t n) {
  size_t i = ((size_t)blockIdx.x * blockDim.x + tidx()) * 2;
  if (i < n) *(unsigned*)(mixb + i) = cvt_pk_bf16(mix[i], mix[i + 1]);
}
#endif

template <bool LAST> struct EpiD {
  static constexpr bool PERM = true, AFTER_DRAIN = false;
  const float* resid; float* xout; bf16_t* xb; float* ssq;
  __device__ __forceinline__ void operator()(const f32x4 (&acc)[2][2][4][2], const Unit& u, int wr_, int wc_, int fr_, int fq_) const {
    const int tz = tidx(), wid_ = tz >> 6, wr = wid_ >> 2, wc = wid_ & 3, fr = tz & 15, fq = (tz >> 4) & 3;
    const int row0 = u.pm * 256 + wr * 64 + fr, col0 = u.pn * 256 + wc * 32 + 8 * fq;
#pragma unroll
    for (int ai = 0; ai < 2; ++ai)
#pragma unroll
      for (int m = 0; m < 4; ++m) {
        const size_t row = (size_t)(row0 + ai * 128 + m * 16);
        float ss = 0.f;
#pragma unroll
        for (int bj = 0; bj < 2; ++bj) {
          const size_t o = row * 1024 + col0 + bj * 128;
          const f32x4 r0 = *(const f32x4*)(resid + o), r1 = *(const f32x4*)(resid + o + 4);
          const f32x4 v0 = acc[ai][bj][m][0] + r0, v1 = acc[ai][bj][m][1] + r1;
          *(f32x4*)(xout + o) = v0; *(f32x4*)(xout + o + 4) = v1;
          if (!LAST) {
            u32x4 pk; pk.x = cvt_pk_bf16(v0[0], v0[1]); pk.y = cvt_pk_bf16(v0[2], v0[3]); pk.z = cvt_pk_bf16(v1[0], v1[1]); pk.w = cvt_pk_bf16(v1[2], v1[3]);
            *(u32x4*)(xb + o) = pk;
            ss += v0[0] * v0[0] + v0[1] * v0[1] + v0[2] * v0[2] + v0[3] * v0[3] + v1[0] * v1[0] + v1[1] * v1[1] + v1[2] * v1[2] + v1[3] * v1[3];
          }
        }
        if (!LAST) {
          ss += __shfl_xor(ss, 16); ss += __shfl_xor(ss, 32);
          if (fq == 0) ssq[row * 16 + u.pn * 4 + wc] = ss;
        }
      }
  }
};
struct PhaseDArgs { const bf16_t* mixb; const bf16_t* WoutT; const float* resid; float* xout; bf16_t* xb; float* ssq; };
template <bool LAST> __device__ __forceinline__ void phaseD(LAS unsigned char* lds, const PhaseDArgs& a) {
  pg8::Gemm g{a.mixb, a.WoutT, NPT, 1024, 1024};
  pg8::StaticOrder S; S.init(NPT, 1024, gridDim.x, blockIdx.x);
  EpiD<LAST> E{a.resid, a.xout, a.xb, a.ssq};
  pg8::gemm_phase<EpiD<LAST>, pg8::StaticOrder, false>(lds, g, S, E, nullptr);
}
#ifdef MULTI_LAUNCH
template <bool LAST> __global__ void __launch_bounds__(512, 2) k_phaseD(PhaseDArgs a) {
  extern __shared__ __attribute__((aligned(16))) unsigned char shm[];
  phaseD<LAST>((LAS unsigned char*)shm, a);
}
#endif

__device__ __forceinline__ int win_logical_col(int np) {
  if (np >= 3072) return np < 3096 ? C_GATE + (np - 3072) : -1;
  const int tile = np >> 8, j = np & 255, bj = j >> 7, wc = (j >> 5) & 3, i = j & 31, jj = j & 127;
  switch (tile) {
    case 0: case 1: return (bj ? C_AGATE : C_AVAL) + tile * 128 + jj;
    case 2: return C_ZA + j;
    case 3: return C_BIN + j;
    case 4: return C_ZB + j;
    case 5: case 6: return C_Q + ((tile - 5) * 4 + wc) * 64 + bj * 32 + i;
    case 7: case 8: case 9: return C_KV + (tile - 7) * 256 + wc * 64 + bj * 32 + i;
    default: return C_ZC + (tile - 10) * 256 + j;
  }
}
#ifdef MULTI_LAUNCH
template <int MODE  >
__global__ void __launch_bounds__(256) k_transpose_w(const float* src, int ld_src, const float* scale, bf16_t* dst, int N, int K) {
  __shared__ float t[64][65];
  const int n0 = blockIdx.x * 64, k0 = blockIdx.y * 64, tid = tidx();
  for (int i = tid; i < 4096; i += 256) {
    const int k = i >> 6, n = i & 63;
    int col = MODE == 1 ? win_logical_col(n0 + n) : (n0 + n);
    float v = 0.f;
    if (n0 + n < N && col >= 0) { v = src[(size_t)(k0 + k) * ld_src + col]; if (scale) v *= scale[k0 + k]; }
    t[k][n] = v;
  }
  __syncthreads();
  for (int i = tid; i < 2048; i += 256) {
    const int n = i >> 5, k = (i & 31) * 2;
    if (n0 + n < N) *(unsigned*)(dst + (size_t)(n0 + n) * K + k0 + k) = cvt_pk_bf16(t[k][n], t[k + 1][n]);
  }
}
#endif

#ifdef MULTI_LAUNCH
__global__ void k_bridge_q(const float* qbuf, bf16_t* qb, size_t n) {
  size_t i = ((size_t)blockIdx.x * blockDim.x + tidx()) * 2;
  const float sc = 0.125f * 1.4426950408889634f;
  if (i < n) *(unsigned*)(qb + i) = cvt_pk_bf16(qbuf[i] * sc, qbuf[i + 1] * sc);
}
#endif
#ifdef MULTI_LAUNCH
__global__ void k_bridge_kv(const float* rows, int br, bf16_t* kk, bf16_t* vT) {
  size_t i = (size_t)blockIdx.x * blockDim.x + tidx();
  if (i >= (size_t)NPT * 128) return;
  const int d = (int)(i & 63), g = (int)((i >> 6) & 1); const size_t tok = i >> 7; const int b = (int)(tok / SEQ), t = (int)(tok % SEQ);
  kk[(((size_t)b * 2 + g) * SEQ + t) * 64 + d] = f2bf(rows[tok * 768 + br * 256 + g * 64 + d]);
  vT[(((size_t)b * 2 + g) * 64 + d) * SEQ + t] = f2bf(rows[tok * 768 + br * 256 + 128 + g * 64 + d]);
}
#endif
#ifdef MULTI_LAUNCH
__global__ void k_bridge_kc(const float* kc, const float* vc, bf16_t* kcP, bf16_t* vcPT, int nseq) {
  size_t i = (size_t)blockIdx.x * blockDim.x + tidx();
  if (i >= (size_t)nseq * 128 * 128) return;
  const int d = (int)(i & 63), g = (int)((i >> 6) & 1), c = (int)((i >> 7) & 127), b = (int)(i >> 14);
  const float kv = c < 127 ? kc[i] : 0.f, vv = c < 127 ? vc[i] : 0.f;
  kcP[(((size_t)b * 2 + g) * 128 + c) * 64 + d] = f2bf(kv);
  vcPT[(((size_t)b * 2 + g) * 64 + d) * 128 + c] = f2bf(vv);
}
#endif
#ifdef MULTI_LAUNCH
__global__ void k_bridge_silu(const float* proj, int col0, int ncol, bf16_t* dst, size_t ntok) {
  size_t i = (size_t)blockIdx.x * blockDim.x + tidx();
  if (i >= ntok * ncol) return;
  const size_t tok = i / ncol; const int c = (int)(i % ncol);
  const float z = proj[tok * D_IN + col0 + c];
  dst[i] = f2bf(z / (1.f + __expf(-z)));
}
#endif

#ifndef SKIPCOND
#define SKIPCOND __any(mine)
#endif
typedef float f32x16 __attribute__((ext_vector_type(16)));
typedef short bf16x4 __attribute__((ext_vector_type(4)));
struct PhaseCArgs { const bf16_t *qb, *ks, *vsT, *kw, *vwT, *kcP, *vcPT, *szc; const float* gates; bf16_t* mixb; const float* g_k;
#ifdef PROBE_CHECK
  unsigned* seldump;
#endif
#ifdef PROBE_REP
  int repc[2];
#endif
};
#define REPC

__device__ __forceinline__ f32x16 qk_tile(const bf16_t* krows, const bf16x8 (&qf)[4], int c32, int hh) {
  f32x16 s;
#pragma unroll
  for (int i = 0; i < 16; ++i) s[i] = 0.f;
  const bf16_t* kp = krows + (size_t)c32 * 64 + 8 * hh;
  bf16x8 kf[4];
#pragma unroll
  for (int ks = 0; ks < 4; ++ks) kf[ks] = *(const bf16x8*)(kp + 16 * ks);
#pragma unroll
  for (int ks = 0; ks < 4; ++ks) s = __builtin_amdgcn_mfma_f32_32x32x16_bf16(kf[ks], qf[ks], s, 0, 0, 0);
  return s;
}
__device__ __forceinline__ void pv_tile(f32x16 (&o)[2], const bf16_t* vT, int ldv, const f32x16& p, int c32, int hh) {
#pragma unroll
  for (int s = 0; s < 2; ++s) {
    union { bf16x8 v; unsigned u[4]; } pf;
#pragma unroll
    for (int j = 0; j < 4; ++j) pf.u[j] = cvt_pk_bf16(p[8 * s + 2 * j], p[8 * s + 2 * j + 1]);
#pragma unroll
    for (int dt = 0; dt < 2; ++dt) {
      const bf16_t* vp = vT + (size_t)(32 * dt + c32) * ldv + 16 * s + 4 * hh;
      union { bf16x8 v; bf16x4 h[2]; } vf;
      vf.h[0] = *(const bf16x4*)(vp);
      vf.h[1] = *(const bf16x4*)(vp + 8);
      o[dt] = __builtin_amdgcn_mfma_f32_32x32x16_bf16(vf.v, pf.v, o[dt], 0, 0, 0);
    }
  }
}

constexpr int AT_KB = 64 * 144, AT_VB = 64 * 136, AT_STAGE = AT_KB + AT_VB;
constexpr int AT_NBUF = 3;
constexpr int AT_IMP = AT_NBUF * AT_STAGE;
constexpr int AT_OT = AT_IMP + 8192;
struct StageRegs { u32x4 k; u32x4 v; };
__device__ __forceinline__ StageRegs stage_load(const bf16_t* ksrc, const bf16_t* vsrc, int ldv, int tid) {
  StageRegs r;
  r.k = *(const u32x4*)(ksrc + (size_t)(tid >> 3) * 64 + (tid & 7) * 8);
  r.v = *(const u32x4*)(vsrc + (size_t)(tid >> 3) * ldv + (tid & 7) * 8);
  return r;
}
__device__ __forceinline__ void stage_store(LAS unsigned char* buf, const StageRegs& r, int tid) {
  *(LAS u32x4*)(buf + (tid >> 3) * 144 + (tid & 7) * 16) = r.k;
  LAS unsigned char* vp = buf + AT_KB + (tid >> 3) * 136 + (tid & 7) * 16;
  *(LAS u32x2*)vp = (u32x2){r.v.x, r.v.y}; *(LAS u32x2*)(vp + 8) = (u32x2){r.v.z, r.v.w};
}
__device__ __forceinline__ f32x16 qk_lds(const LAS unsigned char* buf, int tt, const bf16x8 (&qf)[4], int c32, int hh) {
  f32x16 s;
#pragma unroll
  for (int i = 0; i < 16; ++i) s[i] = 0.f;
  const LAS unsigned char* kp = buf + (32 * tt + c32) * 144 + 16 * hh;
#pragma unroll
  for (int ks = 0; ks < 4; ++ks) { const bf16x8 kf = *(const LAS bf16x8*)(kp + 32 * ks); s = __builtin_amdgcn_mfma_f32_32x32x16_bf16(kf, qf[ks], s, 0, 0, 0); }
  return s;
}
__device__ __forceinline__ void pv_lds(f32x16 (&o)[2], const LAS unsigned char* buf, int tt, const f32x16& p, int c32, int hh) {
#pragma unroll
  for (int s = 0; s < 2; ++s) {
    union { bf16x8 v; unsigned u[4]; } pf;
#pragma unroll
    for (int j = 0; j < 4; ++j) pf.u[j] = cvt_pk_bf16(p[8 * s + 2 * j], p[8 * s + 2 * j + 1]);
#pragma unroll
    for (int dt = 0; dt < 2; ++dt) {
      const LAS unsigned char* vp = buf + AT_KB + (32 * dt + c32) * 136 + (32 * tt + 16 * s + 4 * hh) * 2;
      union { bf16x8 v; u32x2 h[2]; } vf;
      vf.h[0] = *(const LAS u32x2*)vp; vf.h[1] = *(const LAS u32x2*)(vp + 16);
      o[dt] = __builtin_amdgcn_mfma_f32_32x32x16_bf16(vf.v, pf.v, o[dt], 0, 0, 0);
    }
  }
}
__device__ __forceinline__ f32x16 qk_lds_init(const LAS unsigned char* buf, int tt, const bf16x8 (&qf)[4], int c32, int hh, float cinit) {
  f32x16 s;
#pragma unroll
  for (int i = 0; i < 16; ++i) s[i] = cinit;
  const LAS unsigned char* kp = buf + (32 * tt + c32) * 144 + 16 * hh;
#pragma unroll
  for (int ks = 0; ks < 4; ++ks) { const bf16x8 kf = *(const LAS bf16x8*)(kp + 32 * ks); s = __builtin_amdgcn_mfma_f32_32x32x16_bf16(kf, qf[ks], s, 0, 0, 0); }
  return s;
}
template <bool MASKED>
__device__ __forceinline__ void stage_pv_ref(f32x16 (&o)[2], float& l, const LAS unsigned char* buf, const bf16x8 (&qf)[4], int c32, int hh, float cinit, int klim0, int klo0) {
  f32x16 s0 = qk_lds_init(buf, 0, qf, c32, hh, cinit), s1 = qk_lds_init(buf, 1, qf, c32, hh, cinit);
  float ps = 0.f;
#pragma unroll
  for (int i = 0; i < 16; ++i) {
    float p0 = __builtin_amdgcn_exp2f(s0[i]), p1 = __builtin_amdgcn_exp2f(s1[i]);
    if (MASKED) {
      const int x = (i & 3) + 8 * (i >> 2);
      p0 = (x <= klim0 && x > klo0) ? p0 : 0.f;
      p1 = (x <= klim0 - 32 && x > klo0 - 32) ? p1 : 0.f;
    }
    s0[i] = p0; s1[i] = p1; ps += p0 + p1;
  }
  l += ps;
  pv_lds(o, buf, 0, s0, c32, hh);
  pv_lds(o, buf, 1, s1, c32, hh);
}

#ifdef ATTN_ONLINE
template <bool MASKED>
__device__ __forceinline__ void stage_softmax_pv(f32x16 (&o)[2], float& m, float& l, const LAS unsigned char* buf, const bf16x8 (&qf)[4], int c32, int hh, int klim0, int klo0, bool mine) {
  f32x16 s0 = qk_lds(buf, 0, qf, c32, hh), s1 = qk_lds(buf, 1, qf, c32, hh);
  float mt = NEGF;
  if (MASKED) {
#pragma unroll
    for (int i = 0; i < 16; ++i) {
      const int x = (i & 3) + 8 * (i >> 2);
      s0[i] = (x <= klim0 && x > klo0) ? s0[i] : NEGF;
      s1[i] = (x <= klim0 - 32 && x > klo0 - 32) ? s1[i] : NEGF;
      mt = fmaxf(mt, fmaxf(s0[i], s1[i]));
    }
  } else {
#pragma unroll
    for (int i = 0; i < 16; ++i) mt = fmaxf(mt, fmaxf(s0[i], s1[i]));
    mt = mine ? mt : NEGF;
  }
  mt = fmaxf(mt, __shfl_xor(mt, 32));
  const float mn = fmaxf(m, mt);
  const float alpha = __builtin_amdgcn_exp2f(m - mn);
  float ps = 0.f;
  if (MASKED) {
#pragma unroll
    for (int i = 0; i < 16; ++i) {
      const float p0 = (s0[i] > -1e29f) ? __builtin_amdgcn_exp2f(s0[i] - mn) : 0.f, p1 = (s1[i] > -1e29f) ? __builtin_amdgcn_exp2f(s1[i] - mn) : 0.f;
      s0[i] = p0; s1[i] = p1; ps += p0 + p1;
    }
  } else {
    const float msub = mine ? mn : 1e30f;
#pragma unroll
    for (int i = 0; i < 16; ++i) { s0[i] = __builtin_amdgcn_exp2f(s0[i] - msub); s1[i] = __builtin_amdgcn_exp2f(s1[i] - msub); ps += s0[i] + s1[i]; }
  }
  l = l * alpha + ps; m = mn;
  if (!__all(alpha == 1.f)) {
#pragma unroll
    for (int i = 0; i < 16; ++i) { o[0][i] *= alpha; o[1][i] *= alpha; }
  }
  pv_lds(o, buf, 0, s0, c32, hh);
  pv_lds(o, buf, 1, s1, c32, hh);
}

#endif
__device__ __forceinline__ void attn_item(const PhaseCArgs& a, LAS unsigned char* lds, int b, int qbi, int g) {
  const int tid = tidx(), w = tid >> 6, lane = tid & 63, c32 = lane & 31, hh = lane >> 5;
  const int t0 = qbi * 64, tl = c32 >> 2, r = c32 & 3;
  const int t = t0 + 8 * w + tl, head = 4 * g + r;
  const size_t tok = (size_t)b * SEQ + t;
  const size_t bg = (size_t)b * 2 + g;
  LAS float* impl = (LAS float*)(lds + AT_IMP) + w * 256;
  bf16x8 qf[4];
  {
    const bf16_t* qp = a.qb + (tok * 8 + head) * 64 + 8 * hh;
#pragma unroll
    for (int ks = 0; ks < 4; ++ks) qf[ks] = *(const bf16x8*)(qp + 16 * ks);
  }
  const float* gt = a.gates + tok * 24;
  const float gate_c = gt[head], gate_s = gt[8 + head], gate_w = gt[16 + head];
  float ref_s, ref_w;
  {
    float gs = fabsf(a.g_k[64 + lane]), gw = fabsf(a.g_k[128 + lane]);
#pragma unroll
    for (int o_ = 32; o_ > 0; o_ >>= 1) { gs = fmaxf(gs, __shfl_xor(gs, o_)); gw = fmaxf(gw, __shfl_xor(gw, o_)); }
    float qq = 0.f;
#pragma unroll
    for (int ks = 0; ks < 4; ++ks)
#pragma unroll
      for (int j = 0; j < 8; ++j) { const float qv = bf2f((bf16_t)qf[ks][j]); qq = fmaf(qv, qv, qq); }
    qq += __shfl_xor(qq, 32);
    const float qn = sqrtf(qq) * 8.f * 1.02f;
    ref_s = qn * gs; ref_w = qn * gw;
  }
  asm volatile("" : "+v"(ref_s), "+v"(ref_w));
  const int wj0 = qbi >= 4 ? qbi - 4 : 0;
  const int n_slc = qbi + 1, n_win = qbi - wj0 + 1, n_st = 4 + n_slc + n_win;
  const bf16_t* kcb = a.kcP + bg * 128 * 64; const bf16_t* vcb = a.vcPT + bg * 64 * 128;
  const bf16_t* ksb = a.ks + bg * SEQ * 64;  const bf16_t* vsb = a.vsT + bg * 64 * SEQ;
  const bf16_t* kwb = a.kw + bg * SEQ * 64;  const bf16_t* vwb = a.vwT + bg * 64 * SEQ;
#define AT_SRC(s_, KP, VP, LDV) do { const int s__ = (s_);                                                        \
    if (s__ < 4) { KP = kcb + (size_t)(s__ & 1) * 64 * 64; VP = vcb + (s__ & 1) * 64; LDV = 128; }                 \
    else if (s__ < 4 + n_slc) { const int j__ = s__ - 4; KP = ksb + (size_t)j__ * 64 * 64; VP = vsb + j__ * 64; LDV = SEQ; } \
    else { const int j__ = wj0 + (s__ - 4 - n_slc); KP = kwb + (size_t)j__ * 64 * 64; VP = vwb + j__ * 64; LDV = SEQ; } } while (0)
  StageRegs sr0, sr1;
  { const bf16_t* kp; const bf16_t* vp; int ldv; AT_SRC(0, kp, vp, ldv); sr0 = stage_load(kp, vp, ldv, tid); }
  { const bf16_t* kp; const bf16_t* vp; int ldv; AT_SRC(1, kp, vp, ldv); sr1 = stage_load(kp, vp, ldv, tid); }
  stage_store(lds, sr0, tid);
  sr0 = sr1;
  lds_barrier();
  f32x16 o[2];
#pragma unroll
  for (int i = 0; i < 16; ++i) { o[0][i] = 0.f; o[1][i] = 0.f; }
  LAS f32x4* otl = (LAS f32x4*)(lds + AT_OT) + (w * 8) * 64 + lane;
  float m = NEGF, l = 0.f, inv = 0.f, prev = 0.f;
  unsigned selmask = 0u;
  const int clim = ((t - 31) >> 4) - 4 * hh;
#pragma unroll 1
  for (int s = 0; s < n_st; ++s) {
    const LAS unsigned char* buf = lds + (s % AT_NBUF) * AT_STAGE;
    if (s + 2 < n_st) { const bf16_t* kp; const bf16_t* vp; int ldv; AT_SRC(s + 2, kp, vp, ldv); sr1 = stage_load(kp, vp, ldv, tid); }
    if (s < 2) {
      f32x16 s0 = qk_lds(buf, 0, qf, c32, hh), s1 = qk_lds(buf, 1, qf, c32, hh);
      const int cl = clim - 64 * s;
      float mt = NEGF;
#pragma unroll
      for (int i = 0; i < 16; ++i) { const int x = (i & 3) + 8 * (i >> 2); s0[i] = x <= cl ? s0[i] : NEGF; s1[i] = x <= cl - 32 ? s1[i] : NEGF; mt = fmaxf(mt, fmaxf(s0[i], s1[i])); }
      mt = fmaxf(mt, __shfl_xor(mt, 32));
      const float mn = fmaxf(m, mt);
      float ps = 0.f;
#pragma unroll
      for (int i = 0; i < 16; ++i) { ps += (s0[i] > -1e29f) ? __builtin_amdgcn_exp2f(s0[i] - mn) : 0.f; ps += (s1[i] > -1e29f) ? __builtin_amdgcn_exp2f(s1[i] - mn) : 0.f; }
      l = l * __builtin_amdgcn_exp2f(m - mn) + ps; m = mn;
      if (s == 1) { l += __shfl_xor(l, 32); inv = l > 0.f ? 1.f / l : 0.f; }
    } else if (s < 4) {
#pragma unroll
      for (int tt = 0; tt < 2; ++tt) {
        f32x16 sc = qk_lds(buf, tt, qf, c32, hh);
        const int cl = clim - 64 * (s - 2) - 32 * tt;
#pragma unroll
        for (int i = 0; i < 16; ++i) { const bool valid = ((i & 3) + 8 * (i >> 2)) <= cl; sc[i] = valid ? __builtin_amdgcn_exp2f(sc[i] - m) * inv : 0.f; }
#pragma unroll
        for (int ii = 0; ii < 4; ++ii) {
          const float q4 = (sc[4 * ii] + sc[4 * ii + 1]) + (sc[4 * ii + 2] + sc[4 * ii + 3]);
          const float pp = __shfl_xor(sc[4 * ii + 3], 32);
          float v = q4 + (hh ? pp : prev);
          prev = pp;
          v += __shfl_xor(v, 1); v += __shfl_xor(v, 2);
          if (r == 0) impl[tl * 32 + 2 * (4 * (2 * (s - 2) + tt) + ii) + hh] = v;
        }
        pv_lds(o, buf, tt, sc, c32, hh);
      }
      if (s == 3) {
#pragma unroll
        for (int dt = 0; dt < 2; ++dt)
#pragma unroll
          for (int i4 = 0; i4 < 4; ++i4) otl[(dt * 4 + i4) * 64] = (f32x4){gate_c * o[dt][4 * i4], gate_c * o[dt][4 * i4 + 1], gate_c * o[dt][4 * i4 + 2], gate_c * o[dt][4 * i4 + 3]};
#pragma unroll
        for (int i = 0; i < 16; ++i) { o[0][i] = 0.f; o[1][i] = 0.f; }
        m = NEGF; l = 0.f;
      }
    } else if (s < 4 + n_slc) {
      const int j = s - 4;
      const bool mine = (selmask >> j) & 1u;
      if (__any(mine)) {
#ifdef ATTN_ONLINE
        if (j < qbi) stage_softmax_pv<false>(o, m, l, buf, qf, c32, hh, 0, 0, mine);
        else { const int klim = mine ? (t - 64 * j - 4 * hh) : -1; stage_softmax_pv<true>(o, m, l, buf, qf, c32, hh, klim, -1000000, mine); }
#else
        const float cinit = mine ? -ref_s : -1e30f;
        REPC
        if (j < qbi) stage_pv_ref<false>(o, l, buf, qf, c32, hh, cinit, 0, 0);
        else stage_pv_ref<true>(o, l, buf, qf, c32, hh, cinit, t - 64 * j - 4 * hh, -1000000);
#endif
      }
      if (j == qbi) {
        l += __shfl_xor(l, 32);
        const float sc = gate_s / fmaxf(l, 1e-37f);
#pragma unroll
        for (int dt = 0; dt < 2; ++dt)
#pragma unroll
          for (int i4 = 0; i4 < 4; ++i4) { f32x4 v = otl[(dt * 4 + i4) * 64]; v[0] += sc * o[dt][4 * i4]; v[1] += sc * o[dt][4 * i4 + 1]; v[2] += sc * o[dt][4 * i4 + 2]; v[3] += sc * o[dt][4 * i4 + 3]; otl[(dt * 4 + i4) * 64] = v; }
#pragma unroll
        for (int i = 0; i < 16; ++i) { o[0][i] = 0.f; o[1][i] = 0.f; }
        m = NEGF; l = 0.f;
      }
    } else {
      const int j = wj0 + (s - 4 - n_slc);
      const int tmin = t0 + 8 * w;
      if (64 * j + 63 > tmin - 256) {
#ifdef ATTN_ONLINE
        if (j < qbi && j >= qbi - 3) stage_softmax_pv<false>(o, m, l, buf, qf, c32, hh, 0, 0, true);
        else { const int khi = t - 64 * j - 4 * hh; stage_softmax_pv<true>(o, m, l, buf, qf, c32, hh, khi, khi - 256, true); }
#else
        REPC
        if (j < qbi && j >= qbi - 3) stage_pv_ref<false>(o, l, buf, qf, c32, hh, -ref_w, 0, 0);
        else { const int khi = t - 64 * j - 4 * hh; stage_pv_ref<true>(o, l, buf, qf, c32, hh, -ref_w, khi, khi - 256); }
#endif
      }
    }
    if (s + 1 < n_st) stage_store(lds + ((s + 1) % AT_NBUF) * AT_STAGE, sr0, tid);
    sr0 = sr1;
    lds_barrier();
    if (s == 3) {
      const int tl2 = lane >> 3, sg = lane & 7, cur = qbi;
      float scv[32];
#pragma unroll
      for (int s2 = 0; s2 < 32; ++s2) {
        const float v = impl[tl2 * 32 + s2];
        const bool forced = (s2 == 0) || (s2 == cur) || (s2 == cur - 1);
        scv[s2] = (s2 <= cur) ? (forced ? 1e4f : v) : -1e4f;
      }
      unsigned mk = 0u;
#pragma unroll
      for (int e = 0; e < 4; ++e) {
        const int sx = sg * 4 + e;
        float mine = 0.f;
#pragma unroll
        for (int s2 = 0; s2 < 32; ++s2) mine = (s2 == sx) ? scv[s2] : mine;
        int rank = 0;
#pragma unroll
        for (int s2 = 0; s2 < 32; ++s2) rank += (scv[s2] > mine || (scv[s2] == mine && s2 < sx)) ? 1 : 0;
        if (rank < 8 && sx <= cur) mk |= 1u << sx;
      }
      mk |= __shfl_xor(mk, 1); mk |= __shfl_xor(mk, 2); mk |= __shfl_xor(mk, 4);
      selmask = __shfl(mk, tl * 8);
#ifdef PROBE_CHECK
      if (r == 0 && hh == 0) a.seldump[tok * 2 + g] = selmask;
#endif
    }
  }
#undef AT_SRC
  l += __shfl_xor(l, 32);
  const float scw = gate_w / fmaxf(l, 1e-37f);
#pragma unroll
  for (int dt = 0; dt < 2; ++dt)
#pragma unroll
    for (int ii = 0; ii < 4; ++ii) {
      const int d0 = 32 * dt + 8 * ii + 4 * hh;
      const f32x4 pk = otl[(dt * 4 + ii) * 64];
      const u32x2 z = *(const u32x2*)(a.szc + tok * 512 + head * 64 + d0);
      u32x2 ov;
      ov.x = cvt_pk_bf16((pk[0] + scw * o[dt][4 * ii]) * bflo(z.x), (pk[1] + scw * o[dt][4 * ii + 1]) * bfhi(z.x));
      ov.y = cvt_pk_bf16((pk[2] + scw * o[dt][4 * ii + 2]) * bflo(z.y), (pk[3] + scw * o[dt][4 * ii + 3]) * bfhi(z.y));
      *(u32x2*)(a.mixb + tok * 1024 + 512 + head * 64 + d0) = ov;
    }
}
__device__ __forceinline__ void phaseC(LAS unsigned char* lds, const PhaseCArgs& a) {
  for (int p0 = blockIdx.x; p0 < 256; p0 += gridDim.x) {
    const int p = gridDim.x == 256 ? ((p0 & 7) * 32 + (p0 >> 3)) : p0;
    const int b = p >> 5, g = (p >> 4) & 1, qlo = p & 15;
    attn_item(a, lds, b, qlo, g);
    __syncthreads();
    attn_item(a, lds, b, 31 - qlo, g);
    __syncthreads();
  }
}
#ifdef MULTI_LAUNCH
__global__ void __launch_bounds__(512, 2) k_phaseC(PhaseCArgs a) {
  extern __shared__ __attribute__((aligned(16))) unsigned char shm[];
  phaseC((LAS unsigned char*)shm, a);
}
#endif

#ifdef MULTI_LAUNCH
__global__ void k_bridge_cvt(const float* src, int ld_src, int col0, int ncol, bf16_t* dst, size_t ntok) {
  size_t i = (size_t)blockIdx.x * blockDim.x + tidx();
  if (i >= ntok * ncol) return;
  const size_t tok = i / ncol; const int c = (int)(i % ncol);
  dst[i] = f2bf(src[tok * ld_src + col0 + c]);
}
#endif
#ifdef MULTI_LAUNCH
__global__ void __launch_bounds__(256) k_prep_x(const float* xp, const float* xs, bf16_t* xb, float* ssq) {
  const int row = blockIdx.x * 4 + (tidx() >> 6), lane = tidx() & 63;
  if (row >= NTOK) return;
  const float* x = row < NPT ? xp + (size_t)row * 1024 : xs + (size_t)(row - NPT) * 1024;
#pragma unroll
  for (int j = 0; j < 4; ++j) {
    const f32x4 v = *(const f32x4*)(x + j * 256 + lane * 4);
    u32x2 pk; pk.x = cvt_pk_bf16(v[0], v[1]); pk.y = cvt_pk_bf16(v[2], v[3]);
    *(u32x2*)(xb + (size_t)row * 1024 + j * 256 + lane * 4) = pk;
    float ss = v[0] * v[0] + v[1] * v[1] + v[2] * v[2] + v[3] * v[3];
    ss += __shfl_xor(ss, 1); ss += __shfl_xor(ss, 2); ss += __shfl_xor(ss, 4); ss += __shfl_xor(ss, 8);
    if ((lane & 15) == 0) ssq[(size_t)row * 16 + j * 4 + (lane >> 4)] = ss;
  }
}
#endif
#ifdef MULTI_LAUNCH
__global__ void __launch_bounds__(64) k_prep_cbias(const float* pe, const float* w1, float* cbias) {
  const int lk = blockIdx.x, e = tidx();
  const float* pp = pe + (size_t)lk * 2048; const float* ww = w1 + (size_t)lk * 2048 * 64;
  float acc = 0.f;
  for (int k = 0; k < 2048; ++k) acc = fmaf(pp[k], ww[(size_t)k * 64 + e], acc);
  cbias[lk * 64 + e] = acc;
}
#endif
__device__ __forceinline__ float rinv_from_ssq(const float* ssq, size_t row) {
  const f32x4* p = (const f32x4*)(ssq + row * 16);
  const f32x4 a = p[0], b = p[1], c = p[2], d = p[3];
  const float s = ((a[0] + a[1]) + (a[2] + a[3])) + ((b[0] + b[1]) + (b[2] + b[3])) + ((c[0] + c[1]) + (c[2] + c[3])) + ((d[0] + d[1]) + (d[2] + d[3]));
  return rsqrtf(s * (1.f / 1024.f) + 1e-6f);
}
__device__ __forceinline__ f32x4 mfma16(bf16x8 a, bf16x8 b, f32x4 c) { return __builtin_amdgcn_mfma_f32_16x16x32_bf16(a, b, c, 0, 0, 0); }
__device__ __forceinline__ float fsigmoid(float z) { return __builtin_amdgcn_rcpf(1.f + __builtin_amdgcn_exp2f(-1.4426950408889634f * z)); }
__device__ __forceinline__ float fsilu(float z) { return z * fsigmoid(z); }

template <int NT> __device__ __forceinline__ void small_gemm(LAS unsigned char* lds, const bf16_t* A, int lda, const bf16_t* Bt, int ldb, int K, f32x4 (&acc)[NT]) {
  const int tid = tidx(), w = tid >> 6, lane = tid & 63, fr = lane & 15, fq = lane >> 4;
  constexpr int ST = 272, BUF = (128 + 16 * NT) * ST, NB = (16 * NT * 16 + 511) / 512;
  const int ar = tid >> 4, ap = tid & 15;
  const bf16_t* asrc = A + (size_t)ar * lda + ap * 8;
  u32x4 areg[2][4], breg[2][NB];
#pragma unroll
  for (int nt = 0; nt < NT; ++nt) acc[nt] = (f32x4){0.f, 0.f, 0.f, 0.f};
  const int nc = K / 128;
#define SG_LOAD(SET, c_) do { _Pragma("unroll") for (int i = 0; i < 4; ++i) areg[SET][i] = *(const u32x4*)(asrc + (size_t)(32 * i) * lda + (c_) * 128);                                   \
    _Pragma("unroll") for (int i = 0; i < NB; ++i) { const int pc = tid + i * 512; if (pc < 16 * NT * 16) breg[SET][i] = *(const u32x4*)(Bt + (size_t)(pc >> 4) * ldb + (c_) * 128 + (pc & 15) * 8); } } while (0)
#define SG_STORE(SET, c_) do { LAS unsigned char* base_ = lds + ((c_) & 1) * BUF;                                                                                        \
    _Pragma("unroll") for (int i = 0; i < 4; ++i) *(LAS u32x4*)(base_ + (ar + 32 * i) * ST + ap * 16) = areg[SET][i];                                                       \
    _Pragma("unroll") for (int i = 0; i < NB; ++i) { const int pc = tid + i * 512; if (pc < 16 * NT * 16) *(LAS u32x4*)(base_ + (128 + (pc >> 4)) * ST + (pc & 15) * 16) = breg[SET][i]; } } while (0)
#define SG_COMPUTE(c_) do { const LAS unsigned char* base_ = lds + ((c_) & 1) * BUF;                                                                                     \
    _Pragma("unroll") for (int i = 0; i < 4; ++i) { const bf16x8 af = *(const LAS bf16x8*)(base_ + (16 * w + fr) * ST + i * 64 + fq * 16);                                \
      _Pragma("unroll") for (int nt = 0; nt < NT; ++nt) { const bf16x8 bf = *(const LAS bf16x8*)(base_ + (128 + nt * 16 + fr) * ST + i * 64 + fq * 16); acc[nt] = mfma16(bf, af, acc[nt]); } } } while (0)
  SG_LOAD(0, 0);
  if (nc > 1) SG_LOAD(1, 1);
  SG_STORE(0, 0);
  lds_barrier();
#pragma unroll 1
  for (int c = 0; c < nc; c += 2) {
    if (c + 2 < nc) SG_LOAD(0, c + 2);
    SG_COMPUTE(c);
    SG_STORE(1, c + 1);
    lds_barrier();
    if (c + 3 < nc) SG_LOAD(1, c + 3);
    SG_COMPUTE(c + 1);
    if (c + 2 < nc) SG_STORE(0, c + 2);
    lds_barrier();
  }
#undef SG_LOAD
#undef SG_STORE
#undef SG_COMPUTE
}

struct PhaseBArgs {
  const bf16_t *glu, *bin, *sza, *szb, *xb; const float* ssq;
  const bf16_t *WpwT, *WpoolT, *WgT, *W1T, *W2T; const float* cbias;
  const float *w_dw, *b_dw, *ln_g, *ln_b, *b_pw, *pool_scale;
  const float* cmp_rows_p;
  bf16_t *mixb, *kcP, *vcPT; float* gates;
#ifdef PROBE_REP
  int repb[4];
#endif
};
#ifdef PROBE_REP
#define REPB(i) _Pragma("unroll 1") for (int repb_ = 0; repb_ < a.repb[i]; ++repb_)
#else
#define REPB(i)
#endif

template <int NT_>
__device__ __forceinline__ void conv_item(const PhaseBArgs& a, LAS unsigned char* lds, int b, int chunk) {
  const int tid = tidx(), w = tid >> 6, lane = tid & 63;
  const int fr = lane & 15, fq = lane >> 4;
  const int t0 = chunk * NT_;
  constexpr int TPT = NT_ / 4;
  constexpr int ZOFF = NT_ * 1088;
  constexpr int POFF = ZOFF + NT_ * 512;
  const size_t tok0 = (size_t)b * SEQ + t0;
  const int cp = tid & 127, tg = tid >> 7;
  f32x2 wt[31];
#pragma unroll
  for (int k = 0; k < 31; ++k) wt[k] = *(const f32x2*)(a.w_dw + k * 256 + 2 * cp);
  const f32x2 bd = *(const f32x2*)(a.b_dw + 2 * cp);
  for (int i = tid; i < (NT_ + 30) * 32; i += 512) {
    const int row = i >> 5, ch = i & 31, t = t0 - 30 + row;
    u32x4 v = {0u, 0u, 0u, 0u};
    if (t >= 0) v = *(const u32x4*)(a.glu + ((size_t)b * SEQ + t) * 256 + ch * 8);
    *(LAS u32x4*)(lds + row * 512 + ch * 16) = v;
  }
  for (int i = tid; i < NT_ * 32; i += 512) *(LAS u32x4*)(lds + ZOFF + i * 16) = *(const u32x4*)(a.sza + tok0 * 256 + (size_t)i * 8);
  if (w == 0) *(LAS f32x4*)(lds + POFF + tid * 16) = *(const f32x4*)(a.ln_g + (tid & 63) * 4);
  else if (w == 1) *(LAS f32x4*)(lds + POFF + tid * 16) = *(const f32x4*)(a.ln_b + (tid & 63) * 4);
  else if (w == 2) *(LAS f32x4*)(lds + POFF + tid * 16) = *(const f32x4*)(a.b_pw + (tid & 63) * 4);
  __syncthreads();
  f32x2 res[TPT];
  {
    const LAS unsigned* wp = (const LAS unsigned*)(lds + (tg * TPT) * 512 + cp * 4);
#pragma unroll
    for (int blk = 0; blk < TPT / 8; ++blk) {
      f32x2 xw[38];
#pragma unroll
      for (int i = 0; i < 38; ++i) { const unsigned xv = wp[(blk * 8 + i) * 128]; xw[i] = (f32x2){bflo(xv), bfhi(xv)}; }
      f32x2 ac[8];
#pragma unroll
      for (int j = 0; j < 8; ++j) ac[j] = bd;
#pragma unroll
      for (int k = 0; k < 31; ++k)
#pragma unroll
        for (int j = 0; j < 8; ++j) ac[j] = __builtin_elementwise_fma(wt[k], xw[j + k], ac[j]);
#pragma unroll
      for (int j = 0; j < 8; ++j) res[blk * 8 + j] = ac[j];
    }
  }
  bf16x8 bfr[2][8];
#pragma unroll
  for (int nt = 0; nt < 2; ++nt)
#pragma unroll
    for (int ks = 0; ks < 8; ++ks) bfr[nt][ks] = *(const bf16x8*)(a.WpwT + (size_t)(32 * w + nt * 16 + fr) * 256 + ks * 32 + fq * 8);
  __syncthreads();
#pragma unroll
  for (int j = 0; j < TPT; ++j) *(LAS f32x2*)(lds + (tg * TPT + j) * 1088 + cp * 8) = res[j];
  __syncthreads();
  if ((tid >> 2) < NT_) {
    const int tok = tid >> 2, q = tid & 3;
    f32x4 v[16]; float s = 0.f;
#pragma unroll
    for (int i = 0; i < 16; ++i) { v[i] = *(const LAS f32x4*)(lds + tok * 1088 + (4 * i + q) * 16); s += (v[i][0] + v[i][1]) + (v[i][2] + v[i][3]); }
    s += __shfl_xor(s, 1); s += __shfl_xor(s, 2);
    const float mean = s * (1.f / 256.f);
    float s2 = 0.f;
#pragma unroll
    for (int i = 0; i < 16; ++i) { v[i] = v[i] - mean; s2 += (v[i][0] * v[i][0] + v[i][1] * v[i][1]) + (v[i][2] * v[i][2] + v[i][3] * v[i][3]); }
    s2 += __shfl_xor(s2, 1); s2 += __shfl_xor(s2, 2);
    const float rstd = rsqrtf(s2 * (1.f / 256.f) + 1e-6f);
#pragma unroll
    for (int i = 0; i < 16; ++i) {
      const int c0 = (4 * i + q) * 4;
      const f32x4 gg = *(const LAS f32x4*)(lds + POFF + c0 * 4), bb = *(const LAS f32x4*)(lds + POFF + 1024 + c0 * 4);
      f32x4 z = v[i] * rstd * gg + bb;
      u32x2 pk; pk.x = cvt_pk_bf16(fsilu(z[0]), fsilu(z[1])); pk.y = cvt_pk_bf16(fsilu(z[2]), fsilu(z[3]));
      *(LAS u32x2*)(lds + tok * 1088 + c0 * 2) = pk;
    }
  }
  __syncthreads();
  {
#pragma unroll 2
    for (int mt = 0; mt < NT_ / 16; ++mt) {
      f32x4 acc0 = {0.f, 0.f, 0.f, 0.f}, acc1 = {0.f, 0.f, 0.f, 0.f};
#pragma unroll
      for (int ks = 0; ks < 8; ++ks) {
        const bf16x8 af = *(const LAS bf16x8*)(lds + (16 * mt + fr) * 1088 + (ks * 32 + fq * 8) * 2);
        acc0 = mfma16(bfr[0][ks], af, acc0); acc1 = mfma16(bfr[1][ks], af, acc1);
      }
      const size_t tok = tok0 + 16 * mt + fr;
#pragma unroll
      for (int nt = 0; nt < 2; ++nt) {
        const f32x4 ac = nt ? acc1 : acc0;
        const int c0 = 32 * w + nt * 16 + 4 * fq;
        const f32x4 bp = *(const LAS f32x4*)(lds + POFF + 2048 + c0 * 4);
        const u32x2 z = *(const LAS u32x2*)(lds + ZOFF + (16 * mt + fr) * 512 + c0 * 2);
        u32x2 ov;
        ov.x = cvt_pk_bf16((ac[0] + bp[0]) * bflo(z.x), (ac[1] + bp[1]) * bfhi(z.x));
        ov.y = cvt_pk_bf16((ac[2] + bp[2]) * bflo(z.y), (ac[3] + bp[3]) * bfhi(z.y));
        *(u32x2*)(a.mixb + tok * 1024 + c0) = ov;
      }
    }
  }
  __syncthreads();
}

__device__ __forceinline__ void pool_item(const PhaseBArgs& a, LAS unsigned char* lds, int b, int chunk) {
  const int tid = tidx(), w = tid >> 6, lane = tid & 63;
  const int t0 = chunk * 128;
  constexpr int DOFF = 143 * 512;
  for (int i = tid; i < 143 * 32; i += 512) {
    const int row = i >> 5, ch = i & 31, t = t0 - 15 + row;
    u32x4 v = {0u, 0u, 0u, 0u};
    if (t >= 0) v = *(const u32x4*)(a.bin + ((size_t)b * SEQ + t) * 256 + ch * 8);
    *(LAS u32x4*)(lds + row * 512 + ch * 16) = v;
  }
  __syncthreads();
  {
    const int cp = tid & 127, tg = tid >> 7, grp = cp >> 5, wn = 2 << grp;
    const LAS unsigned* wp = (const LAS unsigned*)(lds + cp * 4);
    const int r0 = 15 + tg * 32;
    float run0 = 0.f, run1 = 0.f;
    for (int i = 1; i < wn; ++i) { const unsigned xv = wp[(r0 - i) * 128]; run0 += bflo(xv); run1 += bfhi(xv); }
#pragma unroll 4
    for (int j = 0; j < 32; ++j) {
      const int rr = r0 + j, t = t0 + tg * 32 + j;
      const unsigned xv = wp[rr * 128];
      const float x0 = bflo(xv), x1 = bfhi(xv);
      run0 += x0; run1 += x1;
      const float icnt = 1.f / (float)min(wn, t + 1);
      const unsigned dv = cvt_pk_bf16(run0 * icnt - x0, run1 * icnt - x1);
      *(LAS unsigned*)(lds + DOFF + (tg * 32 + j) * 528 + cp * 4) = dv;
      const unsigned xo = wp[(rr - wn + 1) * 128];
      run0 -= bflo(xo); run1 -= bfhi(xo);
    }
  }
  __syncthreads();
  {
    const int fr = lane & 15, fq = lane >> 4;
    const size_t tok = (size_t)b * SEQ + t0 + 16 * w + fr;
#pragma unroll
    for (int g = 0; g < 4; ++g) {
      f32x4 acc[4];
#pragma unroll
      for (int nt = 0; nt < 4; ++nt) acc[nt] = (f32x4){0.f, 0.f, 0.f, 0.f};
#pragma unroll
      for (int ks = 0; ks < 2; ++ks) {
        const bf16x8 af = *(const LAS bf16x8*)(lds + DOFF + (16 * w + fr) * 528 + (g * 64 + ks * 32 + fq * 8) * 2);
#pragma unroll
        for (int nt = 0; nt < 4; ++nt) {
          const bf16x8 bf = *(const bf16x8*)(a.WpoolT + (size_t)(g * 64 + nt * 16 + fr) * 64 + ks * 32 + fq * 8);
          acc[nt] = mfma16(bf, af, acc[nt]);
        }
      }
#pragma unroll
      for (int nt = 0; nt < 4; ++nt) {
        const int c0 = g * 64 + nt * 16 + 4 * fq;
        const f32x4 sc = *(const f32x4*)(a.pool_scale + c0);
        const u32x2 z = *(const u32x2*)(a.szb + tok * 256 + c0);
        u32x2 ov;
        ov.x = cvt_pk_bf16(acc[nt][0] * sc[0] * bflo(z.x), acc[nt][1] * sc[1] * bfhi(z.x));
        ov.y = cvt_pk_bf16(acc[nt][2] * sc[2] * bflo(z.y), acc[nt][3] * sc[3] * bfhi(z.y));
        *(u32x2*)(a.mixb + tok * 1024 + 256 + c0) = ov;
      }
    }
  }
  __syncthreads();
}

__device__ __forceinline__ void gates_item(const PhaseBArgs& a, LAS unsigned char* lds, int chunk) {
  const int tid = tidx(), w = tid >> 6, lane = tid & 63, fr = lane & 15, fq = lane >> 4;
  const size_t row = (size_t)chunk * 128 + 16 * w + fr;
  f32x4 acc[2];
  small_gemm<2>(lds, a.xb + (size_t)chunk * 128 * 1024, 1024, a.WgT, 1024, 1024, acc);
  const float rinv = rinv_from_ssq(a.ssq, row);
#pragma unroll
  for (int nt = 0; nt < 2; ++nt) {
    const int c0 = nt * 16 + 4 * fq;
    if (c0 < 24) {
      f32x4 o;
#pragma unroll
      for (int e = 0; e < 4; ++e) o[e] = fsigmoid(acc[nt][e] * rinv);
      *(f32x4*)(a.gates + row * 24 + c0) = o;
    }
  }
}

struct CmpSrc { const float* base; const int* pages; };
__device__ __forceinline__ const float* cmp_row_ptr(const CmpSrc& s, int pos) {
  if (s.pages) return s.base + ((size_t)s.pages[pos >> 7] * 128 + (pos & 127)) * 256;
  return s.base + (size_t)pos * 256;
}
__device__ __forceinline__ float gelu_tanh_f(float x) {
  const float u = 0.7978845608028654f * (x + 0.044715f * x * x * x);
  const float e = __expf(2.f * u);
  const float th = 1.f - 2.f / (e + 1.f);
  return 0.5f * x * (1.f + th);
}
template <bool VROWMAJOR>
__device__ __forceinline__ void compress_item(LAS unsigned char* lds, const CmpSrc& src, int g, int kv, const bf16_t* W1T  , const bf16_t* W2T  ,
                                              const float* cbias  , bf16_t* kc_out  , bf16_t* vcT_out  ) {
  const int tid = tidx(), w = tid >> 6, lane = tid & 63, fr = lane & 15, fq = lane >> 4;
  constexpr int ST = 272;
  constexpr int ABUF = 128 * ST;
  constexpr int BUF = 2 * ABUF;
  constexpr int POFF = 0;
  const float* arow[8];
#pragma unroll
  for (int i = 0; i < 8; ++i) { const int idx = i * 512 + tid, piece = idx >> 5, pos = (idx >> 4) & 1; arow[i] = cmp_row_ptr(src, piece * 16 + pos) + kv * 128 + g * 64 + (idx & 15) * 4; }
  const int a_lds = (tid >> 5) * ST + (((tid >> 4) & 1) * 64 + (tid & 15) * 4) * 2;
  const bf16_t* bsrc = W1T + (size_t)(tid >> 4) * 1024 + (tid & 15) * 8;
  const int b_lds = ABUF + (tid >> 4) * ST + (tid & 15) * 16;
  f32x4 acc[8];
#pragma unroll
  for (int nt = 0; nt < 8; ++nt) acc[nt] = (f32x4){0.f, 0.f, 0.f, 0.f};
  u32x4 breg[4]; f32x4 areg[8];
#pragma unroll
  for (int i = 0; i < 4; ++i) breg[i] = *(const u32x4*)(bsrc + (size_t)(32 * i) * 1024);
#pragma unroll
  for (int i = 0; i < 8; ++i) areg[i] = *(const f32x4*)arow[i];
#pragma unroll 1
  for (int c = 0; c < 8; ++c) {
    LAS unsigned char* base = lds + (c & 1) * BUF;
#pragma unroll
    for (int i = 0; i < 4; ++i) *(LAS u32x4*)(base + b_lds + 32 * i * ST) = breg[i];
#pragma unroll
    for (int i = 0; i < 8; ++i) { u32x2 pk; pk.x = cvt_pk_bf16(areg[i][0], areg[i][1]); pk.y = cvt_pk_bf16(areg[i][2], areg[i][3]); *(LAS u32x2*)(base + a_lds + i * 16 * ST) = pk; }
    if (c < 7) {
#pragma unroll
      for (int i = 0; i < 4; ++i) breg[i] = *(const u32x4*)(bsrc + (size_t)(32 * i) * 1024 + (c + 1) * 128);
#pragma unroll
      for (int i = 0; i < 8; ++i) areg[i] = *(const f32x4*)(arow[i] + (size_t)(2 * (c + 1)) * 256);
    }
    lds_barrier();
#pragma unroll
    for (int i = 0; i < 4; ++i) {
      const bf16x8 af = *(const LAS bf16x8*)(base + (16 * w + fr) * ST + i * 64 + fq * 16);
#pragma unroll
      for (int nt = 0; nt < 8; ++nt) {
        const bf16x8 bf = *(const LAS bf16x8*)(base + ABUF + (nt * 16 + fr) * ST + i * 64 + fq * 16);
        acc[nt] = mfma16(bf, af, acc[nt]);
      }
    }
  }
  __syncthreads();
#pragma unroll
  for (int nt = 0; nt < 8; ++nt) *(LAS f32x4*)(lds + POFF + (16 * w + fr) * 528 + (nt * 16 + 4 * fq) * 4) = acc[nt];
  __syncthreads();
  {
    const int i = 16 * w + fr, i1 = i < 127 ? i + 1 : 127;
    f32x4 o[4];
#pragma unroll
    for (int nt = 0; nt < 4; ++nt) o[nt] = (f32x4){0.f, 0.f, 0.f, 0.f};
#pragma unroll
    for (int ks = 0; ks < 2; ++ks) {
      const int k0 = ks * 32 + fq * 8;
      union { bf16x8 v; unsigned u[4]; } hf;
#pragma unroll
      for (int h2 = 0; h2 < 2; ++h2) {
        const f32x4 pa = *(const LAS f32x4*)(lds + POFF + i * 528 + (k0 + 4 * h2) * 4);
        const f32x4 pb = *(const LAS f32x4*)(lds + POFF + i1 * 528 + (64 + k0 + 4 * h2) * 4);
        const f32x4 cb = *(const f32x4*)(cbias + k0 + 4 * h2);
        const f32x4 x = pa + pb + cb;
        hf.u[2 * h2] = cvt_pk_bf16(gelu_tanh_f(x[0]), gelu_tanh_f(x[1]));
        hf.u[2 * h2 + 1] = cvt_pk_bf16(gelu_tanh_f(x[2]), gelu_tanh_f(x[3]));
      }
#pragma unroll
      for (int nt = 0; nt < 4; ++nt) {
        const bf16x8 bf = *(const bf16x8*)(W2T + (size_t)(nt * 16 + fr) * 64 + k0);
        o[nt] = mfma16(bf, hf.v, o[nt]);
      }
    }
    const bool real = i < 127;
#pragma unroll
    for (int nt = 0; nt < 4; ++nt) {
      const int c0 = nt * 16 + 4 * fq;
      const float v0 = real ? o[nt][0] : 0.f, v1 = real ? o[nt][1] : 0.f, v2 = real ? o[nt][2] : 0.f, v3 = real ? o[nt][3] : 0.f;
      if (kv == 0) { u32x2 pk; pk.x = cvt_pk_bf16(v0, v1); pk.y = cvt_pk_bf16(v2, v3); *(u32x2*)(kc_out + (size_t)i * 64 + c0) = pk; }
      else if (VROWMAJOR) { u32x2 pk; pk.x = cvt_pk_bf16(v0, v1); pk.y = cvt_pk_bf16(v2, v3); *(u32x2*)(vcT_out + (size_t)i * 64 + c0) = pk; }
      else { vcT_out[(size_t)(c0 + 0) * 128 + i] = f2bf(v0); vcT_out[(size_t)(c0 + 1) * 128 + i] = f2bf(v1); vcT_out[(size_t)(c0 + 2) * 128 + i] = f2bf(v2); vcT_out[(size_t)(c0 + 3) * 128 + i] = f2bf(v3); }
    }
  }
  __syncthreads();
}

__device__ __forceinline__ void phaseB(LAS unsigned char* lds, const PhaseBArgs& a) {
  const int G = gridDim.x, wg = blockIdx.x;
  REPB(0) for (int it = wg; it < 256; it += G) conv_item<64>(a, lds, it >> 5, it & 31);
  REPB(2) for (int it = wg; it < 32; it += G) {
    const int b = it >> 2, g = (it >> 1) & 1, kv = it & 1;
    CmpSrc src{a.cmp_rows_p + (size_t)b * SEQ * 256, nullptr};
    compress_item<false>(lds, src, g, kv, a.W1T + (size_t)kv * 128 * 1024, a.W2T + (size_t)kv * 4096, a.cbias + kv * 64,
                  a.kcP + ((size_t)b * 2 + g) * 128 * 64, a.vcPT + ((size_t)b * 2 + g) * 64 * 128);
  }
  REPB(1) for (int it = (wg + G - 32 % G) % G; it < 128; it += G) pool_item(a, lds, it >> 4, it & 15);
  REPB(3) for (int it = (wg + G - 128 % G) % G; it < 128; it += G) gates_item(a, lds, it);
}
#ifdef MULTI_LAUNCH
__global__ void __launch_bounds__(512, 2) k_phaseB(PhaseBArgs a) {
  extern __shared__ __attribute__((aligned(16))) unsigned char shm[];
  phaseB((LAS unsigned char*)shm, a);
}
#endif

struct EpiA {
  static constexpr bool PERM = true, AFTER_DRAIN = false;
  int l; int pad_;
  const float* ssq; const float* g_q; const float* g_k; const float* cs;
  bf16_t *glu, *bin, *sza, *szb, *szc, *qb, *ks, *vsT, *kw, *vwT; float* out;
  __device__ __forceinline__ void norm_rope(f32x4 (&v)[2][2], const float* gain, int t, int fq) const {
    float ss = 0.f;
#pragma unroll
    for (int bj = 0; bj < 2; ++bj)
#pragma unroll
      for (int n = 0; n < 2; ++n) ss += (v[bj][n][0] * v[bj][n][0] + v[bj][n][1] * v[bj][n][1]) + (v[bj][n][2] * v[bj][n][2] + v[bj][n][3] * v[bj][n][3]);
    ss += __shfl_xor(ss, 16); ss += __shfl_xor(ss, 32);
    const float rn = rsqrtf(ss * (1.f / 64.f) + 1e-6f);
#pragma unroll
    for (int bj = 0; bj < 2; ++bj)
#pragma unroll
      for (int n = 0; n < 2; ++n) { const f32x4 gg = *(const f32x4*)(gain + 32 * bj + 8 * fq + 4 * n); v[bj][n] = v[bj][n] * rn * gg; }
#pragma unroll
    for (int n = 0; n < 2; ++n) {
      const f32x4 c0 = *(const f32x4*)(cs + t * 16 + 8 * n), c1 = *(const f32x4*)(cs + t * 16 + 8 * n + 4);
      const float cc[4] = {c0[0], c0[2], c1[0], c1[2]}, sn[4] = {c0[1], c0[3], c1[1], c1[3]};
#pragma unroll
      for (int e = 0; e < 4; ++e) {
        const float y = v[0][n][e], pr = __shfl_xor(y, 16);
        const float r0 = y * cc[e] - pr * sn[e], r1 = y * cc[e] + pr * sn[e];
        v[0][n][e] = fq == 0 ? r0 : (fq == 1 ? r1 : y);
      }
    }
  }
  __device__ __forceinline__ void operator()(const f32x4 (&acc)[2][2][4][2], const Unit& u, int wr_, int wc_, int fr_, int fq_) const {
    const int tz = tidx(), wid_ = tz >> 6, wr = wid_ >> 2, wc = wid_ & 3, fr = tz & 15, fq = (tz >> 4) & 3;
    const int pn = u.pn;
    const int row0 = u.pm * 256 + wr * 64 + fr;
    const int jc = 32 * wc + 8 * fq;
#pragma unroll
    for (int ai = 0; ai < 2; ++ai)
#pragma unroll
      for (int m = 0; m < 4; ++m) {
        const int row = row0 + ai * 128 + m * 16;
        const size_t tok = (size_t)row;
        const int b = row >> 11, t = row & 2047;
        float rinv;
        { const f32x4 p = *(const f32x4*)(ssq + tok * 16 + fq * 4); float sq = (p[0] + p[1]) + (p[2] + p[3]); sq += __shfl_xor(sq, 16); sq += __shfl_xor(sq, 32); rinv = rsqrtf(sq * (1.f / 1024.f) + 1e-6f); }
        f32x4 v[2][2];
#pragma unroll
        for (int bj = 0; bj < 2; ++bj)
#pragma unroll
          for (int n = 0; n < 2; ++n) v[bj][n] = acc[ai][bj][m][n] * rinv;
        if (pn < 2) {
          const int c = pn * 128 + jc;
          f32x4 o0, o1;
#pragma unroll
          for (int e = 0; e < 4; ++e) { o0[e] = v[0][0][e] * fsigmoid(v[1][0][e]); o1[e] = v[0][1][e] * fsigmoid(v[1][1][e]); }
          u32x4 pk; pk.x = cvt_pk_bf16(o0[0], o0[1]); pk.y = cvt_pk_bf16(o0[2], o0[3]); pk.z = cvt_pk_bf16(o1[0], o1[1]); pk.w = cvt_pk_bf16(o1[2], o1[3]);
          *(u32x4*)(glu + tok * 256 + c) = pk;
          if (t >= 2018) { float* dst = out + O_CONVP + ((size_t)(l * 8 + b) * 30 + (t - 2018)) * 256 + c; *(f32x4*)dst = o0; *(f32x4*)(dst + 4) = o1; }
        } else if (pn == 3) {
#pragma unroll
          for (int bj = 0; bj < 2; ++bj) {
            const int c = 128 * bj + jc;
            u32x4 pk; pk.x = cvt_pk_bf16(v[bj][0][0], v[bj][0][1]); pk.y = cvt_pk_bf16(v[bj][0][2], v[bj][0][3]); pk.z = cvt_pk_bf16(v[bj][1][0], v[bj][1][1]); pk.w = cvt_pk_bf16(v[bj][1][2], v[bj][1][3]);
            *(u32x4*)(bin + tok * 256 + c) = pk;
            if (t >= 2033) { float* dst = out + O_POOLP + ((size_t)(l * 8 + b) * 15 + (t - 2033)) * 256 + c; *(f32x4*)dst = v[bj][0]; *(f32x4*)(dst + 4) = v[bj][1]; }
          }
        } else if (pn == 2 || pn == 4 || pn >= 10) {
          bf16_t* base = pn == 2 ? sza + tok * 256 : (pn == 4 ? szb + tok * 256 : szc + tok * 512 + (pn - 10) * 256);
#pragma unroll
          for (int bj = 0; bj < 2; ++bj) {
            u32x4 pk; pk.x = cvt_pk_bf16(fsilu(v[bj][0][0]), fsilu(v[bj][0][1])); pk.y = cvt_pk_bf16(fsilu(v[bj][0][2]), fsilu(v[bj][0][3]));
            pk.z = cvt_pk_bf16(fsilu(v[bj][1][0]), fsilu(v[bj][1][1])); pk.w = cvt_pk_bf16(fsilu(v[bj][1][2]), fsilu(v[bj][1][3]));
            *(u32x4*)(base + 128 * bj + jc) = pk;
          }
        } else if (pn <= 6) {
          const int head = (pn - 5) * 4 + wc;
          norm_rope(v, g_q, t, fq);
          const float sc = 0.125f * 1.4426950408889634f;
#pragma unroll
          for (int bj = 0; bj < 2; ++bj) {
            u32x4 pk; pk.x = cvt_pk_bf16(v[bj][0][0] * sc, v[bj][0][1] * sc); pk.y = cvt_pk_bf16(v[bj][0][2] * sc, v[bj][0][3] * sc);
            pk.z = cvt_pk_bf16(v[bj][1][0] * sc, v[bj][1][1] * sc); pk.w = cvt_pk_bf16(v[bj][1][2] * sc, v[bj][1][3] * sc);
            *(u32x4*)(qb + (tok * 8 + head) * 64 + 32 * bj + 8 * fq) = pk;
          }
        } else {
          const int br = pn - 7, kvsel = wc >> 1, g = wc & 1;
          if (kvsel == 0) norm_rope(v, g_k + br * 64, t, fq);
          float* fdst = nullptr;
          if (br == 0) fdst = out + O_CMPP + ((size_t)l * NPT + tok) * 256;
          else if (br == 1) fdst = out + O_SLCP + ((size_t)l * NPT + tok) * 256;
          else if (t >= 1792) fdst = out + O_WINP + ((size_t)(l * 8 + b) * 256 + (t - 1792)) * 256;
          if (fdst) {
#pragma unroll
            for (int bj = 0; bj < 2; ++bj) { float* d2 = fdst + kvsel * 128 + g * 64 + 32 * bj + 8 * fq; *(f32x4*)d2 = v[bj][0]; *(f32x4*)(d2 + 4) = v[bj][1]; }
          }
          if (br >= 1) {
            const size_t bg = (size_t)b * 2 + g;
            if (kvsel == 0) {
              bf16_t* kd = (br == 1 ? ks : kw) + (bg * SEQ + t) * 64;
#pragma unroll
              for (int bj = 0; bj < 2; ++bj) {
                u32x4 pk; pk.x = cvt_pk_bf16(v[bj][0][0], v[bj][0][1]); pk.y = cvt_pk_bf16(v[bj][0][2], v[bj][0][3]); pk.z = cvt_pk_bf16(v[bj][1][0], v[bj][1][1]); pk.w = cvt_pk_bf16(v[bj][1][2], v[bj][1][3]);
                *(u32x4*)(kd + 32 * bj + 8 * fq) = pk;
              }
            } else {
              bf16_t* vd = (br == 1 ? vsT : vwT) + bg * 64 * SEQ + t;
#pragma unroll
              for (int bj = 0; bj < 2; ++bj)
#pragma unroll
                for (int n = 0; n < 2; ++n)
#pragma unroll
                  for (int e = 0; e < 4; ++e) vd[(size_t)(32 * bj + 8 * fq + 4 * n + e) * SEQ] = f2bf(v[bj][n][e]);
            }
          }
        }
      }
  }
};
struct PhaseAArgs { EpiA epi; const bf16_t* xb; const bf16_t* WinT; };
__device__ __forceinline__ void phaseA(LAS unsigned char* lds, const PhaseAArgs& a) {
  pg8::Gemm g{a.xb, a.WinT, NPT, 3072, 1024};
  pg8::StaticOrder S; S.init(NPT, 3072, gridDim.x, blockIdx.x);
  pg8::gemm_phase<EpiA, pg8::StaticOrder, false>(lds, g, S, a.epi, nullptr);
}
#ifdef MULTI_LAUNCH
__global__ void __launch_bounds__(512, 2) k_phaseA(PhaseAArgs a) {
  extern __shared__ __attribute__((aligned(16))) unsigned char shm[];
  phaseA((LAS unsigned char*)shm, a);
}
#endif

__device__ __forceinline__ float wsum(float v) {
#pragma unroll
  for (int o = 32; o > 0; o >>= 1) v += __shfl_xor(v, o);
  return v;
}
__device__ __forceinline__ float wmax(float v) {
#pragma unroll
  for (int o = 32; o > 0; o >>= 1) v = fmaxf(v, __shfl_xor(v, o));
  return v;
}
template <int NT> __device__ __forceinline__ void thin_gemm(const bf16_t* A, int lda, const bf16_t* Bt, int ldb, int K, f32x4 (&acc)[NT], int fr, int fq) {
  const bf16_t* ap = A + (size_t)fr * lda + fq * 8;
  const bf16_t* bp = Bt + (size_t)fr * ldb + fq * 8;
#pragma unroll
  for (int nt = 0; nt < NT; ++nt) acc[nt] = (f32x4){0.f, 0.f, 0.f, 0.f};
#pragma unroll 4
  for (int k0 = 0; k0 < K; k0 += 32) {
    const bf16x8 af = *(const bf16x8*)(ap + k0);
#pragma unroll
    for (int nt = 0; nt < NT; ++nt) { const bf16x8 bf = *(const bf16x8*)(bp + (size_t)nt * 16 * ldb + k0); acc[nt] = mfma16(bf, af, acc[nt]); }
  }
}
__device__ __forceinline__ void s1_unit(LAS unsigned char* lds, const bf16_t* xb_s, const float* ssq_s, const bf16_t* WinT, float* sproj, int u) {
  const int tid = tidx(), w = tid >> 6, lane = tid & 63, fr = lane & 15, fq = lane >> 4;
  const int n0 = 16 * u, row = 16 * w + fr;
  f32x4 acc[1];
  small_gemm<1>(lds, xb_s, 1024, WinT + (size_t)n0 * 1024, 1024, 1024, acc);
  float rinv;
  { const f32x4* pp = (const f32x4*)(ssq_s + (size_t)row * 64); float sq = 0.f;
#pragma unroll
    for (int i = 0; i < 16; ++i) { const f32x4 v = pp[i]; sq += (v[0] + v[1]) + (v[2] + v[3]); }
    rinv = rsqrtf(sq * (1.f / 1024.f) + 1e-6f); }
  const int np = n0 + 4 * fq;
  if (np < 3096) { const int lc = win_logical_col(np); *(f32x4*)(sproj + (size_t)row * 3104 + lc) = acc[0] * rinv; }
}
template <bool LAST> __device__ __forceinline__ void s4_unit(LAS unsigned char* lds, const bf16_t* mix_s, const bf16_t* WoutT, const float* xs, float* xs_out, bf16_t* xb_s, float* ssq_s, int u) {
  const int tid = tidx(), w = tid >> 6, lane = tid & 63, fr = lane & 15, fq = lane >> 4;
  const int n0 = 16 * u, row = 16 * w + fr;
  f32x4 acc[1];
  small_gemm<1>(lds, mix_s, 1024, WoutT + (size_t)n0 * 1024, 1024, 1024, acc);
  const int c = n0 + 4 * fq;
  const f32x4 v = acc[0] + *(const f32x4*)(xs + (size_t)row * 1024 + c);
  *(f32x4*)(xs_out + (size_t)row * 1024 + c) = v;
  if (!LAST) {
    u32x2 pk; pk.x = cvt_pk_bf16(v[0], v[1]); pk.y = cvt_pk_bf16(v[2], v[3]); *(u32x2*)(xb_s + (size_t)row * 1024 + c) = pk;
    float ss = (v[0] * v[0] + v[1] * v[1]) + (v[2] * v[2] + v[3] * v[3]);
    ss += __shfl_xor(ss, 16); ss += __shfl_xor(ss, 32);
    if (fq == 0) ssq_s[(size_t)row * 64 + u] = ss;
  }
}

struct SampArgs {
  int l; int pad_;
  const float* sproj;
  const float *g_q, *g_k, *cs;
  const float *state_conv_l, *state_pool_l;
  const float *w_dw, *b_dw, *ln_g, *ln_b, *w_pw, *b_pw, *w_pool, *pool_scale;
  const float *cache_slc_l, *cache_win_l; const int* page_table;
  const bf16_t *kcS, *vcST;
  float *sq, *srows, *sgates;
  bf16_t* mix_s;
  float* out;
};
__device__ __forceinline__ void s2_item(const SampArgs& a, LAS unsigned char* lds, int b) {
  const int tid = tidx(), w = tid >> 6, lane = tid & 63, l = a.l;
  const float* pr = a.sproj + (size_t)b * 3104;
  LAS float* sh = (LAS float*)lds;
  const float* csp = a.cs + 2048 * 16;
  {
    const float v = pr[C_Q + w * 64 + lane];
    const float y = v * rsqrtf(wsum(v * v) * (1.f / 64.f) + 1e-6f) * a.g_q[lane];
    const float pp = __shfl_xor(y, 8);
    float o = y;
    if (lane < 16) { const int j = lane & 7; const float c = csp[j * 2], sn = csp[j * 2 + 1]; o = lane < 8 ? y * c - pp * sn : y * c + pp * sn; }
    a.sq[(size_t)b * 512 + w * 64 + lane] = o;
  }
  if (w < 6) {
    const int br = w >> 1, g = w & 1;
    const float v = pr[C_KV + br * 256 + g * 64 + lane];
    const float y = v * rsqrtf(wsum(v * v) * (1.f / 64.f) + 1e-6f) * a.g_k[br * 64 + lane];
    const float pp = __shfl_xor(y, 8);
    float o = y;
    if (lane < 16) { const int j = lane & 7; const float c = csp[j * 2], sn = csp[j * 2 + 1]; o = lane < 8 ? y * c - pp * sn : y * c + pp * sn; }
    const float vv = pr[C_KV + br * 256 + 128 + g * 64 + lane];
    a.srows[(size_t)b * 768 + br * 256 + g * 64 + lane] = o;
    a.srows[(size_t)b * 768 + br * 256 + 128 + g * 64 + lane] = vv;
    float* dst = br == 0 ? a.out + O_CMPS + ((size_t)l * NSM + b) * 256 : (br == 1 ? a.out + O_SLCS + ((size_t)l * NSM + b) * 256 : a.out + O_WINS + (((size_t)l * NSM + b) * 256 + 255) * 256);
    dst[g * 64 + lane] = o; dst[128 + g * 64 + lane] = vv;
  }
  if (tid < 24) a.sgates[(size_t)b * 24 + tid] = fsigmoid(pr[C_GATE + tid]);
  float yv = 0.f;
  if (tid < 256) {
    const int c = tid;
    const float glu = pr[C_AVAL + c] * fsigmoid(pr[C_AGATE + c]);
    const float* st = a.state_conv_l + (size_t)b * 30 * 256 + c;
    float* cso = a.out + O_CONVS + ((size_t)l * NSM + b) * 30 * 256 + c;
    float acc = a.b_dw[c];
#pragma unroll
    for (int k = 0; k < 30; ++k) { const float sv = st[k * 256]; acc = fmaf(a.w_dw[k * 256 + c], sv, acc); if (k >= 1) cso[(k - 1) * 256] = sv; }
    acc = fmaf(a.w_dw[30 * 256 + c], glu, acc);
    cso[29 * 256] = glu;
    yv = acc;
  } else {
    const int ch = tid - 256, g = ch >> 6, wn = 2 << g;
    const float cur = pr[C_BIN + ch];
    const float* st = a.state_pool_l + (size_t)b * 15 * 256 + ch;
    float* pso = a.out + O_POOLS + ((size_t)l * NSM + b) * 15 * 256 + ch;
    float total = cur;
#pragma unroll
    for (int j = 1; j < 15; ++j) pso[(j - 1) * 256] = st[j * 256];
    pso[14 * 256] = cur;
    for (int j = 1; j < wn; ++j) total += st[(15 - j) * 256];
    sh[256 + ch] = total / (float)wn - cur;
  }
  { const float s1 = wsum(yv); if (lane == 0) sh[512 + w] = s1; }
  __syncthreads();
  const float mean = (sh[512] + sh[513] + sh[514] + sh[515]) * (1.f / 256.f);
  const float xc = yv - mean;
  { const float s2 = wsum(xc * xc); if (lane == 0) sh[520 + w] = s2; }
  __syncthreads();
  if (tid < 256) {
    const float var = (sh[520] + sh[521] + sh[522] + sh[523]) * (1.f / 256.f);
    const float z = xc * rsqrtf(var + 1e-6f) * a.ln_g[tid] + a.ln_b[tid];
    sh[tid] = fsilu(z);
  }
  __syncthreads();
  {
    const int n = tid & 255, kh = tid >> 8;
    const float* wp = a.w_pw + (size_t)(kh * 128) * 256 + n;
    float o = 0.f;
#pragma unroll 16
    for (int k = 0; k < 128; ++k) o = fmaf(sh[kh * 128 + k], wp[(size_t)k * 256], o);
    sh[528 + kh * 256 + n] = o;
  }
  __syncthreads();
  if (tid < 256) {
    const int n = tid;
    const float o = a.b_pw[n] + sh[528 + n] + sh[528 + 256 + n];
    a.mix_s[(size_t)b * 1024 + n] = f2bf(o * fsilu(pr[C_ZA + n]));
  } else {
    const int ch = tid - 256, g = ch >> 6, e = ch & 63;
    float o = 0.f;
#pragma unroll 16
    for (int c = 0; c < 64; ++c) o = fmaf(sh[256 + g * 64 + c], a.w_pool[(g * 64 + c) * 64 + e], o);
    a.mix_s[(size_t)b * 1024 + 256 + ch] = f2bf(o * a.pool_scale[ch] * fsilu(pr[C_ZB + ch]));
  }
  __syncthreads();
}
__device__ __forceinline__ float dot16(const float (&q)[16], const f32x4& k0, const f32x4& k1, const f32x4& k2, const f32x4& k3) {
  float d = 0.f;
#pragma unroll
  for (int i = 0; i < 4; ++i) { d = fmaf(q[i], k0[i], d); d = fmaf(q[4 + i], k1[i], d); d = fmaf(q[8 + i], k2[i], d); d = fmaf(q[12 + i], k3[i], d); }
  return d;
}
__device__ __forceinline__ void s3_item(const SampArgs& a, LAS unsigned char* lds, int n, int g) {
  const int tid = tidx(), w = tid >> 6, lane = tid & 63;
  const int key_l = lane >> 2, qtr = lane & 3;
  const int ksub = lane >> 4, d4 = lane & 15;
  LAS float* qs = (LAS float*)lds;
  LAS float* sc = qs + 256;
  LAS float* imp = sc + 2048;
  LAS int* sel = (LAS int*)(imp + 64);
  LAS float* red = imp + 128;
  const size_t bg = (size_t)n * 2 + g;
  const float* srow = a.srows + (size_t)n * 768;
  if (tid < 256) qs[tid] = a.sq[(size_t)n * 512 + g * 256 + tid] * 0.125f;
  __syncthreads();
  float q[4][16];
#pragma unroll
  for (int h = 0; h < 4; ++h)
#pragma unroll
    for (int i = 0; i < 16; ++i) q[h][i] = qs[h * 64 + qtr * 16 + i];
  float o_c, o_s, o_w;
#define S3_SOFTMAX(NPL)                                                                              \
  if (w < 4) {                                                                                       \
    float v_[NPL]; float m_ = NEGF;                                                                  \
    _Pragma("unroll") for (int i_ = 0; i_ < NPL; ++i_) { v_[i_] = sc[w * 512 + lane + 64 * i_]; m_ = fmaxf(m_, v_[i_]); } \
    m_ = wmax(m_); float s_ = 0.f;                                                                   \
    _Pragma("unroll") for (int i_ = 0; i_ < NPL; ++i_) { v_[i_] = v_[i_] > -1e29f ? __expf(v_[i_] - m_) : 0.f; s_ += v_[i_]; } \
    s_ = 1.f / fmaxf(wsum(s_), 1e-30f);                                                              \
    _Pragma("unroll") for (int i_ = 0; i_ < NPL; ++i_) sc[w * 512 + lane + 64 * i_] = v_[i_] * s_;   \
  }
#define S3_REDUCE(ACC, OUT)                                                                          \
  _Pragma("unroll") for (int h_ = 0; h_ < 4; ++h_) _Pragma("unroll") for (int e_ = 0; e_ < 4; ++e_) { float t_ = ACC[h_][e_]; t_ += __shfl_xor(t_, 16); t_ += __shfl_xor(t_, 32); ACC[h_][e_] = t_; } \
  if (ksub == 0) { _Pragma("unroll") for (int h_ = 0; h_ < 4; ++h_) *(LAS f32x4*)(red + (w * 4 + h_) * 64 + 4 * d4) = (f32x4){ACC[h_][0], ACC[h_][1], ACC[h_][2], ACC[h_][3]}; } \
  __syncthreads();                                                                                   \
  OUT = 0.f;                                                                                         \
  if (tid < 256) { _Pragma("unroll") for (int w_ = 0; w_ < 8; ++w_) OUT += red[w_ * 256 + tid]; }   \
  __syncthreads();
  {
    const int c = 16 * w + key_l;
    const bf16_t* kr = a.kcS + (bg * 128 + c) * 64 + qtr * 16;
    const u32x4 k0 = *(const u32x4*)kr, k1 = *(const u32x4*)(kr + 8);
    const f32x4 f0 = {bflo(k0.x), bfhi(k0.x), bflo(k0.y), bfhi(k0.y)}, f1 = {bflo(k0.z), bfhi(k0.z), bflo(k0.w), bfhi(k0.w)};
    const f32x4 f2 = {bflo(k1.x), bfhi(k1.x), bflo(k1.y), bfhi(k1.y)}, f3 = {bflo(k1.z), bfhi(k1.z), bflo(k1.w), bfhi(k1.w)};
#pragma unroll
    for (int h = 0; h < 4; ++h) {
      float d = dot16(q[h], f0, f1, f2, f3);
      d += __shfl_xor(d, 1); d += __shfl_xor(d, 2);
      if (qtr == 0) sc[h * 512 + c] = c < 127 ? d : NEGF;
    }
  }
  __syncthreads();
  S3_SOFTMAX(2)
  __syncthreads();
  if (tid < 33) {
    const int s = tid, lo = max(0, 4 * s - 1), hi = min(126, 4 * s + 3);
    float v = 0.f;
    for (int rr = 0; rr < 4; ++rr) for (int c = lo; c <= hi; ++c) v += sc[rr * 512 + c];
    const bool forced = (s == 0) || (s == 32) || (s == 31);
    imp[s] = forced ? 1e4f : v;
  }
  {
    float acc[4][4];
#pragma unroll
    for (int h = 0; h < 4; ++h)
#pragma unroll
      for (int e = 0; e < 4; ++e) acc[h][e] = 0.f;
#pragma unroll
    for (int it = 0; it < 4; ++it) {
      const int c = 16 * w + 4 * it + ksub;
      const u32x2 vv = *(const u32x2*)(a.vcST + (bg * 128 + c) * 64 + 4 * d4);
      const float v0 = bflo(vv.x), v1 = bfhi(vv.x), v2 = bflo(vv.y), v3 = bfhi(vv.y);
#pragma unroll
      for (int h = 0; h < 4; ++h) { const float p = sc[h * 512 + c]; acc[h][0] = fmaf(p, v0, acc[h][0]); acc[h][1] = fmaf(p, v1, acc[h][1]); acc[h][2] = fmaf(p, v2, acc[h][2]); acc[h][3] = fmaf(p, v3, acc[h][3]); }
    }
    S3_REDUCE(acc, o_c)
  }
  if (tid == 0) {
    unsigned long long taken = 0ull;
    for (int k = 0; k < 8; ++k) {
      int best = -1; float bv = -3e38f;
      for (int s = 0; s < 33; ++s) if (!((taken >> s) & 1ull) && imp[s] > bv) { bv = imp[s]; best = s; }
      taken |= 1ull << best; sel[k] = best;
    }
  }
  __syncthreads();
  const int blk = sel[w];
  const float* sl_base;
  if (blk < 32) sl_base = a.cache_slc_l + ((size_t)a.page_table[n * 16 + (blk >> 1)] * 128 + (blk & 1) * 64) * 256 + g * 64;
  else sl_base = srow + 256 + g * 64;
  const float* wbase = a.cache_win_l + ((size_t)n * 256 + 1) * 256 + g * 64;
  f32x4 kk[4][4], vv[16];
#pragma unroll
  for (int ps = 0; ps < 4; ++ps) {
    const int j = 16 * ps + key_l;
    const bool valid = blk < 32 || j == 0;
    const float* kr = sl_base + (size_t)(valid ? j : 0) * 256 + qtr * 16;
#pragma unroll
    for (int i = 0; i < 4; ++i) kk[ps][i] = *(const f32x4*)(kr + 4 * i);
  }
#pragma unroll
  for (int it = 0; it < 16; ++it) {
    const int j = 4 * it + ksub;
    const bool valid = blk < 32 || j == 0;
    vv[it] = *(const f32x4*)(sl_base + (size_t)(valid ? j : 0) * 256 + 128 + 4 * d4);
  }
#pragma unroll
  for (int ps = 0; ps < 4; ++ps) {
    const int j = 16 * ps + key_l;
    const bool valid = blk < 32 || j == 0;
#pragma unroll
    for (int h = 0; h < 4; ++h) {
      float d = dot16(q[h], kk[ps][0], kk[ps][1], kk[ps][2], kk[ps][3]);
      d += __shfl_xor(d, 1); d += __shfl_xor(d, 2);
      if (qtr == 0) sc[h * 512 + w * 64 + j] = valid ? d : NEGF;
    }
  }
  f32x4 wk[2][4];
#pragma unroll
  for (int ps = 0; ps < 2; ++ps) {
    const int i = 32 * w + 16 * ps + key_l;
    const float* kr = (i < 255 ? wbase + (size_t)i * 256 : srow + 512 + g * 64) + qtr * 16;
#pragma unroll
    for (int e = 0; e < 4; ++e) wk[ps][e] = *(const f32x4*)(kr + 4 * e);
  }
  __syncthreads();
  S3_SOFTMAX(8)
  __syncthreads();
  {
    float acc[4][4];
#pragma unroll
    for (int h = 0; h < 4; ++h)
#pragma unroll
      for (int e = 0; e < 4; ++e) acc[h][e] = 0.f;
#pragma unroll
    for (int it = 0; it < 16; ++it) {
      const int j = 4 * it + ksub;
#pragma unroll
      for (int h = 0; h < 4; ++h) { const float p = sc[h * 512 + w * 64 + j];
#pragma unroll
        for (int e = 0; e < 4; ++e) acc[h][e] = fmaf(p, vv[it][e], acc[h][e]); }
    }
    S3_REDUCE(acc, o_s)
  }
  f32x4 wv[8];
#pragma unroll
  for (int it = 0; it < 8; ++it) {
    const int i = 32 * w + 4 * it + ksub;
    wv[it] = *(const f32x4*)((i < 255 ? wbase + (size_t)i * 256 : srow + 512 + g * 64) + 128 + 4 * d4);
  }
#pragma unroll
  for (int ps = 0; ps < 2; ++ps) {
    const int i = 32 * w + 16 * ps + key_l;
#pragma unroll
    for (int h = 0; h < 4; ++h) {
      float d = dot16(q[h], wk[ps][0], wk[ps][1], wk[ps][2], wk[ps][3]);
      d += __shfl_xor(d, 1); d += __shfl_xor(d, 2);
      if (qtr == 0) sc[h * 512 + i] = d;
    }
  }
  __syncthreads();
  S3_SOFTMAX(4)
  __syncthreads();
  {
    float acc[4][4];
#pragma unroll
    for (int h = 0; h < 4; ++h)
#pragma unroll
      for (int e = 0; e < 4; ++e) acc[h][e] = 0.f;
#pragma unroll
    for (int it = 0; it < 8; ++it) {
      const int i = 32 * w + 4 * it + ksub;
#pragma unroll
      for (int h = 0; h < 4; ++h) { const float p = sc[h * 512 + i];
#pragma unroll
        for (int e = 0; e < 4; ++e) acc[h][e] = fmaf(p, wv[it][e], acc[h][e]); }
    }
    S3_REDUCE(acc, o_w)
  }
  if (tid < 256) {
    const int h = g * 4 + (tid >> 6), d = tid & 63;
    const float* gt = a.sgates + (size_t)n * 24;
    const float o = gt[h] * o_c + gt[8 + h] * o_s + gt[16 + h] * o_w;
    a.mix_s[(size_t)n * 1024 + 512 + h * 64 + d] = f2bf(o * fsilu(a.sproj[(size_t)n * 3104 + C_ZC + h * 64 + d]));
  }
  __syncthreads();
#undef S3_SOFTMAX
#undef S3_REDUCE
}

#ifdef MULTI_LAUNCH
__global__ void __launch_bounds__(512, 2) k_s1(const bf16_t* xb_s, const float* ssq_s, const bf16_t* WinT, float* sproj) {
  extern __shared__ __attribute__((aligned(16))) unsigned char shm[];
  for (int u = blockIdx.x; u < 194; u += gridDim.x) s1_unit((LAS unsigned char*)shm, xb_s, ssq_s, WinT, sproj, u);
}
#endif
#ifdef MULTI_LAUNCH
__global__ void __launch_bounds__(512, 2) k_s2(SampArgs a) {
  extern __shared__ __attribute__((aligned(16))) unsigned char shm[];
  for (int b = blockIdx.x; b < NSM; b += gridDim.x) s2_item(a, (LAS unsigned char*)shm, b);
}
#endif
struct CmpSArgs { const float* cache_cmp_l; const int* page_table; const bf16_t *W1T, *W2T; const float* cbias; bf16_t *kcS, *vcST; };
#ifdef MULTI_LAUNCH
__global__ void __launch_bounds__(512, 2) k_cmps(CmpSArgs a) {
  extern __shared__ __attribute__((aligned(16))) unsigned char shm[];
  for (int it = blockIdx.x; it < 512; it += gridDim.x) {
    const int n = it >> 2, g = (it >> 1) & 1, kv = it & 1;
    CmpSrc src{a.cache_cmp_l, a.page_table + n * 16};
    compress_item<true>((LAS unsigned char*)shm, src, g, kv, a.W1T + (size_t)kv * 128 * 1024, a.W2T + (size_t)kv * 4096, a.cbias + kv * 64,
                  a.kcS + ((size_t)n * 2 + g) * 128 * 64, a.vcST + ((size_t)n * 2 + g) * 64 * 128);
  }
}
#endif
#ifdef MULTI_LAUNCH
__global__ void __launch_bounds__(512, 2) k_s3(SampArgs a) {
  extern __shared__ __attribute__((aligned(16))) unsigned char shm[];
  for (int it = blockIdx.x; it < 256; it += gridDim.x) s3_item(a, (LAS unsigned char*)shm, it >> 1, it & 1);
}
#endif
#ifdef MULTI_LAUNCH
template <bool LAST> __global__ void __launch_bounds__(512, 2) k_s4(const bf16_t* mix_s, const bf16_t* WoutT, const float* xs, float* xs_out, bf16_t* xb_s, float* ssq_s) {
  extern __shared__ __attribute__((aligned(16))) unsigned char shm[];
  for (int u = blockIdx.x; u < 64; u += gridDim.x) s4_unit<LAST>((LAS unsigned char*)shm, mix_s, WoutT, xs, xs_out, xb_s, ssq_s, u);
}
#endif
__device__ __forceinline__ void wins_copy(const float* cache_win_l, float* out_l, int part, int nparts) {
  const size_t total4 = (size_t)NSM * 255 * 64;
  for (size_t i = (size_t)part * 512 + tidx(); i < total4; i += (size_t)nparts * 512) {
    const size_t n = i / (255 * 64), rem = i % (255 * 64);
    *(f32x4*)(out_l + n * 65536 + rem * 4) = *(const f32x4*)(cache_win_l + n * 65536 + 256 + rem * 4);
  }
}
#ifdef MULTI_LAUNCH
__global__ void __launch_bounds__(512, 2) k_wins(const float* cache_win_l, float* out_l) { wins_copy(cache_win_l, out_l, blockIdx.x, gridDim.x); }
#endif
}
namespace fast {
constexpr size_t al256(size_t x) { return (x + 255) & ~(size_t)255; }
constexpr size_t WS_BAR = 0;
constexpr size_t WS_CS = al256(WS_BAR + XCD_BAR_WORDS * 4);
constexpr size_t WS_SSQ = al256(WS_CS + 2049 * 16 * 4);
constexpr size_t WS_GATES = al256(WS_SSQ + (size_t)NTOK * 16 * 4);
constexpr size_t WS_CBIAS = al256(WS_GATES + (size_t)NPT * 24 * 4);
constexpr size_t WS_SPROJ = al256(WS_CBIAS + 256 * 4);
constexpr size_t WS_SQ = al256(WS_SPROJ + (size_t)NSM * 3104 * 4);
constexpr size_t WS_SROWS = al256(WS_SQ + (size_t)NSM * 512 * 4);
constexpr size_t WS_SGATES = al256(WS_SROWS + (size_t)NSM * 768 * 4);
constexpr size_t WS_X1P = al256(WS_SGATES + (size_t)NSM * 24 * 4);
constexpr size_t WS_X1S = al256(WS_X1P + (size_t)NPT * 1024 * 4);
constexpr size_t WS_XB = al256(WS_X1S + (size_t)NSM * 1024 * 4);
constexpr size_t WS_MIXB = al256(WS_XB + (size_t)NTOK * 1024 * 2);
constexpr size_t WS_QB = al256(WS_MIXB + (size_t)NTOK * 1024 * 2);
constexpr size_t WS_KSB = al256(WS_QB + (size_t)NPT * 512 * 2);
constexpr size_t WS_VST = al256(WS_KSB + (size_t)NPT * 128 * 2);
constexpr size_t WS_KWB = al256(WS_VST + (size_t)NPT * 128 * 2);
constexpr size_t WS_VWT = al256(WS_KWB + (size_t)NPT * 128 * 2);
constexpr size_t WS_KCP = al256(WS_VWT + (size_t)NPT * 128 * 2);
constexpr size_t WS_VCPT = al256(WS_KCP + (size_t)8 * 2 * 128 * 64 * 2);
constexpr size_t WS_SZC = al256(WS_VCPT + (size_t)8 * 2 * 128 * 64 * 2);
constexpr size_t WS_GLUB = al256(WS_SZC + (size_t)NPT * 512 * 2);
constexpr size_t WS_BINB = al256(WS_GLUB + (size_t)NPT * 256 * 2);
constexpr size_t WS_SZA = al256(WS_BINB + (size_t)NPT * 256 * 2);
constexpr size_t WS_SZB = al256(WS_SZA + (size_t)NPT * 256 * 2);
constexpr size_t WS_WINT = al256(WS_SZB + (size_t)NPT * 256 * 2);
constexpr size_t WS_WOUTT = al256(WS_WINT + (size_t)2 * 3104 * 1024 * 2);
constexpr size_t WS_WPWT = al256(WS_WOUTT + (size_t)2 * 1024 * 1024 * 2);
constexpr size_t WS_WPOOLT = al256(WS_WPWT + (size_t)2 * 65536 * 2);
constexpr size_t WS_W1T = al256(WS_WPOOLT + (size_t)2 * 4 * 4096 * 2);
constexpr size_t WS_W2T = al256(WS_W1T + (size_t)2 * 2 * 128 * 1024 * 2);
constexpr size_t WS_KCS = al256(WS_W2T + (size_t)2 * 2 * 4096 * 2);
constexpr size_t WS_VCST = al256(WS_KCS + (size_t)NSM * 2 * 128 * 64 * 2);
constexpr size_t WS_SSQS = al256(WS_VCST + (size_t)NSM * 2 * 128 * 64 * 2);
constexpr size_t WS_END = al256(WS_SSQS + (size_t)NSM * 64 * 4);

struct MegaArgsK {
  const float *x_prompt, *x_sample, *state_conv, *state_pool, *cache_win, *cache_cmp, *cache_slc; const int* page_table;
  const float *w_norm, *w_in, *w_out, *w_dw, *b_dw, *ln_g, *ln_b, *w_pw, *b_pw, *w_pool, *pool_scale, *g_q, *g_k, *cmp_pe, *cmp_w1, *cmp_w2;
  float* out;
  unsigned char* ws;
#ifdef PROBE_REP
  int rep[8];
#endif
};
struct MegaArgs {
  const float *x_prompt, *x_sample, *state_conv, *state_pool, *cache_win, *cache_cmp, *cache_slc; const int* page_table;
  const float *w_norm, *w_in, *w_out, *w_dw, *b_dw, *ln_g, *ln_b, *w_pw, *b_pw, *w_pool, *pool_scale, *g_q, *g_k, *cmp_pe, *cmp_w1, *cmp_w2;
  float* out;
  unsigned* bar;
  float *cs, *ssq, *ssqs, *gatesf, *cbias, *sproj, *sq, *srows, *sgates, *x1p, *x1s;
  bf16_t *xb, *mixb, *qb, *ksb, *vsT, *kwb, *vwT, *kcP, *vcPT, *szc, *glub, *binb, *sza, *szb, *WinT, *WoutT, *WpwT, *WpoolT, *W1T, *W2T, *kcS, *vcST;
#ifdef PROBE_REP
  int rep[8];
#endif
};
#ifdef PROBE_REP
#define REP(i) _Pragma("unroll 1") for (int rep_ = 0; rep_ < a.rep[i]; ++rep_)
#else
#define REP(i)
#endif
#ifdef PROBE_REPX
#define REPX(i) _Pragma("unroll 1") for (int repx_ = 0; repx_ < ((PROBE_REPX >> (4 * (i))) & 15); ++repx_)
#else
#define REPX(i)
#endif
__device__ __forceinline__ MegaArgs expand_args(const MegaArgsK& k) {
  MegaArgs a;
  a.x_prompt = k.x_prompt; a.x_sample = k.x_sample; a.state_conv = k.state_conv; a.state_pool = k.state_pool; a.cache_win = k.cache_win; a.cache_cmp = k.cache_cmp; a.cache_slc = k.cache_slc;
  a.page_table = k.page_table; a.w_norm = k.w_norm; a.w_in = k.w_in; a.w_out = k.w_out; a.w_dw = k.w_dw; a.b_dw = k.b_dw; a.ln_g = k.ln_g; a.ln_b = k.ln_b; a.w_pw = k.w_pw; a.b_pw = k.b_pw;
  a.w_pool = k.w_pool; a.pool_scale = k.pool_scale; a.g_q = k.g_q; a.g_k = k.g_k; a.cmp_pe = k.cmp_pe; a.cmp_w1 = k.cmp_w1; a.cmp_w2 = k.cmp_w2; a.out = k.out;
  unsigned char* w = k.ws;
  asm volatile("" : "+s"(w));
  a.bar = (unsigned*)(w + WS_BAR); a.cs = (float*)(w + WS_CS); a.ssq = (float*)(w + WS_SSQ); a.ssqs = (float*)(w + WS_SSQS); a.gatesf = (float*)(w + WS_GATES); a.cbias = (float*)(w + WS_CBIAS);
  a.sproj = (float*)(w + WS_SPROJ); a.sq = (float*)(w + WS_SQ); a.srows = (float*)(w + WS_SROWS); a.sgates = (float*)(w + WS_SGATES); a.x1p = (float*)(w + WS_X1P); a.x1s = (float*)(w + WS_X1S);
  a.xb = (bf16_t*)(w + WS_XB); a.mixb = (bf16_t*)(w + WS_MIXB); a.qb = (bf16_t*)(w + WS_QB); a.ksb = (bf16_t*)(w + WS_KSB); a.vsT = (bf16_t*)(w + WS_VST); a.kwb = (bf16_t*)(w + WS_KWB); a.vwT = (bf16_t*)(w + WS_VWT);
  a.kcP = (bf16_t*)(w + WS_KCP); a.vcPT = (bf16_t*)(w + WS_VCPT); a.szc = (bf16_t*)(w + WS_SZC); a.glub = (bf16_t*)(w + WS_GLUB); a.binb = (bf16_t*)(w + WS_BINB); a.sza = (bf16_t*)(w + WS_SZA); a.szb = (bf16_t*)(w + WS_SZB);
  a.WinT = (bf16_t*)(w + WS_WINT); a.WoutT = (bf16_t*)(w + WS_WOUTT); a.WpwT = (bf16_t*)(w + WS_WPWT); a.WpoolT = (bf16_t*)(w + WS_WPOOLT); a.W1T = (bf16_t*)(w + WS_W1T); a.W2T = (bf16_t*)(w + WS_W2T);
  a.kcS = (bf16_t*)(w + WS_KCS); a.vcST = (bf16_t*)(w + WS_VCST);
#ifdef PROBE_REP
  for (int i = 0; i < 8; ++i) a.rep[i] = k.rep[i];
#endif
  return a;
}

template <int MODE>
__device__ __forceinline__ void transpose_tile(const float* src, int ld_src, const float* scale, bf16_t* dst, int N, int K, int n0, int k0, LAS float* t) {
  const int tid = tidx();
#pragma unroll
  for (int j = 0; j < 8; ++j) {
    const int i = tid + j * 512, k = i >> 5, n = (i & 31) * 4;
    const int col = MODE == 1 ? win_logical_col(n0 + n) : (n0 + n);
    f32x4 v = {0.f, 0.f, 0.f, 0.f};
    if (n0 + n < N && k0 + k < K && col >= 0) { v = *(const f32x4*)(src + (size_t)(k0 + k) * ld_src + col); if (scale) v = v * scale[k0 + k]; }
    t[k * 129 + n] = v[0]; t[k * 129 + n + 1] = v[1]; t[k * 129 + n + 2] = v[2]; t[k * 129 + n + 3] = v[3];
  }
  __syncthreads();
#pragma unroll
  for (int j = 0; j < 4; ++j) {
    const int i = tid + j * 512, n = i >> 4, k = (i & 15) * 8;
    if (n0 + n < N && k0 + k < K) {
      u32x4 pk;
      pk.x = cvt_pk_bf16(t[k * 129 + n], t[(k + 1) * 129 + n]); pk.y = cvt_pk_bf16(t[(k + 2) * 129 + n], t[(k + 3) * 129 + n]);
      pk.z = cvt_pk_bf16(t[(k + 4) * 129 + n], t[(k + 5) * 129 + n]); pk.w = cvt_pk_bf16(t[(k + 6) * 129 + n], t[(k + 7) * 129 + n]);
      *(u32x4*)(dst + (size_t)(n0 + n) * K + k0 + k) = pk;
    }
  }
  __syncthreads();
}

#ifdef PROBE_P0CUT
#define P0_MARK() do { if (threadIdx.x == 0) { const unsigned dt_ = (unsigned)(__builtin_amdgcn_s_memrealtime() - p0_t0); atomicMax(a.bar + 64, dt_); } } while (0)
#endif
__device__ __forceinline__ void phase0(const MegaArgs& a, LAS unsigned char* lds) {
#ifdef PROBE_P0CUT
  const unsigned long long p0_t0 = __builtin_amdgcn_s_memrealtime();
#endif
  const int G = gridDim.x, wg = blockIdx.x, tid = tidx();
  LAS float* t = (LAS float*)lds;
  for (int it = wg; it < 2 * 306; it += G) {
    const int l = it / 306; int r = it % 306;
    if (r < 200) { transpose_tile<1>(a.w_in + (size_t)l * 1024 * D_IN, D_IN, a.w_norm + l * 1024, a.WinT + (size_t)l * 3104 * 1024, 3104, 1024, (r % 25) * 128, (r / 25) * 128, t); continue; }
    r -= 200;
    if (r < 64) { transpose_tile<0>(a.w_out + (size_t)l * 1024 * 1024, 1024, nullptr, a.WoutT + (size_t)l * 1024 * 1024, 1024, 1024, (r & 7) * 128, (r >> 3) * 128, t); continue; }
    r -= 64;
    if (r < 4) { transpose_tile<0>(a.w_pw + (size_t)l * 65536, 256, nullptr, a.WpwT + (size_t)l * 65536, 256, 256, (r & 1) * 128, (r >> 1) * 128, t); continue; }
    r -= 4;
    if (r < 4) { transpose_tile<0>(a.w_pool + (size_t)(l * 4 + r) * 4096, 64, nullptr, a.WpoolT + (size_t)(l * 4 + r) * 4096, 64, 64, 0, 0, t); continue; }
    r -= 4;
    if (r < 32) { const int kv = r >> 4, half = (r >> 3) & 1, kt = r & 7;
      transpose_tile<0>(a.cmp_w1 + ((size_t)(l * 2 + kv) * 2048 + half * 1024) * 64, 64, nullptr, a.W1T + ((size_t)(l * 2 + kv) * 128 + half * 64) * 1024, 64, 1024, 0, kt * 128, t); continue; }
    r -= 32;
    transpose_tile<0>(a.cmp_w2 + (size_t)(l * 2 + r) * 4096, 64, nullptr, a.W2T + (size_t)(l * 2 + r) * 4096, 64, 64, 0, 0, t);
  }
#if defined(PROBE_P0CUT) && PROBE_P0CUT == 1
  P0_MARK();
#endif
  for (int lk = G - 1 - wg; lk >= 0 && lk < 4; lk += G) {
    const int e = tid & 63, part = tid >> 6;
    const float* pp = a.cmp_pe + (size_t)lk * 2048 + part * 256; const float* ww = a.cmp_w1 + ((size_t)lk * 2048 + part * 256) * 64 + e;
    float acc = 0.f;
    for (int k = 0; k < 256; ++k) acc = fmaf(pp[k], ww[(size_t)k * 64], acc);
    t[part * 64 + e] = acc;
    __syncthreads();
    if (tid < 64) { float s = 0.f; for (int p2 = 0; p2 < 8; ++p2) s += t[p2 * 64 + tid]; a.cbias[lk * 64 + tid] = s; }
    __syncthreads();
  }
  for (int i = wg * 512 + tid; i < 2049 * 8; i += G * 512) {
    const int pos = i >> 3, j = i & 7;
    const double ang = (double)pos * pow(500000.0, -(double)j / 8.0);
    a.cs[i * 2] = (float)cos(ang); a.cs[i * 2 + 1] = (float)sin(ang);
  }
#if defined(PROBE_P0CUT) && PROBE_P0CUT == 2
  P0_MARK();
#endif
  for (int r0 = (wg * 8 + (tid >> 6)) * 4; r0 < NTOK; r0 += G * 32) {
    const int lane = tid & 63;
    f32x4 v[4][4];
#pragma unroll
    for (int rr = 0; rr < 4; ++rr) {
      const int row = r0 + rr;
      const float* x = row < NPT ? a.x_prompt + (size_t)row * 1024 : a.x_sample + (size_t)(row - NPT) * 1024;
#pragma unroll
      for (int j = 0; j < 4; ++j) v[rr][j] = *(const f32x4*)(x + j * 256 + lane * 4);
    }
#pragma unroll
    for (int rr = 0; rr < 4; ++rr) {
      const int row = r0 + rr;
#pragma unroll
      for (int j = 0; j < 4; ++j) {
        const f32x4 vv = v[rr][j];
        u32x2 pk; pk.x = cvt_pk_bf16(vv[0], vv[1]); pk.y = cvt_pk_bf16(vv[2], vv[3]);
        *(u32x2*)(a.xb + (size_t)row * 1024 + j * 256 + lane * 4) = pk;
        float ss = vv[0] * vv[0] + vv[1] * vv[1] + vv[2] * vv[2] + vv[3] * vv[3];
        ss += __shfl_xor(ss, 1); ss += __shfl_xor(ss, 2);
        if (row >= NPT && (lane & 3) == 0) a.ssqs[(size_t)(row - NPT) * 64 + j * 16 + (lane >> 2)] = ss;
        ss += __shfl_xor(ss, 4); ss += __shfl_xor(ss, 8);
        if (row < NPT && (lane & 15) == 0) a.ssq[(size_t)row * 16 + j * 4 + (lane >> 4)] = ss;
      }
    }
  }
}

#ifdef PROBE_TS
#ifndef PROBE_TS_LO
#define PROBE_TS_LO 0
#define PROBE_TS_HI 100000
#endif
#define TS_MARK(i) do { if (threadIdx.x == 0 && (int)blockIdx.x >= PROBE_TS_LO && (int)blockIdx.x < PROBE_TS_HI) { const unsigned long long now_ = __builtin_amdgcn_s_memrealtime(); if ((i) == PROBE_TS_SEL) ts_begin = now_; \
    if ((i) == PROBE_TS_SEL + 1) { const unsigned dt_ = (unsigned)(now_ - ts_begin); if (PROBE_TS_MIN) atomicMin(ts_word, dt_); else atomicMax(ts_word, dt_); } } } while (0)
#else
#define TS_MARK(i)
#endif
__global__ void __launch_bounds__(512, 2) k_mega(MegaArgsK ka) {
  const MegaArgs a = expand_args(ka);
#ifdef PROBE_TS
  unsigned long long ts_begin = 0ull; unsigned* ts_word = a.bar + 64;
  if (PROBE_TS_MIN && blockIdx.x == 0 && threadIdx.x == 0) atomicExch(ts_word, 0x7fffffffu);
#endif
  extern __shared__ __attribute__((aligned(16))) unsigned char shm[];
  LAS unsigned char* lds = (LAS unsigned char*)shm;
  volatile LAS unsigned* xbw = (volatile LAS unsigned*)(lds + LDS_BYTES - 16);
  if (tidx() == 0) { xbw[0] = 0u; xbw[1] = 0u; xbw[2] = 0u; xbw[3] = 0u; }
  __syncthreads();
  (void)xcd_barrier_post(a.bar, xbw);
#define GRID_BARRIER() do { XcdBarrier b_; b_.bar = (unsigned*)(ka.ws + WS_BAR); b_.x = xb_xcc_id(); b_.st = xbw; xcd_barrier(b_); } while (0)
  const int G = gridDim.x, wg = blockIdx.x;

  TS_MARK(0);
  { const MegaArgs a0 = expand_args(ka); REP(0) phase0(a0, lds); }
  TS_MARK(1);
  GRID_BARRIER();

#define MAKE_SA()                                                                                                                                   \
    SampArgs sa;                                                                                                                                  \
    sa.l = l; sa.pad_ = 0; sa.sproj = a.sproj; sa.g_q = a.g_q + l * 64; sa.g_k = a.g_k + l * 192; sa.cs = a.cs;                                   \
    sa.state_conv_l = a.state_conv + (size_t)l * NSM * 30 * 256; sa.state_pool_l = a.state_pool + (size_t)l * NSM * 15 * 256;                     \
    sa.w_dw = a.w_dw + l * 31 * 256; sa.b_dw = a.b_dw + l * 256; sa.ln_g = a.ln_g + l * 256; sa.ln_b = a.ln_b + l * 256; sa.w_pw = a.w_pw + (size_t)l * 65536; sa.b_pw = a.b_pw + l * 256; \
    sa.w_pool = a.w_pool + (size_t)l * 4 * 4096; sa.pool_scale = a.pool_scale + l * 256;                                                          \
    sa.cache_slc_l = a.cache_slc + (size_t)l * N_PHYS * 128 * 256; sa.cache_win_l = a.cache_win + (size_t)l * NSM * 65536; sa.page_table = a.page_table; \
    sa.kcS = a.kcS; sa.vcST = a.vcST; sa.sq = a.sq; sa.srows = a.srows; sa.sgates = a.sgates; sa.mix_s = a.mixb + (size_t)NPT * 1024; sa.out = a.out;
#ifdef PROBE_REP
#define BA_PROBE() { const int rb[4] = {PROBE_REPB}; for (int i = 0; i < 4; ++i) ba.repb[i] = rb[i]; }
#else
#define BA_PROBE()
#endif
#define MAKE_BA()                                                                                                                                   \
      PhaseBArgs ba;                                                                                                                              \
      ba.glu = a.glub; ba.bin = a.binb; ba.sza = a.sza; ba.szb = a.szb; ba.xb = a.xb; ba.ssq = a.ssq;                                              \
      ba.WpwT = a.WpwT + (size_t)l * 65536; ba.WpoolT = a.WpoolT + (size_t)l * 4 * 4096; ba.WgT = a.WinT + ((size_t)l * 3104 + 3072) * 1024;       \
      ba.W1T = a.W1T + (size_t)l * 2 * 128 * 1024; ba.W2T = a.W2T + (size_t)l * 2 * 4096; ba.cbias = a.cbias + l * 128;                           \
      ba.w_dw = a.w_dw + l * 31 * 256; ba.b_dw = a.b_dw + l * 256; ba.ln_g = a.ln_g + l * 256; ba.ln_b = a.ln_b + l * 256; ba.b_pw = a.b_pw + l * 256; ba.pool_scale = a.pool_scale + l * 256; \
      ba.cmp_rows_p = a.out + O_CMPP + (size_t)l * NPT * 256;                                                                                     \
      ba.mixb = a.mixb; ba.kcP = a.kcP; ba.vcPT = a.vcPT; ba.gates = a.gatesf;                                                                    \
      BA_PROBE()
#pragma unroll 1
  for (int l = 0; l < 2; ++l) {
    TS_MARK(2 + 10 * l);
    REPX(0) {
    const MegaArgs a = expand_args(ka);
    const bf16_t* WinT_l = a.WinT + (size_t)l * 3104 * 1024;
    const bool cmps_first = (wg >> 3) & 1;
#define RUN_CMPS() do { REP(7) for (int it = wg; it < 512; it += G) {                                                                               \
      const int n = it >> 2, g = (it >> 1) & 1, kv = it & 1;                                                                                      \
      CmpSrc src{a.cache_cmp + (size_t)l * N_PHYS * 128 * 256, a.page_table + n * 16};                                                            \
      compress_item<true>(lds, src, g, kv, a.W1T + ((size_t)l * 2 + kv) * 128 * 1024, a.W2T + ((size_t)l * 2 + kv) * 4096, a.cbias + l * 128 + kv * 64, \
                    a.kcS + ((size_t)n * 2 + g) * 128 * 64, a.vcST + ((size_t)n * 2 + g) * 64 * 128); } } while (0)
    if (cmps_first) RUN_CMPS();
    {
      PhaseAArgs aa;
      aa.epi.l = l; aa.epi.pad_ = 0; aa.epi.ssq = a.ssq; aa.epi.g_q = a.g_q + l * 64; aa.epi.g_k = a.g_k + l * 192; aa.epi.cs = a.cs;
      aa.epi.glu = a.glub; aa.epi.bin = a.binb; aa.epi.sza = a.sza; aa.epi.szb = a.szb; aa.epi.szc = a.szc; aa.epi.qb = a.qb;
      aa.epi.ks = a.ksb; aa.epi.vsT = a.vsT; aa.epi.kw = a.kwb; aa.epi.vwT = a.vwT; aa.epi.out = a.out;
      aa.xb = a.xb; aa.WinT = WinT_l;
      REP(1) phaseA(lds, aa);
    }
    TS_MARK(3 + 10 * l);
    for (int u = wg; u < 194; u += G) s1_unit(lds, a.xb + (size_t)NPT * 1024, a.ssqs, WinT_l, a.sproj, u);
    if (!cmps_first) RUN_CMPS();
#undef RUN_CMPS
    }
    TS_MARK(4 + 10 * l);
    GRID_BARRIER();
    TS_MARK(5 + 10 * l);
    REPX(1) {
    const MegaArgs a = expand_args(ka);
    MAKE_SA()
    {
      MAKE_BA()
      REP(3) phaseB(lds, ba);
    }
    if (G == 256) {
      const int b = wg >= 160 ? wg - 160 : (wg >= 32 && wg < 64 ? 96 + wg - 32 : -1);
      if (b >= 0) { REP(2) s2_item(sa, lds, b); }
    } else {
      for (int b = wg; b < NSM; b += G) s2_item(sa, lds, b);
    }
    }
    TS_MARK(6 + 10 * l);
    GRID_BARRIER();
    TS_MARK(7 + 10 * l);
    REPX(2) {
    const MegaArgs a = expand_args(ka);
    {
      PhaseCArgs ca{a.qb, a.ksb, a.vsT, a.kwb, a.vwT, a.kcP, a.vcPT, a.szc, a.gatesf, a.mixb, a.g_k + l * 192};
#ifdef PROBE_CHECK
      ca.seldump = (unsigned*)(ka.ws + WS_END);
#endif
      REP(4) phaseC(lds, ca);
    }
    TS_MARK(8 + 10 * l);
    MAKE_SA()
    REP(5) for (int it = wg; it < 256; it += G) s3_item(sa, lds, it >> 1, it & 1);
    }
    TS_MARK(9 + 10 * l);
    GRID_BARRIER();
    TS_MARK(10 + 10 * l);
    REPX(3) {
    const MegaArgs a = expand_args(ka);
    const float* xp = l == 0 ? a.x_prompt : a.x1p;
    const float* xs = l == 0 ? a.x_sample : a.x1s;
    float* xp_out = l == 0 ? a.x1p : a.out + O_YP;
    float* xs_out = l == 0 ? a.x1s : a.out + O_YS;
    {
      PhaseDArgs da{a.mixb, a.WoutT + (size_t)l * 1024 * 1024, xp, xp_out, a.xb, a.ssq};
      REP(6) { if (l == 0) phaseD<false>(lds, da); else phaseD<true>(lds, da); }
    }
    if (G > 64 && wg >= 64) wins_copy(a.cache_win + (size_t)l * NSM * 65536, a.out + O_WINS + (size_t)l * NSM * 65536, wg - 64, G - 64);
    else if (G <= 64) wins_copy(a.cache_win + (size_t)l * NSM * 65536, a.out + O_WINS + (size_t)l * NSM * 65536, wg, G);
    if (l == 0) { for (int u = wg; u < 64; u += G) s4_unit<false>(lds, a.mixb + (size_t)NPT * 1024, a.WoutT + (size_t)l * 1024 * 1024, xs, xs_out, a.xb + (size_t)NPT * 1024, a.ssqs, u); }
    else { for (int u = wg; u < 64; u += G) s4_unit<true>(lds, a.mixb + (size_t)NPT * 1024, a.WoutT + (size_t)l * 1024 * 1024, xs, xs_out, a.xb + (size_t)NPT * 1024, a.ssqs, u); }
    }
    TS_MARK(11 + 10 * l);
    if (l == 0) GRID_BARRIER();
  }
#undef MAKE_SA
#undef MAKE_BA
#ifdef PROBE_TS
  GRID_BARRIER();
  if (blockIdx.x == 0 && threadIdx.x == 0) {
    const unsigned v = __hip_atomic_load(ts_word, __ATOMIC_RELAXED, __HIP_MEMORY_SCOPE_AGENT);
    const unsigned long long t0 = __builtin_amdgcn_s_memrealtime();
    while (__builtin_amdgcn_s_memrealtime() - t0 < (unsigned long long)v * PROBE_TS_K) __builtin_amdgcn_s_sleep(8);
  }
#endif
}

#ifdef PROBE_CHECK
__device__ __forceinline__ float ck_wsum(float v) { for (int o = 32; o > 0; o >>= 1) v += __shfl_xor(v, o); return v; }
__device__ __forceinline__ float ck_wmax(float v) { for (int o = 32; o > 0; o >>= 1) v = fmaxf(v, __shfl_xor(v, o)); return v; }
__global__ void __launch_bounds__(256) k_check_attn(unsigned char* ws, float* acc  ) {
  const bf16_t* qb = (const bf16_t*)(ws + WS_QB); const bf16_t* ksb = (const bf16_t*)(ws + WS_KSB); const bf16_t* vsT = (const bf16_t*)(ws + WS_VST);
  const bf16_t* kwb = (const bf16_t*)(ws + WS_KWB); const bf16_t* vwT = (const bf16_t*)(ws + WS_VWT); const bf16_t* kcP = (const bf16_t*)(ws + WS_KCP);
  const bf16_t* vcPT = (const bf16_t*)(ws + WS_VCPT); const bf16_t* szc = (const bf16_t*)(ws + WS_SZC); const float* gates = (const float*)(ws + WS_GATES);
  const bf16_t* mixb = (const bf16_t*)(ws + WS_MIXB); const unsigned* seldump = (const unsigned*)(ws + WS_END);
  __shared__ float qs[4][64]; __shared__ float pc[4][128]; __shared__ float ps[4][512]; __shared__ float imp[32]; __shared__ unsigned selm; __shared__ int blks[8]; __shared__ int cnt_s;
  const int tid = threadIdx.x, r = tid >> 6, lane = tid & 63;
  const int tok = blockIdx.x * 37 % NPT;
  if (blockIdx.x >= 4096) return;
  const int g = blockIdx.y, n = tok / SEQ, pos = tok % SEQ, h = g * 4 + r;
  const size_t bg = (size_t)n * 2 + g;
  qs[r][lane] = bf2f(qb[((size_t)tok * 8 + h) * 64 + lane]);
  __syncthreads();
  float o_c = 0.f, o_s = 0.f, o_w = 0.f;
  {
    float s[2]; bool valid[2];
#pragma unroll
    for (int j = 0; j < 2; ++j) { const int c = lane + 64 * j; valid[j] = (c < 127) && (16 * c + 31 <= pos); float d = 0.f;
      if (valid[j]) for (int i = 0; i < 64; ++i) d = fmaf(qs[r][i], bf2f(kcP[(bg * 128 + c) * 64 + i]), d);
      s[j] = valid[j] ? d : NEGF; }
    const float m = ck_wmax(fmaxf(s[0], s[1]));
    const float p0 = valid[0] ? exp2f(s[0] - m) : 0.f, p1 = valid[1] ? exp2f(s[1] - m) : 0.f;
    const float sum = fmaxf(ck_wsum(p0 + p1), 1e-30f);
    pc[r][lane] = p0 / sum; pc[r][lane + 64] = p1 / sum;
    __syncthreads();
    for (int c = 0; c < 127; ++c) o_c = fmaf(pc[r][c], bf2f(vcPT[(bg * 64 + lane) * 128 + c]), o_c);
  }
  const int cur = pos >> 6;
  if (tid < 32) { const int s = tid, lo = max(0, 4 * s - 1), hi = min(126, 4 * s + 3); float v = 0.f;
    for (int rr = 0; rr < 4; ++rr) for (int c = lo; c <= hi; ++c) v += pc[rr][c];
    const bool forced = (s == 0) || (s == cur) || (s == cur - 1);
    imp[s] = (s <= cur) ? (forced ? 1e4f : v) : -1e4f; }
  __syncthreads();
  if (tid == 0) { unsigned taken = 0u, mine = 0u;
    for (int k = 0; k < 8; ++k) { int best = -1; float bv = -3e38f; for (int s = 0; s < 32; ++s) if (!((taken >> s) & 1u) && imp[s] > bv) { bv = imp[s]; best = s; } taken |= 1u << best; if (best <= cur) mine |= 1u << best; }
    const unsigned theirs = seldump[(size_t)tok * 2 + g];
    if (mine != theirs) atomicAdd(acc + 2, 1.f);
    atomicAdd(acc + 3, 1.f);
    selm = theirs; int cnt = 0; for (int j = 0; j < 32; ++j) if ((theirs >> j) & 1u) { if (cnt < 8) blks[cnt] = j; ++cnt; } for (int k = cnt; k < 8; ++k) blks[k] = 0; cnt_s = cnt < 8 ? cnt : 8; }
  __syncthreads();
  {
    float m = NEGF; const int cnt = cnt_s;
    float s8[8]; bool v8[8];
#pragma unroll
    for (int k = 0; k < 8; ++k) { v8[k] = false; s8[k] = NEGF; if (k < cnt) { const int kpos = blks[k] * 64 + lane; v8[k] = kpos <= pos; float d = 0.f;
        if (v8[k]) for (int i = 0; i < 64; ++i) d = fmaf(qs[r][i], bf2f(ksb[(bg * SEQ + kpos) * 64 + i]), d);
        s8[k] = v8[k] ? d : NEGF; } m = fmaxf(m, s8[k]); }
    m = ck_wmax(m); float sum = 0.f;
#pragma unroll
    for (int k = 0; k < 8; ++k) { s8[k] = v8[k] ? exp2f(s8[k] - m) : 0.f; sum += s8[k]; }
    sum = fmaxf(ck_wsum(sum), 1e-30f);
#pragma unroll
    for (int k = 0; k < 8; ++k) ps[r][k * 64 + lane] = s8[k] / sum;
    __syncthreads();
    for (int k = 0; k < cnt && k < 8; ++k) for (int j = 0; j < 64; ++j) { const float p = ps[r][k * 64 + j]; if (p != 0.f) o_s = fmaf(p, bf2f(vsT[(bg * 64 + lane) * SEQ + blks[k] * 64 + j]), o_s); }
    __syncthreads();
  }
  {
    float s4[4]; bool v4[4]; float m = NEGF;
#pragma unroll
    for (int k = 0; k < 4; ++k) { const int kpos = pos - 255 + lane + 64 * k; v4[k] = kpos >= 0; float d = 0.f;
      if (v4[k]) for (int i = 0; i < 64; ++i) d = fmaf(qs[r][i], bf2f(kwb[(bg * SEQ + kpos) * 64 + i]), d);
      s4[k] = v4[k] ? d : NEGF; m = fmaxf(m, s4[k]); }
    m = ck_wmax(m); float sum = 0.f;
#pragma unroll
    for (int k = 0; k < 4; ++k) { s4[k] = v4[k] ? exp2f(s4[k] - m) : 0.f; sum += s4[k]; }
    sum = fmaxf(ck_wsum(sum), 1e-30f);
#pragma unroll
    for (int k = 0; k < 4; ++k) ps[r][k * 64 + lane] = s4[k] / sum;
    __syncthreads();
    for (int j = 0; j < 256; ++j) { const float p = ps[r][j]; if (p != 0.f) o_w = fmaf(p, bf2f(vwT[(bg * 64 + lane) * SEQ + pos - 255 + j]), o_w); }
  }
  const float* gt = gates + (size_t)tok * 24;
  const float ref = (gt[h] * o_c + gt[8 + h] * o_s + gt[16 + h] * o_w) * bf2f(szc[(size_t)tok * 512 + h * 64 + lane]);
  const float got = bf2f(mixb[(size_t)tok * 1024 + 512 + h * 64 + lane]);
  const float d2 = ck_wsum((got - ref) * (got - ref)), r2 = ck_wsum(ref * ref);
  if (lane == 0) { atomicAdd(acc + 0, d2); atomicAdd(acc + 1, r2); }
}
__global__ void k_check_spin(const float* acc) {
  const float ratio = PROBE_CHECK == 1 ? acc[0] / fmaxf(acc[1], 1e-30f) : acc[2] / fmaxf(acc[3], 1.f);
  const float us = fminf(ratio * (PROBE_CHECK == 1 ? 1e7f : 1e4f), 20000.f);
  const unsigned long long t0 = __builtin_amdgcn_s_memrealtime();
  while (__builtin_amdgcn_s_memrealtime() - t0 < (unsigned long long)(us * 100.f)) __builtin_amdgcn_s_sleep(8);
}
#endif
}
extern "C" void kernel_launch(void* const* d_in, const int* in_sizes, int n_in, void* d_out, int out_size, void* d_ws, size_t ws_size, hipStream_t stream) {
  using fast::bf16_t;
  static int grid = 0;
  if (grid == 0) {
    int dev = 0, cus = 0, per_cu = 0;
    (void)hipGetDevice(&dev);
    (void)hipDeviceGetAttribute(&cus, hipDeviceAttributeMultiprocessorCount, dev);
    (void)hipFuncSetAttribute((const void*)fast::k_mega, hipFuncAttributeMaxDynamicSharedMemorySize, fast::LDS_BYTES);
    if (hipOccupancyMaxActiveBlocksPerMultiprocessor(&per_cu, (const void*)fast::k_mega, 512, fast::LDS_BYTES) != hipSuccess || per_cu < 1) per_cu = 1;
    (void)hipGetLastError();
    grid = cus > 0 ? cus : 256;
  }
  fast::MegaArgsK a{};
  a.x_prompt = (const float*)d_in[0]; a.x_sample = (const float*)d_in[1]; a.state_conv = (const float*)d_in[2]; a.state_pool = (const float*)d_in[3];
  a.cache_win = (const float*)d_in[4]; a.cache_cmp = (const float*)d_in[5]; a.cache_slc = (const float*)d_in[6]; a.page_table = (const int*)d_in[7];
  a.w_norm = (const float*)d_in[8]; a.w_in = (const float*)d_in[9]; a.w_out = (const float*)d_in[10]; a.w_dw = (const float*)d_in[11]; a.b_dw = (const float*)d_in[12];
  a.ln_g = (const float*)d_in[13]; a.ln_b = (const float*)d_in[14]; a.w_pw = (const float*)d_in[15]; a.b_pw = (const float*)d_in[16]; a.w_pool = (const float*)d_in[17];
  a.pool_scale = (const float*)d_in[18]; a.g_q = (const float*)d_in[19]; a.g_k = (const float*)d_in[20]; a.cmp_pe = (const float*)d_in[21]; a.cmp_w1 = (const float*)d_in[22]; a.cmp_w2 = (const float*)d_in[23];
  a.out = (float*)d_out;
  a.ws = (unsigned char*)d_ws;
#ifdef PROBE_REP
  { const int rr[8] = {PROBE_REP}; for (int i = 0; i < 8; ++i) a.rep[i] = rr[i]; }
#endif
  (void)hipMemsetAsync((unsigned char*)d_ws + fast::WS_BAR, 0, XCD_BAR_WORDS * 4, stream);
  hipLaunchKernelGGL(fast::k_mega, dim3(grid), dim3(512), fast::LDS_BYTES, stream, a);
#ifdef PROBE_CHECK
  {
    float* acc = (float*)((unsigned char*)d_ws + fast::WS_END + (size_t)NPT * 2 * 4 + 256);
    (void)hipMemsetAsync(acc, 0, 64, stream);
    hipLaunchKernelGGL(fast::k_check_attn, dim3(4096, 2), dim3(256), 0, stream, (unsigned char*)d_ws, acc);
    if (PROBE_CHECK != 3) hipLaunchKernelGGL(fast::k_check_spin, dim3(1), dim3(1), 0, stream, (const float*)acc);
  }
#endif
}
```
